# Optimizing an MI355X kernel written in HIP

```python
import math
import jax, jax.numpy as jnp
from jax import lax
import numpy as np

D_MODEL = 2048
BATCH = 8
SEQ = 2048
DEPTH = 1

A_HEADS = 16
A_HEAD_DIM = 64
A_KV_GROUPS = 4
A_REP = A_HEADS // A_KV_GROUPS
A_WIDTH = A_HEADS * A_HEAD_DIM
A_KV_WIDTH = A_KV_GROUPS * A_HEAD_DIM
CMP_BLOCK = 32
CMP_STRIDE = 16
CMP_HIDDEN = 4 * A_HEAD_DIM
SEL_BLOCK = 64
SEL_TOPK = 16
SEL_QCHUNK = 32
WIN_SIZE = 512
FORCE_BONUS = 1.0e4
B_HEADS = 8
B_HEAD_DIM = 128
B_WIDTH = B_HEADS * B_HEAD_DIM
DILATION_PATTERNS = ((128, 1), (512, 4), (2048, 16))
BAND_BLOCK = 128
ROPE_THETA = 500000.0
ROPE_FRACTION = 4
EPS = 1e-6
NEG = -1e30
IN_SIZES = (A_WIDTH,) + (A_KV_WIDTH,) * 6 + (A_HEADS * 3, A_WIDTH) + (B_WIDTH,) * 4 + (D_MODEL, D_MODEL)
N_IN = sum(IN_SIZES)
IN_SPLITS = [int(s) for s in np.cumsum(IN_SIZES)[:-1]]

kernel_name = 'hybrid_nsa_dilated_gated_block'

F32 = jnp.float32


def rms_norm(x, g):
    xf = x.astype(F32)
    y = xf * lax.rsqrt(jnp.mean(xf * xf, axis=-1, keepdims=True) + EPS)
    return (y * g.astype(F32)).astype(x.dtype)


def partial_rope(x, pos):
    dh = x.shape[-1]
    rot = dh // ROPE_FRACTION
    half = rot // 2
    inv = (ROPE_THETA ** (-np.arange(0, rot, 2) / rot)).astype(np.float32)
    ang = pos.astype(F32)[..., None] * inv
    ang = ang.reshape(ang.shape[:2] + (1,) * (x.ndim - 3) + (half,))
    cos, sin = jnp.cos(ang), jnp.sin(ang)
    x1 = x[..., :half].astype(F32)
    x2 = x[..., half:rot].astype(F32)
    out = jnp.concatenate([x1 * cos - x2 * sin, x2 * cos + x1 * sin, x[..., rot:].astype(F32)], axis=-1)
    return out.astype(x.dtype)


def banded_attention(q, k, v, max_dist):
    N, L, G, R, dh = q.shape
    bs = math.gcd(L, BAND_BLOCK)
    nb = L // bs
    span = max_dist + bs
    kp = jnp.pad(k, ((0, 0), (max_dist, 0), (0, 0), (0, 0)))
    vp = jnp.pad(v, ((0, 0), (max_dist, 0), (0, 0), (0, 0)))
    idx = np.arange(nb)[:, None] * bs + np.arange(span)[None, :]
    kb = kp[:, idx]
    vb = vp[:, idx]
    qb = q.reshape(N, nb, bs, G, R, dh)
    s = jnp.einsum('nbqgrd,nbkgd->nbgrqk', qb, kb, preferred_element_type=F32) * (dh ** -0.5)
    qpos = np.arange(nb)[:, None] * bs + np.arange(bs)[None, :]
    kpos = idx - max_dist
    diff = qpos[:, :, None] - kpos[:, None, :]
    mask = (diff >= 0) & (diff <= max_dist) & (kpos[:, None, :] >= 0)
    s = jnp.where(mask[None, :, None, None], s, NEG)
    lse = jax.nn.logsumexp(s, axis=-1)
    p = jnp.exp(s - lse[..., None])
    o = jnp.einsum('nbgrqk,nbkgd->nbqgrd', p.astype(vb.dtype), vb, preferred_element_type=F32)
    o = o.reshape(N, L, G, R, dh)
    lse = lse.transpose(0, 1, 4, 2, 3).reshape(N, L, G, R)
    return o, lse


def dilated_mixture(q, k, v):
    B, S, H, dh = q.shape
    outs, lses = [], []
    for w, r in DILATION_PATTERNS:
        L = S // r
        def to_cls(t):
            return t.reshape(B, L, r, H, dh).transpose(0, 2, 1, 3, 4).reshape(B * r, L, H, dh)
        o, lse = banded_attention(to_cls(q)[:, :, :, None], to_cls(k), to_cls(v), w // r)
        outs.append(o.reshape(B, r, L, H, dh).transpose(0, 2, 1, 3, 4).reshape(B, S, H, dh))
        lses.append(lse.reshape(B, r, L, H).transpose(0, 2, 1, 3).reshape(B, S, H))
    wts = jax.nn.softmax(jnp.stack(lses, axis=0), axis=0)
    return jnp.sum(wts[..., None] * jnp.stack(outs, axis=0), axis=0)


def nsa_attention(q, k_cmp, v_cmp, k_sel, v_sel, k_win, v_win, gate_logits, pos,
                  pe_ck, pe_cv, w_ck1, w_ck2, w_cv1, w_cv2):
    B, S, G, R, dh = q.shape
    scale = dh ** -0.5
    tq = np.arange(S)
    n_c = (S - CMP_BLOCK) // CMP_STRIDE + 1
    cidx = np.arange(n_c)[:, None] * CMP_STRIDE + np.arange(CMP_BLOCK)[None, :]
    cmp_end = cidx[:, -1]
    def compress(t, pe, w1, w2):
        blk = t[:, cidx] + pe[None, None, :, None, :]
        blk = blk.transpose(0, 1, 3, 2, 4).reshape(B, n_c, G, CMP_BLOCK * dh)
        return jax.nn.gelu(blk @ w1) @ w2
    kc = partial_rope(compress(k_cmp, pe_ck, w_ck1, w_ck2), pos[:, cmp_end])
    vc = compress(v_cmp, pe_cv, w_cv1, w_cv2)
    cmask = (cmp_end[None, :] <= tq[:, None])[None, :, None, None, :]
    s = jnp.einsum('bsgrd,bcgd->bsgrc', q, kc, preferred_element_type=F32) * scale
    s = jnp.where(cmask, s, NEG)
    e = jnp.exp(s - jnp.max(s, axis=-1, keepdims=True)) * cmask
    p_cmp = e / jnp.maximum(jnp.sum(e, axis=-1, keepdims=True), 1.0)
    o_cmp = jnp.einsum('bsgrc,bcgd->bsgrd', p_cmp.astype(vc.dtype), vc, preferred_element_type=F32)
    n_s = S // SEL_BLOCK
    cs = cidx[:, 0]
    ss = np.arange(n_s) * SEL_BLOCK
    overlap = np.clip(np.minimum(cs[:, None] + CMP_BLOCK, ss[None, :] + SEL_BLOCK)
                      - np.maximum(cs[:, None], ss[None, :]), 0, None).astype(np.float32) / CMP_BLOCK
    imp = jnp.einsum('bsgc,cj->bsgj', jnp.sum(p_cmp, axis=3), overlap)
    jb = np.arange(n_s)[None, :]
    cur = (tq // SEL_BLOCK)[:, None]
    valid = ss[None, :] <= tq[:, None]
    forced = (valid & ((jb == 0) | (jb == cur) | (jb == cur - 1))).astype(np.float32)
    score = jnp.where(valid[None, :, None, :], imp + FORCE_BONUS * forced[None, :, None, :], NEG)
    n_sel = min(SEL_TOPK, n_s)
    _, sel_idx = lax.top_k(score, n_sel)
    K = n_sel * SEL_BLOCK
    Qc = SEL_QCHUNK
    nq = S // Qc
    ksT = k_sel.transpose(0, 2, 1, 3)
    vsT = v_sel.transpose(0, 2, 1, 3)
    gather = jax.vmap(jax.vmap(lambda a, i: jnp.take(a, i, axis=0)))
    def sel_chunk(args):
        qb, ib, tb = args
        tok = ib[..., None] * SEL_BLOCK + jnp.arange(SEL_BLOCK, dtype=jnp.int32)
        tok = tok.reshape(B, Qc, G, K).transpose(0, 2, 1, 3)
        flat = tok.reshape(B, G, Qc * K)
        kg = gather(ksT, flat).reshape(B, G, Qc, K, dh)
        vg = gather(vsT, flat).reshape(B, G, Qc, K, dh)
        sc = jnp.einsum('bqgrd,bgqkd->bgrqk', qb, kg, preferred_element_type=F32) * scale
        m = (tok <= tb[None, None, :, None])[:, :, None]
        pr = jax.nn.softmax(jnp.where(m, sc, NEG), axis=-1)
        return jnp.einsum('bgrqk,bgqkd->bqgrd', pr.astype(vg.dtype), vg, preferred_element_type=F32)
    qc = q.reshape(B, nq, Qc, G, R, dh).transpose(1, 0, 2, 3, 4, 5)
    ic = sel_idx.reshape(B, nq, Qc, G, n_sel).transpose(1, 0, 2, 3, 4)
    tc = jnp.asarray(tq.reshape(nq, Qc), dtype=jnp.int32)
    o_sel = lax.map(sel_chunk, (qc, ic, tc)).transpose(1, 0, 2, 3, 4, 5).reshape(B, S, G, R, dh)
    o_win, _ = banded_attention(q, k_win, v_win, WIN_SIZE - 1)
    g = jax.nn.sigmoid(gate_logits.astype(F32)).reshape(B, S, G, R, 3)
    o = g[..., 0:1] * o_cmp + g[..., 1:2] * o_sel + g[..., 2:3] * o_win
    return o.reshape(B, S, G * R * dh)


def hybrid_layer(x, c, pos, w_ada, b_ada, g_pre, g_post, w_in, pe_ck, pe_cv, w_ck1, w_ck2,
                 w_cv1, w_cv2, w_br_a, w_br_b, w_out):
    B, S, D = x.shape
    ada = c @ w_ada + b_ada
    shift, scale, gate = jnp.split(ada, 3, axis=-1)
    h = rms_norm(x, g_pre) * (1.0 + scale[:, None, :]) + shift[:, None, :]
    proj = h @ w_in
    (qa, kc, vc, ks, vs, kw, vw, ga, za, qb, kb, vb, zb, ma, mb) = jnp.split(proj, IN_SPLITS, axis=-1)
    kv = lambda t: t.reshape(B, S, A_KV_GROUPS, A_HEAD_DIM)
    qa = partial_rope(qa.reshape(B, S, A_KV_GROUPS, A_REP, A_HEAD_DIM), pos)
    oa = nsa_attention(qa, kv(kc), kv(vc), partial_rope(kv(ks), pos), kv(vs),
                       partial_rope(kv(kw), pos), kv(vw), ga, pos,
                       pe_ck, pe_cv, w_ck1, w_ck2, w_cv1, w_cv2)
    ya = (oa * jax.nn.silu(za.astype(F32))).astype(x.dtype) @ w_br_a
    hd = lambda t: t.reshape(B, S, B_HEADS, B_HEAD_DIM)
    ob = dilated_mixture(partial_rope(hd(qb), pos), partial_rope(hd(kb), pos), hd(vb))
    ob = ob.reshape(B, S, B_WIDTH)
    yb = (ob * jax.nn.silu(zb.astype(F32))).astype(x.dtype) @ w_br_b
    merged = jax.nn.sigmoid(ma) * ya + jax.nn.sigmoid(mb) * yb
    out = merged @ w_out
    return x + (gate[:, None, :] * rms_norm(out, g_post)).astype(x.dtype)


def setup_inputs(seed: int = 0) -> dict:
    key = jax.random.key(seed)
    ks = jax.random.split(key, 20)
    nrm = lambda k, shape, s: jax.random.normal(k, shape, dtype=F32) * s
    D = D_MODEL
    x = nrm(ks[0], (BATCH, SEQ, D), 1.0)
    c = nrm(ks[1], (BATCH, D), 1.0)
    positions = (jnp.arange(SEQ, dtype=jnp.int32)[None, :]
                 + jax.random.randint(ks[2], (BATCH, 1), 0, 4096, dtype=jnp.int32))
    return {
        'x': x,
        'c': c,
        'positions': positions,
        'w_ada': nrm(ks[3], (DEPTH, D, 3 * D), 0.5 * D ** -0.5),
        'b_ada': nrm(ks[4], (DEPTH, 3 * D), 0.01),
        'g_pre': 1.0 + nrm(ks[5], (DEPTH, D), 0.02),
        'g_post': 1.0 + nrm(ks[6], (DEPTH, D), 0.02),
        'w_in': nrm(ks[7], (DEPTH, D, N_IN), D ** -0.5),
        'pe_ck': nrm(ks[8], (DEPTH, CMP_BLOCK, A_HEAD_DIM), 0.02),
        'pe_cv': nrm(ks[9], (DEPTH, CMP_BLOCK, A_HEAD_DIM), 0.02),
        'w_ck1': nrm(ks[10], (DEPTH, CMP_BLOCK * A_HEAD_DIM, CMP_HIDDEN), (CMP_BLOCK * A_HEAD_DIM) ** -0.5),
        'w_ck2': nrm(ks[11], (DEPTH, CMP_HIDDEN, A_HEAD_DIM), CMP_HIDDEN ** -0.5),
        'w_cv1': nrm(ks[12], (DEPTH, CMP_BLOCK * A_HEAD_DIM, CMP_HIDDEN), (CMP_BLOCK * A_HEAD_DIM) ** -0.5),
        'w_cv2': nrm(ks[13], (DEPTH, CMP_HIDDEN, A_HEAD_DIM), CMP_HIDDEN ** -0.5),
        'w_br_a': nrm(ks[14], (DEPTH, A_WIDTH, D), A_WIDTH ** -0.5),
        'w_br_b': nrm(ks[15], (DEPTH, B_WIDTH, D), B_WIDTH ** -0.5),
        'w_out': nrm(ks[16], (DEPTH, D, D), D ** -0.5),
    }


def reference(x, c, positions, w_ada, b_ada, g_pre, g_post, w_in, pe_ck, pe_cv, w_ck1, w_ck2,
              w_cv1, w_cv2, w_br_a, w_br_b, w_out):
    h = x
    for layer in range(DEPTH):
        h = hybrid_layer(h, c, positions, w_ada[layer], b_ada[layer], g_pre[layer], g_post[layer],
                         w_in[layer], pe_ck[layer], pe_cv[layer], w_ck1[layer], w_ck2[layer],
                         w_cv1[layer], w_cv2[layer], w_br_a[layer], w_br_b[layer], w_out[layer])
    return h
```

```cpp
#define DBG 0
#define DBG_BATCH 5
#define DBG_SEL 0
#define ONE_LAUNCH 1
#define DBG_STOP 7
#include <hip/hip_runtime.h>
#include <hip/hip_cooperative_groups.h>
#include <cmath>
#include <cstdio>
#include <cstdint>

constexpr int NB = 8, SEQ = 2048, DM = 2048, MTOK = NB * SEQ;
constexpr int NIN = 11824, NINP = 12032;
constexpr float LOG2E = 1.4426950408889634f;
constexpr float QS64 = 0.125f * LOG2E, QS128 = 0.08838834764831845f * LOG2E;
constexpr size_t MiB = 1u << 20;
constexpr size_t WS_CTL = 0, CTL_ZERO_BYTES = 1 * MiB;
constexpr size_t WS_ADA = 1 * MiB;
constexpr size_t WS_R64 = 2 * MiB;
constexpr size_t WS_R128 = 3 * MiB;
constexpr size_t WS_BIAS1 = 5 * MiB;
constexpr size_t WS_SSQ = 6 * MiB;
constexpr size_t WS_KCC = 8 * MiB, WS_VCC = 8 * MiB + 512 * 1024;
constexpr size_t WS_W2T = 9 * MiB;
constexpr size_t WS_W1T = 10 * MiB;
constexpr size_t WS_GA = 12 * MiB;
constexpr size_t WS_WBRT = 16 * MiB, WS_WOUTT = 24 * MiB;
constexpr size_t WS_WINT = 32 * MiB;
constexpr size_t WS_XN = 80 * MiB;
constexpr size_t WS_QA = 144 * MiB;
constexpr size_t WS_KC = 176 * MiB;
constexpr size_t WS_ZA = 224 * MiB, WS_QB = 256 * MiB, WS_KB = 288 * MiB, WS_VB = 320 * MiB, WS_ZB = 352 * MiB;
constexpr size_t WS_MERGED = 256 * MiB;
constexpr size_t WS_END = 384 * MiB;
constexpr size_t WS_DBG = 384 * MiB;
constexpr size_t DO_MA = 0, DO_MB = 64 * MiB;

typedef unsigned short bf16_t;
#define LAS __attribute__((address_space(3)))
#define GAS __attribute__((address_space(1)))
typedef unsigned u32x4_t __attribute__((ext_vector_type(4)));
typedef unsigned u32x2_t __attribute__((ext_vector_type(2)));
typedef float f32x4_t __attribute__((ext_vector_type(4)));

__device__ __forceinline__ unsigned f2bf(float f) { unsigned u = __builtin_bit_cast(unsigned, f); return (u + 0x7fffu + ((u >> 16) & 1u)) >> 16; }
__device__ __forceinline__ unsigned pk2(float lo, float hi) { return f2bf(lo) | (f2bf(hi) << 16); }
__device__ __forceinline__ float bf2f(unsigned short h) { return __builtin_bit_cast(float, (unsigned)h << 16); }
__device__ __forceinline__ float bflo(unsigned w) { return __builtin_bit_cast(float, w << 16); }
__device__ __forceinline__ float bfhi(unsigned w) { return __builtin_bit_cast(float, w & 0xffff0000u); }
__device__ __forceinline__ float fast_sigmoid(float x) { return __builtin_amdgcn_rcpf(1.f + __builtin_amdgcn_exp2f(-x * LOG2E)); }
namespace pg8 {
#define PG8_LAS __attribute__((address_space(3)))
typedef unsigned short bf16_t;
typedef short bf16x8 __attribute__((ext_vector_type(8)));
typedef float f32x4 __attribute__((ext_vector_type(4)));
typedef unsigned u32x4 __attribute__((ext_vector_type(4)));
constexpr int BM = 256, BK = 64, HALF = 128, HTB = HALF * BK * 2  , STAGE_BYTES = 8 * HTB, NXCD = 8, WGM = 8;

__host__ __device__ __forceinline__ int lds_byte(int r, int c) { const int st = (r >> 4) * 2 + (c >> 5), rr = r & 15, cc = c & 31, ob = rr * 64 + cc * 2; return st * 1024 + (ob ^ (((ob >> 9) & 1) << 5)); }
__host__ __device__ __forceinline__ void stage_rc(int b, int& R, int& C) { const int st = b / 1024, sb = b % 1024, swz = sb ^ (((sb >> 9) & 1) << 5); R = (st >> 1) * 16 + swz / 64; C = (st & 1) * 32 + (swz % 64) / 2; }
__host__ __device__ __forceinline__ int perm32(int rho) { const int n = rho >> 4, i = rho & 15; return 8 * (i >> 2) + 4 * n + (i & 3); }

struct Unit { int pm, pn; };
struct Gemm { const bf16_t* A; const bf16_t* Bt; int M, N, K; };

struct StaticOrder {
    int nM, nN, nwg, G, c;
    __host__ __device__ void init(int M, int N, int G_, int c_) { nM = M / BM; nN = N / BM; nwg = nM * nN; G = G_; c = c_; }
    __host__ __device__ bool next(int i, Unit& u) const {
        const long L = (long)i * G + c; if (L >= nwg) return false;
        int wgid = (int)L; { const int q = nwg / NXCD, r = nwg % NXCD, xcd = wgid % NXCD, off = wgid / NXCD; wgid = (xcd < r ? xcd * (q + 1) : r * (q + 1) + (xcd - r) * q) + off; }
        const int nig = WGM * nN, gid = wgid / nig, fm = gid * WGM, gsz = (nM - fm) < WGM ? (nM - fm) : WGM;
        u.pm = fm + ((wgid % nig) % gsz); u.pn = (wgid % nig) / gsz; return true;
    }
    __device__ __forceinline__ void a_ready(const Unit&) const {}
    __device__ __forceinline__ void done(const Unit&) const {}
};

__device__ __forceinline__ unsigned cvt_pk_bf16(float lo, float hi) { unsigned r; asm volatile("v_cvt_pk_bf16_f32 %0, %1, %2" : "=v"(r) : "v"(lo), "v"(hi)); return r; }

struct EpiProj {
    static constexpr bool PERM = true, AFTER_DRAIN = false, MIDHOOK = false;
    unsigned char* ws; unsigned char* dout; const float* r64; const float* r128;
    __device__ __forceinline__ void mid(f32x4 (&)[2][2][4][2], const Unit&, int, int, int, int) const {}
    __device__ __forceinline__ void operator()(const f32x4 (&acc)[2][2][4][2], const Unit& u, int wr, int wc, int fr, int fq) const {
        const int pn = u.pn;
        bf16_t* base; int ldc, colt, mode; float sc = 1.f;
        if (pn < 4)       { base = (bf16_t*)(ws + WS_QA); ldc = 1024; colt = 256 * pn; mode = 1; sc = QS64; }
        else if (pn < 10) { base = (bf16_t*)(ws + WS_KC + (size_t)(pn - 4) * 8 * MiB); ldc = 256; colt = 0; mode = (pn == 6 || pn == 8) ? 1 : 0; }
        else if (pn < 14) { base = (bf16_t*)(ws + WS_ZA); ldc = 1024; colt = 256 * (pn - 10); mode = 3; }
        else if (pn < 18) { base = (bf16_t*)(ws + WS_QB); ldc = 1024; colt = 256 * (pn - 14); mode = 2; sc = QS128; }
        else if (pn < 22) { base = (bf16_t*)(ws + WS_KB); ldc = 1024; colt = 256 * (pn - 18); mode = 2; }
        else if (pn < 26) { base = (bf16_t*)(ws + WS_VB); ldc = 1024; colt = 256 * (pn - 22); mode = 0; }
        else if (pn < 30) { base = (bf16_t*)(ws + WS_ZB); ldc = 1024; colt = 256 * (pn - 26); mode = 3; }
        else if (pn < 38) { base = (bf16_t*)(dout + DO_MA); ldc = 2048; colt = 256 * (pn - 30); mode = 4; }
        else if (pn < 46) { base = (bf16_t*)(dout + DO_MB); ldc = 2048; colt = 256 * (pn - 38); mode = 4; }
        else              { base = (bf16_t*)(ws + WS_GA); ldc = 64; colt = 0; mode = 5; }
        const int row0 = u.pm * BM + wr * 64 + fr;
        const int cb = wc * 32 + 8 * fq;
        const bool rope_wave = (mode == 1 && (wc & 1) == 0) || (mode == 2 && wc == 0);
#pragma unroll
        for (int ai = 0; ai < 2; ++ai)
#pragma unroll
            for (int m = 0; m < 4; ++m) {
                const int row = row0 + ai * HALF + m * 16;
                float cs[8], sn[8];
                if (rope_wave) {
                    if (mode == 1) { const f32x4* t = (const f32x4*)(r64 + (size_t)row * 16); const f32x4 c0 = t[0], c1 = t[1], s0 = t[2], s1 = t[3];
#pragma unroll
                        for (int j = 0; j < 4; ++j) { cs[j] = c0[j]; cs[4 + j] = c1[j]; sn[j] = s0[j]; sn[4 + j] = s1[j]; } }
                    else { const f32x4* t = (const f32x4*)(r128 + (size_t)row * 32 + 8 * (fq & 1)); const f32x4 c0 = t[0], c1 = t[1], s0 = t[4], s1 = t[5];
#pragma unroll
                        for (int j = 0; j < 4; ++j) { cs[j] = c0[j]; cs[4 + j] = c1[j]; sn[j] = s0[j]; sn[4 + j] = s1[j]; } }
                }
#pragma unroll
                for (int bj = 0; bj < 2; ++bj) {
                    float v[8];
#pragma unroll
                    for (int j = 0; j < 4; ++j) { v[j] = acc[ai][bj][m][0][j]; v[4 + j] = acc[ai][bj][m][1][j]; }
                    if (rope_wave) {
                        const int xm = (mode == 1) ? 16 : 32;
                        const bool is_x1 = (mode == 1) ? (fq == 0) : (fq < 2);
                        const bool do_rot = (mode == 1) ? (fq < 2) : true;
#pragma unroll
                        for (int j = 0; j < 8; ++j) { const float p = __shfl_xor(v[j], xm); const float r = v[j] * cs[j] + (is_x1 ? -p : p) * sn[j]; v[j] = do_rot ? r : v[j]; }
                    }
                    if (mode == 3) {
#pragma unroll
                        for (int j = 0; j < 8; ++j) v[j] = v[j] * fast_sigmoid(v[j]);
                    } else if (mode >= 4) {
#pragma unroll
                        for (int j = 0; j < 8; ++j) v[j] = fast_sigmoid(v[j]);
                    } else {
#pragma unroll
                        for (int j = 0; j < 8; ++j) v[j] *= sc;
                    }
                    u32x4 w; w.x = cvt_pk_bf16(v[0], v[1]); w.y = cvt_pk_bf16(v[2], v[3]); w.z = cvt_pk_bf16(v[4], v[5]); w.w = cvt_pk_bf16(v[6], v[7]);
                    const int col = cb + bj * HALF;
                    if (mode != 5 || col < 48) *(u32x4*)(base + (size_t)row * ldc + colt + col) = w;
                }
            }
    }
};

struct EpiMerge {
    static constexpr bool PERM = true, AFTER_DRAIN = false, MIDHOOK = true;
    const bf16_t* sma; const bf16_t* smb; bf16_t* out;
    __device__ __forceinline__ void mid(f32x4 (&acc)[2][2][4][2], const Unit& u, int wr, int wc, int fr, int fq) const {
        asm volatile("" : "+v"(fr), "+v"(fq));
        const int row0 = u.pm * BM + wr * 64 + fr, col0 = u.pn * BM + wc * 32 + 8 * fq;
#pragma unroll
        for (int ai = 0; ai < 2; ++ai)
#pragma unroll
            for (int m = 0; m < 4; ++m)
#pragma unroll
                for (int bj = 0; bj < 2; ++bj) { const size_t off = (size_t)(row0 + ai * HALF + m * 16) * 2048 + col0 + bj * HALF;
                    const u32x4 a = *(const u32x4*)(sma + off), b = *(const u32x4*)(smb + off);
#pragma unroll
                    for (int q = 0; q < 4; ++q) { const float a0 = bflo(a[q]), a1 = bfhi(a[q]), b0 = bflo(b[q]), b1 = bfhi(b[q]);
                        acc[ai][bj][m][q >> 1][(q & 1) * 2 + 0] *= a0 * __builtin_amdgcn_rcpf(b0); acc[ai][bj][m][q >> 1][(q & 1) * 2 + 1] *= a1 * __builtin_amdgcn_rcpf(b1); }
                    if (bj == 1) asm volatile("" ::: "memory"); }
    }
    __device__ __forceinline__ void operator()(const f32x4 (&acc)[2][2][4][2], const Unit& u, int wr, int wc, int fr, int fq) const {
        const int row0 = u.pm * BM + wr * 64 + fr, col0 = u.pn * BM + wc * 32 + 8 * fq;
#pragma unroll
        for (int ai = 0; ai < 2; ++ai)
#pragma unroll
            for (int m = 0; m < 4; ++m)
#pragma unroll
                for (int bj = 0; bj < 2; ++bj) { const size_t off = (size_t)(row0 + ai * HALF + m * 16) * 2048 + col0 + bj * HALF;
                    const u32x4 b = *(const u32x4*)(smb + off); u32x4 w;
#pragma unroll
                    for (int q = 0; q < 4; ++q) w[q] = cvt_pk_bf16(acc[ai][bj][m][q >> 1][(q & 1) * 2 + 0] * bflo(b[q]), acc[ai][bj][m][q >> 1][(q & 1) * 2 + 1] * bfhi(b[q]));
                    *(u32x4*)(out + off) = w; if (bj == 1) asm volatile("" ::: "memory"); }
    }
};

struct EpiOut {
    static constexpr bool PERM = false, AFTER_DRAIN = false, MIDHOOK = false;
    float* C; float* ssq;
    __device__ __forceinline__ void mid(f32x4 (&)[2][2][4][2], const Unit&, int, int, int, int) const {}
    __device__ __forceinline__ void operator()(const f32x4 (&acc)[2][2][4][2], const Unit& u, int wr, int wc, int fr, int fq) const {
        const int row0 = u.pm * BM + wr * 64 + fr, col0 = u.pn * BM + wc * 32 + 4 * fq;
#pragma unroll
        for (int ai = 0; ai < 2; ++ai)
#pragma unroll
            for (int m = 0; m < 4; ++m) { const int row = row0 + ai * HALF + m * 16; float* rowp = C + (size_t)row * 2048 + col0; float s = 0.f;
#pragma unroll
                for (int bj = 0; bj < 2; ++bj)
#pragma unroll
                    for (int n = 0; n < 2; ++n) { const f32x4 x = acc[ai][bj][m][n]; *(f32x4*)(rowp + bj * HALF + n * 16) = x; s += (x[0] * x[0] + x[1] * x[1]) + (x[2] * x[2] + x[3] * x[3]); }
                s += __shfl_xor(s, 16); s += __shfl_xor(s, 32);
                if (fq == 0) ssq[(size_t)row * 32 + u.pn * 4 + wc] = s; }
    }
};
template <class Epi, class Sched, bool ALIGN_EPI = false, bool SP2 = false>
__device__ __forceinline__ void gemm_phase(PG8_LAS unsigned char* lds, const Gemm g, const Sched& S, const Epi& E) {
    const int tid = threadIdx.x, wid = __builtin_amdgcn_readfirstlane(tid >> 6), lane = tid & 63, wr = wid >> 2, wc = wid & 3, fr = lane & 15, fq = lane >> 4;
    const int K = g.K, nt = K / BK;
    unsigned voffA[2], voffB[2];
#pragma unroll
    for (int i = 0; i < 2; ++i) { int R, C; stage_rc(tid * 16 + i * 8192, R, C); const int Rb = Epi::PERM ? ((R & ~31) + perm32(R & 31)) : R;
        voffA[i] = (unsigned)(R * K + C) * 2u; voffB[i] = (unsigned)(Rb * K + C) * 2u; }
    const size_t kstep = (size_t)(BK * 2);
    const size_t hstep = (size_t)HALF * K * 2;
    const size_t tstep = 2 * hstep;
    const unsigned ldsw = (unsigned)wid * 1024u;
    const int aoff = lds_byte(wr * 64 + fr, fq * 8), boff = lds_byte(wc * 32 + fr, fq * 8);
#define PG8_SA(b, h) (((b) * 2 + (h)) * HTB)
#define PG8_SB(b, h) ((4 + (b) * 2 + (h)) * HTB)
#define PG8_STAGE(bufoff, gbase, voff) do { _Pragma("unroll") for (int _i = 0; _i < 2; ++_i) \
        __builtin_amdgcn_global_load_lds((const unsigned*)((const char*)(gbase) + (voff)[_i]), (PG8_LAS unsigned*)(lds + (bufoff) + ldsw + _i * 8192), 16, 0, 0); } while (0)
#define PG8_LDA(dst, b, h) do { _Pragma("unroll") for (int m = 0; m < 4; ++m) _Pragma("unroll") for (int k = 0; k < 2; ++k) dst[m][k] = *(const PG8_LAS bf16x8*)(lds + PG8_SA(b, h) + aoff + m * 2048 + k * 1024); } while (0)
#define PG8_LDB(dst, b, h) do { _Pragma("unroll") for (int n = 0; n < 2; ++n) _Pragma("unroll") for (int k = 0; k < 2; ++k) dst[n][k] = *(const PG8_LAS bf16x8*)(lds + PG8_SB(b, h) + boff + n * 2048 + k * 1024); } while (0)
#define PG8_MMA(ai, bj, At, Bt) do { __builtin_amdgcn_s_setprio(1); _Pragma("unroll") for (int m = 0; m < 4; ++m) _Pragma("unroll") for (int n = 0; n < 2; ++n) _Pragma("unroll") for (int k = 0; k < 2; ++k) \
        acc[ai][bj][m][n] = __builtin_amdgcn_mfma_f32_16x16x32_bf16(Bt[n][k], At[m][k], acc[ai][bj][m][n], 0, 0, 0); __builtin_amdgcn_s_setprio(0); } while (0)
#define PG8_WAIT_V(n) asm volatile("s_waitcnt vmcnt(" #n ")" ::: "memory")
#define PG8_WAIT_L(n) asm volatile("s_waitcnt lgkmcnt(" #n ")" ::: "memory")
#define PG8_BAR __builtin_amdgcn_s_barrier()
#define PG8_SCHED __builtin_amdgcn_sched_barrier(0)
    Unit cur, nxt; int ui = 0;
    if (!S.next(0, cur)) return;
    f32x4 acc[2][2][4][2];
#pragma unroll
    for (int a = 0; a < 2; ++a)
#pragma unroll
        for (int b = 0; b < 2; ++b)
#pragma unroll
            for (int m = 0; m < 4; ++m)
#pragma unroll
                for (int n = 0; n < 2; ++n) acc[a][b][m][n] = (f32x4){0.f, 0.f, 0.f, 0.f};
    bf16x8 At[4][2], B0[2][2], B1[2][2];
    const char* cA = (const char*)g.A + (size_t)cur.pm * tstep; const char* cB = (const char*)g.Bt + (size_t)cur.pn * tstep;
    S.a_ready(cur);
    if constexpr (SP2) {
        PG8_STAGE(PG8_SB(0, 0), cB, voffB); PG8_STAGE(PG8_SB(0, 1), cB + hstep, voffB); PG8_STAGE(PG8_SA(0, 0), cA, voffA); PG8_STAGE(PG8_SA(0, 1), cA + hstep, voffA);
        if (wr == 1) PG8_BAR;
        PG8_WAIT_V(2); PG8_BAR;
        PG8_STAGE(PG8_SB(1, 0), cB + kstep, voffB); PG8_STAGE(PG8_SA(1, 0), cA + kstep, voffA); PG8_STAGE(PG8_SB(1, 1), cB + hstep + kstep, voffB);
        PG8_WAIT_V(6); PG8_BAR;
    } else {
        PG8_STAGE(PG8_SB(0, 0), cB, voffB); PG8_STAGE(PG8_SA(0, 0), cA, voffA); PG8_STAGE(PG8_SB(0, 1), cB + hstep, voffB); PG8_STAGE(PG8_SA(0, 1), cA + hstep, voffA);
        if (wr == 1) PG8_BAR;
        PG8_WAIT_V(4); PG8_BAR;
        PG8_STAGE(PG8_SB(1, 0), cB + kstep, voffB); PG8_STAGE(PG8_SA(1, 0), cA + kstep, voffA); PG8_STAGE(PG8_SB(1, 1), cB + hstep + kstep, voffB);
        PG8_WAIT_V(6); PG8_BAR;
    }
    for (;;) {
        const bool has_next = S.next(ui + 1, nxt);
        const char* nA = has_next ? (const char*)g.A + (size_t)nxt.pm * tstep : cA; const char* nB = has_next ? (const char*)g.Bt + (size_t)nxt.pn * tstep : cB;
        for (int t = 0; t < nt; t += 2) {
            const bool last = (t == nt - 2);
            if constexpr (Epi::MIDHOOK) { if (t == nt / 2) E.mid(acc, cur, wr, wc, fr, fq); }
            const char* a1 = cA + (size_t)(t + 1) * kstep;
            const char* a2 = last ? nA : cA + (size_t)(t + 2) * kstep; const char* b2 = last ? nB : cB + (size_t)(t + 2) * kstep;
            const char* a3 = a2 + kstep; const char* b3 = b2 + kstep;
            if (last && has_next) S.a_ready(nxt);
            if constexpr (SP2) {
            PG8_LDB(B0, 0, 0); PG8_LDB(B1, 0, 1); PG8_SCHED; PG8_LDA(At, 0, 0); PG8_STAGE(PG8_SA(1, 1), a1 + hstep, voffA);
            PG8_WAIT_V(8); PG8_WAIT_L(0); PG8_BAR; PG8_MMA(0, 0, At, B0); PG8_MMA(0, 1, At, B1); PG8_BAR; PG8_SCHED;
            PG8_LDA(At, 0, 1); PG8_STAGE(PG8_SB(0, 0), b2, voffB); PG8_STAGE(PG8_SB(0, 1), b2 + hstep, voffB); PG8_STAGE(PG8_SA(0, 0), a2, voffA);
            PG8_WAIT_V(8); PG8_WAIT_L(0); PG8_BAR; PG8_MMA(1, 0, At, B0); PG8_MMA(1, 1, At, B1); PG8_BAR; PG8_SCHED;
            PG8_LDB(B0, 1, 0); PG8_LDB(B1, 1, 1); PG8_SCHED; PG8_LDA(At, 1, 0); PG8_STAGE(PG8_SA(0, 1), a2 + hstep, voffA);
            PG8_WAIT_V(8); PG8_WAIT_L(0); PG8_BAR; PG8_MMA(0, 0, At, B0); PG8_MMA(0, 1, At, B1); PG8_BAR; PG8_SCHED;
            PG8_LDA(At, 1, 1); PG8_STAGE(PG8_SB(1, 0), b3, voffB); PG8_STAGE(PG8_SB(1, 1), b3 + hstep, voffB); PG8_STAGE(PG8_SA(1, 0), a3, voffA);
            PG8_WAIT_V(8); PG8_WAIT_L(0); PG8_BAR; PG8_MMA(1, 0, At, B0); PG8_MMA(1, 1, At, B1); PG8_BAR; PG8_SCHED;
            } else {
            PG8_LDB(B0, 0, 0); PG8_SCHED; PG8_LDA(At, 0, 0); PG8_STAGE(PG8_SA(1, 1), a1 + hstep, voffA);
            PG8_WAIT_L(8); PG8_BAR; PG8_WAIT_L(0); PG8_MMA(0, 0, At, B0); PG8_BAR; PG8_SCHED;
            PG8_LDB(B1, 0, 1); PG8_STAGE(PG8_SB(0, 0), b2, voffB);
            PG8_BAR; PG8_WAIT_L(0); PG8_MMA(0, 1, At, B1); PG8_BAR;
            PG8_LDA(At, 0, 1); PG8_STAGE(PG8_SA(0, 0), a2, voffA);
            PG8_BAR; PG8_WAIT_L(0); PG8_MMA(1, 0, At, B0); PG8_BAR; PG8_SCHED;
            PG8_STAGE(PG8_SB(0, 1), b2 + hstep, voffB);
            PG8_WAIT_V(6); PG8_BAR; PG8_MMA(1, 1, At, B1); PG8_BAR;
            PG8_LDB(B0, 1, 0); PG8_SCHED; PG8_LDA(At, 1, 0); PG8_STAGE(PG8_SA(0, 1), a2 + hstep, voffA);
            PG8_WAIT_L(8); PG8_BAR; PG8_WAIT_L(0); PG8_MMA(0, 0, At, B0); PG8_BAR; PG8_SCHED;
            PG8_LDB(B1, 1, 1); PG8_STAGE(PG8_SB(1, 0), b3, voffB);
            PG8_BAR; PG8_WAIT_L(0); PG8_MMA(0, 1, At, B1); PG8_BAR;
            PG8_LDA(At, 1, 1); PG8_STAGE(PG8_SA(1, 0), a3, voffA);
            PG8_BAR; PG8_WAIT_L(0); PG8_MMA(1, 0, At, B0); PG8_BAR; PG8_SCHED;
            PG8_STAGE(PG8_SB(1, 1), b3 + hstep, voffB);
            PG8_WAIT_V(6); PG8_BAR; PG8_MMA(1, 1, At, B1); PG8_BAR;
            }
        }
        if constexpr (ALIGN_EPI) { if (wr == 0) PG8_BAR; }
        if constexpr (!Epi::AFTER_DRAIN) { E(acc, cur, wr, wc, fr, fq); S.done(cur); }
        if (!has_next) break;
#pragma unroll
        for (int a = 0; a < 2; ++a)
#pragma unroll
            for (int b = 0; b < 2; ++b)
#pragma unroll
                for (int m = 0; m < 4; ++m)
#pragma unroll
                    for (int n = 0; n < 2; ++n) acc[a][b][m][n] = (f32x4){0.f, 0.f, 0.f, 0.f};
        cur = nxt; cA = nA; cB = nB; ++ui;
        if constexpr (ALIGN_EPI) { if (wr == 1) PG8_BAR; }
    }
    PG8_WAIT_V(0);
    if constexpr (!ALIGN_EPI) { if (wr == 0) PG8_BAR; }
    PG8_BAR;
    if constexpr (Epi::AFTER_DRAIN) { E.fused(acc, cur, wr, wc, fr, fq, lds, wid, lane); S.done(cur); }
#undef PG8_SA
#undef PG8_SB
#undef PG8_STAGE
#undef PG8_LDA
#undef PG8_LDB
#undef PG8_MMA
#undef PG8_WAIT_V
#undef PG8_WAIT_L
#undef PG8_BAR
#undef PG8_SCHED
}
}

namespace att {
typedef short bf16x8 __attribute__((ext_vector_type(8)));
typedef short s16x4 __attribute__((ext_vector_type(4)));
typedef short v4i16_t __attribute__((ext_vector_type(4)));
typedef float f32x16 __attribute__((ext_vector_type(16)));
constexpr float NEGINF = -__builtin_inff();

template <int D> struct Tile { u32x4_t k[D / 64]; u32x4_t v[D / 64]; };
template <int D> __device__ __forceinline__ void tile_load(Tile<D>& T, const bf16_t* Kp, const bf16_t* Vp, int pitch, int wid, int lane) {
#pragma unroll
    for (int i = 0; i < D / 64; ++i) { const int pc = wid + 8 * i;
        T.k[i] = *(const u32x4_t*)(Kp + (size_t)lane * pitch + pc * 8);
        T.v[i] = *(const u32x4_t*)(Vp + (size_t)(16 * (pc & 3) + (lane >> 2)) * pitch + 32 * (pc >> 2) + 8 * (lane & 3)); }
}
template <int D> __device__ __forceinline__ void tile_store(const Tile<D>& T, LAS unsigned char* kbuf, LAS unsigned char* vbuf, int wid, int lane) {
#pragma unroll
    for (int i = 0; i < D / 64; ++i) { const int pc = wid + 8 * i;
        *(LAS u32x4_t*)(kbuf + pc * 1024 + lane * 16) = T.k[i]; *(LAS u32x4_t*)(vbuf + pc * 1024 + lane * 16) = T.v[i]; }
}
template <int D> __device__ __forceinline__ void qkt(f32x16& p0, f32x16& p1, const LAS unsigned char* kbuf, const bf16x8* qr, int r32, int hi) {
    p0 = f32x16{}; p1 = f32x16{};
    const LAS unsigned char* kb = kbuf + hi * 1024 + r32 * 16;
#pragma unroll
    for (int d0 = 0; d0 < D / 16; ++d0) {
        const bf16x8 b0 = *(const LAS bf16x8*)(kb + d0 * 2048), b1 = *(const LAS bf16x8*)(kb + d0 * 2048 + 512);
        p0 = __builtin_amdgcn_mfma_f32_32x32x16_bf16(b0, qr[d0], p0, 0, 0, 0);
        p1 = __builtin_amdgcn_mfma_f32_32x32x16_bf16(b1, qr[d0], p1, 0, 0, 0); }
}
__device__ __forceinline__ s16x4 vtr(const LAS unsigned char* p) { return __builtin_bit_cast(s16x4, __builtin_amdgcn_ds_read_tr16_b64_v4i16((LAS v4i16_t*)p)); }
template <int D> __device__ __forceinline__ void pv(f32x16* o, const LAS unsigned char* vbuf, const bf16x8* pa, int lane) {
    const LAS unsigned char* vb = vbuf + ((lane >> 4) & 1) * 32 + (lane & 3) * 8 + (4 * (lane >> 5) + ((lane & 15) >> 2)) * 64;
#pragma unroll
    for (int db = 0; db < D / 32; ++db)
#pragma unroll
        for (int ks = 0; ks < 4; ++ks) {
            const s16x4 lo = vtr(vb + db * 4096 + ks * 1024), hh = vtr(vb + db * 4096 + ks * 1024 + 512);
            const bf16x8 vf = {lo[0], lo[1], lo[2], lo[3], hh[0], hh[1], hh[2], hh[3]};
            o[db] = __builtin_amdgcn_mfma_f32_32x32x16_bf16(vf, pa[ks], o[db], 0, 0, 0); }
}
__device__ __forceinline__ float xhalf_max(float v) { auto rr = __builtin_amdgcn_permlane32_swap(__float_as_uint(v), __float_as_uint(v), false, false); return fmaxf(__uint_as_float(rr[0]), __uint_as_float(rr[1])); }
__device__ __forceinline__ float xhalf_sum(float v) { auto rr = __builtin_amdgcn_permlane32_swap(__float_as_uint(v), __float_as_uint(v), false, false); return __uint_as_float(rr[0]) + __uint_as_float(rr[1]); }
__device__ __forceinline__ unsigned cvtpk(float lo, float hi) { unsigned r; asm volatile("v_cvt_pk_bf16_f32 %0, %1, %2" : "=v"(r) : "v"(lo), "v"(hi)); return r; }
__device__ __forceinline__ bf16x8 pack8(const f32x16& p, int b) { u32x4_t w = {cvtpk(p[b], p[b + 1]), cvtpk(p[b + 2], p[b + 3]), cvtpk(p[b + 4], p[b + 5]), cvtpk(p[b + 6], p[b + 7])}; return __builtin_bit_cast(bf16x8, w); }
__device__ __forceinline__ float rowmax32(const f32x16& p0, const f32x16& p1) {
    float a = fmaxf(p0[0], p1[0]);
#pragma unroll
    for (int r = 1; r < 16; ++r) a = fmaxf(a, fmaxf(p0[r], p1[r]));
    return xhalf_max(a);
}
__device__ __forceinline__ void mask_band(f32x16& p0, f32x16& p1, int dq, unsigned band) {
#pragma unroll
    for (int r = 0; r < 16; ++r) { const int c = (r & 3) + 8 * (r >> 2);
        if ((unsigned)(dq - c) > band) p0[r] = NEGINF;
        if ((unsigned)(dq - c - 32) > band) p1[r] = NEGINF; }
}
template <int D> struct State { float m, l; f32x16 o[D / 32]; };
template <int D> __device__ __forceinline__ void state_reset(State<D>& st) { st.m = -1e30f; st.l = 0.f;
#pragma unroll
    for (int i = 0; i < D / 32; ++i) st.o[i] = f32x16{}; }
template <int D> __device__ __forceinline__ void softmax_pv(State<D>& st, f32x16& p0, f32x16& p1, const LAS unsigned char* vbuf, int lane) {
    const float mx = rowmax32(p0, p1);
    const float mn = fmaxf(st.m, mx);
    const float alpha = __builtin_amdgcn_exp2f(st.m - mn);
    st.m = mn;
    float s = 0.f;
#pragma unroll
    for (int r = 0; r < 16; ++r) { p0[r] = __builtin_amdgcn_exp2f(p0[r] - mn); p1[r] = __builtin_amdgcn_exp2f(p1[r] - mn); s += p0[r] + p1[r]; }
    s = xhalf_sum(s);
    st.l = st.l * alpha + s;
#pragma unroll
    for (int i = 0; i < D / 32; ++i)
#pragma unroll
        for (int r = 0; r < 16; ++r) st.o[i][r] *= alpha;
    bf16x8 pa[4] = {pack8(p0, 0), pack8(p0, 8), pack8(p1, 0), pack8(p1, 8)};
    pv<D>(st.o, vbuf, pa, lane);
}

constexpr int L_K0 = 0, L_K1 = 16384, L_V0 = 32768, L_V1 = 49152;
constexpr int L_IMPA = 65536, L_IMPB = L_IMPA + 4 * 64 * 33 * 4, L_SC = L_IMPB + 4 * 64 * 33 * 4, L_SELM = L_SC + 64 * 33 * 4, L_ORM = L_SELM + 256;
static_assert(L_ORM + 16 <= 143360, "attention LDS map");

struct NsaPtrs { unsigned char* ws;
    __device__ __forceinline__ const bf16_t* QA() const { return (const bf16_t*)(ws + WS_QA); }
    __device__ __forceinline__ const bf16_t* KS() const { return (const bf16_t*)(ws + WS_KC + 2 * 8 * MiB); }
    __device__ __forceinline__ const bf16_t* VS() const { return (const bf16_t*)(ws + WS_KC + 3 * 8 * MiB); }
    __device__ __forceinline__ const bf16_t* KW() const { return (const bf16_t*)(ws + WS_KC + 4 * 8 * MiB); }
    __device__ __forceinline__ const bf16_t* VW() const { return (const bf16_t*)(ws + WS_KC + 5 * 8 * MiB); }
    __device__ __forceinline__ const bf16_t* KCC() const { return (const bf16_t*)(ws + WS_KCC); }
    __device__ __forceinline__ const bf16_t* VCC() const { return (const bf16_t*)(ws + WS_VCC); }
    __device__ __forceinline__ const bf16_t* GA() const { return (const bf16_t*)(ws + WS_GA); }
    __device__ __forceinline__ const bf16_t* ZA() const { return (const bf16_t*)(ws + WS_ZA); }
    __device__ __forceinline__ bf16_t* A2() const { return (bf16_t*)(ws + WS_XN); } };

__device__ __forceinline__ void nsa_unit(const NsaPtrs& P, int b, int g, int qt, LAS unsigned char* lds
#if DBG
    , unsigned* selout
#endif
    ) {
    int tid = threadIdx.x; asm volatile("" : "+v"(tid));
    const int lane = tid & 63, r32 = lane & 31, hi = lane >> 5; const int wid = __builtin_amdgcn_readfirstlane(tid >> 6);
    const int hh = 4 * g + (wid & 3), th = wid >> 2;
    const int tok = 64 * qt + 32 * th + r32; const size_t mrow = (size_t)b * SEQ + tok;
    bf16x8 qr[4];
#pragma unroll
    for (int d0 = 0; d0 < 4; ++d0) qr[d0] = *(const bf16x8*)(P.QA() + mrow * 1024 + hh * 64 + d0 * 16 + hi * 8);
    const float g0 = bf2f(P.GA()[mrow * 64 + hh * 3 + 0]), g1 = bf2f(P.GA()[mrow * 64 + hh * 3 + 1]), g2 = bf2f(P.GA()[mrow * 64 + hh * 3 + 2]);
    f32x16 otot[2] = {f32x16{}, f32x16{}};
    Tile<64> T; State<64> st;
    {
        const bf16_t* Kc = P.KCC() + (size_t)(b * 4 + g) * 128 * 64; const bf16_t* Vc = P.VCC() + (size_t)(b * 4 + g) * 128 * 64;
        tile_load<64>(T, Kc, Vc, 64, wid, lane); tile_store<64>(T, (lds + L_K0), (lds + L_V0), wid, lane);
        tile_load<64>(T, Kc + 64 * 64, Vc + 64 * 64, 64, wid, lane); tile_store<64>(T, (lds + L_K1), (lds + L_V1), wid, lane);
        __syncthreads();
        f32x16 pA0, pA1, pB0, pB1;
        qkt<64>(pA0, pA1, (lds + L_K0), qr, r32, hi); qkt<64>(pB0, pB1, (lds + L_K1), qr, r32, hi);
        const int cmax = (tok - 31) >> 4;
        mask_band(pA0, pA1, cmax - 4 * hi, 0x7fffffffu); mask_band(pB0, pB1, cmax - 64 - 4 * hi, 0x7fffffffu);
        float mx = fmaxf(rowmax32(pA0, pA1), rowmax32(pB0, pB1));
        if (mx == NEGINF) mx = 0.f;
        float s = 0.f;
#pragma unroll
        for (int r = 0; r < 16; ++r) { pA0[r] = __builtin_amdgcn_exp2f(pA0[r] - mx); pA1[r] = __builtin_amdgcn_exp2f(pA1[r] - mx); pB0[r] = __builtin_amdgcn_exp2f(pB0[r] - mx); pB1[r] = __builtin_amdgcn_exp2f(pB1[r] - mx);
            s += (pA0[r] + pA1[r]) + (pB0[r] + pB1[r]); }
        s = xhalf_sum(s);
        const float inv_l = s > 0.f ? 1.f / s : 0.f;
        LAS float* IA = (LAS float*)(lds + L_IMPA) + ((wid & 3) * 64 + 32 * th + r32) * 33; LAS float* IB = (LAS float*)(lds + L_IMPB) + ((wid & 3) * 64 + 32 * th + r32) * 33;
#define IMP_ONE(PX, Tt, Pp) _Pragma("unroll") for (int u = 0; u < 4; ++u) { const int k = 16 * (Tt) + 8 * (Pp) + 2 * u + hi; const float h3 = 0.5f * PX[4 * u + 3]; \
            IA[k] = ((PX[4 * u] + PX[4 * u + 1]) + (PX[4 * u + 2] + h3)) * inv_l; IB[k] = h3 * inv_l; }
        IMP_ONE(pA0, 0, 0) IMP_ONE(pA1, 0, 1) IMP_ONE(pB0, 1, 0) IMP_ONE(pB1, 1, 1)
#undef IMP_ONE
        { bf16x8 pa[4] = {pack8(pA0, 0), pack8(pA0, 8), pack8(pA1, 0), pack8(pA1, 8)}; pv<64>(otot, (lds + L_V0), pa, lane); }
        { bf16x8 pa[4] = {pack8(pB0, 0), pack8(pB0, 8), pack8(pB1, 0), pack8(pB1, 8)}; pv<64>(otot, (lds + L_V1), pa, lane); }
        const float w = g0 * inv_l;
#pragma unroll
        for (int i = 0; i < 2; ++i)
#pragma unroll
            for (int r = 0; r < 16; ++r) otot[i][r] *= w;
    }
    LAS float* SC = (LAS float*)(lds + L_SC); LAS unsigned* SELM = (LAS unsigned*)(lds + L_SELM); LAS unsigned* ORM = (LAS unsigned*)(lds + L_ORM);
    { const int tt = tid & 63, jg = tid >> 6;
        if (jg == 0) SELM[tt] = 0u; if (tid == 0) ORM[0] = 0u;
        __syncthreads();
        const LAS float* IA = (const LAS float*)(lds + L_IMPA); const LAS float* IB = (const LAS float*)(lds + L_IMPB);
        const int T_ = 64 * qt + tt;
#pragma unroll
        for (int jj = 0; jj < 4; ++jj) { const int j = 4 * jg + jj; float imp = 0.f;
#pragma unroll
            for (int h = 0; h < 4; ++h) { float v = IA[(h * 64 + tt) * 33 + j]; if (j > 0) v += IB[(h * 64 + tt) * 33 + j - 1]; imp += v; }
            const bool valid = 64 * j <= T_; const bool forced = valid && (j == 0 || j == qt || j == qt - 1);
            SC[tt * 33 + j] = valid ? imp + (forced ? 1.0e4f : 0.f) : -1e30f; }
        __syncthreads();
        unsigned bits = 0u;
#pragma unroll
        for (int jj = 0; jj < 4; ++jj) { const int j = 4 * jg + jj; const float sj = SC[tt * 33 + j]; int rank = 0;
#pragma unroll 1
            for (int k = 0; k < 32; ++k) { const float sk = SC[tt * 33 + k]; rank += ((sk > sj) || (sk == sj && k < j)) ? 1 : 0; }
            if (rank < 16) bits |= 1u << j; }
        atomicOr((unsigned*)&SELM[tt], bits); atomicOr((unsigned*)&ORM[0], bits);
        __syncthreads();
    }
    const unsigned selbits = SELM[32 * th + r32];
#if DBG
    if (tid < 64) selout[((size_t)b * SEQ + 64 * qt + tid) * 4 + g] = SELM[tid];
#endif
    const unsigned causal_bits = (qt == 31) ? 0xffffffffu : ((2u << qt) - 1u);
    unsigned need = (unsigned)__builtin_amdgcn_readfirstlane(ORM[0]) & causal_bits;
    {
        const bf16_t* Kg = P.KS() + (size_t)b * SEQ * 256 + g * 64; const bf16_t* Vg = P.VS() + (size_t)b * SEQ * 256 + g * 64;
        state_reset<64>(st);
        int j = __builtin_ctz(need); need &= need - 1u;
        tile_load<64>(T, Kg + (size_t)64 * j * 256, Vg + (size_t)64 * j * 256, 256, wid, lane); tile_store<64>(T, (lds + L_K0), (lds + L_V0), wid, lane);
        __syncthreads();
        int cur = 0;
        for (;;) {
            const int jn = need ? __builtin_ctz(need) : -1; need &= need - 1u;
            if (jn >= 0) tile_load<64>(T, Kg + (size_t)64 * jn * 256, Vg + (size_t)64 * jn * 256, 256, wid, lane);
            const bool bit = (selbits >> j) & 1u;
            if (__any(bit)) {
                f32x16 p0, p1; qkt<64>(p0, p1, (lds + L_K0 + cur * 16384), qr, r32, hi);
                if (j == qt || !__all(bit)) mask_band(p0, p1, bit ? tok - 64 * j - 4 * hi : -1, 0x7fffffffu);
                softmax_pv<64>(st, p0, p1, (lds + L_V0 + cur * 16384), lane);
            }
            if (jn < 0) { __syncthreads(); break; }
            tile_store<64>(T, (lds + L_K0 + (cur ^ 1) * 16384), (lds + L_V0 + (cur ^ 1) * 16384), wid, lane);
            __syncthreads(); cur ^= 1; j = jn;
        }
        const float w = g1 / st.l;
#pragma unroll
        for (int i = 0; i < 2; ++i)
#pragma unroll
            for (int r = 0; r < 16; ++r) otot[i][r] += st.o[i][r] * w;
    }
    {
        const bf16_t* Kg = P.KW() + (size_t)b * SEQ * 256 + g * 64; const bf16_t* Vg = P.VW() + (size_t)b * SEQ * 256 + g * 64;
        state_reset<64>(st);
        const int jlo = qt >= 8 ? qt - 8 : 0;
        tile_load<64>(T, Kg + (size_t)64 * jlo * 256, Vg + (size_t)64 * jlo * 256, 256, wid, lane); tile_store<64>(T, (lds + L_K0), (lds + L_V0), wid, lane);
        __syncthreads();
        int cur = 0;
        for (int j = jlo; j <= qt; ++j) {
            if (j < qt) tile_load<64>(T, Kg + (size_t)64 * (j + 1) * 256, Vg + (size_t)64 * (j + 1) * 256, 256, wid, lane);
            f32x16 p0, p1; qkt<64>(p0, p1, (lds + L_K0 + cur * 16384), qr, r32, hi);
            if (j == qt || j == qt - 8) mask_band(p0, p1, tok - 64 * j - 4 * hi, 511u);
            softmax_pv<64>(st, p0, p1, (lds + L_V0 + cur * 16384), lane);
            if (j < qt) tile_store<64>(T, (lds + L_K0 + (cur ^ 1) * 16384), (lds + L_V0 + (cur ^ 1) * 16384), wid, lane);
            __syncthreads(); cur ^= 1;
        }
        const float w = g2 / st.l;
#pragma unroll
        for (int i = 0; i < 2; ++i)
#pragma unroll
            for (int r = 0; r < 16; ++r) otot[i][r] += st.o[i][r] * w;
    }
#pragma unroll
    for (int db = 0; db < 2; ++db)
#pragma unroll
        for (int u = 0; u < 4; ++u) { const int d = 32 * db + 8 * u + 4 * hi;
            const u32x2_t z = *(const u32x2_t*)(P.ZA() + mrow * 1024 + hh * 64 + d);
            u32x2_t w; w.x = cvtpk(otot[db][4 * u] * bflo(z.x), otot[db][4 * u + 1] * bfhi(z.x)); w.y = cvtpk(otot[db][4 * u + 2] * bflo(z.y), otot[db][4 * u + 3] * bfhi(z.y));
            *(u32x2_t*)(P.A2() + mrow * 2048 + hh * 64 + d) = w; }
}

struct MixPtrs { unsigned char* ws;
    __device__ __forceinline__ const bf16_t* QB() const { return (const bf16_t*)(ws + WS_QB); }
    __device__ __forceinline__ const bf16_t* KB() const { return (const bf16_t*)(ws + WS_KB); }
    __device__ __forceinline__ const bf16_t* VB() const { return (const bf16_t*)(ws + WS_VB); }
    __device__ __forceinline__ const bf16_t* ZB() const { return (const bf16_t*)(ws + WS_ZB); }
    __device__ __forceinline__ bf16_t* A2() const { return (bf16_t*)(ws + WS_XN); } };
__device__ __forceinline__ void mixb_unit(const MixPtrs& P, int b, int h, int a, LAS unsigned char* lds) {
    int tid = threadIdx.x; asm volatile("" : "+v"(tid));
    const int lane = tid & 63, r32 = lane & 31, hi = lane >> 5; const int wid = __builtin_amdgcn_readfirstlane(tid >> 6);
    const int tok = 256 * a + 32 * wid + r32; const size_t mrow = (size_t)b * SEQ + tok;
    bf16x8 qr[8];
#pragma unroll
    for (int d0 = 0; d0 < 8; ++d0) qr[d0] = *(const bf16x8*)(P.QB() + mrow * 1024 + h * 128 + d0 * 16 + hi * 8);
    const int E16 = (tok - 4 * hi) & 15;
    bool is16[8], is4[4];
#pragma unroll
    for (int i = 0; i < 8; ++i) is16[i] = E16 == ((i & 3) + 8 * (i >> 2));
#pragma unroll
    for (int i = 0; i < 4; ++i) is4[i] = (E16 & 3) == i;
    const bf16_t* Kg = P.KB() + (size_t)b * SEQ * 1024 + h * 128; const bf16_t* Vg = P.VB() + (size_t)b * SEQ * 1024 + h * 128;
    Tile<128> T; State<128> st; state_reset<128>(st);
    const int nt = 4 * a + 4, wlast = 4 * a + (wid >> 1);
    tile_load<128>(T, Kg, Vg, 1024, wid, lane); tile_store<128>(T, (lds + L_K0), (lds + L_V0), wid, lane);
    __syncthreads();
    int cur = 0;
    for (int kt = 0; kt < nt; ++kt) {
        if (kt + 1 < nt) tile_load<128>(T, Kg + (size_t)64 * (kt + 1) * 1024, Vg + (size_t)64 * (kt + 1) * 1024, 1024, wid, lane);
        if (kt <= wlast) {
            f32x16 p0, p1; qkt<128>(p0, p1, (lds + L_K0 + cur * 16384), qr, r32, hi);
            const int wlo = 256 * a + 32 * wid - 64 * kt;
            const int dmin = wlo - 63, dmax = wlo + 31;
            if (dmin > 512) {
#pragma unroll
                for (int r = 0; r < 16; ++r) { const int i16 = (r & 3) + 4 * ((r >> 2) & 1); p0[r] = is16[i16] ? p0[r] : NEGINF; p1[r] = is16[i16] ? p1[r] : NEGINF; }
            } else if (dmin > 128 && dmax <= 512) {
#pragma unroll
                for (int r = 0; r < 16; ++r) { const int i16 = (r & 3) + 4 * ((r >> 2) & 1), i4 = r & 3;
                    p0[r] = is4[i4] ? (is16[i16] ? p0[r] + 1.f : p0[r]) : NEGINF; p1[r] = is4[i4] ? (is16[i16] ? p1[r] + 1.f : p1[r]) : NEGINF; }
            } else if (dmin >= 0 && dmax <= 128) {
#pragma unroll
                for (int r = 0; r < 16; ++r) { const int i16 = (r & 3) + 4 * ((r >> 2) & 1), i4 = r & 3;
                    p0[r] = is16[i16] ? p0[r] + 1.5849625007f : (is4[i4] ? p0[r] + 1.f : p0[r]); p1[r] = is16[i16] ? p1[r] + 1.5849625007f : (is4[i4] ? p1[r] + 1.f : p1[r]); }
            } else {
                const int e = tok - 64 * kt - 4 * hi;
#pragma unroll
                for (int r = 0; r < 16; ++r) { const int i16 = (r & 3) + 4 * ((r >> 2) & 1), i4 = r & 3; const int c = (r & 3) + 8 * (r >> 2);
#pragma unroll
                    for (int pp = 0; pp < 2; ++pp) { const int d = e - c - 32 * pp;
                        const int cnt = ((unsigned)d <= 128u ? 1 : 0) + ((is4[i4] && (unsigned)d <= 512u) ? 1 : 0) + ((is16[i16] && d >= 0) ? 1 : 0);
                        const float add = cnt == 3 ? 1.5849625007f : (cnt == 2 ? 1.f : 0.f);
                        if (pp == 0) p0[r] = cnt ? p0[r] + add : NEGINF; else p1[r] = cnt ? p1[r] + add : NEGINF; } }
            }
            softmax_pv<128>(st, p0, p1, (lds + L_V0 + cur * 16384), lane);
        }
        if (kt + 1 < nt) tile_store<128>(T, (lds + L_K0 + (cur ^ 1) * 16384), (lds + L_V0 + (cur ^ 1) * 16384), wid, lane);
        __syncthreads(); cur ^= 1;
    }
    const float inv_l = 1.f / st.l;
#pragma unroll
    for (int db = 0; db < 4; ++db)
#pragma unroll
        for (int u = 0; u < 4; ++u) { const int d = 32 * db + 8 * u + 4 * hi;
            const u32x2_t z = *(const u32x2_t*)(P.ZB() + mrow * 1024 + h * 128 + d);
            u32x2_t w; w.x = cvtpk(st.o[db][4 * u] * inv_l * bflo(z.x), st.o[db][4 * u + 1] * inv_l * bfhi(z.x)); w.y = cvtpk(st.o[db][4 * u + 2] * inv_l * bflo(z.y), st.o[db][4 * u + 3] * inv_l * bfhi(z.y));
            *(u32x2_t*)(P.A2() + mrow * 2048 + 1024 + h * 128 + d) = w; }
}
}
typedef GAS unsigned gu32;
#define RLX_AGENT __ATOMIC_RELAXED, __HIP_MEMORY_SCOPE_AGENT
#define LDS_WAIT() asm volatile("s_waitcnt lgkmcnt(0)" ::: "memory")
#define VM_WAIT() asm volatile("s_waitcnt vmcnt(0)" ::: "memory")
#define XB_TMO      128
#define XB_XCNT(j)  (256  + 64 * (j))
#define XB_XSUB(j)  (1280 + 64 * (j))
#define XB_XGEN(j)  (2304 + 64 * (j))
#define XB_TOP      3328
#define XB_TOPGEN   3392
#define XCD_BAR_WORDS 3456
#define XB_SPIN_CAP (1u << 18)
__device__ __forceinline__ unsigned xb_ld(unsigned* p)              { return __hip_atomic_load(p, __ATOMIC_RELAXED, __HIP_MEMORY_SCOPE_AGENT); }
__device__ __forceinline__ unsigned xb_add(unsigned* p, unsigned v) { return __hip_atomic_fetch_add(p, v, __ATOMIC_RELAXED, __HIP_MEMORY_SCOPE_AGENT); }
__device__ __forceinline__ unsigned xb_xcc_id() { return (unsigned)__builtin_amdgcn_s_getreg((3 << 11) | 20) & 0xFu; }
#define XB_SPIN(cond, bar) do { unsigned _sp = 0; while (cond) { __builtin_amdgcn_s_sleep(1); \
    if ((++_sp & 255u) == 0u) { if (xb_ld(&(bar)[XB_TMO])) break; if (_sp > XB_SPIN_CAP) { atomicAdd(&(bar)[XB_TMO], 1u); break; } } } } while (0)
struct XcdBarrier { unsigned* bar; unsigned x; volatile LAS unsigned* st; };
__device__ __forceinline__ XcdBarrier xcd_barrier_post(unsigned* bar, volatile LAS unsigned* st) {
    XcdBarrier b; b.bar = bar; b.x = xb_xcc_id(); b.st = st;
    if (threadIdx.x == 0) (void)xb_add(&bar[XB_XCNT(b.x)], 1u);
    return b;
}
__device__ __forceinline__ void xcd_barrier_complete(unsigned* bar, unsigned x, unsigned& nloc, unsigned& nx) {
    const unsigned G = gridDim.x * gridDim.y * gridDim.z;
    unsigned sum, cnt, mine, sp = 0u;
    for (;;) {
        sum = 0u; cnt = 0u; mine = 0u;
#pragma unroll
        for (unsigned j = 0; j < 16; ++j) { const unsigned c = xb_ld(&bar[XB_XCNT(j)]); sum += c; cnt += (c > 0u) ? 1u : 0u; mine = (j == x) ? c : mine; }
        if (sum == G) break;
        __builtin_amdgcn_s_sleep(1);
        if ((++sp & 255u) == 0u) { if (xb_ld(&bar[XB_TMO])) break; if (sp > XB_SPIN_CAP) { atomicAdd(&bar[XB_TMO], 1u); break; } }
    }
    nloc = mine > 0u ? mine : 1u; nx = cnt > 0u ? cnt : 1u;
}
__device__ __forceinline__ void xcd_barrier(const XcdBarrier& b) {
    asm volatile("s_waitcnt vmcnt(0)" ::: "memory");
    __syncthreads();
    if (threadIdx.x == 0) {
        unsigned* bar = b.bar;
        __builtin_amdgcn_s_waitcnt(0);
        unsigned nloc = b.st[0], nx = b.st[1];
        if (nloc == 0u) { xcd_barrier_complete(bar, b.x, nloc, nx); b.st[0] = nloc; b.st[1] = nx; }
        const unsigned old = xb_add(&bar[XB_XSUB(b.x)], 1u);
        const unsigned gen = old / nloc;
        if (old + 1u == (gen + 1u) * nloc) {
            __builtin_amdgcn_fence(__ATOMIC_RELEASE, "agent");
            asm volatile("s_waitcnt vmcnt(0)" ::: "memory");
            const unsigned og = xb_add(&bar[XB_TOP], 1u);
            const unsigned tg = og / nx;
            if (og + 1u == (tg + 1u) * nx) xb_add(&bar[XB_TOPGEN], 1u);
            else XB_SPIN(xb_ld(&bar[XB_TOPGEN]) == tg, bar);
            __builtin_amdgcn_fence(__ATOMIC_ACQUIRE, "agent");
            xb_add(&bar[XB_XGEN(b.x)], 1u);
            asm volatile("s_waitcnt vmcnt(0)" ::: "memory");
        } else {
            XB_SPIN(xb_ld(&bar[XB_XGEN(b.x)]) == gen, bar);
            __builtin_amdgcn_fence(__ATOMIC_ACQUIRE, "agent");
            asm volatile("s_waitcnt vmcnt(0)" ::: "memory");
        }
    }
    __syncthreads();
}

struct Frame {
    LAS unsigned char* lds; int tid, lane, wave, G, vcu;
    const float *x, *c; const int* pos; const float *w_ada, *b_ada, *g_pre, *g_post, *w_in, *pe_ck, *pe_cv, *w_ck1, *w_ck2, *w_cv1, *w_cv2, *w_br_a, *w_br_b, *w_out;
    unsigned char* ws; unsigned char* dout;
};
__device__ __forceinline__ float wave_sum(float v) {
#pragma unroll
    for (int o = 1; o < 64; o <<= 1) v += __shfl_xor(v, o);
    return v;
}
__device__ __forceinline__ void p0_ada(Frame& F) {
    float* ada = (float*)(F.ws + WS_ADA);
    LAS float* red = (LAS float*)F.lds;
    for (int cg = blockIdx.x; cg < 256; cg += F.G) {
        const int tid = F.tid, kk = tid / 6, c4 = tid % 6; const bool on = tid < 510;
        f32x4_t acc[8];
#pragma unroll
        for (int b = 0; b < 8; ++b) acc[b] = (f32x4_t){0.f, 0.f, 0.f, 0.f};
        if (on) for (int k = kk; k < DM; k += 85) {
            const f32x4_t w = *(const f32x4_t*)(F.w_ada + (size_t)k * 6144 + 24 * cg + 4 * c4);
#pragma unroll
            for (int b = 0; b < 8; ++b) { const float cv = F.c[b * DM + k]; acc[b] += w * cv; }
        }
        if (on) {
#pragma unroll
            for (int b = 0; b < 8; ++b)
#pragma unroll
                for (int e = 0; e < 4; ++e) red[tid * 33 + b * 4 + e] = acc[b][e];
        }
        __syncthreads();
        if (tid < 192) { const int b = tid / 24, col = tid % 24, cc4 = col >> 2, e = col & 3; float s = 0.f;
            for (int q = 0; q < 85; ++q) s += red[(q * 6 + cc4) * 33 + b * 4 + e];
            ada[b * 6144 + 24 * cg + col] = s + F.b_ada[24 * cg + col]; }
        __syncthreads();
    }
}
template <bool REMAP> __device__ __forceinline__ int dst_row(int n) { if (!REMAP) return n; return n < 2560 ? n : (n < 2608 ? 11776 + (n - 2560) : n - 48); }
template <bool REMAP> __device__ __forceinline__ void p0_transpose_item(const float* W, int K, int N, bf16_t* WT, int ldt, int kofs, LAS float* scr, int item, int lane) {
    const int nblk = (N + 31) / 32, kb = item / nblk, nb = item % nblk, k0 = 64 * kb, n0 = 32 * nb;
    const bool cok = n0 + (lane & 31) < N;
#pragma unroll 8
    for (int i = 0; i < 32; ++i) { const int kk = 2 * i + (lane >> 5); scr[kk * 33 + (lane & 31)] = cok ? W[(size_t)(k0 + kk) * N + n0 + (lane & 31)] : 0.f; }
    LDS_WAIT(); asm volatile("" ::: "memory");
    const int c = lane & 7;
#pragma unroll
    for (int j = 0; j < 4; ++j) { const int n = (lane >> 3) + 8 * j; const LAS float* s = scr + (8 * c) * 33 + n;
        u32x4_t o; o.x = pk2(s[0 * 33], s[1 * 33]); o.y = pk2(s[2 * 33], s[3 * 33]); o.z = pk2(s[4 * 33], s[5 * 33]); o.w = pk2(s[6 * 33], s[7 * 33]);
        if (n0 + n < N) *(GAS u32x4_t*)(WT + (size_t)dst_row<REMAP>(n0 + n) * ldt + kofs + k0 + 8 * c) = o; }
    LDS_WAIT(); asm volatile("" ::: "memory");
}
__device__ __forceinline__ void p0_items(Frame& F) {
    LAS float* scr = (LAS float*)(F.lds + 68 * 1024 + F.wave * 8704);
    const int gw = F.vcu * 8 + F.wave, NGW = F.G * 8, lane = F.lane;
    bf16_t* WinT = (bf16_t*)(F.ws + WS_WINT); bf16_t* WbrT = (bf16_t*)(F.ws + WS_WBRT); bf16_t* WoutT = (bf16_t*)(F.ws + WS_WOUTT);
    bf16_t* W1T = (bf16_t*)(F.ws + WS_W1T); bf16_t* W2T = (bf16_t*)(F.ws + WS_W2T);
    constexpr int I_IN = 32 * 370, I_BR = 16 * 64, I_OUT = 32 * 64, I_C1 = 32 * 8, I_C2 = 4 * 2;
    constexpr int I_ROPE = MTOK / 64, I_B1 = 8, I_Z = 13;
    constexpr int NITEMS = I_IN + 2 * I_BR + I_OUT + 2 * I_C1 + 2 * I_C2 + I_ROPE + I_B1 + I_Z;
    for (int it = gw; it < NITEMS; it += NGW) {
        int r = it;
        if (r < I_IN) { p0_transpose_item<true>(F.w_in, 2048, NIN, WinT, 2048, 0, scr, r, lane); continue; } r -= I_IN;
        if (r < I_BR) { p0_transpose_item<false>(F.w_br_a, 1024, 2048, WbrT, 2048, 0, scr, r, lane); continue; } r -= I_BR;
        if (r < I_BR) { p0_transpose_item<false>(F.w_br_b, 1024, 2048, WbrT, 2048, 1024, scr, r, lane); continue; } r -= I_BR;
        if (r < I_OUT) { p0_transpose_item<false>(F.w_out, 2048, 2048, WoutT, 2048, 0, scr, r, lane); continue; } r -= I_OUT;
        if (r < I_C1) { p0_transpose_item<false>(F.w_ck1, 2048, 256, W1T, 2048, 0, scr, r, lane); continue; } r -= I_C1;
        if (r < I_C1) { p0_transpose_item<false>(F.w_cv1, 2048, 256, W1T + 256 * 2048, 2048, 0, scr, r, lane); continue; } r -= I_C1;
        if (r < I_C2) { p0_transpose_item<false>(F.w_ck2, 256, 64, W2T, 256, 0, scr, r, lane); continue; } r -= I_C2;
        if (r < I_C2) { p0_transpose_item<false>(F.w_cv2, 256, 64, W2T + 64 * 256, 256, 0, scr, r, lane); continue; } r -= I_C2;
        if (r < I_ROPE) {
            const int m = r * 64 + lane; const float pf = (float)F.pos[m];
            float* t64 = (float*)(F.ws + WS_R64) + (size_t)m * 16; float* t128 = (float*)(F.ws + WS_R128) + (size_t)m * 32;
            for (int i = 0; i < 8; ++i) { const float inv = (float)pow(500000.0, -(double)(2 * i) / 16.0); const float ang = pf * inv; t64[i] = cosf(ang); t64[8 + i] = sinf(ang); }
            for (int i = 0; i < 16; ++i) { const float inv = (float)pow(500000.0, -(double)(2 * i) / 32.0); const float ang = pf * inv; t128[i] = cosf(ang); t128[16 + i] = sinf(ang); }
            continue; } r -= I_ROPE;
        if (r < I_B1) {
            const int kv = r >> 2, n = (r & 3) * 64 + lane; const float* pe = kv ? F.pe_cv : F.pe_ck; const float* w1 = kv ? F.w_cv1 : F.w_ck1; float s = 0.f;
            for (int k = 0; k < 2048; ++k) s += pe[k] * w1[(size_t)k * 256 + n];
            ((float*)(F.ws + WS_BIAS1))[kv * 256 + n] = s; continue; } r -= I_B1;
        {
            for (int q = lane; q < 16 * 256; q += 64) *(GAS u32x4_t*)(WinT + (size_t)(11824 + r * 16) * 2048 + q * 8) = (u32x4_t){0u, 0u, 0u, 0u};
        }
    }
}
__device__ __forceinline__ void p0_xn(Frame& F) {
    const int gw = F.vcu * 8 + F.wave, NGW = F.G * 8, lane = F.lane;
    const float* ada = (const float*)(F.ws + WS_ADA); bf16_t* XN = (bf16_t*)(F.ws + WS_XN);
    for (int m = gw; m < MTOK; m += NGW) {
        const int b = m >> 11; const f32x4_t* xr = (const f32x4_t*)(F.x + (size_t)m * DM) + lane;
        f32x4_t v[8]; float s = 0.f;
#pragma unroll
        for (int j = 0; j < 8; ++j) { v[j] = xr[64 * j]; s += (v[j][0] * v[j][0] + v[j][1] * v[j][1]) + (v[j][2] * v[j][2] + v[j][3] * v[j][3]); }
        const float rstd = rsqrtf(wave_sum(s) * (1.f / DM) + 1e-6f);
        u32x2_t* o8 = (u32x2_t*)(XN + (size_t)m * DM) + lane;
#pragma unroll
        for (int j = 0; j < 8; ++j) { const int k = 256 * j + 4 * lane;
            const f32x4_t g = *(const f32x4_t*)(F.g_pre + k), sc = *(const f32x4_t*)(ada + b * 6144 + 2048 + k), sh = *(const f32x4_t*)(ada + b * 6144 + k);
            const f32x4_t y = (v[j] * rstd * g) * (sc + 1.f) + sh;
            u32x2_t w; w.x = pk2(y[0], y[1]); w.y = pk2(y[2], y[3]); o8[64 * j] = w; }
    }
}
typedef short cbf16x8 __attribute__((ext_vector_type(8)));
typedef float cf32x16 __attribute__((ext_vector_type(16)));
__device__ __forceinline__ void compress_unit(Frame& F, int unit) {
    const int kv = unit >> 6, b = (unit >> 3) & 7, g = (unit >> 1) & 3, mh = unit & 1;
    const int lane = F.lane, r32 = lane & 31, hi = lane >> 5, wid = F.wave, wm = wid >> 2, wn = wid & 3;
    const bf16_t* src = (const bf16_t*)(F.ws + WS_KC + (size_t)kv * 8 * MiB) + (size_t)b * SEQ * 256 + g * 64;
    const bf16_t* W1T = (const bf16_t*)(F.ws + WS_W1T) + (size_t)kv * 256 * 2048;
    const bf16_t* W2T = (const bf16_t*)(F.ws + WS_W2T) + (size_t)kv * 64 * 256;
    const float* bias1 = (const float*)(F.ws + WS_BIAS1) + kv * 256;
    bf16_t* dst = (bf16_t*)(F.ws + (kv ? WS_VCC : WS_KCC)) + (size_t)(b * 4 + g) * 128 * 64;
    LAS bf16_t* HID = (LAS bf16_t*)F.lds;
    const int c_row = 64 * mh + 32 * wm + r32;
    cf32x16 acc0 = cf32x16{}, acc1 = cf32x16{};
    const bf16_t* w1p0 = W1T + (size_t)(64 * wn + r32) * 2048 + 8 * hi; const bf16_t* w1p1 = w1p0 + (size_t)32 * 2048;
#pragma unroll 4
    for (int ks = 0; ks < 128; ++ks) {
        int trow = 16 * c_row + (ks >> 2); trow = trow > 2047 ? 2047 : trow;
        const cbf16x8 a = *(const cbf16x8*)(src + (size_t)trow * 256 + (ks & 3) * 16 + 8 * hi);
        const cbf16x8 b0 = *(const cbf16x8*)(w1p0 + ks * 16), b1 = *(const cbf16x8*)(w1p1 + ks * 16);
        acc0 = __builtin_amdgcn_mfma_f32_32x32x16_bf16(a, b0, acc0, 0, 0, 0);
        acc1 = __builtin_amdgcn_mfma_f32_32x32x16_bf16(a, b1, acc1, 0, 0, 0);
    }
#pragma unroll
    for (int t = 0; t < 2; ++t) { const int n = 64 * wn + 32 * t + r32; const float bb = bias1[n];
#pragma unroll
        for (int r = 0; r < 16; ++r) { const float xv = (t ? acc1[r] : acc0[r]) + bb;
            const float u = 0.7978845608028654f * (xv + 0.044715f * xv * xv * xv);
            const float th = 1.f - 2.f * __builtin_amdgcn_rcpf(1.f + __builtin_amdgcn_exp2f(2.f * LOG2E * u));
            const float gl = 0.5f * xv * (1.f + th);
            HID[(32 * wm + (r & 3) + 8 * (r >> 2) + 4 * hi) * 264 + n] = (bf16_t)f2bf(gl); } }
    __syncthreads();
    if (wid < 4) {
        const int mi = wid >> 1, nd = wid & 1;
        cf32x16 o = cf32x16{};
#pragma unroll
        for (int ks = 0; ks < 16; ++ks) {
            const cbf16x8 a = *(const LAS cbf16x8*)(HID + (32 * mi + r32) * 264 + 16 * ks + 8 * hi);
            const cbf16x8 bq = *(const cbf16x8*)(W2T + (size_t)(32 * nd + r32) * 256 + 16 * ks + 8 * hi);
            o = __builtin_amdgcn_mfma_f32_32x32x16_bf16(a, bq, o, 0, 0, 0);
        }
        const int d = 32 * nd + r32;
#pragma unroll
        for (int r = 0; r < 16; ++r) { const int c = 64 * mh + 32 * mi + (r & 3) + 8 * (r >> 2) + 4 * hi; float v = o[r];
            if (kv == 0 && nd == 0) {
                int trow = 16 * c + 31; trow = trow > 2047 ? 2047 : trow;
                const float* tb = (const float*)(F.ws + WS_R64) + ((size_t)b * SEQ + trow) * 16;
                const float pr = __shfl_xor(v, 8); const float cs = tb[r32 & 7], sn = tb[8 + (r32 & 7)];
                const float rot = v * cs + (r32 < 8 ? -pr : pr) * sn;
                v = r32 < 16 ? rot : v; }
            dst[(size_t)c * 64 + d] = (c == 127) ? (bf16_t)0 : (bf16_t)f2bf(v); }
    }
    __syncthreads();
}
__device__ __forceinline__ void p6_final(Frame& F) {
    const int gw = F.vcu * 8 + F.wave, NGW = F.G * 8, lane = F.lane;
    const float* ada = (const float*)(F.ws + WS_ADA); const float* ssq = (const float*)(F.ws + WS_SSQ); float* out = (float*)F.dout;
    for (int m = gw; m < MTOK; m += NGW) {
        const int b = m >> 11; float s = 0.f;
        for (int q = 0; q < 32; ++q) s += ssq[(size_t)m * 32 + q];
        const float rstd = rsqrtf(s * (1.f / DM) + 1e-6f);
        const f32x4_t* xr = (const f32x4_t*)(F.x + (size_t)m * DM) + lane; f32x4_t* orow = (f32x4_t*)(out + (size_t)m * DM) + lane;
#pragma unroll
        for (int j = 0; j < 8; ++j) { const int k = 256 * j + 4 * lane;
            const f32x4_t gp = *(const f32x4_t*)(F.g_post + k), gt = *(const f32x4_t*)(ada + b * 6144 + 4096 + k);
            orow[64 * j] = xr[64 * j] + gt * (orow[64 * j] * rstd * gp); }
    }
}
constexpr int LDS_BYTES = 147456;
constexpr int LDSCTL_OFF = 143360;
constexpr int CW_BAR = 4096;
constexpr int NPHASE = 8;
struct Args { const void* in[17]; float* out; unsigned char* ws; int ph_lo, ph_hi; };

__global__ void __launch_bounds__(512, 2) mk_fwd(Args args) {
    extern __shared__ __attribute__((aligned(16))) unsigned char lds_raw[];
    Frame F;
    F.lds = (LAS unsigned char*)lds_raw;
    F.tid = threadIdx.x; F.lane = F.tid & 63; F.wave = __builtin_amdgcn_readfirstlane(F.tid >> 6);
    F.G = gridDim.x; { const int bx = blockIdx.x; F.vcu = (F.G % 8 == 0) ? (bx % 8) * (F.G / 8) + bx / 8 : bx; }
    F.x = (const float*)args.in[0]; F.c = (const float*)args.in[1]; F.pos = (const int*)args.in[2]; F.w_ada = (const float*)args.in[3]; F.b_ada = (const float*)args.in[4];
    F.g_pre = (const float*)args.in[5]; F.g_post = (const float*)args.in[6]; F.w_in = (const float*)args.in[7]; F.pe_ck = (const float*)args.in[8]; F.pe_cv = (const float*)args.in[9];
    F.w_ck1 = (const float*)args.in[10]; F.w_ck2 = (const float*)args.in[11]; F.w_cv1 = (const float*)args.in[12]; F.w_cv2 = (const float*)args.in[13];
    F.w_br_a = (const float*)args.in[14]; F.w_br_b = (const float*)args.in[15]; F.w_out = (const float*)args.in[16];
    F.ws = args.ws; F.dout = (unsigned char*)args.out;
    unsigned char* ws = args.ws;
    for (int u = F.tid; u < (LDS_BYTES - LDSCTL_OFF) / 4; u += 512) ((LAS unsigned*)(F.lds + LDSCTL_OFF))[u] = 0u;
    __syncthreads();
    const int lo = args.ph_lo, hi = args.ph_hi;
    const bool multi = (hi - lo) > 1;
    XcdBarrier bar; bar.bar = (unsigned*)(ws + WS_CTL) + CW_BAR; bar.x = 0; bar.st = nullptr;
    if (multi) bar = xcd_barrier_post((unsigned*)(ws + WS_CTL) + CW_BAR, (volatile LAS unsigned*)(F.lds + LDSCTL_OFF + 32));
#ifndef PH_MASK
#define PH_MASK 0xff
#endif
#define IN(k) (((PH_MASK >> (k)) & 1) && lo <= (k) && (k) < hi)
#define SEAM(k) do { if (IN(k) && IN((k) + 1)) xcd_barrier(bar); } while (0)

    if (IN(0)) { p0_ada(F); p0_items(F); }
    SEAM(0);
    if (IN(1)) { p0_xn(F); }
    SEAM(1);
    if (IN(2)) {
        pg8::Gemm g{(const bf16_t*)(ws + WS_XN), (const bf16_t*)(ws + WS_WINT), MTOK, NINP, 2048}; pg8::StaticOrder S; S.init(MTOK, NINP, F.G, (int)blockIdx.x);
        pg8::EpiProj E{ws, F.dout, (const float*)(ws + WS_R64), (const float*)(ws + WS_R128)};
        pg8::gemm_phase<pg8::EpiProj, pg8::StaticOrder, true, true>(F.lds, g, S, E);
    }
    SEAM(2);
    if (IN(3)) { for (int u = F.vcu; u < 128; u += F.G) compress_unit(F, u); }
    SEAM(3);
    if (IN(4)) {
        att::NsaPtrs NP{ws}; att::MixPtrs MP{ws};
        for (int v = F.vcu; v < 256; v += F.G) {
#ifndef NO_NSA
            { const int bg = v >> 3, s = v & 7;
#pragma unroll 1
              for (int i = 0; i < 4; ++i) { const int qt = (i == 0) ? 31 - s : (i == 1) ? 16 + s : (i == 2) ? 15 - s : s; att::nsa_unit(NP, bg >> 2, bg & 3, qt, F.lds
#if DBG
                  , (unsigned*)(ws + WS_DBG + 101 * MiB)
#endif
                  ); } }
#endif
#ifndef NO_MIX
            { const int bh = v >> 2, s = v & 3;
#pragma unroll 1
              for (int i = 0; i < 2; ++i) { const int a = (i == 0) ? 7 - s : s; att::mixb_unit(MP, bh >> 3, bh & 7, a, F.lds); } }
#endif
        }
    }
    SEAM(4);
    if (IN(5)) {
        pg8::Gemm g{(const bf16_t*)(ws + WS_XN), (const bf16_t*)(ws + WS_WBRT), MTOK, 2048, 2048}; pg8::StaticOrder S; S.init(MTOK, 2048, F.G, (int)blockIdx.x);
        pg8::EpiMerge E{(const bf16_t*)(F.dout + DO_MA), (const bf16_t*)(F.dout + DO_MB), (bf16_t*)(ws + WS_MERGED)};
        pg8::gemm_phase<pg8::EpiMerge, pg8::StaticOrder, true, true>(F.lds, g, S, E);
    }
    SEAM(5);
    if (IN(6)) {
        pg8::Gemm g{(const bf16_t*)(ws + WS_MERGED), (const bf16_t*)(ws + WS_WOUTT), MTOK, 2048, 2048}; pg8::StaticOrder S; S.init(MTOK, 2048, F.G, (int)blockIdx.x);
        pg8::EpiOut E{(float*)F.dout, (float*)(ws + WS_SSQ)};
        pg8::gemm_phase<pg8::EpiOut, pg8::StaticOrder, true, true>(F.lds, g, S, E);
    }
    SEAM(6);
    if (IN(7)) { p6_final(F); }
#undef IN
#undef SEAM
}

#if DBG
namespace dbg {
constexpr int BD = DBG_BATCH;
constexpr size_t E_PROJ = 0, E_KC = 48 * MiB, E_VC = 48 * MiB + 256 * 1024, E_SEL = 48 * MiB + 512 * 1024, E_AA = 50 * MiB, E_AB = 58 * MiB, E_MG = 66 * MiB, E_OF = 82 * MiB, E_ADA = 98 * MiB, DIAG = 100 * MiB, SELOUT = 101 * MiB;
__global__ void k_f2b(const float* __restrict__ s, bf16_t* __restrict__ d, size_t n) { for (size_t i = (size_t)blockIdx.x * 256 + threadIdx.x; i < n; i += (size_t)gridDim.x * 256) d[i] = (bf16_t)f2bf(s[i]); }
__global__ void k_copy(const float* __restrict__ s, float* __restrict__ d, size_t n) { for (size_t i = (size_t)blockIdx.x * 256 + threadIdx.x; i < n; i += (size_t)gridDim.x * 256) d[i] = s[i]; }
template <class T> __device__ __forceinline__ float tof(T v);
template <> __device__ __forceinline__ float tof<float>(float v) { return v; }
template <> __device__ __forceinline__ float tof<bf16_t>(bf16_t v) { return bf2f(v); }
template <class FT, class ET, int XF> __global__ void k_cmp(const FT* __restrict__ f, int ldf, const ET* __restrict__ e, int lde, int rows, int cols, float fscale, float* __restrict__ acc) {
    __shared__ float sh[8];
    float num = 0.f, den = 0.f;
    for (size_t i = (size_t)blockIdx.x * 256 + threadIdx.x; i < (size_t)rows * cols; i += (size_t)gridDim.x * 256) { const int r = (int)(i / cols), c = (int)(i % cols);
        const float vf = tof<FT>(f[(size_t)r * ldf + c]) * fscale; float ve = tof<ET>(e[(size_t)r * lde + c]);
        if (XF == 1) ve = ve / (1.f + expf(-ve)); if (XF == 2) ve = 1.f / (1.f + expf(-ve));
        num += (vf - ve) * (vf - ve); den += ve * ve; }
    for (int o = 32; o > 0; o >>= 1) { num += __shfl_xor(num, o); den += __shfl_xor(den, o); }
    if ((threadIdx.x & 63) == 0) { sh[threadIdx.x >> 6] = num; sh[4 + (threadIdx.x >> 6)] = den; }
    __syncthreads();
    if (threadIdx.x == 0) { atomicAdd(acc, sh[0] + sh[1] + sh[2] + sh[3]); atomicAdd(acc + 1, sh[4] + sh[5] + sh[6] + sh[7]); }
}
__global__ void k_cmp_sel(const unsigned* __restrict__ f, const unsigned* __restrict__ e, float* __restrict__ acc) {
    const int idx = blockIdx.x * 256 + threadIdx.x; if (idx >= 2048 * 4) return; const int s = idx >> 2;
    const unsigned valid = (s >> 6) == 31 ? 0xffffffffu : ((2u << (s >> 6)) - 1u);
    const bool bad = ((f[idx] ^ e[idx]) & valid) != 0u;
    atomicAdd(acc, bad ? 1.f : 0.f); if (threadIdx.x == 0 && blockIdx.x == 0) atomicAdd(acc + 1, 8192.f);
}
constexpr int NCHK = 24;
__global__ void k_report(const float* __restrict__ diag, float* __restrict__ out, int sel) {
    if (threadIdx.x != 0) return;
    if (sel == 0) { for (int k = 1; k < NCHK; ++k) { const float num = diag[2 * k], den = diag[2 * k + 1]; if (den == 0.f) continue;
            const float err = (k == 19) ? num / den : sqrtf(num / den);
            const float tol = k == 1 ? 1e-4f : (k == 17 || k == 18 || k == 21) ? 3e-2f : k == 19 ? 0.12f : (k == 20 || k == 22 || k == 23) ? 0.1f : 2e-2f;
            if (!(err <= tol)) { out[0] = (float)k * 1.0e4f; return; } }
        out[0] = 7.7e7f; }
    else { const float num = diag[2 * sel], den = diag[2 * sel + 1]; const float err = (sel == 19) ? num / den : sqrtf(num / den); out[0] = err * 1.0e6f; }
}
}
#endif

extern "C" void kernel_launch(void* const* d_in, const int* in_sizes, int n_in, void* d_out, int out_size, void* d_ws, size_t ws_size, hipStream_t stream) {
    static int grid = 0;
    if (grid == 0) {
        int dev = 0, cus = 0;
        if (hipGetDevice(&dev) != hipSuccess || hipDeviceGetAttribute(&cus, hipDeviceAttributeMultiprocessorCount, dev) != hipSuccess) { fprintf(stderr, "kernel_launch: device query failed\n"); grid = -1; return; }
        if (hipFuncSetAttribute((const void*)mk_fwd, hipFuncAttributeMaxDynamicSharedMemorySize, LDS_BYTES) != hipSuccess) { fprintf(stderr, "kernel_launch: hipFuncSetAttribute failed\n"); grid = -1; return; }
        int per_cu = 0;
        if (hipOccupancyMaxActiveBlocksPerMultiprocessor(&per_cu, (const void*)mk_fwd, 512, LDS_BYTES) != hipSuccess || per_cu < 1) fprintf(stderr, "kernel_launch: occupancy query reports %d\n", per_cu);
        (void)hipGetLastError();
        grid = cus;
    }
    if (grid < 0) return;
    unsigned char* ws = (unsigned char*)d_ws;
#if DBG
    {
        ref::In I;
        I.x = (const float*)d_in[0]; I.c = (const float*)d_in[1]; I.pos = (const int*)d_in[2]; I.w_ada = (const float*)d_in[3]; I.b_ada = (const float*)d_in[4];
        I.g_pre = (const float*)d_in[5]; I.g_post = (const float*)d_in[6]; I.w_in = (const float*)d_in[7]; I.pe_ck = (const float*)d_in[8]; I.pe_cv = (const float*)d_in[9];
        I.w_ck1 = (const float*)d_in[10]; I.w_ck2 = (const float*)d_in[11]; I.w_cv1 = (const float*)d_in[12]; I.w_cv2 = (const float*)d_in[13];
        I.w_br_a = (const float*)d_in[14]; I.w_br_b = (const float*)d_in[15]; I.w_out = (const float*)d_in[16];
        ref::Bufs B = ref::carve((char*)d_ws);
        ref::run_ada(I, B, stream);
        ref::run_batch(I, B, dbg::BD, (float*)d_out, stream);
        unsigned char* E = ws + WS_DBG;
        dbg::k_f2b<<<2048, 256, 0, stream>>>(B.proj, (bf16_t*)(E + dbg::E_PROJ), (size_t)2048 * NIN);
        dbg::k_copy<<<64, 256, 0, stream>>>(B.kc, (float*)(E + dbg::E_KC), 512 * 64); dbg::k_copy<<<64, 256, 0, stream>>>(B.vc, (float*)(E + dbg::E_VC), 512 * 64);
        dbg::k_copy<<<32, 256, 0, stream>>>((const float*)B.selmask, (float*)(E + dbg::E_SEL), 2048 * 4);
        dbg::k_copy<<<1024, 256, 0, stream>>>(B.Aa, (float*)(E + dbg::E_AA), (size_t)2048 * 1024); dbg::k_copy<<<1024, 256, 0, stream>>>(B.Ab, (float*)(E + dbg::E_AB), (size_t)2048 * 1024);
        dbg::k_copy<<<1024, 256, 0, stream>>>(B.mg, (float*)(E + dbg::E_MG), (size_t)2048 * 2048); dbg::k_copy<<<1024, 256, 0, stream>>>(B.of, (float*)(E + dbg::E_OF), (size_t)2048 * 2048);
        dbg::k_copy<<<64, 256, 0, stream>>>(B.ada, (float*)(E + dbg::E_ADA), 8 * 6144);
        (void)hipMemsetAsync(E + dbg::DIAG, 0, 4096, stream);
    }
#endif
    if (hipMemsetAsync(ws + WS_CTL, 0, CTL_ZERO_BYTES, stream) != hipSuccess) { fprintf(stderr, "kernel_launch: memset failed\n"); return; }
    Args a{};
    for (int i = 0; i < 17; ++i) a.in[i] = d_in[i];
    a.out = (float*)d_out; a.ws = ws;
#if ONE_LAUNCH
    a.ph_lo = 0; a.ph_hi = NPHASE;
    { void* kargs[] = {&a}; const hipError_t e = hipLaunchCooperativeKernel((const void*)mk_fwd, dim3(grid), dim3(512), kargs, LDS_BYTES, stream);
      if (e != hipSuccess) fprintf(stderr, "kernel_launch: cooperative launch failed: %s (grid %d)\n", hipGetErrorString(e), grid); }
#else
    for (int p = 0; p < NPHASE && p <= DBG_STOP; ++p) { a.ph_lo = p; a.ph_hi = p + 1; hipLaunchKernelGGL(mk_fwd, dim3(grid), dim3(512), LDS_BYTES, stream, a); }
#endif
#if DBG
    {
        unsigned char* E = ws + WS_DBG; float* diag = (float*)(E + dbg::DIAG); const bf16_t* EP = (const bf16_t*)(E + dbg::E_PROJ);
        const size_t r0 = (size_t)dbg::BD * 2048;
#define CMPB(id, fastptr, ldf, ecol, cols, XF, fs) dbg::k_cmp<bf16_t, bf16_t, XF><<<512, 256, 0, stream>>>((const bf16_t*)(fastptr) + r0 * (ldf), ldf, EP + (ecol), NIN, 2048, cols, fs, diag + 2 * (id))
        dbg::k_cmp<float, float, 0><<<64, 256, 0, stream>>>((const float*)(ws + WS_ADA), 6144, (const float*)(E + dbg::E_ADA), 6144, 8, 6144, 1.f, diag + 2 * 1);
        CMPB(2, ws + WS_QA, 1024, ref::C_QA, 1024, 0, 1.f / QS64);
        CMPB(3, ws + WS_KC + 0 * 8 * MiB, 256, ref::C_KC, 256, 0, 1.f); CMPB(4, ws + WS_KC + 1 * 8 * MiB, 256, ref::C_VC, 256, 0, 1.f); CMPB(5, ws + WS_KC + 2 * 8 * MiB, 256, ref::C_KS, 256, 0, 1.f);
        CMPB(6, ws + WS_KC + 3 * 8 * MiB, 256, ref::C_VS, 256, 0, 1.f); CMPB(7, ws + WS_KC + 4 * 8 * MiB, 256, ref::C_KW, 256, 0, 1.f); CMPB(8, ws + WS_KC + 5 * 8 * MiB, 256, ref::C_VW, 256, 0, 1.f);
        CMPB(9, ws + WS_ZA, 1024, ref::C_ZA, 1024, 1, 1.f);
        if (DBG_STOP < 5) { CMPB(10, ws + WS_QB, 1024, ref::C_QB, 1024, 0, 1.f / QS128); CMPB(11, ws + WS_KB, 1024, ref::C_KB, 1024, 0, 1.f); }
        if (DBG_STOP < 6) { CMPB(14, (unsigned char*)d_out + DO_MA, 2048, ref::C_MA, 2048, 2, 1.f); CMPB(15, (unsigned char*)d_out + DO_MB, 2048, ref::C_MB, 2048, 2, 1.f); }
        if (DBG_STOP == 6) dbg::k_cmp<float, float, 0><<<512, 256, 0, stream>>>((const float*)d_out + r0 * 2048, 2048, (const float*)(E + dbg::E_OF), 2048, 2048, 2048, 1.f, diag + 2 * 23);
        CMPB(12, ws + WS_VB, 1024, ref::C_VB, 1024, 0, 1.f); CMPB(13, ws + WS_ZB, 1024, ref::C_ZB, 1024, 1, 1.f);
        CMPB(16, ws + WS_GA, 64, ref::C_GA, 48, 2, 1.f);
        if (DBG_STOP >= 3) {
        dbg::k_cmp<bf16_t, float, 0><<<64, 256, 0, stream>>>((const bf16_t*)(ws + WS_KCC) + (size_t)dbg::BD * 512 * 64, 64, (const float*)(E + dbg::E_KC), 64, 512, 64, 1.f, diag + 2 * 17);
        dbg::k_cmp<bf16_t, float, 0><<<64, 256, 0, stream>>>((const bf16_t*)(ws + WS_VCC) + (size_t)dbg::BD * 512 * 64, 64, (const float*)(E + dbg::E_VC), 64, 512, 64, 1.f, diag + 2 * 18); }
        if (DBG_STOP >= 4) {
        dbg::k_cmp_sel<<<32, 256, 0, stream>>>((const unsigned*)(E + dbg::SELOUT) + r0 * 4, (const unsigned*)(E + dbg::E_SEL), diag + 2 * 19);
        dbg::k_cmp<bf16_t, float, 0><<<512, 256, 0, stream>>>((const bf16_t*)(ws + WS_XN) + r0 * 2048, 2048, (const float*)(E + dbg::E_AA), 1024, 2048, 1024, 1.f, diag + 2 * 20);
        dbg::k_cmp<bf16_t, float, 0><<<512, 256, 0, stream>>>((const bf16_t*)(ws + WS_XN) + r0 * 2048 + 1024, 2048, (const float*)(E + dbg::E_AB), 1024, 2048, 1024, 1.f, diag + 2 * 21); }
        if (DBG_STOP >= 5)
        dbg::k_cmp<bf16_t, float, 0><<<512, 256, 0, stream>>>((const bf16_t*)(ws + WS_MERGED) + r0 * 2048, 2048, (const float*)(E + dbg::E_MG), 2048, 2048, 2048, 1.f, diag + 2 * 22);
#undef CMPB
        dbg::k_report<<<1, 64, 0, stream>>>(diag, (float*)d_out, DBG_SEL);
    }
#endif
}
```

```cpp
#define DBG 0
#define DBG_BATCH 5
#define DBG_SEL 0
#define ONE_LAUNCH 1
#define DBG_STOP 7
#define REP_MASK 0
#define STAMP 0
#define STAMP_A 0
#define STAMP_B 8
#define MAN_PV 1
#define NSA_QUEUE 1
#define MIX_QUEUE 1
#define MAX_STRIDE 16
#include <hip/hip_runtime.h>
#include <hip/hip_cooperative_groups.h>
#include <cmath>
#include <cstdio>
#include <cstdint>

constexpr int NB = 8, SEQ = 2048, DM = 2048, MTOK = NB * SEQ;
constexpr int NIN = 11824, NINP = 12032;
constexpr float LOG2E = 1.4426950408889634f;
constexpr float QS64 = 0.125f * LOG2E, QS128 = 0.08838834764831845f * LOG2E;
constexpr size_t MiB = 1u << 20;
constexpr size_t WS_CTL = 0, CTL_ZERO_BYTES = 1 * MiB;
constexpr size_t WS_ADA = 1 * MiB;
constexpr size_t WS_R64 = 2 * MiB;
constexpr size_t WS_R128 = 3 * MiB;
constexpr size_t WS_BIAS1 = 5 * MiB;
constexpr size_t WS_SSQ = 6 * MiB;
constexpr size_t WS_KCC = 8 * MiB, WS_VCC = 8 * MiB + 512 * 1024;
constexpr size_t WS_W2T = 9 * MiB;
constexpr size_t WS_W1T = 10 * MiB;
constexpr size_t WS_GA = 12 * MiB;
constexpr size_t WS_WBRT = 16 * MiB, WS_WOUTT = 24 * MiB;
constexpr size_t WS_WINT = 32 * MiB;
constexpr size_t WS_XN = 80 * MiB;
constexpr size_t WS_QA = 144 * MiB;
constexpr size_t WS_KC = 176 * MiB;
constexpr size_t WS_ZA = 224 * MiB, WS_QB = 256 * MiB, WS_KB = 288 * MiB, WS_VB = 320 * MiB, WS_ZB = 352 * MiB;
constexpr size_t WS_MERGED = 256 * MiB;
#if DBG
constexpr size_t WS_A2 = WS_XN;
#else
constexpr size_t WS_A2 = 384 * MiB;
#endif
constexpr size_t WS_END = 448 * MiB;
constexpr size_t WS_DBG = 384 * MiB;
constexpr size_t DO_MA = 0, DO_MB = 64 * MiB;

typedef unsigned short bf16_t;
#define LAS __attribute__((address_space(3)))
#define GAS __attribute__((address_space(1)))
typedef unsigned u32x4_t __attribute__((ext_vector_type(4)));
typedef unsigned u32x2_t __attribute__((ext_vector_type(2)));
typedef float f32x4_t __attribute__((ext_vector_type(4)));

__device__ __forceinline__ unsigned f2bf(float f) { unsigned u = __builtin_bit_cast(unsigned, f); return (u + 0x7fffu + ((u >> 16) & 1u)) >> 16; }
__device__ __forceinline__ unsigned pk2(float lo, float hi) { return f2bf(lo) | (f2bf(hi) << 16); }
__device__ __forceinline__ float bf2f(unsigned short h) { return __builtin_bit_cast(float, (unsigned)h << 16); }
__device__ __forceinline__ float bflo(unsigned w) { return __builtin_bit_cast(float, w << 16); }
__device__ __forceinline__ float bfhi(unsigned w) { return __builtin_bit_cast(float, w & 0xffff0000u); }
__device__ __forceinline__ float fast_sigmoid(float x) { return __builtin_amdgcn_rcpf(1.f + __builtin_amdgcn_exp2f(-x * LOG2E)); }
namespace pg8 {
#define PG8_LAS __attribute__((address_space(3)))
typedef unsigned short bf16_t;
typedef short bf16x8 __attribute__((ext_vector_type(8)));
typedef float f32x4 __attribute__((ext_vector_type(4)));
typedef unsigned u32x4 __attribute__((ext_vector_type(4)));
constexpr int BM = 256, BK = 64, HALF = 128, HTB = HALF * BK * 2  , STAGE_BYTES = 8 * HTB, NXCD = 8, WGM = 8;

__host__ __device__ __forceinline__ int lds_byte(int r, int c) { const int st = (r >> 4) * 2 + (c >> 5), rr = r & 15, cc = c & 31, ob = rr * 64 + cc * 2; return st * 1024 + (ob ^ (((ob >> 9) & 1) << 5)); }
__host__ __device__ __forceinline__ void stage_rc(int b, int& R, int& C) { const int st = b / 1024, sb = b % 1024, swz = sb ^ (((sb >> 9) & 1) << 5); R = (st >> 1) * 16 + swz / 64; C = (st & 1) * 32 + (swz % 64) / 2; }
__host__ __device__ __forceinline__ int perm32(int rho) { const int n = rho >> 4, i = rho & 15; return 8 * (i >> 2) + 4 * n + (i & 3); }

struct Unit { int pm, pn; };
struct Gemm { const bf16_t* A; const bf16_t* Bt; int M, N, K; };

struct StaticOrder {
    int nM, nN, nwg, G, c;
    __host__ __device__ void init(int M, int N, int G_, int c_) { nM = M / BM; nN = N / BM; nwg = nM * nN; G = G_; c = c_; }
    __host__ __device__ bool next(int i, Unit& u) const {
        const long L = (long)i * G + c; if (L >= nwg) return false;
        int wgid = (int)L; { const int q = nwg / NXCD, r = nwg % NXCD, xcd = wgid % NXCD, off = wgid / NXCD; wgid = (xcd < r ? xcd * (q + 1) : r * (q + 1) + (xcd - r) * q) + off; }
        const int nig = WGM * nN, gid = wgid / nig, fm = gid * WGM, gsz = (nM - fm) < WGM ? (nM - fm) : WGM;
        u.pm = fm + ((wgid % nig) % gsz); u.pn = (wgid % nig) / gsz; return true;
    }
    __device__ __forceinline__ void a_ready(const Unit&) const {}
    __device__ __forceinline__ void done(const Unit&) const {}
};
struct ProjOrder {
    int nM, nN, nwg, G, c, i0, i1;
    static constexpr int NFIRST = 18;
    __host__ __device__ void init(int M, int N, int G_, int c_) { nM = M / BM; nN = N / BM; nwg = nM * nN; G = G_; c = c_; i0 = 0; i1 = 1 << 30; }
    __host__ __device__ static int perm(int i) { return i < 2 ? 4 + i : i < 18 ? 12 + i : i < 22 ? i - 18 : i < 26 ? i - 16 : i < 30 ? i - 16 : i; }
    __host__ __device__ bool decode(int i, int& pm, int& pi) const {
        const long L = (long)i * G + c; if (L >= nwg) return false;
        int wgid = (int)L; { const int q = nwg / NXCD, r = nwg % NXCD, xcd = wgid % NXCD, off = wgid / NXCD; wgid = (xcd < r ? xcd * (q + 1) : r * (q + 1) + (xcd - r) * q) + off; }
        const int nig = WGM * nN, gid = wgid / nig, fm = gid * WGM, gsz = (nM - fm) < WGM ? (nM - fm) : WGM;
        pm = fm + ((wgid % nig) % gsz); pi = (wgid % nig) / gsz; return true; }
    __host__ __device__ int count_first() const { int n = 0, pm, pi; while (decode(n, pm, pi) && pi < NFIRST) ++n; return n; }
    __host__ __device__ bool next(int i, Unit& u) const { int pi; if (i0 + i >= i1 || !decode(i0 + i, u.pm, pi)) return false; u.pn = perm(pi); return true; }
    __device__ __forceinline__ void a_ready(const Unit&) const {}
    __device__ __forceinline__ void done(const Unit&) const {}
};

typedef float f32x2_cv __attribute__((ext_vector_type(2))); typedef __bf16 bf16x2_cv __attribute__((ext_vector_type(2)));
__device__ __forceinline__ unsigned cvt_pk_bf16(float lo, float hi) { f32x2_cv v = {lo, hi}; bf16x2_cv b = __builtin_convertvector(v, bf16x2_cv); return __builtin_bit_cast(unsigned, b); }

struct EpiProj {
    static constexpr bool PERM = true, AFTER_DRAIN = false, MIDHOOK = false;
    unsigned char* ws; unsigned char* dout; const float* r64; const float* r128;
    __device__ __forceinline__ void mid(f32x4 (&)[2][2][4][2], const Unit&, int, int, int, int) const {}
    __device__ __forceinline__ void operator()(const f32x4 (&acc)[2][2][4][2], const Unit& u, int wr, int wc, int fr, int fq) const {
        const int pn = u.pn;
        bf16_t* base; int ldc, colt, mode; float sc = 1.f;
        if (pn < 4)       { base = (bf16_t*)(ws + WS_QA); ldc = 1024; colt = 256 * pn; mode = 1; sc = QS64; }
        else if (pn < 10) { base = (bf16_t*)(ws + WS_KC + (size_t)(pn - 4) * 8 * MiB); ldc = 256; colt = 0; mode = (pn == 6 || pn == 8) ? 1 : 0; }
        else if (pn < 14) { base = (bf16_t*)(ws + WS_ZA); ldc = 1024; colt = 256 * (pn - 10); mode = 3; }
        else if (pn < 18) { base = (bf16_t*)(ws + WS_QB); ldc = 1024; colt = 256 * (pn - 14); mode = 2; sc = QS128; }
        else if (pn < 22) { base = (bf16_t*)(ws + WS_KB); ldc = 1024; colt = 256 * (pn - 18); mode = 2; }
        else if (pn < 26) { base = (bf16_t*)(ws + WS_VB); ldc = 1024; colt = 256 * (pn - 22); mode = 0; }
        else if (pn < 30) { base = (bf16_t*)(ws + WS_ZB); ldc = 1024; colt = 256 * (pn - 26); mode = 3; }
        else if (pn < 38) { base = (bf16_t*)(dout + DO_MA); ldc = 2048; colt = 256 * (pn - 30); mode = 4; }
        else if (pn < 46) { base = (bf16_t*)(dout + DO_MB); ldc = 2048; colt = 256 * (pn - 38); mode = 4; }
        else              { base = (bf16_t*)(ws + WS_GA); ldc = 64; colt = 0; mode = 5; }
        const int row0 = u.pm * BM + wr * 64 + fr;
        const int cb = wc * 32 + 8 * fq;
        const bool rope_wave = (mode == 1 && (wc & 1) == 0) || (mode == 2 && wc == 0);
#pragma unroll
        for (int ai = 0; ai < 2; ++ai)
#pragma unroll
            for (int m = 0; m < 4; ++m) {
                const int row = row0 + ai * HALF + m * 16;
                float v2[2][8];
#pragma unroll
                for (int bj = 0; bj < 2; ++bj)
#pragma unroll
                    for (int j = 0; j < 4; ++j) { v2[bj][j] = acc[ai][bj][m][0][j]; v2[bj][4 + j] = acc[ai][bj][m][1][j]; }
                if (rope_wave) {
                    float cs[8], sn[8];
                    if (mode == 1) { const f32x4* t = (const f32x4*)(r64 + (size_t)row * 16); const f32x4 c0 = t[0], c1 = t[1], s0 = t[2], s1 = t[3];
#pragma unroll
                        for (int j = 0; j < 4; ++j) { cs[j] = c0[j]; cs[4 + j] = c1[j]; sn[j] = s0[j]; sn[4 + j] = s1[j]; } }
                    else { const f32x4* t = (const f32x4*)(r128 + (size_t)row * 32 + 8 * (fq & 1)); const f32x4 c0 = t[0], c1 = t[1], s0 = t[4], s1 = t[5];
#pragma unroll
                        for (int j = 0; j < 4; ++j) { cs[j] = c0[j]; cs[4 + j] = c1[j]; sn[j] = s0[j]; sn[4 + j] = s1[j]; } }
                    const int xm = (mode == 1) ? 16 : 32;
                    const bool is_x1 = (mode == 1) ? (fq == 0) : (fq < 2);
                    const bool do_rot = (mode == 1) ? (fq < 2) : true;
#pragma unroll
                    for (int bj = 0; bj < 2; ++bj)
#pragma unroll
                        for (int j = 0; j < 8; ++j) { const float p = __shfl_xor(v2[bj][j], xm); const float r = v2[bj][j] * cs[j] + (is_x1 ? -p : p) * sn[j]; v2[bj][j] = do_rot ? r : v2[bj][j]; }
                }
#pragma unroll
                for (int bj = 0; bj < 2; ++bj) {
                    float v[8];
#pragma unroll
                    for (int j = 0; j < 8; ++j) v[j] = v2[bj][j];
                    if (mode == 3) {
#pragma unroll
                        for (int j = 0; j < 8; ++j) v[j] = v[j] * fast_sigmoid(v[j]);
                    } else if (mode >= 4) {
#pragma unroll
                        for (int j = 0; j < 8; ++j) v[j] = fast_sigmoid(v[j]);
                    } else {
#pragma unroll
                        for (int j = 0; j < 8; ++j) v[j] *= sc;
                    }
                    u32x4 w; w.x = cvt_pk_bf16(v[0], v[1]); w.y = cvt_pk_bf16(v[2], v[3]); w.z = cvt_pk_bf16(v[4], v[5]); w.w = cvt_pk_bf16(v[6], v[7]);
                    const int col = cb + bj * HALF;
                    if (mode != 5 || col < 48) *(u32x4*)(base + (size_t)row * ldc + colt + col) = w;
                }
            }
    }
};

struct EpiMerge {
    static constexpr bool PERM = true, AFTER_DRAIN = false, MIDHOOK = true;
    const bf16_t* sma; const bf16_t* smb; bf16_t* out;
    __device__ __forceinline__ void mid(f32x4 (&acc)[2][2][4][2], const Unit& u, int wr, int wc, int fr, int fq) const {
        asm volatile("" : "+v"(fr), "+v"(fq));
        const int row0 = u.pm * BM + wr * 64 + fr, col0 = u.pn * BM + wc * 32 + 8 * fq;
#pragma unroll
        for (int ai = 0; ai < 2; ++ai)
#pragma unroll
            for (int m = 0; m < 4; ++m)
#pragma unroll
                for (int bj = 0; bj < 2; ++bj) { const size_t off = (size_t)(row0 + ai * HALF + m * 16) * 2048 + col0 + bj * HALF;
                    const u32x4 a = *(const u32x4*)(sma + off), b = *(const u32x4*)(smb + off);
#pragma unroll
                    for (int q = 0; q < 4; ++q) { const float a0 = bflo(a[q]), a1 = bfhi(a[q]), b0 = bflo(b[q]), b1 = bfhi(b[q]);
                        acc[ai][bj][m][q >> 1][(q & 1) * 2 + 0] *= a0 * __builtin_amdgcn_rcpf(b0); acc[ai][bj][m][q >> 1][(q & 1) * 2 + 1] *= a1 * __builtin_amdgcn_rcpf(b1); }
                    if (bj == 1) asm volatile("" ::: "memory"); }
    }
    __device__ __forceinline__ void operator()(const f32x4 (&acc)[2][2][4][2], const Unit& u, int wr, int wc, int fr, int fq) const {
        const int row0 = u.pm * BM + wr * 64 + fr, col0 = u.pn * BM + wc * 32 + 8 * fq;
#pragma unroll
        for (int ai = 0; ai < 2; ++ai)
#pragma unroll
            for (int m = 0; m < 4; ++m)
#pragma unroll
                for (int bj = 0; bj < 2; ++bj) { const size_t off = (size_t)(row0 + ai * HALF + m * 16) * 2048 + col0 + bj * HALF;
                    const u32x4 b = *(const u32x4*)(smb + off); u32x4 w;
#pragma unroll
                    for (int q = 0; q < 4; ++q) w[q] = cvt_pk_bf16(acc[ai][bj][m][q >> 1][(q & 1) * 2 + 0] * bflo(b[q]), acc[ai][bj][m][q >> 1][(q & 1) * 2 + 1] * bfhi(b[q]));
                    *(u32x4*)(out + off) = w; if (bj == 1) asm volatile("" ::: "memory"); }
    }
};

struct EpiOut {
    static constexpr bool PERM = false, AFTER_DRAIN = false, MIDHOOK = false;
    float* C; float* ssq;
    __device__ __forceinline__ void mid(f32x4 (&)[2][2][4][2], const Unit&, int, int, int, int) const {}
    __device__ __forceinline__ void operator()(const f32x4 (&acc)[2][2][4][2], const Unit& u, int wr, int wc, int fr, int fq) const {
        const int row0 = u.pm * BM + wr * 64 + fr, col0 = u.pn * BM + wc * 32 + 4 * fq;
#pragma unroll
        for (int ai = 0; ai < 2; ++ai)
#pragma unroll
            for (int m = 0; m < 4; ++m) { const int row = row0 + ai * HALF + m * 16; float* rowp = C + (size_t)row * 2048 + col0; float s = 0.f;
#pragma unroll
                for (int bj = 0; bj < 2; ++bj)
#pragma unroll
                    for (int n = 0; n < 2; ++n) { const f32x4 x = acc[ai][bj][m][n]; *(f32x4*)(rowp + bj * HALF + n * 16) = x; s += (x[0] * x[0] + x[1] * x[1]) + (x[2] * x[2] + x[3] * x[3]); }
                s += __shfl_xor(s, 16); s += __shfl_xor(s, 32);
                if (fq == 0) ssq[(size_t)row * 32 + u.pn * 4 + wc] = s; }
    }
};

struct EpiOutB {
    static constexpr bool PERM = true, AFTER_DRAIN = false, MIDHOOK = false;
    bf16_t* C; float* ssq;
    __device__ __forceinline__ void mid(f32x4 (&)[2][2][4][2], const Unit&, int, int, int, int) const {}
    __device__ __forceinline__ void operator()(const f32x4 (&acc)[2][2][4][2], const Unit& u, int wr, int wc, int fr, int fq) const {
        const int row0 = u.pm * BM + wr * 64 + fr, col0 = u.pn * BM + wc * 32 + 8 * fq;
#pragma unroll
        for (int ai = 0; ai < 2; ++ai)
#pragma unroll
            for (int m = 0; m < 4; ++m) { const int row = row0 + ai * HALF + m * 16; bf16_t* rowp = C + (size_t)row * 2048 + col0; float s = 0.f;
#pragma unroll
                for (int bj = 0; bj < 2; ++bj) { const f32x4 x0 = acc[ai][bj][m][0], x1 = acc[ai][bj][m][1];
                    s += ((x0[0] * x0[0] + x0[1] * x0[1]) + (x0[2] * x0[2] + x0[3] * x0[3])) + ((x1[0] * x1[0] + x1[1] * x1[1]) + (x1[2] * x1[2] + x1[3] * x1[3]));
                    u32x4 w; w.x = cvt_pk_bf16(x0[0], x0[1]); w.y = cvt_pk_bf16(x0[2], x0[3]); w.z = cvt_pk_bf16(x1[0], x1[1]); w.w = cvt_pk_bf16(x1[2], x1[3]);
                    *(u32x4*)(rowp + bj * HALF) = w; }
                s += __shfl_xor(s, 16); s += __shfl_xor(s, 32);
                if (fq == 0) ssq[(size_t)row * 32 + u.pn * 4 + wc] = s; }
    }
};

struct EpiFinal {
    static constexpr bool PERM = false, AFTER_DRAIN = false, MIDHOOK = false;
    const float* x; float* out; float* ssq; unsigned* cnt; const float* ada; const float* gpost;
    __device__ __forceinline__ void mid(f32x4 (&)[2][2][4][2], const Unit&, int, int, int, int) const {}
    __device__ __forceinline__ void operator()(const f32x4 (&acc)[2][2][4][2], const Unit& u, int wr, int wc, int fr, int fq) const {
        const int row0 = u.pm * BM + wr * 64 + fr, col0 = u.pn * BM + wc * 32 + 4 * fq;
#pragma unroll
        for (int ai = 0; ai < 2; ++ai)
#pragma unroll
            for (int m = 0; m < 4; ++m) { const int row = row0 + ai * HALF + m * 16; float s = 0.f;
#pragma unroll
                for (int bj = 0; bj < 2; ++bj)
#pragma unroll
                    for (int n = 0; n < 2; ++n) { const f32x4 v = acc[ai][bj][m][n]; s += (v[0] * v[0] + v[1] * v[1]) + (v[2] * v[2] + v[3] * v[3]); }
                s += __shfl_xor(s, 16); s += __shfl_xor(s, 32);
                if (fq == 0) __hip_atomic_store(ssq + (size_t)row * 32 + u.pn * 4 + wc, s, __ATOMIC_RELAXED, __HIP_MEMORY_SCOPE_AGENT); }
        asm volatile("s_waitcnt vmcnt(0)" ::: "memory");
        unsigned* c = cnt + 64 * u.pm;
        if (fr == 0 && fq == 0) __hip_atomic_fetch_add(c, 1u, __ATOMIC_RELAXED, __HIP_MEMORY_SCOPE_AGENT);
        { unsigned spins = 0;
          while ((unsigned)__builtin_amdgcn_readfirstlane(__hip_atomic_load(c, __ATOMIC_RELAXED, __HIP_MEMORY_SCOPE_AGENT)) < 64u) { __builtin_amdgcn_s_sleep(2); if (++spins > (1u << 22)) break; } }
        const int b = (u.pm * BM) >> 11;
        f32x4 gg[2][2];
#pragma unroll
        for (int bj = 0; bj < 2; ++bj)
#pragma unroll
            for (int n = 0; n < 2; ++n) { const int col = col0 + bj * HALF + n * 16; gg[bj][n] = *(const f32x4*)(ada + b * 6144 + 4096 + col) * *(const f32x4*)(gpost + col); }
#pragma unroll
        for (int ai = 0; ai < 2; ++ai)
#pragma unroll
            for (int m = 0; m < 4; ++m) { const int row = row0 + ai * HALF + m * 16; const float* sp = ssq + (size_t)row * 32 + 8 * fq; float s = 0.f;
#pragma unroll
                for (int q = 0; q < 8; ++q) s += __hip_atomic_load(sp + q, __ATOMIC_RELAXED, __HIP_MEMORY_SCOPE_AGENT);
                s += __shfl_xor(s, 16); s += __shfl_xor(s, 32);
                const float rstd = rsqrtf(s * (1.f / 2048.f) + 1e-6f);
                const float* xr = x + (size_t)row * 2048 + col0; float* orow = out + (size_t)row * 2048 + col0;
#pragma unroll
                for (int bj = 0; bj < 2; ++bj)
#pragma unroll
                    for (int n = 0; n < 2; ++n) { const f32x4 xv = *(const f32x4*)(xr + bj * HALF + n * 16); *(f32x4*)(orow + bj * HALF + n * 16) = xv + gg[bj][n] * (acc[ai][bj][m][n] * rstd); }
                if (m & 1) asm volatile("" ::: "memory"); }
    }
};

struct PanelOrder {
    int nN, nwg, G, v;
    __host__ __device__ void init(int M, int N, int G_, int v_) { nN = N / BM; nwg = (M / BM) * nN; G = G_; v = v_; }
    __host__ __device__ bool next(int i, Unit& u) const { const long L = (long)i * G + v; if (L >= nwg) return false; u.pm = (int)(L / nN); u.pn = (int)(L % nN); return true; }
    __device__ __forceinline__ void a_ready(const Unit&) const {}
    __device__ __forceinline__ void done(const Unit&) const {}
};
template <class Epi, class Sched, bool ALIGN_EPI = false, bool SP2 = false>
__device__ __forceinline__ void gemm_phase(PG8_LAS unsigned char* lds, const Gemm g, const Sched& S, const Epi& E) {
    const int tid = threadIdx.x, wid = __builtin_amdgcn_readfirstlane(tid >> 6), lane = tid & 63, wr = wid >> 2, wc = wid & 3, fr = lane & 15, fq = lane >> 4;
    const int K = g.K, nt = K / BK;
    unsigned voffA[2], voffB[2];
#pragma unroll
    for (int i = 0; i < 2; ++i) { int R, C; stage_rc(tid * 16 + i * 8192, R, C); const int Rb = Epi::PERM ? ((R & ~31) + perm32(R & 31)) : R;
        voffA[i] = (unsigned)(R * K + C) * 2u; voffB[i] = (unsigned)(Rb * K + C) * 2u; }
    const size_t kstep = (size_t)(BK * 2);
    const size_t hstep = (size_t)HALF * K * 2;
    const size_t tstep = 2 * hstep;
    const unsigned ldsw = (unsigned)wid * 1024u;
    const int aoff = lds_byte(wr * 64 + fr, fq * 8), boff = lds_byte(wc * 32 + fr, fq * 8);
#define PG8_SA(b, h) (((b) * 2 + (h)) * HTB)
#define PG8_SB(b, h) ((4 + (b) * 2 + (h)) * HTB)
#define PG8_STAGE(bufoff, gbase, voff) do { _Pragma("unroll") for (int _i = 0; _i < 2; ++_i) \
        __builtin_amdgcn_global_load_lds((const unsigned*)((const char*)(gbase) + (voff)[_i]), (PG8_LAS unsigned*)(lds + (bufoff) + ldsw + _i * 8192), 16, 0, 0); } while (0)
#define PG8_LDA(dst, b, h) do { _Pragma("unroll") for (int m = 0; m < 4; ++m) _Pragma("unroll") for (int k = 0; k < 2; ++k) dst[m][k] = *(const PG8_LAS bf16x8*)(lds + PG8_SA(b, h) + aoff + m * 2048 + k * 1024); } while (0)
#define PG8_LDB(dst, b, h) do { _Pragma("unroll") for (int n = 0; n < 2; ++n) _Pragma("unroll") for (int k = 0; k < 2; ++k) dst[n][k] = *(const PG8_LAS bf16x8*)(lds + PG8_SB(b, h) + boff + n * 2048 + k * 1024); } while (0)
#define PG8_MMA(ai, bj, At, Bt) do { __builtin_amdgcn_s_setprio(1); _Pragma("unroll") for (int m = 0; m < 4; ++m) _Pragma("unroll") for (int n = 0; n < 2; ++n) _Pragma("unroll") for (int k = 0; k < 2; ++k) \
        acc[ai][bj][m][n] = __builtin_amdgcn_mfma_f32_16x16x32_bf16(Bt[n][k], At[m][k], acc[ai][bj][m][n], 0, 0, 0); __builtin_amdgcn_s_setprio(0); } while (0)
#define PG8_WAIT_V(n) asm volatile("s_waitcnt vmcnt(" #n ")" ::: "memory")
#define PG8_WAIT_L(n) asm volatile("s_waitcnt lgkmcnt(" #n ")" ::: "memory")
#define PG8_BAR __builtin_amdgcn_s_barrier()
#define PG8_SCHED __builtin_amdgcn_sched_barrier(0)
    Unit cur, nxt; int ui = 0;
    if (!S.next(0, cur)) return;
    f32x4 acc[2][2][4][2];
#pragma unroll
    for (int a = 0; a < 2; ++a)
#pragma unroll
        for (int b = 0; b < 2; ++b)
#pragma unroll
            for (int m = 0; m < 4; ++m)
#pragma unroll
                for (int n = 0; n < 2; ++n) acc[a][b][m][n] = (f32x4){0.f, 0.f, 0.f, 0.f};
    bf16x8 At[4][2], B0[2][2], B1[2][2];
    const char* cA = (const char*)g.A + (size_t)cur.pm * tstep; const char* cB = (const char*)g.Bt + (size_t)cur.pn * tstep;
    S.a_ready(cur);
    if constexpr (SP2) {
        PG8_STAGE(PG8_SB(0, 0), cB, voffB); PG8_STAGE(PG8_SB(0, 1), cB + hstep, voffB); PG8_STAGE(PG8_SA(0, 0), cA, voffA); PG8_STAGE(PG8_SA(0, 1), cA + hstep, voffA);
        if (wr == 1) PG8_BAR;
        PG8_WAIT_V(2); PG8_BAR;
        PG8_STAGE(PG8_SB(1, 0), cB + kstep, voffB); PG8_STAGE(PG8_SA(1, 0), cA + kstep, voffA); PG8_STAGE(PG8_SB(1, 1), cB + hstep + kstep, voffB);
        PG8_WAIT_V(6); PG8_BAR;
    } else {
        PG8_STAGE(PG8_SB(0, 0), cB, voffB); PG8_STAGE(PG8_SA(0, 0), cA, voffA); PG8_STAGE(PG8_SB(0, 1), cB + hstep, voffB); PG8_STAGE(PG8_SA(0, 1), cA + hstep, voffA);
        if (wr == 1) PG8_BAR;
        PG8_WAIT_V(4); PG8_BAR;
        PG8_STAGE(PG8_SB(1, 0), cB + kstep, voffB); PG8_STAGE(PG8_SA(1, 0), cA + kstep, voffA); PG8_STAGE(PG8_SB(1, 1), cB + hstep + kstep, voffB);
        PG8_WAIT_V(6); PG8_BAR;
    }
    for (;;) {
        const bool has_next = S.next(ui + 1, nxt);
        const char* nA = has_next ? (const char*)g.A + (size_t)nxt.pm * tstep : cA; const char* nB = has_next ? (const char*)g.Bt + (size_t)nxt.pn * tstep : cB;
        for (int t = 0; t < nt; t += 2) {
            const bool last = (t == nt - 2);
            if constexpr (Epi::MIDHOOK) { if (t == nt / 2) E.mid(acc, cur, wr, wc, fr, fq); }
            const char* a1 = cA + (size_t)(t + 1) * kstep;
            const char* a2 = last ? nA : cA + (size_t)(t + 2) * kstep; const char* b2 = last ? nB : cB + (size_t)(t + 2) * kstep;
            const char* a3 = a2 + kstep; const char* b3 = b2 + kstep;
            if (last && has_next) S.a_ready(nxt);
            if constexpr (SP2) {
            PG8_LDB(B0, 0, 0); PG8_LDB(B1, 0, 1); PG8_SCHED; PG8_LDA(At, 0, 0); PG8_STAGE(PG8_SA(1, 1), a1 + hstep, voffA);
            PG8_WAIT_V(8); PG8_WAIT_L(0); PG8_BAR; PG8_MMA(0, 0, At, B0); PG8_MMA(0, 1, At, B1); PG8_BAR; PG8_SCHED;
            PG8_LDA(At, 0, 1); PG8_STAGE(PG8_SB(0, 0), b2, voffB); PG8_STAGE(PG8_SB(0, 1), b2 + hstep, voffB); PG8_STAGE(PG8_SA(0, 0), a2, voffA);
            PG8_WAIT_V(8); PG8_WAIT_L(0); PG8_BAR; PG8_MMA(1, 0, At, B0); PG8_MMA(1, 1, At, B1); PG8_BAR; PG8_SCHED;
            PG8_LDB(B0, 1, 0); PG8_LDB(B1, 1, 1); PG8_SCHED; PG8_LDA(At, 1, 0); PG8_STAGE(PG8_SA(0, 1), a2 + hstep, voffA);
            PG8_WAIT_V(8); PG8_WAIT_L(0); PG8_BAR; PG8_MMA(0, 0, At, B0); PG8_MMA(0, 1, At, B1); PG8_BAR; PG8_SCHED;
            PG8_LDA(At, 1, 1); PG8_STAGE(PG8_SB(1, 0), b3, voffB); PG8_STAGE(PG8_SB(1, 1), b3 + hstep, voffB); PG8_STAGE(PG8_SA(1, 0), a3, voffA);
            PG8_WAIT_V(8); PG8_WAIT_L(0); PG8_BAR; PG8_MMA(1, 0, At, B0); PG8_MMA(1, 1, At, B1); PG8_BAR; PG8_SCHED;
            } else {
            PG8_LDB(B0, 0, 0); PG8_SCHED; PG8_LDA(At, 0, 0); PG8_STAGE(PG8_SA(1, 1), a1 + hstep, voffA);
            PG8_WAIT_L(8); PG8_BAR; PG8_WAIT_L(0); PG8_MMA(0, 0, At, B0); PG8_BAR; PG8_SCHED;
            PG8_LDB(B1, 0, 1); PG8_STAGE(PG8_SB(0, 0), b2, voffB);
            PG8_BAR; PG8_WAIT_L(0); PG8_MMA(0, 1, At, B1); PG8_BAR;
            PG8_LDA(At, 0, 1); PG8_STAGE(PG8_SA(0, 0), a2, voffA);
            PG8_BAR; PG8_WAIT_L(0); PG8_MMA(1, 0, At, B0); PG8_BAR; PG8_SCHED;
            PG8_STAGE(PG8_SB(0, 1), b2 + hstep, voffB);
            PG8_WAIT_V(6); PG8_BAR; PG8_MMA(1, 1, At, B1); PG8_BAR;
            PG8_LDB(B0, 1, 0); PG8_SCHED; PG8_LDA(At, 1, 0); PG8_STAGE(PG8_SA(0, 1), a2 + hstep, voffA);
            PG8_WAIT_L(8); PG8_BAR; PG8_WAIT_L(0); PG8_MMA(0, 0, At, B0); PG8_BAR; PG8_SCHED;
            PG8_LDB(B1, 1, 1); PG8_STAGE(PG8_SB(1, 0), b3, voffB);
            PG8_BAR; PG8_WAIT_L(0); PG8_MMA(0, 1, At, B1); PG8_BAR;
            PG8_LDA(At, 1, 1); PG8_STAGE(PG8_SA(1, 0), a3, voffA);
            PG8_BAR; PG8_WAIT_L(0); PG8_MMA(1, 0, At, B0); PG8_BAR; PG8_SCHED;
            PG8_STAGE(PG8_SB(1, 1), b3 + hstep, voffB);
            PG8_WAIT_V(6); PG8_BAR; PG8_MMA(1, 1, At, B1); PG8_BAR;
            }
        }
        if constexpr (ALIGN_EPI) { if (wr == 0) PG8_BAR; }
        if constexpr (!Epi::AFTER_DRAIN) { E(acc, cur, wr, wc, fr, fq); S.done(cur); }
        if (!has_next) break;
#pragma unroll
        for (int a = 0; a < 2; ++a)
#pragma unroll
            for (int b = 0; b < 2; ++b)
#pragma unroll
                for (int m = 0; m < 4; ++m)
#pragma unroll
                    for (int n = 0; n < 2; ++n) acc[a][b][m][n] = (f32x4){0.f, 0.f, 0.f, 0.f};
        cur = nxt; cA = nA; cB = nB; ++ui;
        if constexpr (ALIGN_EPI) { if (wr == 1) PG8_BAR; }
    }
    PG8_WAIT_V(0);
    if constexpr (!ALIGN_EPI) { if (wr == 0) PG8_BAR; }
    PG8_BAR;
    if constexpr (Epi::AFTER_DRAIN) { E.fused(acc, cur, wr, wc, fr, fq, lds, wid, lane); S.done(cur); }
#undef PG8_SA
#undef PG8_SB
#undef PG8_STAGE
#undef PG8_LDA
#undef PG8_LDB
#undef PG8_MMA
#undef PG8_WAIT_V
#undef PG8_WAIT_L
#undef PG8_BAR
#undef PG8_SCHED
}
}

namespace att {
typedef short bf16x8 __attribute__((ext_vector_type(8)));
typedef short s16x4 __attribute__((ext_vector_type(4)));
typedef short v4i16_t __attribute__((ext_vector_type(4)));
typedef float f32x16 __attribute__((ext_vector_type(16)));
constexpr float NEGINF = -__builtin_inff();

constexpr int L_K0 = 0, L_K1 = 16384, L_V0 = 32768, L_V1 = 49152;
template <int D> struct Tile { u32x4_t k[D / 64]; u32x4_t v[D / 64]; };
template <int D> __device__ __forceinline__ void tile_load(Tile<D>& T, const bf16_t* Kp, const bf16_t* Vp, int pitch, int wid, int lane) {
#pragma unroll
    for (int i = 0; i < D / 64; ++i) { const int pc = wid + 8 * i;
        T.k[i] = *(const u32x4_t*)(Kp + (size_t)lane * pitch + pc * 8);
        T.v[i] = *(const u32x4_t*)(Vp + (size_t)(16 * (pc & 3) + (lane >> 2)) * pitch + 32 * (pc >> 2) + 8 * (lane & 3)); }
}
template <int D> __device__ __forceinline__ void tile_store(const Tile<D>& T, LAS unsigned char* kbuf, LAS unsigned char* vbuf, int wid, int lane) {
#pragma unroll
    for (int i = 0; i < D / 64; ++i) { const int pc = wid + 8 * i;
        *(LAS u32x4_t*)(kbuf + pc * 1024 + lane * 16) = T.k[i]; *(LAS u32x4_t*)(vbuf + pc * 1024 + lane * 16) = T.v[i]; }
}
template <int D> __device__ __forceinline__ void k_load(Tile<D>& T, const bf16_t* Kp, int pitch, int wid, int lane) {
#pragma unroll
    for (int i = 0; i < D / 64; ++i) T.k[i] = *(const u32x4_t*)(Kp + (size_t)lane * pitch + (wid + 8 * i) * 8);
}
template <int D> __device__ __forceinline__ void v_load(Tile<D>& T, const bf16_t* Vp, int pitch, int wid, int lane) {
#pragma unroll
    for (int i = 0; i < D / 64; ++i) { const int pc = wid + 8 * i; T.v[i] = *(const u32x4_t*)(Vp + (size_t)(16 * (pc & 3) + (lane >> 2)) * pitch + 32 * (pc >> 2) + 8 * (lane & 3)); }
}
template <int D> __device__ __forceinline__ void k_store(const Tile<D>& T, LAS unsigned char* kbuf, int wid, int lane) {
#pragma unroll
    for (int i = 0; i < D / 64; ++i) *(LAS u32x4_t*)(kbuf + (wid + 8 * i) * 1024 + lane * 16) = T.k[i];
}
template <int D> __device__ __forceinline__ void v_store(const Tile<D>& T, LAS unsigned char* vbuf, int wid, int lane) {
#pragma unroll
    for (int i = 0; i < D / 64; ++i) *(LAS u32x4_t*)(vbuf + (wid + 8 * i) * 1024 + lane * 16) = T.v[i];
}
template <int D> __device__ __forceinline__ void qkt(f32x16& p0, f32x16& p1, const LAS unsigned char* kbuf, const bf16x8* qr, int r32, int hi) {
    p0 = f32x16{}; p1 = f32x16{};
    const LAS unsigned char* kb = kbuf + hi * 1024 + r32 * 16;
#pragma unroll
    for (int d0 = 0; d0 < D / 16; ++d0) {
        const bf16x8 b0 = *(const LAS bf16x8*)(kb + d0 * 2048), b1 = *(const LAS bf16x8*)(kb + d0 * 2048 + 512);
        p0 = __builtin_amdgcn_mfma_f32_32x32x16_bf16(b0, qr[d0], p0, 0, 0, 0);
        p1 = __builtin_amdgcn_mfma_f32_32x32x16_bf16(b1, qr[d0], p1, 0, 0, 0); }
}
__device__ __forceinline__ s16x4 vtr(const LAS unsigned char* p) { return __builtin_bit_cast(s16x4, __builtin_amdgcn_ds_read_tr16_b64_v4i16((LAS v4i16_t*)p)); }
template <int D> __device__ __forceinline__ void pv(f32x16* o, const LAS unsigned char* vbuf, const bf16x8* pa, int lane) {
    const LAS unsigned char* vb = vbuf + ((lane >> 4) & 1) * 32 + (lane & 3) * 8 + (4 * (lane >> 5) + ((lane & 15) >> 2)) * 64;
#pragma unroll
    for (int dp = 0; dp < D / 64; ++dp) {
        s16x4 lo[2][4], hh[2][4];
#pragma unroll
        for (int e = 0; e < 2; ++e)
#pragma unroll
            for (int ks = 0; ks < 4; ++ks) { lo[e][ks] = vtr(vb + (2 * dp + e) * 4096 + ks * 1024); hh[e][ks] = vtr(vb + (2 * dp + e) * 4096 + ks * 1024 + 512); }
        __builtin_amdgcn_sched_barrier(0);
#pragma unroll
        for (int e = 0; e < 2; ++e)
#pragma unroll
            for (int ks = 0; ks < 4; ++ks) { const bf16x8 vf = {lo[e][ks][0], lo[e][ks][1], lo[e][ks][2], lo[e][ks][3], hh[e][ks][0], hh[e][ks][1], hh[e][ks][2], hh[e][ks][3]};
                o[2 * dp + e] = __builtin_amdgcn_mfma_f32_32x32x16_bf16(vf, pa[ks], o[2 * dp + e], 0, 0, 0); }
    }
}
__device__ __forceinline__ float xhalf_max(float v) { auto rr = __builtin_amdgcn_permlane32_swap(__float_as_uint(v), __float_as_uint(v), false, false); return fmaxf(__uint_as_float(rr[0]), __uint_as_float(rr[1])); }
__device__ __forceinline__ float xhalf_sum(float v) { auto rr = __builtin_amdgcn_permlane32_swap(__float_as_uint(v), __float_as_uint(v), false, false); return __uint_as_float(rr[0]) + __uint_as_float(rr[1]); }
typedef float f32x2_cv __attribute__((ext_vector_type(2))); typedef __bf16 bf16x2_cv __attribute__((ext_vector_type(2)));
__device__ __forceinline__ unsigned cvtpk(float lo, float hi) { f32x2_cv v = {lo, hi}; bf16x2_cv b = __builtin_convertvector(v, bf16x2_cv); return __builtin_bit_cast(unsigned, b); }
__device__ __forceinline__ bf16x8 pack8(const f32x16& p, int b) { u32x4_t w = {cvtpk(p[b], p[b + 1]), cvtpk(p[b + 2], p[b + 3]), cvtpk(p[b + 4], p[b + 5]), cvtpk(p[b + 6], p[b + 7])}; return __builtin_bit_cast(bf16x8, w); }
__device__ __forceinline__ float rowmax32(const f32x16& p0, const f32x16& p1) {
    float a = fmaxf(p0[0], p1[0]);
#pragma unroll
    for (int r = 1; r < 16; ++r) a = fmaxf(a, fmaxf(p0[r], p1[r]));
    return xhalf_max(a);
}
__device__ __forceinline__ void mask_band(f32x16& p0, f32x16& p1, int dq, unsigned band) {
#pragma unroll
    for (int r = 0; r < 16; ++r) { const int c = (r & 3) + 8 * (r >> 2);
        if ((unsigned)(dq - c) > band) p0[r] = NEGINF;
        if ((unsigned)(dq - c - 32) > band) p1[r] = NEGINF; }
}
constexpr float THR = 10.f;
template <int D> struct State { float m; int cls, tc; f32x16 ci; f32x16 o[D / 32]; f32x16 ol; };
template <int D> __device__ __forceinline__ void state_reset(State<D>& st) { st.m = 0.f; st.cls = -1; st.tc = 0; st.ci = f32x16{}; st.ol = f32x16{};
#pragma unroll
    for (int i = 0; i < D / 32; ++i) st.o[i] = f32x16{}; }
__device__ __forceinline__ f32x16 mfma3(bf16x8 a, bf16x8 b, const f32x16& c) { f32x16 d; asm volatile("v_mfma_f32_32x32x16_bf16 %0, %1, %2, %3" : "=&v"(d) : "v"(a), "v"(b), "v"(c)); return d; }
template <int D> __device__ __forceinline__ void qkt_c(f32x16& p0, f32x16& p1, const LAS unsigned char* kbuf, const bf16x8* qr, int r32, int hi, const f32x16& c0, const f32x16& c1) {
    const LAS unsigned char* kb = kbuf + hi * 1024 + r32 * 16;
#pragma unroll
    for (int dc = 0; dc < D / 64; ++dc) {
        bf16x8 kf0[4], kf1[4];
#pragma unroll
        for (int e = 0; e < 4; ++e) { kf0[e] = *(const LAS bf16x8*)(kb + (4 * dc + e) * 2048); kf1[e] = *(const LAS bf16x8*)(kb + (4 * dc + e) * 2048 + 512); }
        __builtin_amdgcn_sched_barrier(0);
        __builtin_amdgcn_s_setprio(1);
#pragma unroll
        for (int e = 0; e < 4; ++e) { const int d0 = 4 * dc + e;
            if (d0 == 0) { p0 = mfma3(kf0[e], qr[d0], c0); p1 = mfma3(kf1[e], qr[d0], c1); }
            else { p0 = __builtin_amdgcn_mfma_f32_32x32x16_bf16(kf0[e], qr[d0], p0, 0, 0, 0); p1 = __builtin_amdgcn_mfma_f32_32x32x16_bf16(kf1[e], qr[d0], p1, 0, 0, 0); } }
        __builtin_amdgcn_s_setprio(0);
    }
}
__device__ __forceinline__ float rowmax32_3(const f32x16& p0, const f32x16& p1) {
    float a = fmaxf(fmaxf(p0[0], p0[1]), p1[0]), b = fmaxf(fmaxf(p0[2], p0[3]), p1[1]); a = fmaxf(fmaxf(a, p1[2]), p1[3]);
#pragma unroll
    for (int r = 4; r < 16; r += 4) { a = fmaxf(fmaxf(a, p0[r]), p0[r + 1]); b = fmaxf(fmaxf(b, p0[r + 2]), p0[r + 3]); a = fmaxf(fmaxf(a, p1[r]), p1[r + 1]); b = fmaxf(fmaxf(b, p1[r + 2]), p1[r + 3]); }
    return xhalf_max(fmaxf(a, b));
}
template <int D, class Pol> __device__ __forceinline__ void softmax_p(State<D>& st, const Pol& pol, f32x16& p0, f32x16& p1, bf16x8* pa) {
    const float mx = rowmax32_3(p0, p1);
    if (__builtin_expect(__any(mx > THR), 0)) {
        const float dl = fmaxf(mx, 0.f); st.m += dl; const float f = __builtin_amdgcn_exp2f(-dl);
#pragma unroll
        for (int r = 0; r < 16; ++r) { p0[r] -= dl; p1[r] -= dl; st.ol[r] *= f; }
#pragma unroll
        for (int i = 0; i < D / 32; ++i)
#pragma unroll
            for (int r = 0; r < 16; ++r) st.o[i][r] *= f;
        pol.build(st);
    }
#pragma unroll
    for (int r = 0; r < 16; ++r) { p0[r] = __builtin_amdgcn_exp2f(p0[r]); p1[r] = __builtin_amdgcn_exp2f(p1[r]); }
    pa[0] = pack8(p0, 0); pa[1] = pack8(p0, 8); pa[2] = pack8(p1, 0); pa[3] = pack8(p1, 8);
}
#ifndef SGB_XV
#define SGB_XV 0
#endif
template <int D, class Pol> __device__ __forceinline__ void softmax_head(State<D>& st, const Pol& pol, f32x16& p0, f32x16& p1) {
#ifdef MAX_STRIDE
    if ((st.tc++ & (MAX_STRIDE - 1)) != 0) return;
#endif
    const float mx = rowmax32_3(p0, p1);
    if (__builtin_expect(__any(mx > THR), 0)) {
        const float dl = fmaxf(mx, 0.f); st.m += dl; const float f = __builtin_amdgcn_exp2f(-dl);
#pragma unroll
        for (int r = 0; r < 16; ++r) { p0[r] -= dl; p1[r] -= dl; st.ol[r] *= f; }
#pragma unroll
        for (int i = 0; i < D / 32; ++i)
#pragma unroll
            for (int r = 0; r < 16; ++r) st.o[i][r] *= f;
        pol.build(st);
    }
}
template <int D, class Pol> __device__ __forceinline__ void exp_pv_manual(State<D>& st, const Pol& pol, int jc, f32x16& c0, f32x16& c1, const LAS unsigned char* vbuf, int lane) {
    constexpr int NE = D / 32, XE = 8 / NE;
    const LAS unsigned char* vb = vbuf + ((lane >> 4) & 1) * 32 + (lane & 3) * 8 + (4 * (lane >> 5) + ((lane & 15) >> 2)) * 64;
    const bf16x8 ones = {16256, 16256, 16256, 16256, 16256, 16256, 16256, 16256};
    s16x4 lo[2][NE], hh[2][NE];
#pragma unroll
    for (int e = 0; e < NE; ++e) { lo[0][e] = vtr(vb + e * 4096); hh[0][e] = vtr(vb + e * 4096 + 512); }
#pragma unroll
    for (int r = 0; r < 8; ++r) c0[r] = __builtin_amdgcn_exp2f(c0[r]);
    bf16x8 pk = pack8(c0, 0); pol.maskp1(jc, pk);
    __builtin_amdgcn_sched_barrier(0);
#pragma unroll
    for (int ks = 0; ks < 4; ++ks) {
        f32x16& src = (ks + 1) < 2 ? c0 : c1; const int base = 8 * ((ks + 1) & 1);
#pragma unroll
        for (int e = 0; e < NE; ++e) {
            const bf16x8 vf = {lo[ks & 1][e][0], lo[ks & 1][e][1], lo[ks & 1][e][2], lo[ks & 1][e][3], hh[ks & 1][e][0], hh[ks & 1][e][1], hh[ks & 1][e][2], hh[ks & 1][e][3]};
            st.o[e] = __builtin_amdgcn_mfma_f32_32x32x16_bf16(vf, pk, st.o[e], 0, 0, 0);
            if (ks < 3) { lo[(ks + 1) & 1][e] = vtr(vb + e * 4096 + (ks + 1) * 1024); hh[(ks + 1) & 1][e] = vtr(vb + e * 4096 + (ks + 1) * 1024 + 512);
#pragma unroll
                for (int x = 0; x < XE; ++x) src[base + e * XE + x] = __builtin_amdgcn_exp2f(src[base + e * XE + x]); }
            __builtin_amdgcn_sched_barrier(0);
        }
        st.ol = __builtin_amdgcn_mfma_f32_32x32x16_bf16(ones, pk, st.ol, 0, 0, 0);
        if (ks < 3) { pk = pack8(src, base); pol.maskp1(jc, pk); }
        __builtin_amdgcn_sched_barrier(0);
    }
}
template <int D> __device__ __forceinline__ void pv_all(State<D>& st, const bf16x8* pa, const LAS unsigned char* vbuf, int lane) {
    pv<D>(st.o, vbuf, pa, lane);
    const bf16x8 ones = {16256, 16256, 16256, 16256, 16256, 16256, 16256, 16256};
#pragma unroll
    for (int ks = 0; ks < 4; ++ks) st.ol = __builtin_amdgcn_mfma_f32_32x32x16_bf16(ones, pa[ks], st.ol, 0, 0, 0);
}
__device__ __forceinline__ void glds16(const void* gsrc, unsigned lds_dst) { unsigned keep;
    asm volatile("s_mov_b32 %0, m0\n\ts_mov_b32 m0, %2\n\ts_nop 0\n\tglobal_load_lds_dwordx4 %1, off\n\ts_mov_b32 m0, %0" : "=&s"(keep) : "v"(gsrc), "s"(lds_dst) : "memory"); }
template <int D> __device__ __forceinline__ void tile_dma(const bf16_t* Kp, const bf16_t* Vp, int pitch, unsigned kdst, unsigned vdst, int wid, int lane) {
#pragma unroll
    for (int i = 0; i < D / 64; ++i) { const int pc = wid + 8 * i;
        glds16(Kp + (size_t)lane * pitch + pc * 8, (unsigned)__builtin_amdgcn_readfirstlane(kdst + pc * 1024));
        glds16(Vp + (size_t)(16 * (pc & 3) + (lane >> 2)) * pitch + 32 * (pc >> 2) + 8 * (lane & 3), (unsigned)__builtin_amdgcn_readfirstlane(vdst + pc * 1024)); }
}
__device__ __forceinline__ void wait_lg_bar() { asm volatile("s_waitcnt lgkmcnt(0)\n\ts_barrier" ::: "memory"); }
template <int N> __device__ __forceinline__ void wait_vm_bar() { asm volatile("s_waitcnt vmcnt(%0) lgkmcnt(0)\n\ts_barrier" :: "i"(N) : "memory"); }
template <int D, class Pol> __device__ __forceinline__ void compute_tile(State<D>& st, const Pol& pol, int jc, const bf16x8* qr, const LAS unsigned char* kbuf, const LAS unsigned char* vbuf, int lane) {
    if (pol.active(jc)) {
        const int r32 = lane & 31, hi = lane >> 5;
        f32x16 c0, c1;
        pol.prep(jc, st);
        qkt_c<D>(c0, c1, kbuf, qr, r32, hi, st.ci, st.ci); pol.postmask(jc, c0, c1);
#ifdef MAN_PV
        softmax_head<D, Pol>(st, pol, c0, c1); exp_pv_manual<D, Pol>(st, pol, jc, c0, c1, vbuf, lane);
#else
        bf16x8 pa[4]; softmax_p<D, Pol>(st, pol, c0, c1, pa); pol.maskp(jc, pa); pv_all<D>(st, pa, vbuf, lane);
#endif
    }
}
template <int D, class Pol> __device__ __forceinline__ void run_branch(State<D>& st, const Pol& pol, const bf16x8* qr, LAS unsigned char* lds, int wid, int lane) {
    constexpr int SLOT = 256 * D, NI = 2 * (D / 64);
    const unsigned lds0 = (unsigned)(size_t)lds;
    int jc = pol.first(), jn = pol.next(jc), jnn = jn >= 0 ? pol.next(jn) : -1;
    tile_dma<D>(pol.kptr(jc), pol.vptr(jc), pol.pitch, lds0, lds0 + SLOT / 2, wid, lane);
    if (jn >= 0) { tile_dma<D>(pol.kptr(jn), pol.vptr(jn), pol.pitch, lds0 + SLOT, lds0 + SLOT + SLOT / 2, wid, lane); wait_vm_bar<NI>(); } else wait_vm_bar<0>();
    int sc = 0;
    for (;;) {
        const int s2 = sc == 0 ? 2 : sc - 1;
        if (jnn >= 0) tile_dma<D>(pol.kptr(jnn), pol.vptr(jnn), pol.pitch, lds0 + s2 * SLOT, lds0 + s2 * SLOT + SLOT / 2, wid, lane);
        compute_tile<D, Pol>(st, pol, jc, qr, lds + sc * SLOT, lds + sc * SLOT + SLOT / 2, lane);
        if (jn < 0) { wait_vm_bar<0>(); break; }
        if (jnn >= 0) wait_vm_bar<NI>(); else wait_vm_bar<0>();
        sc = sc == 2 ? 0 : sc + 1; jc = jn; jn = jnn; jnn = jn >= 0 ? pol.next(jn) : -1;
    }
}
__device__ __forceinline__ f32x16 splat16(float v) { f32x16 c;
#pragma unroll
    for (int r = 0; r < 16; ++r) c[r] = v;
    return c; }

constexpr int L_IMPA = 65536, L_IMPB = L_IMPA + 4 * 64 * 33 * 4, L_SC = L_IMPB + 4 * 64 * 33 * 4, L_SELM = L_SC + 64 * 33 * 4, L_ORM = L_SELM + 256;
static_assert(L_ORM + 16 <= 143360, "attention LDS map");

struct NsaPtrs { unsigned char* ws;
    __device__ __forceinline__ const bf16_t* QA() const { return (const bf16_t*)(ws + WS_QA); }
    __device__ __forceinline__ const bf16_t* KS() const { return (const bf16_t*)(ws + WS_KC + 2 * 8 * MiB); }
    __device__ __forceinline__ const bf16_t* VS() const { return (const bf16_t*)(ws + WS_KC + 3 * 8 * MiB); }
    __device__ __forceinline__ const bf16_t* KW() const { return (const bf16_t*)(ws + WS_KC + 4 * 8 * MiB); }
    __device__ __forceinline__ const bf16_t* VW() const { return (const bf16_t*)(ws + WS_KC + 5 * 8 * MiB); }
    __device__ __forceinline__ const bf16_t* KCC() const { return (const bf16_t*)(ws + WS_KCC); }
    __device__ __forceinline__ const bf16_t* VCC() const { return (const bf16_t*)(ws + WS_VCC); }
    __device__ __forceinline__ const bf16_t* GA() const { return (const bf16_t*)(ws + WS_GA); }
    __device__ __forceinline__ const bf16_t* ZA() const { return (const bf16_t*)(ws + WS_ZA); }
    __device__ __forceinline__ bf16_t* A2() const { return (bf16_t*)(ws + WS_A2); } };

__device__ __forceinline__ void nsa_unit(const NsaPtrs& P, int b, int g, int qt, LAS unsigned char* lds
#if DBG
    , unsigned* selout
#endif
    ) {
    int tid = threadIdx.x; asm volatile("" : "+v"(tid));
    const int lane = tid & 63, r32 = lane & 31, hi = lane >> 5; const int wid = __builtin_amdgcn_readfirstlane(tid >> 6);
    const int hh = 4 * g + (wid & 3), th = wid >> 2;
    const int tok = 64 * qt + 32 * th + r32; const size_t mrow = (size_t)b * SEQ + tok;
    bf16x8 qr[4];
#pragma unroll
    for (int d0 = 0; d0 < 4; ++d0) qr[d0] = *(const bf16x8*)(P.QA() + mrow * 1024 + hh * 64 + d0 * 16 + hi * 8);
    const float g0 = bf2f(P.GA()[mrow * 64 + hh * 3 + 0]), g1 = bf2f(P.GA()[mrow * 64 + hh * 3 + 1]), g2 = bf2f(P.GA()[mrow * 64 + hh * 3 + 2]);
    f32x16 otot[2] = {f32x16{}, f32x16{}};
    Tile<64> T; State<64> st;
    LAS float* SC = (LAS float*)(lds + L_SC); LAS unsigned* SELM = (LAS unsigned*)(lds + L_SELM); LAS unsigned* ORM = (LAS unsigned*)(lds + L_ORM);
    {
        const bf16_t* Kc = P.KCC() + (size_t)(b * 4 + g) * 128 * 64; const bf16_t* Vc = P.VCC() + (size_t)(b * 4 + g) * 128 * 64;
        const bool two = qt >= 16;
        tile_load<64>(T, Kc, Vc, 64, wid, lane); tile_store<64>(T, (lds + L_K0), (lds + L_V0), wid, lane);
        if (two) { tile_load<64>(T, Kc + 64 * 64, Vc + 64 * 64, 64, wid, lane); tile_store<64>(T, (lds + L_K1), (lds + L_V1), wid, lane); }
        __syncthreads();
        f32x16 pA0, pA1, pB0, pB1;
        qkt<64>(pA0, pA1, (lds + L_K0), qr, r32, hi);
        const int cmax = (tok - 31) >> 4;
        mask_band(pA0, pA1, cmax - 4 * hi, 0x7fffffffu);
        float mx = rowmax32(pA0, pA1);
        if (two) { qkt<64>(pB0, pB1, (lds + L_K1), qr, r32, hi); mask_band(pB0, pB1, cmax - 64 - 4 * hi, 0x7fffffffu); mx = fmaxf(mx, rowmax32(pB0, pB1)); }
        if (mx == NEGINF) mx = 0.f;
        float s = 0.f;
#pragma unroll
        for (int r = 0; r < 16; ++r) { pA0[r] = __builtin_amdgcn_exp2f(pA0[r] - mx); pA1[r] = __builtin_amdgcn_exp2f(pA1[r] - mx); s += pA0[r] + pA1[r]; }
        if (two) {
#pragma unroll
            for (int r = 0; r < 16; ++r) { pB0[r] = __builtin_amdgcn_exp2f(pB0[r] - mx); pB1[r] = __builtin_amdgcn_exp2f(pB1[r] - mx); s += pB0[r] + pB1[r]; }
        }
        s = xhalf_sum(s);
        const float inv_l = s > 0.f ? 1.f / s : 0.f;
        if (two) {
        LAS float* IA = (LAS float*)(lds + L_IMPA) + ((wid & 3) * 64 + 32 * th + r32) * 33; LAS float* IB = (LAS float*)(lds + L_IMPB) + ((wid & 3) * 64 + 32 * th + r32) * 33;
#define IMP_ONE(PX, Tt, Pp) _Pragma("unroll") for (int u = 0; u < 4; ++u) { const int k = 16 * (Tt) + 8 * (Pp) + 2 * u + hi; const float h3 = 0.5f * PX[4 * u + 3]; \
            IA[k] = ((PX[4 * u] + PX[4 * u + 1]) + (PX[4 * u + 2] + h3)) * inv_l; IB[k] = h3 * inv_l; }
        IMP_ONE(pA0, 0, 0) IMP_ONE(pA1, 0, 1) IMP_ONE(pB0, 1, 0) IMP_ONE(pB1, 1, 1)
#undef IMP_ONE
        }
        { bf16x8 pa[4] = {pack8(pA0, 0), pack8(pA0, 8), pack8(pA1, 0), pack8(pA1, 8)}; pv<64>(otot, (lds + L_V0), pa, lane); }
        if (two) { bf16x8 pa[4] = {pack8(pB0, 0), pack8(pB0, 8), pack8(pB1, 0), pack8(pB1, 8)}; pv<64>(otot, (lds + L_V1), pa, lane); }
        const float w = g0 * inv_l;
#pragma unroll
        for (int i = 0; i < 2; ++i)
#pragma unroll
            for (int r = 0; r < 16; ++r) otot[i][r] *= w;
    }
    if (qt < 16) { __syncthreads(); }
    else { const int tt = tid & 63, jg = tid >> 6;
        if (jg == 0) SELM[tt] = 0u; if (tid == 0) ORM[0] = 0u;
        __syncthreads();
        const LAS float* IA = (const LAS float*)(lds + L_IMPA); const LAS float* IB = (const LAS float*)(lds + L_IMPB);
        const int T_ = 64 * qt + tt;
#pragma unroll
        for (int jj = 0; jj < 4; ++jj) { const int j = 4 * jg + jj; float imp = 0.f;
#pragma unroll
            for (int h = 0; h < 4; ++h) { float v = IA[(h * 64 + tt) * 33 + j]; if (j > 0) v += IB[(h * 64 + tt) * 33 + j - 1]; imp += v; }
            const bool valid = 64 * j <= T_; const bool forced = valid && (j == 0 || j == qt || j == qt - 1);
            SC[tt * 33 + j] = valid ? imp + (forced ? 1.0e4f : 0.f) : -1e30f; }
        __syncthreads();
        unsigned bits = 0u;
        {
            float sj[4]; int rank[4] = {0, 0, 0, 0}; unsigned eq[4] = {0u, 0u, 0u, 0u};
#pragma unroll
            for (int jj = 0; jj < 4; ++jj) sj[jj] = SC[tt * 33 + 4 * jg + jj];
#pragma unroll 1
            for (int kh = 0; kh < 4; ++kh) {
                float sk[8];
#pragma unroll
                for (int k = 0; k < 8; ++k) sk[k] = SC[tt * 33 + 8 * kh + k];
#pragma unroll
                for (int jj = 0; jj < 4; ++jj)
#pragma unroll
                    for (int k = 0; k < 8; ++k) { rank[jj] += (sk[k] > sj[jj]) ? 1 : 0; eq[jj] |= (sk[k] == sj[jj]) ? (1u << (8 * kh + k)) : 0u; }
            }
#pragma unroll
            for (int jj = 0; jj < 4; ++jj) { const int j = 4 * jg + jj; const unsigned lt = (1u << j) - 1u;
                if (rank[jj] + __builtin_popcount(eq[jj] & lt) < 16) bits |= 1u << j; }
        }
        atomicOr((unsigned*)&SELM[tt], bits); atomicOr((unsigned*)&ORM[0], bits);
        __syncthreads();
    }
    const unsigned causal_bits = (qt == 31) ? 0xffffffffu : ((2u << qt) - 1u);
    const unsigned selbits = qt < 16 ? causal_bits : SELM[32 * th + r32];
#if DBG
    if (tid < 64) selout[((size_t)b * SEQ + 64 * qt + tid) * 4 + g] = qt < 16 ? causal_bits : SELM[tid];
#endif
    unsigned need = qt < 16 ? causal_bits : ((unsigned)__builtin_amdgcn_readfirstlane(ORM[0]) & causal_bits);
    {
        struct SelPol { const bf16_t* Kg; const bf16_t* Vg; int pitch; unsigned need, selbits; int qt, tok4;
            __device__ __forceinline__ int first() const { return __builtin_ctz(need); }
            __device__ __forceinline__ int next(int j) const { const unsigned r = j >= 31 ? 0u : (need & ~((2u << j) - 1u)); return r ? __builtin_ctz(r) : -1; }
            __device__ __forceinline__ const bf16_t* kptr(int j) const { return Kg + (size_t)64 * j * 256; }
            __device__ __forceinline__ const bf16_t* vptr(int j) const { return Vg + (size_t)64 * j * 256; }
            __device__ __forceinline__ bool active(int j) const { return __any((selbits >> j) & 1u); }
            __device__ __forceinline__ void prep(int, State<64>&) const {}
            __device__ __forceinline__ void build(State<64>& st) const { st.ci = splat16(-st.m); }
            __device__ __forceinline__ void maskp(int j, bf16x8* pa) const { const unsigned km = ((selbits >> j) & 1u) ? 0xffffffffu : 0u;
#pragma unroll
                for (int k = 0; k < 4; ++k) { u32x4_t w = __builtin_bit_cast(u32x4_t, pa[k]); w &= km; pa[k] = __builtin_bit_cast(bf16x8, w); } }
            __device__ __forceinline__ void maskp1(int j, bf16x8& f) const { const unsigned km = ((selbits >> j) & 1u) ? 0xffffffffu : 0u; u32x4_t w = __builtin_bit_cast(u32x4_t, f); w &= km; f = __builtin_bit_cast(bf16x8, w); }
            __device__ __forceinline__ void postmask(int j, f32x16& p0, f32x16& p1) const { if (j == qt) mask_band(p0, p1, tok4 - 64 * j, 0x7fffffffu); } };
        SelPol pol{P.KS() + (size_t)b * SEQ * 256 + g * 64, P.VS() + (size_t)b * SEQ * 256 + g * 64, 256, need, selbits, qt, tok - 4 * hi};
        state_reset<64>(st);
        run_branch<64, SelPol>(st, pol, qr, lds, wid, lane);
        const float w = g1 / st.ol[0];
#pragma unroll
        for (int i = 0; i < 2; ++i)
#pragma unroll
            for (int r = 0; r < 16; ++r) otot[i][r] += st.o[i][r] * w;
    }
    {
        struct WinPol { const bf16_t* Kg; const bf16_t* Vg; int pitch; int qt, jlo, tok4;
            __device__ __forceinline__ int first() const { return jlo; }
            __device__ __forceinline__ int next(int j) const { return j < qt ? j + 1 : -1; }
            __device__ __forceinline__ const bf16_t* kptr(int j) const { return Kg + (size_t)64 * j * 256; }
            __device__ __forceinline__ const bf16_t* vptr(int j) const { return Vg + (size_t)64 * j * 256; }
            __device__ __forceinline__ bool active(int) const { return true; }
            __device__ __forceinline__ void prep(int, State<64>&) const {}
            __device__ __forceinline__ void build(State<64>& st) const { st.ci = splat16(-st.m); }
            __device__ __forceinline__ void maskp(int, bf16x8*) const {}
            __device__ __forceinline__ void maskp1(int, bf16x8&) const {}
            __device__ __forceinline__ void postmask(int j, f32x16& p0, f32x16& p1) const { if (j == qt || j == qt - 8) mask_band(p0, p1, tok4 - 64 * j, 511u); } };
        WinPol pol{P.KW() + (size_t)b * SEQ * 256 + g * 64, P.VW() + (size_t)b * SEQ * 256 + g * 64, 256, qt, qt >= 8 ? qt - 8 : 0, tok - 4 * hi};
        state_reset<64>(st);
        run_branch<64, WinPol>(st, pol, qr, lds, wid, lane);
        const float w = g2 / st.ol[0];
#pragma unroll
        for (int i = 0; i < 2; ++i)
#pragma unroll
            for (int r = 0; r < 16; ++r) otot[i][r] += st.o[i][r] * w;
    }
    {
        LAS float* stg = (LAS float*)(lds + 65536 + wid * 8192);
#pragma unroll
        for (int db = 0; db < 2; ++db)
#pragma unroll
            for (int u = 0; u < 4; ++u) { const int d = 32 * db + 8 * u + 4 * hi;
                *(LAS f32x4_t*)(stg + r32 * 64 + (d ^ ((r32 & 7) << 3))) = (f32x4_t){otot[db][4 * u], otot[db][4 * u + 1], otot[db][4 * u + 2], otot[db][4 * u + 3]}; }
        asm volatile("s_waitcnt lgkmcnt(0)" ::: "memory");
        const size_t row0 = (size_t)b * SEQ + 64 * qt + 32 * th;
#pragma unroll
        for (int i = 0; i < 4; ++i) { const int row = 8 * i + (lane >> 3), ch = lane & 7, d = 8 * ch;
            const f32x4_t a = *(const LAS f32x4_t*)(stg + row * 64 + (d ^ ((row & 7) << 3))), c = *(const LAS f32x4_t*)(stg + row * 64 + ((d + 4) ^ ((row & 7) << 3)));
            const u32x4_t z = *(const u32x4_t*)(P.ZA() + (row0 + row) * 1024 + hh * 64 + d);
            u32x4_t w; w.x = cvtpk(a[0] * bflo(z.x), a[1] * bfhi(z.x)); w.y = cvtpk(a[2] * bflo(z.y), a[3] * bfhi(z.y)); w.z = cvtpk(c[0] * bflo(z.z), c[1] * bfhi(z.z)); w.w = cvtpk(c[2] * bflo(z.w), c[3] * bfhi(z.w));
            *(u32x4_t*)(P.A2() + (row0 + row) * 2048 + hh * 64 + d) = w; }
    }
}

struct MixPtrs { unsigned char* ws;
    __device__ __forceinline__ const bf16_t* QB() const { return (const bf16_t*)(ws + WS_QB); }
    __device__ __forceinline__ const bf16_t* KB() const { return (const bf16_t*)(ws + WS_KB); }
    __device__ __forceinline__ const bf16_t* VB() const { return (const bf16_t*)(ws + WS_VB); }
    __device__ __forceinline__ const bf16_t* ZB() const { return (const bf16_t*)(ws + WS_ZB); }
    __device__ __forceinline__ bf16_t* A2() const { return (bf16_t*)(ws + WS_A2); } };
__device__ __forceinline__ void mixb_unit(const MixPtrs& P, int b, int h, int a, LAS unsigned char* lds) {
    int tid = threadIdx.x; asm volatile("" : "+v"(tid));
    const int lane = tid & 63, r32 = lane & 31, hi = lane >> 5; const int wid = __builtin_amdgcn_readfirstlane(tid >> 6);
    const int tok = 256 * a + 32 * wid + r32; const size_t mrow = (size_t)b * SEQ + tok;
    bf16x8 qr[8];
#pragma unroll
    for (int d0 = 0; d0 < 8; ++d0) qr[d0] = *(const bf16x8*)(P.QB() + mrow * 1024 + h * 128 + d0 * 16 + hi * 8);
    const int E16 = (tok - 4 * hi) & 15;
    bool is16[8], is4[4];
#pragma unroll
    for (int i = 0; i < 8; ++i) is16[i] = E16 == ((i & 3) + 8 * (i >> 2));
#pragma unroll
    for (int i = 0; i < 4; ++i) is4[i] = (E16 & 3) == i;
    const bf16_t* Kg = P.KB() + (size_t)b * SEQ * 1024 + h * 128; const bf16_t* Vg = P.VB() + (size_t)b * SEQ * 1024 + h * 128;
    State<128> st; state_reset<128>(st);
    struct MixPol { const bf16_t* Kg; const bf16_t* Vg; int pitch; int nt, wlast, wbase, tok4; bool i16[8], i4[4];
        __device__ __forceinline__ int first() const { return 0; }
        __device__ __forceinline__ int next(int j) const { return j + 1 < nt ? j + 1 : -1; }
        __device__ __forceinline__ const bf16_t* kptr(int j) const { return Kg + (size_t)64 * j * 1024; }
        __device__ __forceinline__ const bf16_t* vptr(int j) const { return Vg + (size_t)64 * j * 1024; }
        __device__ __forceinline__ bool active(int j) const { return j <= wlast; }
        __device__ __forceinline__ int cls(int j) const { const int wlo = wbase - 64 * j, dmin = wlo - 63, dmax = wlo + 31;
            return dmin > 512 ? 0 : (dmin > 128 && dmax <= 512) ? 1 : dmin < 0 ? 3 : dmax <= 128 ? 2 : dmax <= 512 ? 4 : 5; }
        __device__ __forceinline__ void build(State<128>& st) const { const int c = st.cls; const float m = st.m;
            if (c == 0) {
#pragma unroll
                for (int r = 0; r < 16; ++r) st.ci[r] = i16[(r & 3) + 4 * ((r >> 2) & 1)] ? -m : NEGINF;
            } else if (c == 1) {
#pragma unroll
                for (int r = 0; r < 16; ++r) st.ci[r] = i4[r & 3] ? (i16[(r & 3) + 4 * ((r >> 2) & 1)] ? 1.f - m : -m) : NEGINF;
            } else if (c == 2 || c == 3) {
#pragma unroll
                for (int r = 0; r < 16; ++r) st.ci[r] = i16[(r & 3) + 4 * ((r >> 2) & 1)] ? 1.5849625007f - m : (i4[r & 3] ? 1.f - m : -m);
            } else st.ci = splat16(-m); }
        __device__ __forceinline__ void prep(int j, State<128>& st) const { const int c = cls(j); if (c != st.cls) { st.cls = c; build(st); } }
        __device__ __forceinline__ void maskp(int, bf16x8*) const {}
        __device__ __forceinline__ void maskp1(int, bf16x8&) const {}
        __device__ __forceinline__ void postmask(int j, f32x16& p0, f32x16& p1) const {
            const int c = cls(j);
            if (c < 3) return;
            const int e = tok4 - 64 * j;
            if (c == 3) { mask_band(p0, p1, e, 0x7fffffffu); return; }
            const int thr = c == 4 ? 128 : 512;
#pragma unroll
            for (int r = 0; r < 16; ++r) { const bool b16 = i16[(r & 3) + 4 * ((r >> 2) & 1)], b4 = i4[r & 3]; const int cc = (r & 3) + 8 * (r >> 2);
                const float vnear = b16 ? 1.5849625007f : (b4 ? 1.f : 0.f), vmid = b4 ? (b16 ? 1.f : 0.f) : NEGINF, vfar = b16 ? 0.f : NEGINF;
                const float lo = c == 4 ? vnear : vmid, hi_ = c == 4 ? vmid : vfar;
                p0[r] += (e - cc <= thr) ? lo : hi_; p1[r] += (e - cc - 32 <= thr) ? lo : hi_; } } };
    MixPol pol{Kg, Vg, 1024, 4 * a + 4, 4 * a + (wid >> 1), 256 * a + 32 * wid, tok - 4 * hi, {is16[0], is16[1], is16[2], is16[3], is16[4], is16[5], is16[6], is16[7]}, {is4[0], is4[1], is4[2], is4[3]}};
    run_branch<128, MixPol>(st, pol, qr, lds, wid, lane);
    const float inv_l = 1.f / st.ol[0];
#pragma unroll
    for (int db = 0; db < 4; ++db)
#pragma unroll
        for (int u = 0; u < 4; ++u) { const int d = 32 * db + 8 * u + 4 * hi;
            const u32x2_t z = *(const u32x2_t*)(P.ZB() + mrow * 1024 + h * 128 + d);
            u32x2_t w; w.x = cvtpk(st.o[db][4 * u] * inv_l * bflo(z.x), st.o[db][4 * u + 1] * inv_l * bfhi(z.x)); w.y = cvtpk(st.o[db][4 * u + 2] * inv_l * bflo(z.y), st.o[db][4 * u + 3] * inv_l * bfhi(z.y));
            *(u32x2_t*)(P.A2() + mrow * 2048 + 1024 + h * 128 + d) = w; }
}
}
typedef GAS unsigned gu32;
#define RLX_AGENT __ATOMIC_RELAXED, __HIP_MEMORY_SCOPE_AGENT
#define LDS_WAIT() asm volatile("s_waitcnt lgkmcnt(0)" ::: "memory")
#define VM_WAIT() asm volatile("s_waitcnt vmcnt(0)" ::: "memory")
#define XB_TMO      128
#define XB_XCNT(j)  (256  + 64 * (j))
#define XB_XSUB(j)  (1280 + 64 * (j))
#define XB_XGEN(j)  (2304 + 64 * (j))
#define XB_TOP      3328
#define XB_TOPGEN   3392
#define XCD_BAR_WORDS 3456
#define XB_SPIN_CAP (1u << 18)
__device__ __forceinline__ unsigned xb_ld(unsigned* p)              { return __hip_atomic_load(p, __ATOMIC_RELAXED, __HIP_MEMORY_SCOPE_AGENT); }
__device__ __forceinline__ unsigned xb_add(unsigned* p, unsigned v) { return __hip_atomic_fetch_add(p, v, __ATOMIC_RELAXED, __HIP_MEMORY_SCOPE_AGENT); }
__device__ __forceinline__ unsigned xb_xcc_id() { return (unsigned)__builtin_amdgcn_s_getreg((3 << 11) | 20) & 0xFu; }
#define XB_SPIN(cond, bar) do { unsigned _sp = 0; while (cond) { __builtin_amdgcn_s_sleep(1); \
    if ((++_sp & 255u) == 0u) { if (xb_ld(&(bar)[XB_TMO])) break; if (_sp > XB_SPIN_CAP) { atomicAdd(&(bar)[XB_TMO], 1u); break; } } } } while (0)
struct XcdBarrier { unsigned* bar; unsigned x; volatile LAS unsigned* st; };
__device__ __forceinline__ XcdBarrier xcd_barrier_post(unsigned* bar, volatile LAS unsigned* st) {
    XcdBarrier b; b.bar = bar; b.x = xb_xcc_id(); b.st = st;
    if (threadIdx.x == 0) (void)xb_add(&bar[XB_XCNT(b.x)], 1u);
    return b;
}
__device__ __forceinline__ void xcd_barrier_complete(unsigned* bar, unsigned x, unsigned& nloc, unsigned& nx) {
    const unsigned G = gridDim.x * gridDim.y * gridDim.z;
    unsigned sum, cnt, mine, sp = 0u;
    for (;;) {
        sum = 0u; cnt = 0u; mine = 0u;
#pragma unroll
        for (unsigned j = 0; j < 16; ++j) { const unsigned c = xb_ld(&bar[XB_XCNT(j)]); sum += c; cnt += (c > 0u) ? 1u : 0u; mine = (j == x) ? c : mine; }
        if (sum == G) break;
        __builtin_amdgcn_s_sleep(1);
        if ((++sp & 255u) == 0u) { if (xb_ld(&bar[XB_TMO])) break; if (sp > XB_SPIN_CAP) { atomicAdd(&bar[XB_TMO], 1u); break; } }
    }
    nloc = mine > 0u ? mine : 1u; nx = cnt > 0u ? cnt : 1u;
}
__device__ __forceinline__ void xcd_barrier(const XcdBarrier& b) {
    asm volatile("s_waitcnt vmcnt(0)" ::: "memory");
    __syncthreads();
    if (threadIdx.x == 0) {
        unsigned* bar = b.bar;
        __builtin_amdgcn_s_waitcnt(0);
        unsigned nloc = b.st[0], nx = b.st[1];
        if (nloc == 0u) { xcd_barrier_complete(bar, b.x, nloc, nx); b.st[0] = nloc; b.st[1] = nx; }
        const unsigned old = xb_add(&bar[XB_XSUB(b.x)], 1u);
        const unsigned gen = old / nloc;
        if (old + 1u == (gen + 1u) * nloc) {
            __builtin_amdgcn_fence(__ATOMIC_RELEASE, "agent");
            asm volatile("s_waitcnt vmcnt(0)" ::: "memory");
            const unsigned og = xb_add(&bar[XB_TOP], 1u);
            const unsigned tg = og / nx;
            if (og + 1u == (tg + 1u) * nx) xb_add(&bar[XB_TOPGEN], 1u);
            else XB_SPIN(xb_ld(&bar[XB_TOPGEN]) == tg, bar);
            __builtin_amdgcn_fence(__ATOMIC_ACQUIRE, "agent");
            xb_add(&bar[XB_XGEN(b.x)], 1u);
            asm volatile("s_waitcnt vmcnt(0)" ::: "memory");
        } else {
            XB_SPIN(xb_ld(&bar[XB_XGEN(b.x)]) == gen, bar);
            __builtin_amdgcn_fence(__ATOMIC_ACQUIRE, "agent");
            asm volatile("s_waitcnt vmcnt(0)" ::: "memory");
        }
    }
    __syncthreads();
}

struct Frame {
    LAS unsigned char* lds; int tid, lane, wave, G, vcu;
    const float *x, *c; const int* pos; const float *w_ada, *b_ada, *g_pre, *g_post, *w_in, *pe_ck, *pe_cv, *w_ck1, *w_ck2, *w_cv1, *w_cv2, *w_br_a, *w_br_b, *w_out;
    unsigned char* ws; unsigned char* dout;
};
__device__ __forceinline__ float wave_sum(float v) {
#pragma unroll
    for (int o = 1; o < 64; o <<= 1) v += __shfl_xor(v, o);
    return v;
}
__device__ __forceinline__ void p0_ada(Frame& F) {
    float* ada = (float*)(F.ws + WS_ADA);
    LAS float* red = (LAS float*)F.lds;
    LAS float* cT = (LAS float*)(F.lds + 69632);
    int tid0 = threadIdx.x; asm volatile("" : "+v"(tid0));
    for (int i = tid0; i < 8 * DM; i += 512) cT[(i & (DM - 1)) * 8 + (i >> 11)] = F.c[i];
    __syncthreads();
    for (int cg = blockIdx.x; cg < 256; cg += F.G) {
        const int tid = tid0, kk = tid / 6, c4 = tid % 6; const bool on = tid < 510;
        f32x4_t acc[8];
#pragma unroll
        for (int b = 0; b < 8; ++b) acc[b] = (f32x4_t){0.f, 0.f, 0.f, 0.f};
        if (on) for (int k0 = kk; k0 < DM; k0 += 85 * 13) {
            f32x4_t w[13];
#pragma unroll
            for (int u = 0; u < 13; ++u) { const int k = k0 + 85 * u; w[u] = k < DM ? *(const f32x4_t*)(F.w_ada + (size_t)k * 6144 + 24 * cg + 4 * c4) : (f32x4_t){0.f, 0.f, 0.f, 0.f}; }
#pragma unroll
            for (int u = 0; u < 13; ++u) { const int k = k0 + 85 * u < DM ? k0 + 85 * u : 0;
                const f32x4_t ca = *(const LAS f32x4_t*)(cT + k * 8), cb = *(const LAS f32x4_t*)(cT + k * 8 + 4);
#pragma unroll
                for (int b = 0; b < 4; ++b) { acc[b] += w[u] * ca[b]; acc[4 + b] += w[u] * cb[b]; } }
        }
        if (on) {
#pragma unroll
            for (int b = 0; b < 8; ++b)
#pragma unroll
                for (int e = 0; e < 4; ++e) red[tid * 33 + b * 4 + e] = acc[b][e];
        }
        __syncthreads();
        if (tid < 192) { const int b = tid / 24, col = tid % 24, cc4 = col >> 2, e = col & 3; float s = 0.f;
            for (int q = 0; q < 85; ++q) s += red[(q * 6 + cc4) * 33 + b * 4 + e];
            ada[b * 6144 + 24 * cg + col] = s + F.b_ada[24 * cg + col]; }
        __syncthreads();
    }
}
template <bool REMAP> __device__ __forceinline__ int dst_row(int n) { if (!REMAP) return n; return n < 2560 ? n : (n < 2608 ? 11776 + (n - 2560) : n - 48); }
template <bool REMAP> __device__ __forceinline__ void p0_transpose_item(const float* W, int K, int N, bf16_t* WT, int ldt, int kofs, LAS float* scr, int item, int lane) {
    const int nblk = (N + 31) / 32, kb = item / nblk, nb = item % nblk, k0 = 64 * kb, n0 = 32 * nb;
    const bool cok = n0 + (lane & 31) < N;
    float tv[32];
#pragma unroll
    for (int i = 0; i < 32; ++i) { const int kk = 2 * i + (lane >> 5); tv[i] = cok ? W[(size_t)(k0 + kk) * N + n0 + (lane & 31)] : 0.f; }
#pragma unroll
    for (int i = 0; i < 32; ++i) { const int kk = 2 * i + (lane >> 5); scr[kk * 33 + (lane & 31)] = tv[i]; }
    LDS_WAIT(); asm volatile("" ::: "memory");
    const int c = lane & 7;
#pragma unroll
    for (int j = 0; j < 4; ++j) { const int n = (lane >> 3) + 8 * j; const LAS float* s = scr + (8 * c) * 33 + n;
        u32x4_t o; o.x = pk2(s[0 * 33], s[1 * 33]); o.y = pk2(s[2 * 33], s[3 * 33]); o.z = pk2(s[4 * 33], s[5 * 33]); o.w = pk2(s[6 * 33], s[7 * 33]);
        if (n0 + n < N) *(GAS u32x4_t*)(WT + (size_t)dst_row<REMAP>(n0 + n) * ldt + kofs + k0 + 8 * c) = o; }
    LDS_WAIT(); asm volatile("" ::: "memory");
}
__device__ __forceinline__ void p0_items(Frame& F) {
    LAS float* scr = (LAS float*)(F.lds + 68 * 1024 + F.wave * 8704);
    int tid_ = threadIdx.x; asm volatile("" : "+v"(tid_)); const int lane = tid_ & 63;
    const int gw = F.vcu * 8 + F.wave, NGW = F.G * 8;
    bf16_t* WinT = (bf16_t*)(F.ws + WS_WINT); bf16_t* WbrT = (bf16_t*)(F.ws + WS_WBRT); bf16_t* WoutT = (bf16_t*)(F.ws + WS_WOUTT);
    bf16_t* W1T = (bf16_t*)(F.ws + WS_W1T); bf16_t* W2T = (bf16_t*)(F.ws + WS_W2T);
    constexpr int I_IN = 32 * 370, I_BR = 16 * 64, I_OUT = 32 * 64, I_C1 = 32 * 8, I_C2 = 4 * 2;
    constexpr int I_ROPE = MTOK / 64, I_B1 = 128, I_Z = 13;
    constexpr int NITEMS = I_IN + 2 * I_BR + I_OUT + 2 * I_C1 + 2 * I_C2 + I_ROPE + I_B1 + I_Z;
    for (int it = gw; it < NITEMS; it += NGW) {
        int r = it;
        if (r < I_IN) { p0_transpose_item<true>(F.w_in, 2048, NIN, WinT, 2048, 0, scr, r, lane); continue; } r -= I_IN;
        if (r < I_BR) { p0_transpose_item<false>(F.w_br_a, 1024, 2048, WbrT, 2048, 0, scr, r, lane); continue; } r -= I_BR;
        if (r < I_BR) { p0_transpose_item<false>(F.w_br_b, 1024, 2048, WbrT, 2048, 1024, scr, r, lane); continue; } r -= I_BR;
        if (r < I_OUT) { p0_transpose_item<false>(F.w_out, 2048, 2048, WoutT, 2048, 0, scr, r, lane); continue; } r -= I_OUT;
        if (r < I_C1) { p0_transpose_item<false>(F.w_ck1, 2048, 256, W1T, 2048, 0, scr, r, lane); continue; } r -= I_C1;
        if (r < I_C1) { p0_transpose_item<false>(F.w_cv1, 2048, 256, W1T + 256 * 2048, 2048, 0, scr, r, lane); continue; } r -= I_C1;
        if (r < I_C2) { p0_transpose_item<false>(F.w_ck2, 256, 64, W2T, 256, 0, scr, r, lane); continue; } r -= I_C2;
        if (r < I_C2) { p0_transpose_item<false>(F.w_cv2, 256, 64, W2T + 64 * 256, 256, 0, scr, r, lane); continue; } r -= I_C2;
        if (r < I_ROPE) {
            const int m = r * 64 + lane; const float pf = (float)F.pos[m];
            const float myinv = (lane < 8) ? (float)pow(500000.0, -(double)(2 * lane) / 16.0) : (float)pow(500000.0, -(double)(2 * ((lane - 8) & 15)) / 32.0);
            float* t64 = (float*)(F.ws + WS_R64) + (size_t)m * 16; float* t128 = (float*)(F.ws + WS_R128) + (size_t)m * 32;
            for (int i = 0; i < 8; ++i) { const float inv = __shfl(myinv, i); const float ang = pf * inv; t64[i] = cosf(ang); t64[8 + i] = sinf(ang); }
            for (int i = 0; i < 16; ++i) { const float inv = __shfl(myinv, 8 + i); const float ang = pf * inv; t128[i] = cosf(ang); t128[16 + i] = sinf(ang); }
            continue; } r -= I_ROPE;
        if (r < I_B1) {
            const int kc = r & 15, cg = (r >> 4) & 3, kv = r >> 6, n = cg * 64 + lane; const float* pe = kv ? F.pe_cv : F.pe_ck; const float* w1 = kv ? F.w_cv1 : F.w_ck1; float s = 0.f;
#pragma unroll 16
            for (int k = 128 * kc; k < 128 * kc + 128; ++k) s += pe[k] * w1[(size_t)k * 256 + n];
            ((float*)(F.ws + WS_BIAS1))[(kc * 2 + kv) * 256 + n] = s; continue; } r -= I_B1;
        {
            for (int q = lane; q < 16 * 256; q += 64) *(GAS u32x4_t*)(WinT + (size_t)(11824 + r * 16) * 2048 + q * 8) = (u32x4_t){0u, 0u, 0u, 0u};
        }
    }
}
__device__ __forceinline__ void p0_xn(Frame& F) {
    int tid_ = threadIdx.x; asm volatile("" : "+v"(tid_)); const int lane = tid_ & 63;
    const int gw = F.vcu * 8 + F.wave, NGW = F.G * 8;
    const float* ada = (const float*)(F.ws + WS_ADA); bf16_t* XN = (bf16_t*)(F.ws + WS_XN);
    for (int m = gw; m < MTOK; m += NGW) {
        const int b = m >> 11; const f32x4_t* xr = (const f32x4_t*)(F.x + (size_t)m * DM) + lane;
        f32x4_t v[8]; float s = 0.f;
#pragma unroll
        for (int j = 0; j < 8; ++j) { v[j] = xr[64 * j]; s += (v[j][0] * v[j][0] + v[j][1] * v[j][1]) + (v[j][2] * v[j][2] + v[j][3] * v[j][3]); }
        const float rstd = rsqrtf(wave_sum(s) * (1.f / DM) + 1e-6f);
        u32x2_t* o8 = (u32x2_t*)(XN + (size_t)m * DM) + lane;
#pragma unroll
        for (int j = 0; j < 8; ++j) { const int k = 256 * j + 4 * lane;
            const f32x4_t g = *(const f32x4_t*)(F.g_pre + k), sc = *(const f32x4_t*)(ada + b * 6144 + 2048 + k), sh = *(const f32x4_t*)(ada + b * 6144 + k);
            const f32x4_t y = (v[j] * rstd * g) * (sc + 1.f) + sh;
            u32x2_t w; w.x = pk2(y[0], y[1]); w.y = pk2(y[2], y[3]); o8[64 * j] = w; }
    }
}
typedef short cbf16x8 __attribute__((ext_vector_type(8)));
typedef float cf32x16 __attribute__((ext_vector_type(16)));
__device__ __forceinline__ void compress_unit(Frame& F, int unit) {
    const int kv = unit >> 5, b = (unit >> 2) & 7, g = unit & 3;
    int tid = threadIdx.x; asm volatile("" : "+v"(tid));
    const int lane = tid & 63, r32 = lane & 31, hi = lane >> 5, wid = F.wave;
    const bf16_t* src = (const bf16_t*)(F.ws + WS_KC + (size_t)kv * 8 * MiB) + (size_t)b * SEQ * 256 + g * 64;
    const bf16_t* W1T = (const bf16_t*)(F.ws + WS_W1T) + (size_t)kv * 256 * 2048;
    const bf16_t* W2T = (const bf16_t*)(F.ws + WS_W2T) + (size_t)kv * 64 * 256;
    const float* bias1p = (const float*)(F.ws + WS_BIAS1) + kv * 256;
    bf16_t* dst = (bf16_t*)(F.ws + (kv ? WS_VCC : WS_KCC)) + (size_t)(b * 4 + g) * 128 * 64;
    LAS bf16_t* HID = (LAS bf16_t*)F.lds;
    constexpr int WSLOT = 32768, AOFF = 3 * WSLOT, ASLOT = 8 * 129 * 16;
    const unsigned lds0 = (unsigned)(size_t)F.lds;
    const bf16_t* wp = W1T + (size_t)(tid & 255) * 2048 + (tid >> 8) * 8;
    auto dma_w = [&](int l, int slot) {
#pragma unroll
        for (int j = 0; j < 4; ++j) att::glds16(wp + l * 64 + j * 16, (unsigned)__builtin_amdgcn_readfirstlane(lds0 + slot * WSLOT + (j * 512 + wid * 64) * 16)); };
    auto dma_a = [&](int l, int slot) {
#pragma unroll
        for (int j = 0; j < 2; ++j) { const int p = j * 512 + tid, kc = p >> 7, row = p & 127;
            att::glds16(src + (size_t)(16 * row + l) * 256 + kc * 8, (unsigned)__builtin_amdgcn_readfirstlane(lds0 + AOFF + slot * ASLOT + ((j * 4 + (wid >> 1)) * 129 + (wid & 1) * 64) * 16)); } };
    cf32x16 acc[4] = {cf32x16{}, cf32x16{}, cf32x16{}, cf32x16{}};
    dma_a(0, 0); dma_w(0, 0); dma_w(16, 1); att::wait_vm_bar<4>();
    int sc = 0;
#pragma unroll 1
    for (int it = 0; it < 16; ++it) {
#pragma unroll
        for (int hf = 0; hf < 2; ++hf) {
            const int s2 = sc == 0 ? 2 : sc - 1;
            if (hf == 0) { if (it + 1 < 16) { dma_a(it + 1, (it + 1) & 1); dma_w(it + 1, s2); } }
            else if (it + 1 < 16) dma_w(it + 17, s2);
            const LAS unsigned char* ab = F.lds + AOFF + (it & 1) * ASLOT + hi * (129 * 16) + (r32 + hf) * 16;
            const LAS unsigned char* wb = F.lds + sc * WSLOT + hi * 4096 + (32 * wid + r32) * 16;
#pragma unroll
            for (int ks = 0; ks < 4; ++ks) { const cbf16x8 bq = *(const LAS cbf16x8*)(wb + ks * 8192);
#pragma unroll
                for (int rq = 0; rq < 4; ++rq) { const cbf16x8 af = *(const LAS cbf16x8*)(ab + ks * (2 * 129 * 16) + rq * 512);
                    acc[rq] = __builtin_amdgcn_mfma_f32_32x32x16_bf16(af, bq, acc[rq], 0, 0, 0); } }
            if (it + 1 < 16) { if (hf == 0) att::wait_vm_bar<6>(); else att::wait_vm_bar<4>(); } else att::wait_vm_bar<0>();
            sc = sc == 2 ? 0 : sc + 1;
        }
    }
    {
        const int n = 32 * wid + r32; float bb = 0.f;
#pragma unroll
        for (int q = 0; q < 16; ++q) bb += bias1p[q * 512 + n];
#pragma unroll
        for (int rq = 0; rq < 4; ++rq)
#pragma unroll
            for (int r = 0; r < 16; ++r) { const float xv = acc[rq][r] + bb;
                const float u = 0.7978845608028654f * (xv + 0.044715f * xv * xv * xv);
                const float th = 1.f - 2.f * __builtin_amdgcn_rcpf(1.f + __builtin_amdgcn_exp2f(2.f * LOG2E * u));
                const float gl = 0.5f * xv * (1.f + th);
                HID[(32 * rq + (r & 3) + 8 * (r >> 2) + 4 * hi) * 264 + n] = (bf16_t)f2bf(gl); }
    }
    __syncthreads();
    {
        const int mi = wid >> 1, nd = wid & 1;
        cf32x16 o = cf32x16{};
#pragma unroll
        for (int ks = 0; ks < 16; ++ks) {
            const cbf16x8 a = *(const LAS cbf16x8*)(HID + (32 * mi + r32) * 264 + 16 * ks + 8 * hi);
            const cbf16x8 bq = *(const cbf16x8*)(W2T + (size_t)(32 * nd + r32) * 256 + 16 * ks + 8 * hi);
            o = __builtin_amdgcn_mfma_f32_32x32x16_bf16(a, bq, o, 0, 0, 0);
        }
        const int d = 32 * nd + r32;
#pragma unroll
        for (int r = 0; r < 16; ++r) { const int c = 32 * mi + (r & 3) + 8 * (r >> 2) + 4 * hi; float v = o[r];
            if (kv == 0 && nd == 0) {
                int trow = 16 * c + 31; trow = trow > 2047 ? 2047 : trow;
                const float* tb = (const float*)(F.ws + WS_R64) + ((size_t)b * SEQ + trow) * 16;
                const float pr = __shfl_xor(v, 8); const float cs = tb[r32 & 7], sn = tb[8 + (r32 & 7)];
                const float rot = v * cs + (r32 < 8 ? -pr : pr) * sn;
                v = r32 < 16 ? rot : v; }
            dst[(size_t)c * 64 + d] = (c == 127) ? (bf16_t)0 : (bf16_t)f2bf(v); }
    }
    __syncthreads();
}
__device__ __forceinline__ void p6_final(Frame& F) {
    int tid_ = threadIdx.x; asm volatile("" : "+v"(tid_)); const int lane = tid_ & 63;
    const int gw = F.vcu * 8 + F.wave, NGW = F.G * 8;
    const float* ada = (const float*)(F.ws + WS_ADA); const float* ssq = (const float*)(F.ws + WS_SSQ); float* out = (float*)F.dout; const bf16_t* pre = (const bf16_t*)(F.ws + WS_XN);
    for (int m = gw; m < MTOK; m += NGW) {
        const int b = m >> 11; float s = 0.f;
        for (int q = 0; q < 32; ++q) s += ssq[(size_t)m * 32 + q];
        const float rstd = rsqrtf(s * (1.f / DM) + 1e-6f);
        const f32x4_t* xr = (const f32x4_t*)(F.x + (size_t)m * DM) + lane; f32x4_t* orow = (f32x4_t*)(out + (size_t)m * DM) + lane; const u32x2_t* pr = (const u32x2_t*)(pre + (size_t)m * DM) + lane;
        f32x4_t xv[8]; u32x2_t pv[8];
#pragma unroll
        for (int j = 0; j < 8; ++j) { xv[j] = xr[64 * j]; pv[j] = pr[64 * j]; }
#pragma unroll
        for (int j = 0; j < 8; ++j) { const int k = 256 * j + 4 * lane;
            const f32x4_t gp = *(const f32x4_t*)(F.g_post + k), gt = *(const f32x4_t*)(ada + b * 6144 + 4096 + k);
            const f32x4_t o = {bflo(pv[j].x), bfhi(pv[j].x), bflo(pv[j].y), bfhi(pv[j].y)};
            orow[64 * j] = xv[j] + gt * (o * rstd * gp); }
    }
}
constexpr int LDS_BYTES = 147456;
constexpr int LDSCTL_OFF = 143360;
constexpr int CW_BAR = 4096, CW_PANEL = 16384, CW_CMP = 32768, CW_NSAQ = 33792, CW_G1A = 35008, CW_G1B = 35040, CW_MIXQ = 36864;
constexpr int NPHASE = 8;
#ifndef REP_MIXU
#define REP_MIXU 0
#endif
#ifndef REP_UNIT_N
#define REP_UNIT_N 0
#define REP_UNIT_I 0
#define REP_PMODE 0
#endif
#ifndef PROBE_NOREMAP
#define PROBE_NOREMAP 0
#endif
struct Args { const void* in[17]; float* out; unsigned char* ws; int ph_lo, ph_hi; };

__device__ __forceinline__ void touch_lines(const unsigned char* base, size_t row_pitch_bytes, int nrows, int lines_per_row, int tid) {
    const int n = nrows * lines_per_row;
    for (int i = tid; i < n; i += 512) { const unsigned char* p = base + (size_t)(i / lines_per_row) * row_pitch_bytes + (size_t)(i % lines_per_row) * 128; unsigned t;
        asm volatile("global_load_dword %0, %1, off" : "=v"(t) : "v"(p) : "memory"); }
    asm volatile("s_waitcnt vmcnt(0)" ::: "memory");
}
__global__ void __launch_bounds__(512, 2) mk_fwd(Args args) {
    extern __shared__ __attribute__((aligned(16))) unsigned char lds_raw[];
    Frame F;
    F.lds = (LAS unsigned char*)lds_raw;
    F.tid = threadIdx.x; F.lane = F.tid & 63; F.wave = __builtin_amdgcn_readfirstlane(F.tid >> 6);
    F.G = gridDim.x; { const int bx = blockIdx.x; F.vcu = (F.G % 8 == 0) ? (bx % 8) * (F.G / 8) + bx / 8 : bx; }
    F.x = (const float*)args.in[0]; F.c = (const float*)args.in[1]; F.pos = (const int*)args.in[2]; F.w_ada = (const float*)args.in[3]; F.b_ada = (const float*)args.in[4];
    F.g_pre = (const float*)args.in[5]; F.g_post = (const float*)args.in[6]; F.w_in = (const float*)args.in[7]; F.pe_ck = (const float*)args.in[8]; F.pe_cv = (const float*)args.in[9];
    F.w_ck1 = (const float*)args.in[10]; F.w_ck2 = (const float*)args.in[11]; F.w_cv1 = (const float*)args.in[12]; F.w_cv2 = (const float*)args.in[13];
    F.w_br_a = (const float*)args.in[14]; F.w_br_b = (const float*)args.in[15]; F.w_out = (const float*)args.in[16];
    F.ws = args.ws; F.dout = (unsigned char*)args.out;
    unsigned char* ws = args.ws;
    { int t0 = threadIdx.x; asm volatile("" : "+v"(t0));
      for (int u = t0; u < (LDS_BYTES - LDSCTL_OFF) / 4; u += 512) ((LAS unsigned*)(F.lds + LDSCTL_OFF))[u] = 0u; }
    __syncthreads();
    const int lo = args.ph_lo, hi = args.ph_hi;
#if STAMP
    unsigned long long ts_[10]; int nts_ = 0;
#define TS() do { ts_[nts_ < 9 ? nts_ : 9] = __builtin_amdgcn_s_memrealtime(); ++nts_; } while (0)
    TS();
#else
#define TS() do {} while (0)
#endif
    const bool multi = (hi - lo) > 1;
    XcdBarrier bar; bar.bar = (unsigned*)(ws + WS_CTL) + CW_BAR; bar.x = 0; bar.st = nullptr;
    if (multi) bar = xcd_barrier_post((unsigned*)(ws + WS_CTL) + CW_BAR, (volatile LAS unsigned*)(F.lds + LDSCTL_OFF + 32));
#ifndef PH_MASK
#define PH_MASK 0xff
#endif
#define IN(k) (((PH_MASK >> (k)) & 1) && lo <= (k) && (k) < hi)
#ifndef REP_MASK
#define REP_MASK 0
#endif
#define REPS(k) for (int rep_ = 0; rep_ < 1 + ((REP_MASK >> (k)) & 1); ++rep_)
#define SEAM(k) do { if (IN(k) && IN((k) + 1)) xcd_barrier(bar); } while (0)

    if (IN(0)) REPS(0) { p0_ada(F); }
    SEAM(0); TS();
    if (IN(1)) REPS(1) { p0_xn(F); p0_items(F); }
    SEAM(1); TS();
    if (IN(2)) REPS(2) {
        const int bx = (int)blockIdx.x, cs = (F.G == 256 && !PROBE_NOREMAP) ? (bx & 7) + 8 * ((((bx >> 3) & 7) << 2) + (bx >> 6)) : bx;
        pg8::Gemm g{(const bf16_t*)(ws + WS_XN), (const bf16_t*)(ws + WS_WINT), MTOK, NINP, 2048}; pg8::ProjOrder S; S.init(MTOK, NINP, F.G, cs);
        pg8::EpiProj E{ws, F.dout, (const float*)(ws + WS_R64), (const float*)(ws + WS_R128)};
        const int nf = S.count_first();
#pragma unroll 1
        for (int part = 0; part < 2; ++part) {
            S.i0 = part ? nf : 0; S.i1 = part ? (1 << 30) : nf;
            pg8::gemm_phase<pg8::EpiProj, pg8::ProjOrder, true, true>(F.lds, g, S, E);
            if (part == 0) { asm volatile("s_waitcnt vmcnt(0)" ::: "memory"); __syncthreads();
                if (threadIdx.x == 0) { __builtin_amdgcn_fence(__ATOMIC_RELEASE, "agent"); (void)xb_add((unsigned*)(ws + WS_CTL) + CW_G1A, (unsigned)nf); __builtin_amdgcn_s_waitcnt(0); } }
        }
        asm volatile("s_waitcnt vmcnt(0)" ::: "memory"); __syncthreads();
        if (threadIdx.x == 0) { __builtin_amdgcn_fence(__ATOMIC_RELEASE, "agent"); (void)xb_add((unsigned*)(ws + WS_CTL) + CW_G1B, 1u); __builtin_amdgcn_s_waitcnt(0); }
    }
#ifdef KEEP_SEAM2
    SEAM(2);
#endif
    TS();
    if (IN(3)) REPS(3) {
        att::MixPtrs MP{ws};
        if (threadIdx.x == 0) { unsigned* cw = (unsigned*)(ws + WS_CTL) + CW_G1A; while (xb_ld(cw) < (unsigned)(pg8::ProjOrder::NFIRST * (MTOK / 256))) __builtin_amdgcn_s_sleep(8);
            __builtin_amdgcn_fence(__ATOMIC_ACQUIRE, "agent"); }
        __syncthreads();
        for (int v = F.vcu; v < 256; v += F.G) {
            const int j = v & 7, bh = 2 * (v >> 3) + (j & 1), b_ = bh >> 3, h_ = bh & 7;
#ifdef USE_WARM
            { const size_t off = ((size_t)b_ * SEQ + 512 * (j >> 1)) * 2048 + h_ * 256;
              touch_lines(ws + WS_KB + off, 2048, 512, 2, F.tid); touch_lines(ws + WS_VB + off, 2048, 512, 2, F.tid); }
#endif
#ifndef REP_CMP
#define REP_CMP 0
#endif
            if (j < 2) { compress_unit(F, (v >> 3) * 2 + j);
                asm volatile("s_waitcnt vmcnt(0)" ::: "memory"); __syncthreads();
                if (threadIdx.x == 0) { __builtin_amdgcn_fence(__ATOMIC_RELEASE, "agent"); (void)xb_add((unsigned*)(ws + WS_CTL) + CW_CMP, 1u); } }
#ifndef NO_MIX
#ifdef MIX_QUEUE
            {
                unsigned* qc = (unsigned*)(ws + WS_CTL) + CW_MIXQ + 32 * (v >> 3); volatile LAS unsigned* qn = (volatile LAS unsigned*)(F.lds + LDSCTL_OFF + 80);
                if (threadIdx.x == 0) qn[0] = xb_add(qc, 1u);
                __syncthreads();
                unsigned k = qn[0];
#pragma unroll 1
                for (int par = 1; k < 16u; par ^= 1) {
                    if (threadIdx.x == 0) qn[par] = xb_add(qc, 1u);
                    const int bh2 = 2 * (v >> 3) + (int)(k & 1u);
                    att::mixb_unit(MP, bh2 >> 3, bh2 & 7, 7 - (int)(k >> 1), F.lds);
                    __syncthreads();
                    k = qn[par];
                }
            }
#else
            const int alist = j < 2 ? 0x4 : j < 4 ? 0x16 : j < 6 ? 0x25 : 0x037, na = j < 2 ? 1 : j < 6 ? 2 : 3;
#pragma unroll 1
            for (int i = 0; i < na + REP_MIXU; ++i) att::mixb_unit(MP, b_, h_, i < na ? ((alist >> (4 * i)) & 15) : 0, F.lds);
#endif
#endif
        }
    }
    TS();
    if (IN(4)) REPS(4) {
        att::NsaPtrs NP{ws};
        asm volatile("s_waitcnt vmcnt(0)" ::: "memory");
        if (threadIdx.x == 0) { unsigned* cw = (unsigned*)(ws + WS_CTL) + CW_CMP; while (xb_ld(cw) < 64u) __builtin_amdgcn_s_sleep(8);
            cw = (unsigned*)(ws + WS_CTL) + CW_G1B; while (xb_ld(cw) < (unsigned)F.G) __builtin_amdgcn_s_sleep(8);
            __builtin_amdgcn_fence(__ATOMIC_ACQUIRE, "agent"); }
        __syncthreads();
        for (int v = F.vcu; v < 256; v += F.G) {
#ifdef USE_WARM
            { const int bg = v >> 3, s = v & 7; const size_t off = ((size_t)(bg >> 2) * SEQ + 256 * s) * 512 + (bg & 3) * 128;
#pragma unroll 1
              for (int t = 2; t < 6; ++t) touch_lines(ws + WS_KC + (size_t)t * 8 * MiB + off, 512, 256, 1, F.tid); }
#endif
#ifndef NO_NSA
#ifdef NSA_QUEUE
            {
                const int bg = v >> 3; unsigned* qc = (unsigned*)(ws + WS_CTL) + CW_NSAQ + 32 * bg; volatile LAS unsigned* qn = (volatile LAS unsigned*)(F.lds + LDSCTL_OFF + 64);
                if (threadIdx.x == 0) qn[0] = xb_add(qc, 1u);
                __syncthreads();
                unsigned k = qn[0];
#pragma unroll 1
                for (int par = 1; k < 32u; par ^= 1) {
                    if (threadIdx.x == 0) qn[par] = xb_add(qc, 1u);
                    att::nsa_unit(NP, bg >> 2, bg & 3, 31 - (int)k, F.lds
#if DBG
                        , (unsigned*)(ws + WS_DBG + 101 * MiB)
#endif
                        );
                    __syncthreads();
                    k = qn[par];
                }
            }
#else
            { const int bg = v >> 3, s = v & 7;
#pragma unroll 1
              for (int i_ = 0; i_ < 4 + REP_UNIT_N; ++i_) { const int i = i_ < 4 ? i_ : REP_UNIT_I; const unsigned long long qtab = (i == 0) ? 0xcdb9beffdaull : (i == 1) ? 0xbd2b09ca38ull : (i == 2) ? 0x4ad4c6b90full : 0x21c66104a0ull;
                  const int qt = (int)((qtab >> (5 * s)) & 31ull); att::nsa_unit(NP, bg >> 2, bg & 3, qt, F.lds
#if DBG
                  , (unsigned*)(ws + WS_DBG + 101 * MiB)
#endif
                  ); } }
#endif
#endif
        }
    }
    SEAM(4); TS();
    if (IN(5)) REPS(5) {
        pg8::Gemm g{(const bf16_t*)(ws + WS_A2), (const bf16_t*)(ws + WS_WBRT), MTOK, 2048, 2048}; pg8::StaticOrder S; S.init(MTOK, 2048, F.G, (int)blockIdx.x);
        pg8::EpiMerge E{(const bf16_t*)(F.dout + DO_MA), (const bf16_t*)(F.dout + DO_MB), (bf16_t*)(ws + WS_MERGED)};
        pg8::gemm_phase<pg8::EpiMerge, pg8::StaticOrder, true, true>(F.lds, g, S, E);
    }
    SEAM(5); TS();
    if (IN(6)) REPS(6) {
        pg8::Gemm g{(const bf16_t*)(ws + WS_MERGED), (const bf16_t*)(ws + WS_WOUTT), MTOK, 2048, 2048}; pg8::StaticOrder S; S.init(MTOK, 2048, F.G, (int)blockIdx.x);
#ifndef FUSE_FINAL
        pg8::EpiOutB E{(bf16_t*)(ws + WS_XN), (float*)(ws + WS_SSQ)};
        pg8::gemm_phase<pg8::EpiOutB, pg8::StaticOrder, true, true>(F.lds, g, S, E);
#else
        pg8::EpiFinal E{F.x, (float*)F.dout, (float*)(ws + WS_SSQ), (unsigned*)(ws + WS_CTL) + CW_PANEL, (const float*)(ws + WS_ADA), F.g_post};
        pg8::PanelOrder PO; PO.init(MTOK, 2048, F.G, F.vcu);
        if ((F.G & 7) == 0) pg8::gemm_phase<pg8::EpiFinal, pg8::PanelOrder, true, true>(F.lds, g, PO, E);
#endif
    }
#ifndef FUSE_FINAL
    SEAM(6);
#endif
    TS();
#ifndef FUSE_FINAL
    if (IN(7)) { p6_final(F); }
#endif
    TS();
#if STAMP
    if (F.vcu == 0 && F.tid == 0) { VM_WAIT(); args.out[0] = (float)(ts_[STAMP_B] - ts_[STAMP_A]); }
#endif
#undef IN
#undef SEAM
}

#if DBG
namespace dbg {
constexpr int BD = DBG_BATCH;
constexpr size_t E_PROJ = 0, E_KC = 48 * MiB, E_VC = 48 * MiB + 256 * 1024, E_SEL = 48 * MiB + 512 * 1024, E_AA = 50 * MiB, E_AB = 58 * MiB, E_MG = 66 * MiB, E_OF = 82 * MiB, E_ADA = 98 * MiB, DIAG = 100 * MiB, SELOUT = 101 * MiB;
__global__ void k_f2b(const float* __restrict__ s, bf16_t* __restrict__ d, size_t n) { for (size_t i = (size_t)blockIdx.x * 256 + threadIdx.x; i < n; i += (size_t)gridDim.x * 256) d[i] = (bf16_t)f2bf(s[i]); }
__global__ void k_copy(const float* __restrict__ s, float* __restrict__ d, size_t n) { for (size_t i = (size_t)blockIdx.x * 256 + threadIdx.x; i < n; i += (size_t)gridDim.x * 256) d[i] = s[i]; }
template <class T> __device__ __forceinline__ float tof(T v);
template <> __device__ __forceinline__ float tof<float>(float v) { return v; }
template <> __device__ __forceinline__ float tof<bf16_t>(bf16_t v) { return bf2f(v); }
template <class FT, class ET, int XF> __global__ void k_cmp(const FT* __restrict__ f, int ldf, const ET* __restrict__ e, int lde, int rows, int cols, float fscale, float* __restrict__ acc) {
    __shared__ float sh[8];
    float num = 0.f, den = 0.f;
    for (size_t i = (size_t)blockIdx.x * 256 + threadIdx.x; i < (size_t)rows * cols; i += (size_t)gridDim.x * 256) { const int r = (int)(i / cols), c = (int)(i % cols);
        const float vf = tof<FT>(f[(size_t)r * ldf + c]) * fscale; float ve = tof<ET>(e[(size_t)r * lde + c]);
        if (XF == 1) ve = ve / (1.f + expf(-ve)); if (XF == 2) ve = 1.f / (1.f + expf(-ve));
        num += (vf - ve) * (vf - ve); den += ve * ve; }
    for (int o = 32; o > 0; o >>= 1) { num += __shfl_xor(num, o); den += __shfl_xor(den, o); }
    if ((threadIdx.x & 63) == 0) { sh[threadIdx.x >> 6] = num; sh[4 + (threadIdx.x >> 6)] = den; }
    __syncthreads();
    if (threadIdx.x == 0) { atomicAdd(acc, sh[0] + sh[1] + sh[2] + sh[3]); atomicAdd(acc + 1, sh[4] + sh[5] + sh[6] + sh[7]); }
}
__global__ void k_cmp_sel(const unsigned* __restrict__ f, const unsigned* __restrict__ e, float* __restrict__ acc) {
    const int idx = blockIdx.x * 256 + threadIdx.x; if (idx >= 2048 * 4) return; const int s = idx >> 2;
    const unsigned valid = (s >> 6) == 31 ? 0xffffffffu : ((2u << (s >> 6)) - 1u);
    const bool bad = ((f[idx] ^ e[idx]) & valid) != 0u;
    atomicAdd(acc, bad ? 1.f : 0.f); if (threadIdx.x == 0 && blockIdx.x == 0) atomicAdd(acc + 1, 8192.f);
}
constexpr int NCHK = 24;
__global__ void k_report(const float* __restrict__ diag, float* __restrict__ out, int sel) {
    if (threadIdx.x != 0) return;
    if (sel == 0) { for (int k = 1; k < NCHK; ++k) { const float num = diag[2 * k], den = diag[2 * k + 1]; if (den == 0.f) continue;
            const float err = (k == 19) ? num / den : sqrtf(num / den);
            const float tol = k == 1 ? 1e-4f : (k == 17 || k == 18 || k == 21) ? 3e-2f : k == 19 ? 0.12f : (k == 20 || k == 22 || k == 23) ? 0.1f : 2e-2f;
            if (!(err <= tol)) { out[0] = (float)k * 1.0e4f; return; } }
        out[0] = 7.7e7f; }
    else { const float num = diag[2 * sel], den = diag[2 * sel + 1]; const float err = (sel == 19) ? num / den : sqrtf(num / den); out[0] = err * 1.0e6f; }
}
}
#endif

extern "C" void kernel_launch(void* const* d_in, const int* in_sizes, int n_in, void* d_out, int out_size, void* d_ws, size_t ws_size, hipStream_t stream) {
    static int grid = 0;
    if (grid == 0) {
        int dev = 0, cus = 0;
        if (hipGetDevice(&dev) != hipSuccess || hipDeviceGetAttribute(&cus, hipDeviceAttributeMultiprocessorCount, dev) != hipSuccess) { fprintf(stderr, "kernel_launch: device query failed\n"); grid = -1; return; }
        if (hipFuncSetAttribute((const void*)mk_fwd, hipFuncAttributeMaxDynamicSharedMemorySize, LDS_BYTES) != hipSuccess) { fprintf(stderr, "kernel_launch: hipFuncSetAttribute failed\n"); grid = -1; return; }
        int per_cu = 0;
        if (hipOccupancyMaxActiveBlocksPerMultiprocessor(&per_cu, (const void*)mk_fwd, 512, LDS_BYTES) != hipSuccess || per_cu < 1) fprintf(stderr, "kernel_launch: occupancy query reports %d\n", per_cu);
        (void)hipGetLastError();
        grid = cus;
    }
    if (grid < 0) return;
    if (ws_size < WS_END) { fprintf(stderr, "kernel_launch: workspace too small (%zu < %zu bytes)\n", ws_size, (size_t)WS_END); return; }
    unsigned char* ws = (unsigned char*)d_ws;
#if DBG
    {
        ref::In I;
        I.x = (const float*)d_in[0]; I.c = (const float*)d_in[1]; I.pos = (const int*)d_in[2]; I.w_ada = (const float*)d_in[3]; I.b_ada = (const float*)d_in[4];
        I.g_pre = (const float*)d_in[5]; I.g_post = (const float*)d_in[6]; I.w_in = (const float*)d_in[7]; I.pe_ck = (const float*)d_in[8]; I.pe_cv = (const float*)d_in[9];
        I.w_ck1 = (const float*)d_in[10]; I.w_ck2 = (const float*)d_in[11]; I.w_cv1 = (const float*)d_in[12]; I.w_cv2 = (const float*)d_in[13];
        I.w_br_a = (const float*)d_in[14]; I.w_br_b = (const float*)d_in[15]; I.w_out = (const float*)d_in[16];
        ref::Bufs B = ref::carve((char*)d_ws);
        ref::run_ada(I, B, stream);
        ref::run_batch(I, B, dbg::BD, (float*)d_out, stream);
        unsigned char* E = ws + WS_DBG;
        dbg::k_f2b<<<2048, 256, 0, stream>>>(B.proj, (bf16_t*)(E + dbg::E_PROJ), (size_t)2048 * NIN);
        dbg::k_copy<<<64, 256, 0, stream>>>(B.kc, (float*)(E + dbg::E_KC), 512 * 64); dbg::k_copy<<<64, 256, 0, stream>>>(B.vc, (float*)(E + dbg::E_VC), 512 * 64);
        dbg::k_copy<<<32, 256, 0, stream>>>((const float*)B.selmask, (float*)(E + dbg::E_SEL), 2048 * 4);
        dbg::k_copy<<<1024, 256, 0, stream>>>(B.Aa, (float*)(E + dbg::E_AA), (size_t)2048 * 1024); dbg::k_copy<<<1024, 256, 0, stream>>>(B.Ab, (float*)(E + dbg::E_AB), (size_t)2048 * 1024);
        dbg::k_copy<<<1024, 256, 0, stream>>>(B.mg, (float*)(E + dbg::E_MG), (size_t)2048 * 2048); dbg::k_copy<<<1024, 256, 0, stream>>>(B.of, (float*)(E + dbg::E_OF), (size_t)2048 * 2048);
        dbg::k_copy<<<64, 256, 0, stream>>>(B.ada, (float*)(E + dbg::E_ADA), 8 * 6144);
        (void)hipMemsetAsync(E + dbg::DIAG, 0, 4096, stream);
    }
#endif
    if (hipMemsetAsync(ws + WS_CTL, 0, CTL_ZERO_BYTES, stream) != hipSuccess) { fprintf(stderr, "kernel_launch: memset failed\n"); return; }
    Args a{};
    for (int i = 0; i < 17; ++i) a.in[i] = d_in[i];
    a.out = (float*)d_out; a.ws = ws;
#if ONE_LAUNCH
    a.ph_lo = 0; a.ph_hi = NPHASE;
    { void* kargs[] = {&a}; const hipError_t e = hipLaunchCooperativeKernel((const void*)mk_fwd, dim3(grid), dim3(512), kargs, LDS_BYTES, stream);
      if (e != hipSuccess) fprintf(stderr, "kernel_launch: cooperative launch failed: %s (grid %d)\n", hipGetErrorString(e), grid); }
#else
    for (int p = 0; p < NPHASE && p <= DBG_STOP; ++p) { a.ph_lo = p; a.ph_hi = p + 1; hipLaunchKernelGGL(mk_fwd, dim3(grid), dim3(512), LDS_BYTES, stream, a); }
#endif
#if DBG
    {
        unsigned char* E = ws + WS_DBG; float* diag = (float*)(E + dbg::DIAG); const bf16_t* EP = (const bf16_t*)(E + dbg::E_PROJ);
        const size_t r0 = (size_t)dbg::BD * 2048;
#define CMPB(id, fastptr, ldf, ecol, cols, XF, fs) dbg::k_cmp<bf16_t, bf16_t, XF><<<512, 256, 0, stream>>>((const bf16_t*)(fastptr) + r0 * (ldf), ldf, EP + (ecol), NIN, 2048, cols, fs, diag + 2 * (id))
        dbg::k_cmp<float, float, 0><<<64, 256, 0, stream>>>((const float*)(ws + WS_ADA), 6144, (const float*)(E + dbg::E_ADA), 6144, 8, 6144, 1.f, diag + 2 * 1);
        CMPB(2, ws + WS_QA, 1024, ref::C_QA, 1024, 0, 1.f / QS64);
        CMPB(3, ws + WS_KC + 0 * 8 * MiB, 256, ref::C_KC, 256, 0, 1.f); CMPB(4, ws + WS_KC + 1 * 8 * MiB, 256, ref::C_VC, 256, 0, 1.f); CMPB(5, ws + WS_KC + 2 * 8 * MiB, 256, ref::C_KS, 256, 0, 1.f);
        CMPB(6, ws + WS_KC + 3 * 8 * MiB, 256, ref::C_VS, 256, 0, 1.f); CMPB(7, ws + WS_KC + 4 * 8 * MiB, 256, ref::C_KW, 256, 0, 1.f); CMPB(8, ws + WS_KC + 5 * 8 * MiB, 256, ref::C_VW, 256, 0, 1.f);
        CMPB(9, ws + WS_ZA, 1024, ref::C_ZA, 1024, 1, 1.f);
        if (DBG_STOP < 5) { CMPB(10, ws + WS_QB, 1024, ref::C_QB, 1024, 0, 1.f / QS128); CMPB(11, ws + WS_KB, 1024, ref::C_KB, 1024, 0, 1.f); }
        if (DBG_STOP < 6) { CMPB(14, (unsigned char*)d_out + DO_MA, 2048, ref::C_MA, 2048, 2, 1.f); CMPB(15, (unsigned char*)d_out + DO_MB, 2048, ref::C_MB, 2048, 2, 1.f); }
        if (DBG_STOP == 6) dbg::k_cmp<float, float, 0><<<512, 256, 0, stream>>>((const float*)d_out + r0 * 2048, 2048, (const float*)(E + dbg::E_OF), 2048, 2048, 2048, 1.f, diag + 2 * 23);
        CMPB(12, ws + WS_VB, 1024, ref::C_VB, 1024, 0, 1.f); CMPB(13, ws + WS_ZB, 1024, ref::C_ZB, 1024, 1, 1.f);
        CMPB(16, ws + WS_GA, 64, ref::C_GA, 48, 2, 1.f);
        if (DBG_STOP >= 3) {
        dbg::k_cmp<bf16_t, float, 0><<<64, 256, 0, stream>>>((const bf16_t*)(ws + WS_KCC) + (size_t)dbg::BD * 512 * 64, 64, (const float*)(E + dbg::E_KC), 64, 512, 64, 1.f, diag + 2 * 17);
        dbg::k_cmp<bf16_t, float, 0><<<64, 256, 0, stream>>>((const bf16_t*)(ws + WS_VCC) + (size_t)dbg::BD * 512 * 64, 64, (const float*)(E + dbg::E_VC), 64, 512, 64, 1.f, diag + 2 * 18); }
        if (DBG_STOP >= 4) {
        dbg::k_cmp_sel<<<32, 256, 0, stream>>>((const unsigned*)(E + dbg::SELOUT) + r0 * 4, (const unsigned*)(E + dbg::E_SEL), diag + 2 * 19);
        dbg::k_cmp<bf16_t, float, 0><<<512, 256, 0, stream>>>((const bf16_t*)(ws + WS_A2) + r0 * 2048, 2048, (const float*)(E + dbg::E_AA), 1024, 2048, 1024, 1.f, diag + 2 * 20);
        dbg::k_cmp<bf16_t, float, 0><<<512, 256, 0, stream>>>((const bf16_t*)(ws + WS_A2) + r0 * 2048 + 1024, 2048, (const float*)(E + dbg::E_AB), 1024, 2048, 1024, 1.f, diag + 2 * 21); }
        if (DBG_STOP >= 5)
        dbg::k_cmp<bf16_t, float, 0><<<512, 256, 0, stream>>>((const bf16_t*)(ws + WS_MERGED) + r0 * 2048, 2048, (const float*)(E + dbg::E_MG), 2048, 2048, 2048, 1.f, diag + 2 * 22);
#undef CMPB
        dbg::k_report<<<1, 64, 0, stream>>>(diag, (float*)d_out, DBG_SEL);
    }
#endif
}
```

```cpp
#define DBG 0
#define DBG_BATCH 5
#define DBG_SEL 0
#define ONE_LAUNCH 1
#define DBG_STOP 7
#define REP_MASK 0
#define STAMP 0
#define STAMP_A 0
#define STAMP_B 8
#define MAN_PV 1
#define NSA_QUEUE 1
#define MIX_QUEUE 1
#define MAX_STRIDE 4
#define MIX_FASTMASK 1
#include <hip/hip_runtime.h>
#include <hip/hip_cooperative_groups.h>
#include <cmath>
#include <cstdio>
#include <cstdint>

constexpr int NB = 8, SEQ = 2048, DM = 2048, MTOK = NB * SEQ;
constexpr int NIN = 11824, NINP = 12032;
constexpr float LOG2E = 1.4426950408889634f;
constexpr float QS64 = 0.125f * LOG2E, QS128 = 0.08838834764831845f * LOG2E;
constexpr size_t MiB = 1u << 20;
constexpr size_t WS_CTL = 0, CTL_ZERO_BYTES = 1 * MiB;
constexpr size_t WS_ADA = 1 * MiB;
constexpr size_t WS_R64 = 2 * MiB;
constexpr size_t WS_R128 = 3 * MiB;
constexpr size_t WS_BIAS1 = 5 * MiB;
constexpr size_t WS_SSQ = 6 * MiB;
constexpr size_t WS_KCC = 8 * MiB, WS_VCC = 8 * MiB + 512 * 1024;
constexpr size_t WS_W2T = 9 * MiB;
constexpr size_t WS_W1T = 10 * MiB;
constexpr size_t WS_GA = 12 * MiB;
constexpr size_t WS_WBRT = 16 * MiB, WS_WOUTT = 24 * MiB;
constexpr size_t WS_WINT = 32 * MiB;
constexpr size_t WS_XN = 80 * MiB;
constexpr size_t WS_QA = 144 * MiB;
constexpr size_t WS_KC = 176 * MiB;
constexpr size_t WS_ZA = 224 * MiB, WS_QB = 256 * MiB, WS_KB = 288 * MiB, WS_VB = 320 * MiB, WS_ZB = 352 * MiB;
constexpr size_t WS_MERGED = 256 * MiB;
#if DBG
constexpr size_t WS_A2 = WS_XN;
#else
constexpr size_t WS_A2 = 384 * MiB;
#endif
constexpr size_t WS_END = 448 * MiB;
constexpr size_t WS_DBG = 384 * MiB;
constexpr size_t DO_MA = 0, DO_MB = 64 * MiB;

typedef unsigned short bf16_t;
#define LAS __attribute__((address_space(3)))
#define GAS __attribute__((address_space(1)))
typedef unsigned u32x4_t __attribute__((ext_vector_type(4)));
typedef unsigned u32x2_t __attribute__((ext_vector_type(2)));
typedef float f32x4_t __attribute__((ext_vector_type(4)));

__device__ __forceinline__ unsigned f2bf(float f) { unsigned u = __builtin_bit_cast(unsigned, f); return (u + 0x7fffu + ((u >> 16) & 1u)) >> 16; }
__device__ __forceinline__ unsigned pk2(float lo, float hi) { return f2bf(lo) | (f2bf(hi) << 16); }
__device__ __forceinline__ float bf2f(unsigned short h) { return __builtin_bit_cast(float, (unsigned)h << 16); }
__device__ __forceinline__ float bflo(unsigned w) { return __builtin_bit_cast(float, w << 16); }
__device__ __forceinline__ float bfhi(unsigned w) { return __builtin_bit_cast(float, w & 0xffff0000u); }
__device__ __forceinline__ float fast_sigmoid(float x) { return __builtin_amdgcn_rcpf(1.f + __builtin_amdgcn_exp2f(-x * LOG2E)); }
namespace pg8 {
#define PG8_LAS __attribute__((address_space(3)))
typedef unsigned short bf16_t;
typedef short bf16x8 __attribute__((ext_vector_type(8)));
typedef float f32x4 __attribute__((ext_vector_type(4)));
typedef unsigned u32x4 __attribute__((ext_vector_type(4)));
constexpr int BM = 256, BK = 64, HALF = 128, HTB = HALF * BK * 2  , STAGE_BYTES = 8 * HTB, NXCD = 8, WGM = 8;

__host__ __device__ __forceinline__ int lds_byte(int r, int c) { const int st = (r >> 4) * 2 + (c >> 5), rr = r & 15, cc = c & 31, ob = rr * 64 + cc * 2; return st * 1024 + (ob ^ (((ob >> 9) & 1) << 5)); }
__host__ __device__ __forceinline__ void stage_rc(int b, int& R, int& C) { const int st = b / 1024, sb = b % 1024, swz = sb ^ (((sb >> 9) & 1) << 5); R = (st >> 1) * 16 + swz / 64; C = (st & 1) * 32 + (swz % 64) / 2; }
__host__ __device__ __forceinline__ int perm32(int rho) { const int n = rho >> 4, i = rho & 15; return 8 * (i >> 2) + 4 * n + (i & 3); }

struct Unit { int pm, pn; };
struct Gemm { const bf16_t* A; const bf16_t* Bt; int M, N, K; };

struct StaticOrder {
    int nM, nN, nwg, G, c;
    __host__ __device__ void init(int M, int N, int G_, int c_) { nM = M / BM; nN = N / BM; nwg = nM * nN; G = G_; c = c_; }
    __host__ __device__ bool next(int i, Unit& u) const {
        const long L = (long)i * G + c; if (L >= nwg) return false;
        int wgid = (int)L; { const int q = nwg / NXCD, r = nwg % NXCD, xcd = wgid % NXCD, off = wgid / NXCD; wgid = (xcd < r ? xcd * (q + 1) : r * (q + 1) + (xcd - r) * q) + off; }
        const int nig = WGM * nN, gid = wgid / nig, fm = gid * WGM, gsz = (nM - fm) < WGM ? (nM - fm) : WGM;
        u.pm = fm + ((wgid % nig) % gsz); u.pn = (wgid % nig) / gsz; return true;
    }
    __device__ __forceinline__ void a_ready(const Unit&) const {}
    __device__ __forceinline__ void done(const Unit&) const {}
};
struct ProjOrder {
    int nM, nN, nwg, G, c, i0, i1;
    static constexpr int NFIRST = 18;
    __host__ __device__ void init(int M, int N, int G_, int c_) { nM = M / BM; nN = N / BM; nwg = nM * nN; G = G_; c = c_; i0 = 0; i1 = 1 << 30; }
    __host__ __device__ static int perm(int i) { return i < 2 ? 4 + i : i < 18 ? 12 + i : i < 22 ? i - 18 : i < 26 ? i - 16 : i < 30 ? i - 16 : i; }
    __host__ __device__ bool decode(int i, int& pm, int& pi) const {
        const long L = (long)i * G + c; if (L >= nwg) return false;
        int wgid = (int)L; { const int q = nwg / NXCD, r = nwg % NXCD, xcd = wgid % NXCD, off = wgid / NXCD; wgid = (xcd < r ? xcd * (q + 1) : r * (q + 1) + (xcd - r) * q) + off; }
        const int nig = WGM * nN, gid = wgid / nig, fm = gid * WGM, gsz = (nM - fm) < WGM ? (nM - fm) : WGM;
        pm = fm + ((wgid % nig) % gsz); pi = (wgid % nig) / gsz; return true; }
    __host__ __device__ int count_first() const { int n = 0, pm, pi; while (decode(n, pm, pi) && pi < NFIRST) ++n; return n; }
    __host__ __device__ bool next(int i, Unit& u) const { int pi; if (i0 + i >= i1 || !decode(i0 + i, u.pm, pi)) return false; u.pn = perm(pi); return true; }
    __device__ __forceinline__ void a_ready(const Unit&) const {}
    __device__ __forceinline__ void done(const Unit&) const {}
};

typedef float f32x2_cv __attribute__((ext_vector_type(2))); typedef __bf16 bf16x2_cv __attribute__((ext_vector_type(2)));
__device__ __forceinline__ unsigned cvt_pk_bf16(float lo, float hi) { f32x2_cv v = {lo, hi}; bf16x2_cv b = __builtin_convertvector(v, bf16x2_cv); return __builtin_bit_cast(unsigned, b); }

struct EpiProj {
    static constexpr bool PERM = true, AFTER_DRAIN = false, MIDHOOK = false;
    unsigned char* ws; unsigned char* dout; const float* r64; const float* r128;
    __device__ __forceinline__ void mid(f32x4 (&)[2][2][4][2], const Unit&, int, int, int, int) const {}
    __device__ __forceinline__ void operator()(const f32x4 (&acc)[2][2][4][2], const Unit& u, int wr, int wc, int fr, int fq) const {
        const int pn = u.pn;
        bf16_t* base; int ldc, colt, mode; float sc = 1.f;
        if (pn < 4)       { base = (bf16_t*)(ws + WS_QA); ldc = 1024; colt = 256 * pn; mode = 1; sc = QS64; }
        else if (pn < 10) { base = (bf16_t*)(ws + WS_KC + (size_t)(pn - 4) * 8 * MiB); ldc = 256; colt = 0; mode = (pn == 6 || pn == 8) ? 1 : 0; }
        else if (pn < 14) { base = (bf16_t*)(ws + WS_ZA); ldc = 1024; colt = 256 * (pn - 10); mode = 3; }
        else if (pn < 18) { base = (bf16_t*)(ws + WS_QB); ldc = 1024; colt = 256 * (pn - 14); mode = 2; sc = QS128; }
        else if (pn < 22) { base = (bf16_t*)(ws + WS_KB); ldc = 1024; colt = 256 * (pn - 18); mode = 2; }
        else if (pn < 26) { base = (bf16_t*)(ws + WS_VB); ldc = 1024; colt = 256 * (pn - 22); mode = 0; }
        else if (pn < 30) { base = (bf16_t*)(ws + WS_ZB); ldc = 1024; colt = 256 * (pn - 26); mode = 3; }
        else if (pn < 38) { base = (bf16_t*)(dout + DO_MA); ldc = 2048; colt = 256 * (pn - 30); mode = 4; }
        else if (pn < 46) { base = (bf16_t*)(dout + DO_MB); ldc = 2048; colt = 256 * (pn - 38); mode = 4; }
        else              { base = (bf16_t*)(ws + WS_GA); ldc = 64; colt = 0; mode = 5; }
        const int row0 = u.pm * BM + wr * 64 + fr;
        const int cb = wc * 32 + 8 * fq;
        const bool rope_wave = (mode == 1 && (wc & 1) == 0) || (mode == 2 && wc == 0);
#pragma unroll
        for (int ai = 0; ai < 2; ++ai)
#pragma unroll
            for (int m = 0; m < 4; ++m) {
                const int row = row0 + ai * HALF + m * 16;
                float v2[2][8];
#pragma unroll
                for (int bj = 0; bj < 2; ++bj)
#pragma unroll
                    for (int j = 0; j < 4; ++j) { v2[bj][j] = acc[ai][bj][m][0][j]; v2[bj][4 + j] = acc[ai][bj][m][1][j]; }
                if (rope_wave) {
                    float cs[8], sn[8];
                    if (mode == 1) { const f32x4* t = (const f32x4*)(r64 + (size_t)row * 16); const f32x4 c0 = t[0], c1 = t[1], s0 = t[2], s1 = t[3];
#pragma unroll
                        for (int j = 0; j < 4; ++j) { cs[j] = c0[j]; cs[4 + j] = c1[j]; sn[j] = s0[j]; sn[4 + j] = s1[j]; } }
                    else { const f32x4* t = (const f32x4*)(r128 + (size_t)row * 32 + 8 * (fq & 1)); const f32x4 c0 = t[0], c1 = t[1], s0 = t[4], s1 = t[5];
#pragma unroll
                        for (int j = 0; j < 4; ++j) { cs[j] = c0[j]; cs[4 + j] = c1[j]; sn[j] = s0[j]; sn[4 + j] = s1[j]; } }
                    const int xm = (mode == 1) ? 16 : 32;
                    const bool is_x1 = (mode == 1) ? (fq == 0) : (fq < 2);
                    const bool do_rot = (mode == 1) ? (fq < 2) : true;
#pragma unroll
                    for (int bj = 0; bj < 2; ++bj)
#pragma unroll
                        for (int j = 0; j < 8; ++j) { const float p = __shfl_xor(v2[bj][j], xm); const float r = v2[bj][j] * cs[j] + (is_x1 ? -p : p) * sn[j]; v2[bj][j] = do_rot ? r : v2[bj][j]; }
                }
#pragma unroll
                for (int bj = 0; bj < 2; ++bj) {
                    float v[8];
#pragma unroll
                    for (int j = 0; j < 8; ++j) v[j] = v2[bj][j];
                    if (mode == 3) {
#pragma unroll
                        for (int j = 0; j < 8; ++j) v[j] = v[j] * fast_sigmoid(v[j]);
                    } else if (mode >= 4) {
#pragma unroll
                        for (int j = 0; j < 8; ++j) v[j] = fast_sigmoid(v[j]);
                    } else {
#pragma unroll
                        for (int j = 0; j < 8; ++j) v[j] *= sc;
                    }
                    u32x4 w; w.x = cvt_pk_bf16(v[0], v[1]); w.y = cvt_pk_bf16(v[2], v[3]); w.z = cvt_pk_bf16(v[4], v[5]); w.w = cvt_pk_bf16(v[6], v[7]);
                    const int col = cb + bj * HALF;
                    if (mode != 5 || col < 48) *(u32x4*)(base + (size_t)row * ldc + colt + col) = w;
                }
            }
    }
};

struct EpiMerge {
    static constexpr bool PERM = true, AFTER_DRAIN = false, MIDHOOK = true;
    const bf16_t* sma; const bf16_t* smb; bf16_t* out;
    __device__ __forceinline__ void mid(f32x4 (&acc)[2][2][4][2], const Unit& u, int wr, int wc, int fr, int fq) const {
        asm volatile("" : "+v"(fr), "+v"(fq));
        const int row0 = u.pm * BM + wr * 64 + fr, col0 = u.pn * BM + wc * 32 + 8 * fq;
#pragma unroll
        for (int ai = 0; ai < 2; ++ai)
#pragma unroll
            for (int m = 0; m < 4; ++m)
#pragma unroll
                for (int bj = 0; bj < 2; ++bj) { const size_t off = (size_t)(row0 + ai * HALF + m * 16) * 2048 + col0 + bj * HALF;
                    const u32x4 a = *(const u32x4*)(sma + off), b = *(const u32x4*)(smb + off);
#pragma unroll
                    for (int q = 0; q < 4; ++q) { const float a0 = bflo(a[q]), a1 = bfhi(a[q]), b0 = bflo(b[q]), b1 = bfhi(b[q]);
                        acc[ai][bj][m][q >> 1][(q & 1) * 2 + 0] *= a0 * __builtin_amdgcn_rcpf(b0); acc[ai][bj][m][q >> 1][(q & 1) * 2 + 1] *= a1 * __builtin_amdgcn_rcpf(b1); }
                    if (bj == 1) asm volatile("" ::: "memory"); }
    }
    __device__ __forceinline__ void operator()(const f32x4 (&acc)[2][2][4][2], const Unit& u, int wr, int wc, int fr, int fq) const {
        const int row0 = u.pm * BM + wr * 64 + fr, col0 = u.pn * BM + wc * 32 + 8 * fq;
#pragma unroll
        for (int ai = 0; ai < 2; ++ai)
#pragma unroll
            for (int m = 0; m < 4; ++m)
#pragma unroll
                for (int bj = 0; bj < 2; ++bj) { const size_t off = (size_t)(row0 + ai * HALF + m * 16) * 2048 + col0 + bj * HALF;
                    const u32x4 b = *(const u32x4*)(smb + off); u32x4 w;
#pragma unroll
                    for (int q = 0; q < 4; ++q) w[q] = cvt_pk_bf16(acc[ai][bj][m][q >> 1][(q & 1) * 2 + 0] * bflo(b[q]), acc[ai][bj][m][q >> 1][(q & 1) * 2 + 1] * bfhi(b[q]));
                    *(u32x4*)(out + off) = w; if (bj == 1) asm volatile("" ::: "memory"); }
    }
};

struct EpiOut {
    static constexpr bool PERM = false, AFTER_DRAIN = false, MIDHOOK = false;
    float* C; float* ssq;
    __device__ __forceinline__ void mid(f32x4 (&)[2][2][4][2], const Unit&, int, int, int, int) const {}
    __device__ __forceinline__ void operator()(const f32x4 (&acc)[2][2][4][2], const Unit& u, int wr, int wc, int fr, int fq) const {
        const int row0 = u.pm * BM + wr * 64 + fr, col0 = u.pn * BM + wc * 32 + 4 * fq;
#pragma unroll
        for (int ai = 0; ai < 2; ++ai)
#pragma unroll
            for (int m = 0; m < 4; ++m) { const int row = row0 + ai * HALF + m * 16; float* rowp = C + (size_t)row * 2048 + col0; float s = 0.f;
#pragma unroll
                for (int bj = 0; bj < 2; ++bj)
#pragma unroll
                    for (int n = 0; n < 2; ++n) { const f32x4 x = acc[ai][bj][m][n]; *(f32x4*)(rowp + bj * HALF + n * 16) = x; s += (x[0] * x[0] + x[1] * x[1]) + (x[2] * x[2] + x[3] * x[3]); }
                s += __shfl_xor(s, 16); s += __shfl_xor(s, 32);
                if (fq == 0) ssq[(size_t)row * 32 + u.pn * 4 + wc] = s; }
    }
};

struct EpiOutB {
    static constexpr bool PERM = true, AFTER_DRAIN = false, MIDHOOK = false;
    bf16_t* C; float* ssq;
    __device__ __forceinline__ void mid(f32x4 (&)[2][2][4][2], const Unit&, int, int, int, int) const {}
    __device__ __forceinline__ void operator()(const f32x4 (&acc)[2][2][4][2], const Unit& u, int wr, int wc, int fr, int fq) const {
        const int row0 = u.pm * BM + wr * 64 + fr, col0 = u.pn * BM + wc * 32 + 8 * fq;
#pragma unroll
        for (int ai = 0; ai < 2; ++ai)
#pragma unroll
            for (int m = 0; m < 4; ++m) { const int row = row0 + ai * HALF + m * 16; bf16_t* rowp = C + (size_t)row * 2048 + col0; float s = 0.f;
#pragma unroll
                for (int bj = 0; bj < 2; ++bj) { const f32x4 x0 = acc[ai][bj][m][0], x1 = acc[ai][bj][m][1];
                    s += ((x0[0] * x0[0] + x0[1] * x0[1]) + (x0[2] * x0[2] + x0[3] * x0[3])) + ((x1[0] * x1[0] + x1[1] * x1[1]) + (x1[2] * x1[2] + x1[3] * x1[3]));
                    u32x4 w; w.x = cvt_pk_bf16(x0[0], x0[1]); w.y = cvt_pk_bf16(x0[2], x0[3]); w.z = cvt_pk_bf16(x1[0], x1[1]); w.w = cvt_pk_bf16(x1[2], x1[3]);
                    *(u32x4*)(rowp + bj * HALF) = w; }
                s += __shfl_xor(s, 16); s += __shfl_xor(s, 32);
                if (fq == 0) ssq[(size_t)row * 32 + u.pn * 4 + wc] = s; }
    }
};

struct EpiFinal {
    static constexpr bool PERM = false, AFTER_DRAIN = false, MIDHOOK = false;
    const float* x; float* out; float* ssq; unsigned* cnt; const float* ada; const float* gpost;
    __device__ __forceinline__ void mid(f32x4 (&)[2][2][4][2], const Unit&, int, int, int, int) const {}
    __device__ __forceinline__ void operator()(const f32x4 (&acc)[2][2][4][2], const Unit& u, int wr, int wc, int fr, int fq) const {
        const int row0 = u.pm * BM + wr * 64 + fr, col0 = u.pn * BM + wc * 32 + 4 * fq;
#pragma unroll
        for (int ai = 0; ai < 2; ++ai)
#pragma unroll
            for (int m = 0; m < 4; ++m) { const int row = row0 + ai * HALF + m * 16; float s = 0.f;
#pragma unroll
                for (int bj = 0; bj < 2; ++bj)
#pragma unroll
                    for (int n = 0; n < 2; ++n) { const f32x4 v = acc[ai][bj][m][n]; s += (v[0] * v[0] + v[1] * v[1]) + (v[2] * v[2] + v[3] * v[3]); }
                s += __shfl_xor(s, 16); s += __shfl_xor(s, 32);
                if (fq == 0) __hip_atomic_store(ssq + (size_t)row * 32 + u.pn * 4 + wc, s, __ATOMIC_RELAXED, __HIP_MEMORY_SCOPE_AGENT); }
        asm volatile("s_waitcnt vmcnt(0)" ::: "memory");
        unsigned* c = cnt + 64 * u.pm;
        if (fr == 0 && fq == 0) __hip_atomic_fetch_add(c, 1u, __ATOMIC_RELAXED, __HIP_MEMORY_SCOPE_AGENT);
        { unsigned spins = 0;
          while ((unsigned)__builtin_amdgcn_readfirstlane(__hip_atomic_load(c, __ATOMIC_RELAXED, __HIP_MEMORY_SCOPE_AGENT)) < 64u) { __builtin_amdgcn_s_sleep(2); if (++spins > (1u << 22)) break; } }
        const int b = (u.pm * BM) >> 11;
        f32x4 gg[2][2];
#pragma unroll
        for (int bj = 0; bj < 2; ++bj)
#pragma unroll
            for (int n = 0; n < 2; ++n) { const int col = col0 + bj * HALF + n * 16; gg[bj][n] = *(const f32x4*)(ada + b * 6144 + 4096 + col) * *(const f32x4*)(gpost + col); }
#pragma unroll
        for (int ai = 0; ai < 2; ++ai)
#pragma unroll
            for (int m = 0; m < 4; ++m) { const int row = row0 + ai * HALF + m * 16; const float* sp = ssq + (size_t)row * 32 + 8 * fq; float s = 0.f;
#pragma unroll
                for (int q = 0; q < 8; ++q) s += __hip_atomic_load(sp + q, __ATOMIC_RELAXED, __HIP_MEMORY_SCOPE_AGENT);
                s += __shfl_xor(s, 16); s += __shfl_xor(s, 32);
                const float rstd = rsqrtf(s * (1.f / 2048.f) + 1e-6f);
                const float* xr = x + (size_t)row * 2048 + col0; float* orow = out + (size_t)row * 2048 + col0;
#pragma unroll
                for (int bj = 0; bj < 2; ++bj)
#pragma unroll
                    for (int n = 0; n < 2; ++n) { const f32x4 xv = *(const f32x4*)(xr + bj * HALF + n * 16); *(f32x4*)(orow + bj * HALF + n * 16) = xv + gg[bj][n] * (acc[ai][bj][m][n] * rstd); }
                if (m & 1) asm volatile("" ::: "memory"); }
    }
};

struct PanelOrder {
    int nN, nwg, G, v;
    __host__ __device__ void init(int M, int N, int G_, int v_) { nN = N / BM; nwg = (M / BM) * nN; G = G_; v = v_; }
    __host__ __device__ bool next(int i, Unit& u) const { const long L = (long)i * G + v; if (L >= nwg) return false; u.pm = (int)(L / nN); u.pn = (int)(L % nN); return true; }
    __device__ __forceinline__ void a_ready(const Unit&) const {}
    __device__ __forceinline__ void done(const Unit&) const {}
};
template <class Epi, class Sched, bool ALIGN_EPI = false, bool SP2 = false>
__device__ __forceinline__ void gemm_phase(PG8_LAS unsigned char* lds, const Gemm g, const Sched& S, const Epi& E) {
    const int tid = threadIdx.x, wid = __builtin_amdgcn_readfirstlane(tid >> 6), lane = tid & 63, wr = wid >> 2, wc = wid & 3, fr = lane & 15, fq = lane >> 4;
    const int K = g.K, nt = K / BK;
    unsigned voffA[2], voffB[2];
#pragma unroll
    for (int i = 0; i < 2; ++i) { int R, C; stage_rc(tid * 16 + i * 8192, R, C); const int Rb = Epi::PERM ? ((R & ~31) + perm32(R & 31)) : R;
        voffA[i] = (unsigned)(R * K + C) * 2u; voffB[i] = (unsigned)(Rb * K + C) * 2u; }
    const size_t kstep = (size_t)(BK * 2);
    const size_t hstep = (size_t)HALF * K * 2;
    const size_t tstep = 2 * hstep;
    const unsigned ldsw = (unsigned)wid * 1024u;
    const int aoff = lds_byte(wr * 64 + fr, fq * 8), boff = lds_byte(wc * 32 + fr, fq * 8);
#define PG8_SA(b, h) (((b) * 2 + (h)) * HTB)
#define PG8_SB(b, h) ((4 + (b) * 2 + (h)) * HTB)
#define PG8_STAGE(bufoff, gbase, voff) do { _Pragma("unroll") for (int _i = 0; _i < 2; ++_i) \
        __builtin_amdgcn_global_load_lds((const unsigned*)((const char*)(gbase) + (voff)[_i]), (PG8_LAS unsigned*)(lds + (bufoff) + ldsw + _i * 8192), 16, 0, 0); } while (0)
#define PG8_LDA(dst, b, h) do { _Pragma("unroll") for (int m = 0; m < 4; ++m) _Pragma("unroll") for (int k = 0; k < 2; ++k) dst[m][k] = *(const PG8_LAS bf16x8*)(lds + PG8_SA(b, h) + aoff + m * 2048 + k * 1024); } while (0)
#define PG8_LDB(dst, b, h) do { _Pragma("unroll") for (int n = 0; n < 2; ++n) _Pragma("unroll") for (int k = 0; k < 2; ++k) dst[n][k] = *(const PG8_LAS bf16x8*)(lds + PG8_SB(b, h) + boff + n * 2048 + k * 1024); } while (0)
#define PG8_MMA(ai, bj, At, Bt) do { __builtin_amdgcn_s_setprio(1); _Pragma("unroll") for (int m = 0; m < 4; ++m) _Pragma("unroll") for (int n = 0; n < 2; ++n) _Pragma("unroll") for (int k = 0; k < 2; ++k) \
        acc[ai][bj][m][n] = __builtin_amdgcn_mfma_f32_16x16x32_bf16(Bt[n][k], At[m][k], acc[ai][bj][m][n], 0, 0, 0); __builtin_amdgcn_s_setprio(0); } while (0)
#define PG8_WAIT_V(n) asm volatile("s_waitcnt vmcnt(" #n ")" ::: "memory")
#define PG8_WAIT_L(n) asm volatile("s_waitcnt lgkmcnt(" #n ")" ::: "memory")
#define PG8_BAR __builtin_amdgcn_s_barrier()
#define PG8_SCHED __builtin_amdgcn_sched_barrier(0)
    Unit cur, nxt; int ui = 0;
    if (!S.next(0, cur)) return;
    f32x4 acc[2][2][4][2];
#pragma unroll
    for (int a = 0; a < 2; ++a)
#pragma unroll
        for (int b = 0; b < 2; ++b)
#pragma unroll
            for (int m = 0; m < 4; ++m)
#pragma unroll
                for (int n = 0; n < 2; ++n) acc[a][b][m][n] = (f32x4){0.f, 0.f, 0.f, 0.f};
    bf16x8 At[4][2], B0[2][2], B1[2][2];
    const char* cA = (const char*)g.A + (size_t)cur.pm * tstep; const char* cB = (const char*)g.Bt + (size_t)cur.pn * tstep;
    S.a_ready(cur);
    if constexpr (SP2) {
        PG8_STAGE(PG8_SB(0, 0), cB, voffB); PG8_STAGE(PG8_SB(0, 1), cB + hstep, voffB); PG8_STAGE(PG8_SA(0, 0), cA, voffA); PG8_STAGE(PG8_SA(0, 1), cA + hstep, voffA);
        if (wr == 1) PG8_BAR;
        PG8_WAIT_V(2); PG8_BAR;
        PG8_STAGE(PG8_SB(1, 0), cB + kstep, voffB); PG8_STAGE(PG8_SA(1, 0), cA + kstep, voffA); PG8_STAGE(PG8_SB(1, 1), cB + hstep + kstep, voffB);
        PG8_WAIT_V(6); PG8_BAR;
    } else {
        PG8_STAGE(PG8_SB(0, 0), cB, voffB); PG8_STAGE(PG8_SA(0, 0), cA, voffA); PG8_STAGE(PG8_SB(0, 1), cB + hstep, voffB); PG8_STAGE(PG8_SA(0, 1), cA + hstep, voffA);
        if (wr == 1) PG8_BAR;
        PG8_WAIT_V(4); PG8_BAR;
        PG8_STAGE(PG8_SB(1, 0), cB + kstep, voffB); PG8_STAGE(PG8_SA(1, 0), cA + kstep, voffA); PG8_STAGE(PG8_SB(1, 1), cB + hstep + kstep, voffB);
        PG8_WAIT_V(6); PG8_BAR;
    }
    for (;;) {
        const bool has_next = S.next(ui + 1, nxt);
        const char* nA = has_next ? (const char*)g.A + (size_t)nxt.pm * tstep : cA; const char* nB = has_next ? (const char*)g.Bt + (size_t)nxt.pn * tstep : cB;
        for (int t = 0; t < nt; t += 2) {
            const bool last = (t == nt - 2);
            if constexpr (Epi::MIDHOOK) { if (t == nt / 2) E.mid(acc, cur, wr, wc, fr, fq); }
            const char* a1 = cA + (size_t)(t + 1) * kstep;
            const char* a2 = last ? nA : cA + (size_t)(t + 2) * kstep; const char* b2 = last ? nB : cB + (size_t)(t + 2) * kstep;
            const char* a3 = a2 + kstep; const char* b3 = b2 + kstep;
            if (last && has_next) S.a_ready(nxt);
            if constexpr (SP2) {
            PG8_LDB(B0, 0, 0); PG8_LDB(B1, 0, 1); PG8_SCHED; PG8_LDA(At, 0, 0); PG8_STAGE(PG8_SA(1, 1), a1 + hstep, voffA);
            PG8_WAIT_V(8); PG8_WAIT_L(0); PG8_BAR; PG8_MMA(0, 0, At, B0); PG8_MMA(0, 1, At, B1); PG8_BAR; PG8_SCHED;
            PG8_LDA(At, 0, 1); PG8_STAGE(PG8_SB(0, 0), b2, voffB); PG8_STAGE(PG8_SB(0, 1), b2 + hstep, voffB); PG8_STAGE(PG8_SA(0, 0), a2, voffA);
            PG8_WAIT_V(8); PG8_WAIT_L(0); PG8_BAR; PG8_MMA(1, 0, At, B0); PG8_MMA(1, 1, At, B1); PG8_BAR; PG8_SCHED;
            PG8_LDB(B0, 1, 0); PG8_LDB(B1, 1, 1); PG8_SCHED; PG8_LDA(At, 1, 0); PG8_STAGE(PG8_SA(0, 1), a2 + hstep, voffA);
            PG8_WAIT_V(8); PG8_WAIT_L(0); PG8_BAR; PG8_MMA(0, 0, At, B0); PG8_MMA(0, 1, At, B1); PG8_BAR; PG8_SCHED;
            PG8_LDA(At, 1, 1); PG8_STAGE(PG8_SB(1, 0), b3, voffB); PG8_STAGE(PG8_SB(1, 1), b3 + hstep, voffB); PG8_STAGE(PG8_SA(1, 0), a3, voffA);
            PG8_WAIT_V(8); PG8_WAIT_L(0); PG8_BAR; PG8_MMA(1, 0, At, B0); PG8_MMA(1, 1, At, B1); PG8_BAR; PG8_SCHED;
            } else {
            PG8_LDB(B0, 0, 0); PG8_SCHED; PG8_LDA(At, 0, 0); PG8_STAGE(PG8_SA(1, 1), a1 + hstep, voffA);
            PG8_WAIT_L(8); PG8_BAR; PG8_WAIT_L(0); PG8_MMA(0, 0, At, B0); PG8_BAR; PG8_SCHED;
            PG8_LDB(B1, 0, 1); PG8_STAGE(PG8_SB(0, 0), b2, voffB);
            PG8_BAR; PG8_WAIT_L(0); PG8_MMA(0, 1, At, B1); PG8_BAR;
            PG8_LDA(At, 0, 1); PG8_STAGE(PG8_SA(0, 0), a2, voffA);
            PG8_BAR; PG8_WAIT_L(0); PG8_MMA(1, 0, At, B0); PG8_BAR; PG8_SCHED;
            PG8_STAGE(PG8_SB(0, 1), b2 + hstep, voffB);
            PG8_WAIT_V(6); PG8_BAR; PG8_MMA(1, 1, At, B1); PG8_BAR;
            PG8_LDB(B0, 1, 0); PG8_SCHED; PG8_LDA(At, 1, 0); PG8_STAGE(PG8_SA(0, 1), a2 + hstep, voffA);
            PG8_WAIT_L(8); PG8_BAR; PG8_WAIT_L(0); PG8_MMA(0, 0, At, B0); PG8_BAR; PG8_SCHED;
            PG8_LDB(B1, 1, 1); PG8_STAGE(PG8_SB(1, 0), b3, voffB);
            PG8_BAR; PG8_WAIT_L(0); PG8_MMA(0, 1, At, B1); PG8_BAR;
            PG8_LDA(At, 1, 1); PG8_STAGE(PG8_SA(1, 0), a3, voffA);
            PG8_BAR; PG8_WAIT_L(0); PG8_MMA(1, 0, At, B0); PG8_BAR; PG8_SCHED;
            PG8_STAGE(PG8_SB(1, 1), b3 + hstep, voffB);
            PG8_WAIT_V(6); PG8_BAR; PG8_MMA(1, 1, At, B1); PG8_BAR;
            }
        }
        if constexpr (ALIGN_EPI) { if (wr == 0) PG8_BAR; }
        if constexpr (!Epi::AFTER_DRAIN) { E(acc, cur, wr, wc, fr, fq); S.done(cur); }
        if (!has_next) break;
#pragma unroll
        for (int a = 0; a < 2; ++a)
#pragma unroll
            for (int b = 0; b < 2; ++b)
#pragma unroll
                for (int m = 0; m < 4; ++m)
#pragma unroll
                    for (int n = 0; n < 2; ++n) acc[a][b][m][n] = (f32x4){0.f, 0.f, 0.f, 0.f};
        cur = nxt; cA = nA; cB = nB; ++ui;
        if constexpr (ALIGN_EPI) { if (wr == 1) PG8_BAR; }
    }
    PG8_WAIT_V(0);
    if constexpr (!ALIGN_EPI) { if (wr == 0) PG8_BAR; }
    PG8_BAR;
    if constexpr (Epi::AFTER_DRAIN) { E.fused(acc, cur, wr, wc, fr, fq, lds, wid, lane); S.done(cur); }
#undef PG8_SA
#undef PG8_SB
#undef PG8_STAGE
#undef PG8_LDA
#undef PG8_LDB
#undef PG8_MMA
#undef PG8_WAIT_V
#undef PG8_WAIT_L
#undef PG8_BAR
#undef PG8_SCHED
}
}

namespace att {
typedef short bf16x8 __attribute__((ext_vector_type(8)));
typedef short s16x4 __attribute__((ext_vector_type(4)));
typedef short v4i16_t __attribute__((ext_vector_type(4)));
typedef float f32x16 __attribute__((ext_vector_type(16)));
constexpr float NEGINF = -__builtin_inff();

constexpr int L_K0 = 0, L_K1 = 16384, L_V0 = 32768, L_V1 = 49152;
template <int D> struct Tile { u32x4_t k[D / 64]; u32x4_t v[D / 64]; };
template <int D> __device__ __forceinline__ void tile_load(Tile<D>& T, const bf16_t* Kp, const bf16_t* Vp, int pitch, int wid, int lane) {
#pragma unroll
    for (int i = 0; i < D / 64; ++i) { const int pc = wid + 8 * i;
        T.k[i] = *(const u32x4_t*)(Kp + (size_t)lane * pitch + pc * 8);
        T.v[i] = *(const u32x4_t*)(Vp + (size_t)(16 * (pc & 3) + (lane >> 2)) * pitch + 32 * (pc >> 2) + 8 * (lane & 3)); }
}
template <int D> __device__ __forceinline__ void tile_store(const Tile<D>& T, LAS unsigned char* kbuf, LAS unsigned char* vbuf, int wid, int lane) {
#pragma unroll
    for (int i = 0; i < D / 64; ++i) { const int pc = wid + 8 * i;
        *(LAS u32x4_t*)(kbuf + pc * 1024 + lane * 16) = T.k[i]; *(LAS u32x4_t*)(vbuf + pc * 1024 + lane * 16) = T.v[i]; }
}
template <int D> __device__ __forceinline__ void k_load(Tile<D>& T, const bf16_t* Kp, int pitch, int wid, int lane) {
#pragma unroll
    for (int i = 0; i < D / 64; ++i) T.k[i] = *(const u32x4_t*)(Kp + (size_t)lane * pitch + (wid + 8 * i) * 8);
}
template <int D> __device__ __forceinline__ void v_load(Tile<D>& T, const bf16_t* Vp, int pitch, int wid, int lane) {
#pragma unroll
    for (int i = 0; i < D / 64; ++i) { const int pc = wid + 8 * i; T.v[i] = *(const u32x4_t*)(Vp + (size_t)(16 * (pc & 3) + (lane >> 2)) * pitch + 32 * (pc >> 2) + 8 * (lane & 3)); }
}
template <int D> __device__ __forceinline__ void k_store(const Tile<D>& T, LAS unsigned char* kbuf, int wid, int lane) {
#pragma unroll
    for (int i = 0; i < D / 64; ++i) *(LAS u32x4_t*)(kbuf + (wid + 8 * i) * 1024 + lane * 16) = T.k[i];
}
template <int D> __device__ __forceinline__ void v_store(const Tile<D>& T, LAS unsigned char* vbuf, int wid, int lane) {
#pragma unroll
    for (int i = 0; i < D / 64; ++i) *(LAS u32x4_t*)(vbuf + (wid + 8 * i) * 1024 + lane * 16) = T.v[i];
}
template <int D> __device__ __forceinline__ void qkt(f32x16& p0, f32x16& p1, const LAS unsigned char* kbuf, const bf16x8* qr, int r32, int hi) {
    p0 = f32x16{}; p1 = f32x16{};
    const LAS unsigned char* kb = kbuf + hi * 1024 + r32 * 16;
#pragma unroll
    for (int d0 = 0; d0 < D / 16; ++d0) {
        const bf16x8 b0 = *(const LAS bf16x8*)(kb + d0 * 2048), b1 = *(const LAS bf16x8*)(kb + d0 * 2048 + 512);
        p0 = __builtin_amdgcn_mfma_f32_32x32x16_bf16(b0, qr[d0], p0, 0, 0, 0);
        p1 = __builtin_amdgcn_mfma_f32_32x32x16_bf16(b1, qr[d0], p1, 0, 0, 0); }
}
__device__ __forceinline__ s16x4 vtr(const LAS unsigned char* p) { return __builtin_bit_cast(s16x4, __builtin_amdgcn_ds_read_tr16_b64_v4i16((LAS v4i16_t*)p)); }
template <int D> __device__ __forceinline__ void pv(f32x16* o, const LAS unsigned char* vbuf, const bf16x8* pa, int lane) {
    const LAS unsigned char* vb = vbuf + ((lane >> 4) & 1) * 32 + (lane & 3) * 8 + (4 * (lane >> 5) + ((lane & 15) >> 2)) * 64;
#pragma unroll
    for (int dp = 0; dp < D / 64; ++dp) {
        s16x4 lo[2][4], hh[2][4];
#pragma unroll
        for (int e = 0; e < 2; ++e)
#pragma unroll
            for (int ks = 0; ks < 4; ++ks) { lo[e][ks] = vtr(vb + (2 * dp + e) * 4096 + ks * 1024); hh[e][ks] = vtr(vb + (2 * dp + e) * 4096 + ks * 1024 + 512); }
        __builtin_amdgcn_sched_barrier(0);
#pragma unroll
        for (int e = 0; e < 2; ++e)
#pragma unroll
            for (int ks = 0; ks < 4; ++ks) { const bf16x8 vf = {lo[e][ks][0], lo[e][ks][1], lo[e][ks][2], lo[e][ks][3], hh[e][ks][0], hh[e][ks][1], hh[e][ks][2], hh[e][ks][3]};
                o[2 * dp + e] = __builtin_amdgcn_mfma_f32_32x32x16_bf16(vf, pa[ks], o[2 * dp + e], 0, 0, 0); }
    }
}
__device__ __forceinline__ float xhalf_max(float v) { auto rr = __builtin_amdgcn_permlane32_swap(__float_as_uint(v), __float_as_uint(v), false, false); return fmaxf(__uint_as_float(rr[0]), __uint_as_float(rr[1])); }
__device__ __forceinline__ float xhalf_sum(float v) { auto rr = __builtin_amdgcn_permlane32_swap(__float_as_uint(v), __float_as_uint(v), false, false); return __uint_as_float(rr[0]) + __uint_as_float(rr[1]); }
typedef float f32x2_cv __attribute__((ext_vector_type(2))); typedef __bf16 bf16x2_cv __attribute__((ext_vector_type(2)));
__device__ __forceinline__ unsigned cvtpk(float lo, float hi) { f32x2_cv v = {lo, hi}; bf16x2_cv b = __builtin_convertvector(v, bf16x2_cv); return __builtin_bit_cast(unsigned, b); }
__device__ __forceinline__ bf16x8 pack8(const f32x16& p, int b) { u32x4_t w = {cvtpk(p[b], p[b + 1]), cvtpk(p[b + 2], p[b + 3]), cvtpk(p[b + 4], p[b + 5]), cvtpk(p[b + 6], p[b + 7])}; return __builtin_bit_cast(bf16x8, w); }
__device__ __forceinline__ float rowmax32(const f32x16& p0, const f32x16& p1) {
    float a = fmaxf(p0[0], p1[0]);
#pragma unroll
    for (int r = 1; r < 16; ++r) a = fmaxf(a, fmaxf(p0[r], p1[r]));
    return xhalf_max(a);
}
__device__ __forceinline__ void mask_band(f32x16& p0, f32x16& p1, int dq, unsigned band) {
#pragma unroll
    for (int r = 0; r < 16; ++r) { const int c = (r & 3) + 8 * (r >> 2);
        if ((unsigned)(dq - c) > band) p0[r] = NEGINF;
        if ((unsigned)(dq - c - 32) > band) p1[r] = NEGINF; }
}
__device__ __forceinline__ void mask_causal(f32x16& p0, f32x16& p1, int dq) {
#pragma unroll
    for (int r = 0; r < 16; ++r) { const int c = (r & 3) + 8 * (r >> 2);
        p0[r] = (c > dq) ? NEGINF : p0[r]; p1[r] = (c + 32 > dq) ? NEGINF : p1[r]; }
}
constexpr float THR = 10.f;
template <int D> struct State { float m; int cls, tc; f32x16 ci; f32x16 o[D / 32]; f32x16 ol; };
template <int D> __device__ __forceinline__ void state_reset(State<D>& st) { st.m = 0.f; st.cls = -1; st.tc = 0; st.ci = f32x16{}; st.ol = f32x16{};
#pragma unroll
    for (int i = 0; i < D / 32; ++i) st.o[i] = f32x16{}; }
__device__ __forceinline__ f32x16 mfma3(bf16x8 a, bf16x8 b, const f32x16& c) { f32x16 d; asm volatile("v_mfma_f32_32x32x16_bf16 %0, %1, %2, %3" : "=&v"(d) : "v"(a), "v"(b), "v"(c)); return d; }
template <int D> __device__ __forceinline__ void qkt_c(f32x16& p0, f32x16& p1, const LAS unsigned char* kbuf, const bf16x8* qr, int r32, int hi, const f32x16& c0, const f32x16& c1) {
    const LAS unsigned char* kb = kbuf + hi * 1024 + r32 * 16;
#pragma unroll
    for (int dc = 0; dc < D / 64; ++dc) {
        bf16x8 kf0[4], kf1[4];
#pragma unroll
        for (int e = 0; e < 4; ++e) { kf0[e] = *(const LAS bf16x8*)(kb + (4 * dc + e) * 2048); kf1[e] = *(const LAS bf16x8*)(kb + (4 * dc + e) * 2048 + 512); }
        __builtin_amdgcn_sched_barrier(0);
        __builtin_amdgcn_s_setprio(1);
#pragma unroll
        for (int e = 0; e < 4; ++e) { const int d0 = 4 * dc + e;
            if (d0 == 0) { p0 = mfma3(kf0[e], qr[d0], c0); p1 = mfma3(kf1[e], qr[d0], c1); }
            else { p0 = __builtin_amdgcn_mfma_f32_32x32x16_bf16(kf0[e], qr[d0], p0, 0, 0, 0); p1 = __builtin_amdgcn_mfma_f32_32x32x16_bf16(kf1[e], qr[d0], p1, 0, 0, 0); } }
        __builtin_amdgcn_s_setprio(0);
    }
}
__device__ __forceinline__ float rowmax32_3(const f32x16& p0, const f32x16& p1) {
    float a = fmaxf(fmaxf(p0[0], p0[1]), p1[0]), b = fmaxf(fmaxf(p0[2], p0[3]), p1[1]); a = fmaxf(fmaxf(a, p1[2]), p1[3]);
#pragma unroll
    for (int r = 4; r < 16; r += 4) { a = fmaxf(fmaxf(a, p0[r]), p0[r + 1]); b = fmaxf(fmaxf(b, p0[r + 2]), p0[r + 3]); a = fmaxf(fmaxf(a, p1[r]), p1[r + 1]); b = fmaxf(fmaxf(b, p1[r + 2]), p1[r + 3]); }
    return xhalf_max(fmaxf(a, b));
}
template <int D, class Pol> __device__ __forceinline__ void softmax_p(State<D>& st, const Pol& pol, f32x16& p0, f32x16& p1, bf16x8* pa) {
    const float mx = rowmax32_3(p0, p1);
    if (__builtin_expect(__any(mx > THR), 0)) {
        const float dl = fmaxf(mx, 0.f); st.m += dl; const float f = __builtin_amdgcn_exp2f(-dl);
#pragma unroll
        for (int r = 0; r < 16; ++r) { p0[r] -= dl; p1[r] -= dl; st.ol[r] *= f; }
#pragma unroll
        for (int i = 0; i < D / 32; ++i)
#pragma unroll
            for (int r = 0; r < 16; ++r) st.o[i][r] *= f;
        pol.build(st);
    }
#pragma unroll
    for (int r = 0; r < 16; ++r) { p0[r] = __builtin_amdgcn_exp2f(p0[r]); p1[r] = __builtin_amdgcn_exp2f(p1[r]); }
    pa[0] = pack8(p0, 0); pa[1] = pack8(p0, 8); pa[2] = pack8(p1, 0); pa[3] = pack8(p1, 8);
}
#ifndef SGB_XV
#define SGB_XV 0
#endif
template <int D, class Pol> __device__ __forceinline__ void softmax_head(State<D>& st, const Pol& pol, f32x16& p0, f32x16& p1) {
#ifdef MAX_STRIDE
    if ((st.tc++ & (MAX_STRIDE - 1)) != 0) return;
#endif
    const float mx = rowmax32_3(p0, p1);
    if (__builtin_expect(__any(mx > THR), 0)) {
        const float dl = fmaxf(mx, 0.f); st.m += dl; const float f = __builtin_amdgcn_exp2f(-dl);
#pragma unroll
        for (int r = 0; r < 16; ++r) { p0[r] -= dl; p1[r] -= dl; st.ol[r] *= f; }
#pragma unroll
        for (int i = 0; i < D / 32; ++i)
#pragma unroll
            for (int r = 0; r < 16; ++r) st.o[i][r] *= f;
        pol.build(st);
    }
}
template <int D, class Pol> __device__ __forceinline__ void exp_pv_manual(State<D>& st, const Pol& pol, int jc, f32x16& c0, f32x16& c1, const LAS unsigned char* vbuf, int lane) {
    constexpr int NE = D / 32, XE = 8 / NE;
    const LAS unsigned char* vb = vbuf + ((lane >> 4) & 1) * 32 + (lane & 3) * 8 + (4 * (lane >> 5) + ((lane & 15) >> 2)) * 64;
    const bf16x8 ones = {16256, 16256, 16256, 16256, 16256, 16256, 16256, 16256};
    s16x4 lo[2][NE], hh[2][NE];
#pragma unroll
    for (int e = 0; e < NE; ++e) { lo[0][e] = vtr(vb + e * 4096); hh[0][e] = vtr(vb + e * 4096 + 512); }
#pragma unroll
    for (int r = 0; r < 8; ++r) c0[r] = __builtin_amdgcn_exp2f(c0[r]);
    bf16x8 pk = pack8(c0, 0); pol.maskp1(jc, pk);
    __builtin_amdgcn_sched_barrier(0);
#pragma unroll
    for (int ks = 0; ks < 4; ++ks) {
        f32x16& src = (ks + 1) < 2 ? c0 : c1; const int base = 8 * ((ks + 1) & 1);
#pragma unroll
        for (int e = 0; e < NE; ++e) {
            const bf16x8 vf = {lo[ks & 1][e][0], lo[ks & 1][e][1], lo[ks & 1][e][2], lo[ks & 1][e][3], hh[ks & 1][e][0], hh[ks & 1][e][1], hh[ks & 1][e][2], hh[ks & 1][e][3]};
            st.o[e] = __builtin_amdgcn_mfma_f32_32x32x16_bf16(vf, pk, st.o[e], 0, 0, 0);
            if (ks < 3) { lo[(ks + 1) & 1][e] = vtr(vb + e * 4096 + (ks + 1) * 1024); hh[(ks + 1) & 1][e] = vtr(vb + e * 4096 + (ks + 1) * 1024 + 512);
#pragma unroll
                for (int x = 0; x < XE; ++x) src[base + e * XE + x] = __builtin_amdgcn_exp2f(src[base + e * XE + x]); }
            __builtin_amdgcn_sched_barrier(0);
        }
        st.ol = __builtin_amdgcn_mfma_f32_32x32x16_bf16(ones, pk, st.ol, 0, 0, 0);
        if (ks < 3) { pk = pack8(src, base); pol.maskp1(jc, pk); }
        __builtin_amdgcn_sched_barrier(0);
    }
}
template <int D> __device__ __forceinline__ void pv_all(State<D>& st, const bf16x8* pa, const LAS unsigned char* vbuf, int lane) {
    pv<D>(st.o, vbuf, pa, lane);
    const bf16x8 ones = {16256, 16256, 16256, 16256, 16256, 16256, 16256, 16256};
#pragma unroll
    for (int ks = 0; ks < 4; ++ks) st.ol = __builtin_amdgcn_mfma_f32_32x32x16_bf16(ones, pa[ks], st.ol, 0, 0, 0);
}
__device__ __forceinline__ void glds16(const void* gsrc, unsigned lds_dst) { unsigned keep;
    asm volatile("s_mov_b32 %0, m0\n\ts_mov_b32 m0, %2\n\ts_nop 0\n\tglobal_load_lds_dwordx4 %1, off\n\ts_mov_b32 m0, %0" : "=&s"(keep) : "v"(gsrc), "s"(lds_dst) : "memory"); }
template <int D> __device__ __forceinline__ void tile_dma(const bf16_t* Kp, const bf16_t* Vp, int pitch, unsigned kdst, unsigned vdst, int wid, int lane) {
#pragma unroll
    for (int i = 0; i < D / 64; ++i) { const int pc = wid + 8 * i;
        glds16(Kp + (size_t)lane * pitch + pc * 8, (unsigned)__builtin_amdgcn_readfirstlane(kdst + pc * 1024));
        glds16(Vp + (size_t)(16 * (pc & 3) + (lane >> 2)) * pitch + 32 * (pc >> 2) + 8 * (lane & 3), (unsigned)__builtin_amdgcn_readfirstlane(vdst + pc * 1024)); }
}
__device__ __forceinline__ void wait_lg_bar() { asm volatile("s_waitcnt lgkmcnt(0)\n\ts_barrier" ::: "memory"); }
template <int N> __device__ __forceinline__ void wait_vm_bar() { asm volatile("s_waitcnt vmcnt(%0) lgkmcnt(0)\n\ts_barrier" :: "i"(N) : "memory"); }
template <int D, class Pol> __device__ __forceinline__ void compute_tile(State<D>& st, const Pol& pol, int jc, const bf16x8* qr, const LAS unsigned char* kbuf, const LAS unsigned char* vbuf, int lane) {
    if (pol.active(jc)) {
        const int r32 = lane & 31, hi = lane >> 5;
        f32x16 c0, c1;
        pol.prep(jc, st);
        qkt_c<D>(c0, c1, kbuf, qr, r32, hi, st.ci, st.ci); pol.postmask(jc, c0, c1);
#ifdef MAN_PV
        softmax_head<D, Pol>(st, pol, c0, c1); exp_pv_manual<D, Pol>(st, pol, jc, c0, c1, vbuf, lane);
#else
        bf16x8 pa[4]; softmax_p<D, Pol>(st, pol, c0, c1, pa); pol.maskp(jc, pa); pv_all<D>(st, pa, vbuf, lane);
#endif
    }
}
template <int D, class Pol> __device__ __forceinline__ void run_branch(State<D>& st, const Pol& pol, const bf16x8* qr, LAS unsigned char* lds, int wid, int lane) {
    constexpr int SLOT = 256 * D, NI = 2 * (D / 64);
    const unsigned lds0 = (unsigned)(size_t)lds;
    int jc = pol.first(), jn = pol.next(jc), jnn = jn >= 0 ? pol.next(jn) : -1;
    tile_dma<D>(pol.kptr(jc), pol.vptr(jc), pol.pitch, lds0, lds0 + SLOT / 2, wid, lane);
    if (jn >= 0) { tile_dma<D>(pol.kptr(jn), pol.vptr(jn), pol.pitch, lds0 + SLOT, lds0 + SLOT + SLOT / 2, wid, lane); wait_vm_bar<NI>(); } else wait_vm_bar<0>();
    int sc = 0;
    for (;;) {
        const int s2 = sc == 0 ? 2 : sc - 1;
        if (jnn >= 0) tile_dma<D>(pol.kptr(jnn), pol.vptr(jnn), pol.pitch, lds0 + s2 * SLOT, lds0 + s2 * SLOT + SLOT / 2, wid, lane);
        compute_tile<D, Pol>(st, pol, jc, qr, lds + sc * SLOT, lds + sc * SLOT + SLOT / 2, lane);
        if (jn < 0) { wait_vm_bar<0>(); break; }
        if (jnn >= 0) wait_vm_bar<NI>(); else wait_vm_bar<0>();
        sc = sc == 2 ? 0 : sc + 1; jc = jn; jn = jnn; jnn = jn >= 0 ? pol.next(jn) : -1;
    }
}
__device__ __forceinline__ f32x16 splat16(float v) { f32x16 c;
#pragma unroll
    for (int r = 0; r < 16; ++r) c[r] = v;
    return c; }

constexpr int L_IMPA = 65536, L_IMPB = L_IMPA + 4 * 64 * 33 * 4, L_SC = L_IMPB + 4 * 64 * 33 * 4, L_SELM = L_SC + 64 * 33 * 4, L_ORM = L_SELM + 256;
static_assert(L_ORM + 16 <= 143360, "attention LDS map");

struct NsaPtrs { unsigned char* ws;
    __device__ __forceinline__ const bf16_t* QA() const { return (const bf16_t*)(ws + WS_QA); }
    __device__ __forceinline__ const bf16_t* KS() const { return (const bf16_t*)(ws + WS_KC + 2 * 8 * MiB); }
    __device__ __forceinline__ const bf16_t* VS() const { return (const bf16_t*)(ws + WS_KC + 3 * 8 * MiB); }
    __device__ __forceinline__ const bf16_t* KW() const { return (const bf16_t*)(ws + WS_KC + 4 * 8 * MiB); }
    __device__ __forceinline__ const bf16_t* VW() const { return (const bf16_t*)(ws + WS_KC + 5 * 8 * MiB); }
    __device__ __forceinline__ const bf16_t* KCC() const { return (const bf16_t*)(ws + WS_KCC); }
    __device__ __forceinline__ const bf16_t* VCC() const { return (const bf16_t*)(ws + WS_VCC); }
    __device__ __forceinline__ const bf16_t* GA() const { return (const bf16_t*)(ws + WS_GA); }
    __device__ __forceinline__ const bf16_t* ZA() const { return (const bf16_t*)(ws + WS_ZA); }
    __device__ __forceinline__ bf16_t* A2() const { return (bf16_t*)(ws + WS_A2); } };

__device__ __forceinline__ void nsa_unit(const NsaPtrs& P, int b, int g, int qt, LAS unsigned char* lds
#if DBG
    , unsigned* selout
#endif
    ) {
    int tid = threadIdx.x; asm volatile("" : "+v"(tid));
    const int lane = tid & 63, r32 = lane & 31, hi = lane >> 5; const int wid = __builtin_amdgcn_readfirstlane(tid >> 6);
    const int hh = 4 * g + (wid & 3), th = wid >> 2;
    const int tok = 64 * qt + 32 * th + r32; const size_t mrow = (size_t)b * SEQ + tok;
    bf16x8 qr[4];
#pragma unroll
    for (int d0 = 0; d0 < 4; ++d0) qr[d0] = *(const bf16x8*)(P.QA() + mrow * 1024 + hh * 64 + d0 * 16 + hi * 8);
    const float g0 = bf2f(P.GA()[mrow * 64 + hh * 3 + 0]), g1 = bf2f(P.GA()[mrow * 64 + hh * 3 + 1]), g2 = bf2f(P.GA()[mrow * 64 + hh * 3 + 2]);
    f32x16 otot[2] = {f32x16{}, f32x16{}};
    Tile<64> T; State<64> st;
    LAS float* SC = (LAS float*)(lds + L_SC); LAS unsigned* SELM = (LAS unsigned*)(lds + L_SELM); LAS unsigned* ORM = (LAS unsigned*)(lds + L_ORM);
    {
        const bf16_t* Kc = P.KCC() + (size_t)(b * 4 + g) * 128 * 64; const bf16_t* Vc = P.VCC() + (size_t)(b * 4 + g) * 128 * 64;
        const bool two = qt >= 16;
        tile_load<64>(T, Kc, Vc, 64, wid, lane); tile_store<64>(T, (lds + L_K0), (lds + L_V0), wid, lane);
        if (two) { tile_load<64>(T, Kc + 64 * 64, Vc + 64 * 64, 64, wid, lane); tile_store<64>(T, (lds + L_K1), (lds + L_V1), wid, lane); }
        __syncthreads();
        f32x16 pA0, pA1, pB0, pB1;
        qkt<64>(pA0, pA1, (lds + L_K0), qr, r32, hi);
        const int cmax = (tok - 31) >> 4;
        mask_band(pA0, pA1, cmax - 4 * hi, 0x7fffffffu);
        float mx = rowmax32(pA0, pA1);
        if (two) { qkt<64>(pB0, pB1, (lds + L_K1), qr, r32, hi); mask_band(pB0, pB1, cmax - 64 - 4 * hi, 0x7fffffffu); mx = fmaxf(mx, rowmax32(pB0, pB1)); }
        if (mx == NEGINF) mx = 0.f;
        float s = 0.f;
#pragma unroll
        for (int r = 0; r < 16; ++r) { pA0[r] = __builtin_amdgcn_exp2f(pA0[r] - mx); pA1[r] = __builtin_amdgcn_exp2f(pA1[r] - mx); s += pA0[r] + pA1[r]; }
        if (two) {
#pragma unroll
            for (int r = 0; r < 16; ++r) { pB0[r] = __builtin_amdgcn_exp2f(pB0[r] - mx); pB1[r] = __builtin_amdgcn_exp2f(pB1[r] - mx); s += pB0[r] + pB1[r]; }
        }
        s = xhalf_sum(s);
        const float inv_l = s > 0.f ? 1.f / s : 0.f;
        if (two) {
        LAS float* IA = (LAS float*)(lds + L_IMPA) + ((wid & 3) * 64 + 32 * th + r32) * 33; LAS float* IB = (LAS float*)(lds + L_IMPB) + ((wid & 3) * 64 + 32 * th + r32) * 33;
#define IMP_ONE(PX, Tt, Pp) _Pragma("unroll") for (int u = 0; u < 4; ++u) { const int k = 16 * (Tt) + 8 * (Pp) + 2 * u + hi; const float h3 = 0.5f * PX[4 * u + 3]; \
            IA[k] = ((PX[4 * u] + PX[4 * u + 1]) + (PX[4 * u + 2] + h3)) * inv_l; IB[k] = h3 * inv_l; }
        IMP_ONE(pA0, 0, 0) IMP_ONE(pA1, 0, 1) IMP_ONE(pB0, 1, 0) IMP_ONE(pB1, 1, 1)
#undef IMP_ONE
        }
        { bf16x8 pa[4] = {pack8(pA0, 0), pack8(pA0, 8), pack8(pA1, 0), pack8(pA1, 8)}; pv<64>(otot, (lds + L_V0), pa, lane); }
        if (two) { bf16x8 pa[4] = {pack8(pB0, 0), pack8(pB0, 8), pack8(pB1, 0), pack8(pB1, 8)}; pv<64>(otot, (lds + L_V1), pa, lane); }
        const float w = g0 * inv_l;
#pragma unroll
        for (int i = 0; i < 2; ++i)
#pragma unroll
            for (int r = 0; r < 16; ++r) otot[i][r] *= w;
    }
    if (qt < 16) { __syncthreads(); }
    else { const int tt = tid & 63, jg = tid >> 6;
        if (jg == 0) SELM[tt] = 0u; if (tid == 0) ORM[0] = 0u;
        __syncthreads();
        const LAS float* IA = (const LAS float*)(lds + L_IMPA); const LAS float* IB = (const LAS float*)(lds + L_IMPB);
        const int T_ = 64 * qt + tt;
#pragma unroll
        for (int jj = 0; jj < 4; ++jj) { const int j = 4 * jg + jj; float imp = 0.f;
#pragma unroll
            for (int h = 0; h < 4; ++h) { float v = IA[(h * 64 + tt) * 33 + j]; if (j > 0) v += IB[(h * 64 + tt) * 33 + j - 1]; imp += v; }
            const bool valid = 64 * j <= T_; const bool forced = valid && (j == 0 || j == qt || j == qt - 1);
            SC[tt * 33 + j] = valid ? imp + (forced ? 1.0e4f : 0.f) : -1e30f; }
        __syncthreads();
        unsigned bits = 0u;
        {
            float sj[4]; int rank[4] = {0, 0, 0, 0}; unsigned eq[4] = {0u, 0u, 0u, 0u};
#pragma unroll
            for (int jj = 0; jj < 4; ++jj) sj[jj] = SC[tt * 33 + 4 * jg + jj];
#pragma unroll 1
            for (int kh = 0; kh < 4; ++kh) {
                float sk[8];
#pragma unroll
                for (int k = 0; k < 8; ++k) sk[k] = SC[tt * 33 + 8 * kh + k];
#pragma unroll
                for (int jj = 0; jj < 4; ++jj)
#pragma unroll
                    for (int k = 0; k < 8; ++k) { rank[jj] += (sk[k] > sj[jj]) ? 1 : 0; eq[jj] |= (sk[k] == sj[jj]) ? (1u << (8 * kh + k)) : 0u; }
            }
#pragma unroll
            for (int jj = 0; jj < 4; ++jj) { const int j = 4 * jg + jj; const unsigned lt = (1u << j) - 1u;
                if (rank[jj] + __builtin_popcount(eq[jj] & lt) < 16) bits |= 1u << j; }
        }
        atomicOr((unsigned*)&SELM[tt], bits); atomicOr((unsigned*)&ORM[0], bits);
        __syncthreads();
    }
    const unsigned causal_bits = (qt == 31) ? 0xffffffffu : ((2u << qt) - 1u);
    const unsigned selbits = qt < 16 ? causal_bits : SELM[32 * th + r32];
#if DBG
    if (tid < 64) selout[((size_t)b * SEQ + 64 * qt + tid) * 4 + g] = qt < 16 ? causal_bits : SELM[tid];
#endif
    unsigned need = qt < 16 ? causal_bits : ((unsigned)__builtin_amdgcn_readfirstlane(ORM[0]) & causal_bits);
    {
        struct SelPol { const bf16_t* Kg; const bf16_t* Vg; int pitch; unsigned need, selbits; int qt, tok4;
            __device__ __forceinline__ int first() const { return __builtin_ctz(need); }
            __device__ __forceinline__ int next(int j) const { const unsigned r = j >= 31 ? 0u : (need & ~((2u << j) - 1u)); return r ? __builtin_ctz(r) : -1; }
            __device__ __forceinline__ const bf16_t* kptr(int j) const { return Kg + (size_t)64 * j * 256; }
            __device__ __forceinline__ const bf16_t* vptr(int j) const { return Vg + (size_t)64 * j * 256; }
            __device__ __forceinline__ bool active(int j) const { return __any((selbits >> j) & 1u); }
            __device__ __forceinline__ void prep(int, State<64>&) const {}
            __device__ __forceinline__ void build(State<64>& st) const { st.ci = splat16(-st.m); }
            __device__ __forceinline__ void maskp(int j, bf16x8* pa) const { const unsigned km = ((selbits >> j) & 1u) ? 0xffffffffu : 0u;
#pragma unroll
                for (int k = 0; k < 4; ++k) { u32x4_t w = __builtin_bit_cast(u32x4_t, pa[k]); w &= km; pa[k] = __builtin_bit_cast(bf16x8, w); } }
            __device__ __forceinline__ void maskp1(int j, bf16x8& f) const { const unsigned km = ((selbits >> j) & 1u) ? 0xffffffffu : 0u; u32x4_t w = __builtin_bit_cast(u32x4_t, f); w &= km; f = __builtin_bit_cast(bf16x8, w); }
            __device__ __forceinline__ void postmask(int j, f32x16& p0, f32x16& p1) const { if (j == qt) mask_band(p0, p1, tok4 - 64 * j, 0x7fffffffu); } };
        SelPol pol{P.KS() + (size_t)b * SEQ * 256 + g * 64, P.VS() + (size_t)b * SEQ * 256 + g * 64, 256, need, selbits, qt, tok - 4 * hi};
        state_reset<64>(st);
        run_branch<64, SelPol>(st, pol, qr, lds, wid, lane);
        const float w = g1 / st.ol[0];
#pragma unroll
        for (int i = 0; i < 2; ++i)
#pragma unroll
            for (int r = 0; r < 16; ++r) otot[i][r] += st.o[i][r] * w;
    }
    {
        struct WinPol { const bf16_t* Kg; const bf16_t* Vg; int pitch; int qt, jlo, tok4;
            __device__ __forceinline__ int first() const { return jlo; }
            __device__ __forceinline__ int next(int j) const { return j < qt ? j + 1 : -1; }
            __device__ __forceinline__ const bf16_t* kptr(int j) const { return Kg + (size_t)64 * j * 256; }
            __device__ __forceinline__ const bf16_t* vptr(int j) const { return Vg + (size_t)64 * j * 256; }
            __device__ __forceinline__ bool active(int) const { return true; }
            __device__ __forceinline__ void prep(int, State<64>&) const {}
            __device__ __forceinline__ void build(State<64>& st) const { st.ci = splat16(-st.m); }
            __device__ __forceinline__ void maskp(int, bf16x8*) const {}
            __device__ __forceinline__ void maskp1(int, bf16x8&) const {}
            __device__ __forceinline__ void postmask(int j, f32x16& p0, f32x16& p1) const { if (j == qt || j == qt - 8) mask_band(p0, p1, tok4 - 64 * j, 511u); } };
        WinPol pol{P.KW() + (size_t)b * SEQ * 256 + g * 64, P.VW() + (size_t)b * SEQ * 256 + g * 64, 256, qt, qt >= 8 ? qt - 8 : 0, tok - 4 * hi};
        state_reset<64>(st);
        run_branch<64, WinPol>(st, pol, qr, lds, wid, lane);
        const float w = g2 / st.ol[0];
#pragma unroll
        for (int i = 0; i < 2; ++i)
#pragma unroll
            for (int r = 0; r < 16; ++r) otot[i][r] += st.o[i][r] * w;
    }
    {
        LAS float* stg = (LAS float*)(lds + 65536 + wid * 8192);
#pragma unroll
        for (int db = 0; db < 2; ++db)
#pragma unroll
            for (int u = 0; u < 4; ++u) { const int d = 32 * db + 8 * u + 4 * hi;
                *(LAS f32x4_t*)(stg + r32 * 64 + (d ^ ((r32 & 7) << 3))) = (f32x4_t){otot[db][4 * u], otot[db][4 * u + 1], otot[db][4 * u + 2], otot[db][4 * u + 3]}; }
        asm volatile("s_waitcnt lgkmcnt(0)" ::: "memory");
        const size_t row0 = (size_t)b * SEQ + 64 * qt + 32 * th;
#pragma unroll
        for (int i = 0; i < 4; ++i) { const int row = 8 * i + (lane >> 3), ch = lane & 7, d = 8 * ch;
            const f32x4_t a = *(const LAS f32x4_t*)(stg + row * 64 + (d ^ ((row & 7) << 3))), c = *(const LAS f32x4_t*)(stg + row * 64 + ((d + 4) ^ ((row & 7) << 3)));
            const u32x4_t z = *(const u32x4_t*)(P.ZA() + (row0 + row) * 1024 + hh * 64 + d);
            u32x4_t w; w.x = cvtpk(a[0] * bflo(z.x), a[1] * bfhi(z.x)); w.y = cvtpk(a[2] * bflo(z.y), a[3] * bfhi(z.y)); w.z = cvtpk(c[0] * bflo(z.z), c[1] * bfhi(z.z)); w.w = cvtpk(c[2] * bflo(z.w), c[3] * bfhi(z.w));
            *(u32x4_t*)(P.A2() + (row0 + row) * 2048 + hh * 64 + d) = w; }
    }
}

struct MixPtrs { unsigned char* ws;
    __device__ __forceinline__ const bf16_t* QB() const { return (const bf16_t*)(ws + WS_QB); }
    __device__ __forceinline__ const bf16_t* KB() const { return (const bf16_t*)(ws + WS_KB); }
    __device__ __forceinline__ const bf16_t* VB() const { return (const bf16_t*)(ws + WS_VB); }
    __device__ __forceinline__ const bf16_t* ZB() const { return (const bf16_t*)(ws + WS_ZB); }
    __device__ __forceinline__ bf16_t* A2() const { return (bf16_t*)(ws + WS_A2); } };
__device__ __forceinline__ void mixb_unit(const MixPtrs& P, int b, int h, int a, LAS unsigned char* lds) {
    int tid = threadIdx.x; asm volatile("" : "+v"(tid));
    const int lane = tid & 63, r32 = lane & 31, hi = lane >> 5; const int wid = __builtin_amdgcn_readfirstlane(tid >> 6);
    const int tok = 256 * a + 32 * wid + r32; const size_t mrow = (size_t)b * SEQ + tok;
    bf16x8 qr[8];
#pragma unroll
    for (int d0 = 0; d0 < 8; ++d0) qr[d0] = *(const bf16x8*)(P.QB() + mrow * 1024 + h * 128 + d0 * 16 + hi * 8);
    const int E16 = (tok - 4 * hi) & 15;
    bool is16[8], is4[4];
#pragma unroll
    for (int i = 0; i < 8; ++i) is16[i] = E16 == ((i & 3) + 8 * (i >> 2));
#pragma unroll
    for (int i = 0; i < 4; ++i) is4[i] = (E16 & 3) == i;
    const bf16_t* Kg = P.KB() + (size_t)b * SEQ * 1024 + h * 128; const bf16_t* Vg = P.VB() + (size_t)b * SEQ * 1024 + h * 128;
    State<128> st; state_reset<128>(st);
    struct MixPol { const bf16_t* Kg; const bf16_t* Vg; int pitch; int nt, wlast, wbase, tok4; bool i16[8], i4[4];
        __device__ __forceinline__ int first() const { return 0; }
        __device__ __forceinline__ int next(int j) const { return j + 1 < nt ? j + 1 : -1; }
        __device__ __forceinline__ const bf16_t* kptr(int j) const { return Kg + (size_t)64 * j * 1024; }
        __device__ __forceinline__ const bf16_t* vptr(int j) const { return Vg + (size_t)64 * j * 1024; }
        __device__ __forceinline__ bool active(int j) const { return j <= wlast; }
        __device__ __forceinline__ int cls(int j) const { const int wlo = wbase - 64 * j, dmin = wlo - 63, dmax = wlo + 31;
            return dmin > 512 ? 0 : (dmin > 128 && dmax <= 512) ? 1 : dmin < 0 ? 3 : dmax <= 128 ? 2 : dmax <= 512 ? 4 : 5; }
        __device__ __forceinline__ void build(State<128>& st) const { const int c = st.cls; const float m = st.m;
            if (c == 0) {
#pragma unroll
                for (int r = 0; r < 16; ++r) st.ci[r] = i16[(r & 3) + 4 * ((r >> 2) & 1)] ? -m : NEGINF;
#ifdef MIX_FASTMASK
            } else if (c == 1 || c == 5) {
#else
            } else if (c == 1) {
#endif
#pragma unroll
                for (int r = 0; r < 16; ++r) st.ci[r] = i4[r & 3] ? (i16[(r & 3) + 4 * ((r >> 2) & 1)] ? 1.f - m : -m) : NEGINF;
#ifdef MIX_FASTMASK
            } else if (c == 2 || c == 3 || c == 4) {
#else
            } else if (c == 2 || c == 3) {
#endif
#pragma unroll
                for (int r = 0; r < 16; ++r) st.ci[r] = i16[(r & 3) + 4 * ((r >> 2) & 1)] ? 1.5849625007f - m : (i4[r & 3] ? 1.f - m : -m);
            } else st.ci = splat16(-m); }
        __device__ __forceinline__ void prep(int j, State<128>& st) const { const int c = cls(j); if (c != st.cls) { st.cls = c; build(st); } }
        __device__ __forceinline__ void maskp(int, bf16x8*) const {}
        __device__ __forceinline__ void maskp1(int, bf16x8&) const {}
        __device__ __forceinline__ void postmask(int j, f32x16& p0, f32x16& p1) const {
            const int c = cls(j);
            if (c < 3) return;
            const int e = tok4 - 64 * j;
#ifdef MIX_FASTMASK
            if (c == 3) { mask_causal(p0, p1, e); return; }
            const int x = e - (c == 4 ? 128 : 512);
#pragma unroll
            for (int r = 0; r < 8; ++r) { const bool b16 = i16[(r & 3) + 4 * ((r >> 2) & 1)], b4 = i4[r & 3];
                const float adj = c == 4 ? (b16 ? 1.f - 1.5849625007f : (b4 ? -1.f : NEGINF)) : (b16 ? -1.f : NEGINF);
#pragma unroll
                for (int q = 0; q < 2; ++q) { const int rr = r + 8 * q, cc = (rr & 3) + 8 * (rr >> 2);
                    p0[rr] += (cc < x) ? adj : 0.f; p1[rr] += (cc + 32 < x) ? adj : 0.f; } } } };
#else
            if (c == 3) { mask_band(p0, p1, e, 0x7fffffffu); return; }
            const int thr = c == 4 ? 128 : 512;
#pragma unroll
            for (int r = 0; r < 16; ++r) { const bool b16 = i16[(r & 3) + 4 * ((r >> 2) & 1)], b4 = i4[r & 3]; const int cc = (r & 3) + 8 * (r >> 2);
                const float vnear = b16 ? 1.5849625007f : (b4 ? 1.f : 0.f), vmid = b4 ? (b16 ? 1.f : 0.f) : NEGINF, vfar = b16 ? 0.f : NEGINF;
                const float lo = c == 4 ? vnear : vmid, hi_ = c == 4 ? vmid : vfar;
                p0[r] += (e - cc <= thr) ? lo : hi_; p1[r] += (e - cc - 32 <= thr) ? lo : hi_; } } };
#endif
    MixPol pol{Kg, Vg, 1024, 4 * a + 4, 4 * a + (wid >> 1), 256 * a + 32 * wid, tok - 4 * hi, {is16[0], is16[1], is16[2], is16[3], is16[4], is16[5], is16[6], is16[7]}, {is4[0], is4[1], is4[2], is4[3]}};
    run_branch<128, MixPol>(st, pol, qr, lds, wid, lane);
    const float inv_l = 1.f / st.ol[0];
#pragma unroll
    for (int db = 0; db < 4; ++db)
#pragma unroll
        for (int u = 0; u < 4; ++u) { const int d = 32 * db + 8 * u + 4 * hi;
            const u32x2_t z = *(const u32x2_t*)(P.ZB() + mrow * 1024 + h * 128 + d);
            u32x2_t w; w.x = cvtpk(st.o[db][4 * u] * inv_l * bflo(z.x), st.o[db][4 * u + 1] * inv_l * bfhi(z.x)); w.y = cvtpk(st.o[db][4 * u + 2] * inv_l * bflo(z.y), st.o[db][4 * u + 3] * inv_l * bfhi(z.y));
            *(u32x2_t*)(P.A2() + mrow * 2048 + 1024 + h * 128 + d) = w; }
}
}
typedef GAS unsigned gu32;
#define RLX_AGENT __ATOMIC_RELAXED, __HIP_MEMORY_SCOPE_AGENT
#define LDS_WAIT() asm volatile("s_waitcnt lgkmcnt(0)" ::: "memory")
#define VM_WAIT() asm volatile("s_waitcnt vmcnt(0)" ::: "memory")
#define XB_TMO      128
#define XB_XCNT(j)  (256  + 64 * (j))
#define XB_XSUB(j)  (1280 + 64 * (j))
#define XB_XGEN(j)  (2304 + 64 * (j))
#define XB_TOP      3328
#define XB_TOPGEN   3392
#define XCD_BAR_WORDS 3456
#define XB_SPIN_CAP (1u << 18)
__device__ __forceinline__ unsigned xb_ld(unsigned* p)              { return __hip_atomic_load(p, __ATOMIC_RELAXED, __HIP_MEMORY_SCOPE_AGENT); }
__device__ __forceinline__ unsigned xb_add(unsigned* p, unsigned v) { return __hip_atomic_fetch_add(p, v, __ATOMIC_RELAXED, __HIP_MEMORY_SCOPE_AGENT); }
__device__ __forceinline__ unsigned xb_xcc_id() { return (unsigned)__builtin_amdgcn_s_getreg((3 << 11) | 20) & 0xFu; }
#define XB_SPIN(cond, bar) do { unsigned _sp = 0; while (cond) { __builtin_amdgcn_s_sleep(1); \
    if ((++_sp & 255u) == 0u) { if (xb_ld(&(bar)[XB_TMO])) break; if (_sp > XB_SPIN_CAP) { atomicAdd(&(bar)[XB_TMO], 1u); break; } } } } while (0)
struct XcdBarrier { unsigned* bar; unsigned x; volatile LAS unsigned* st; };
__device__ __forceinline__ XcdBarrier xcd_barrier_post(unsigned* bar, volatile LAS unsigned* st) {
    XcdBarrier b; b.bar = bar; b.x = xb_xcc_id(); b.st = st;
    if (threadIdx.x == 0) (void)xb_add(&bar[XB_XCNT(b.x)], 1u);
    return b;
}
__device__ __forceinline__ void xcd_barrier_complete(unsigned* bar, unsigned x, unsigned& nloc, unsigned& nx) {
    const unsigned G = gridDim.x * gridDim.y * gridDim.z;
    unsigned sum, cnt, mine, sp = 0u;
    for (;;) {
        sum = 0u; cnt = 0u; mine = 0u;
#pragma unroll
        for (unsigned j = 0; j < 16; ++j) { const unsigned c = xb_ld(&bar[XB_XCNT(j)]); sum += c; cnt += (c > 0u) ? 1u : 0u; mine = (j == x) ? c : mine; }
        if (sum == G) break;
        __builtin_amdgcn_s_sleep(1);
        if ((++sp & 255u) == 0u) { if (xb_ld(&bar[XB_TMO])) break; if (sp > XB_SPIN_CAP) { atomicAdd(&bar[XB_TMO], 1u); break; } }
    }
    nloc = mine > 0u ? mine : 1u; nx = cnt > 0u ? cnt : 1u;
}
__device__ __forceinline__ void xcd_barrier(const XcdBarrier& b) {
    asm volatile("s_waitcnt vmcnt(0)" ::: "memory");
    __syncthreads();
    if (threadIdx.x == 0) {
        unsigned* bar = b.bar;
        __builtin_amdgcn_s_waitcnt(0);
        unsigned nloc = b.st[0], nx = b.st[1];
        if (nloc == 0u) { xcd_barrier_complete(bar, b.x, nloc, nx); b.st[0] = nloc; b.st[1] = nx; }
        const unsigned old = xb_add(&bar[XB_XSUB(b.x)], 1u);
        const unsigned gen = old / nloc;
        if (old + 1u == (gen + 1u) * nloc) {
            __builtin_amdgcn_fence(__ATOMIC_RELEASE, "agent");
            asm volatile("s_waitcnt vmcnt(0)" ::: "memory");
            const unsigned og = xb_add(&bar[XB_TOP], 1u);
            const unsigned tg = og / nx;
            if (og + 1u == (tg + 1u) * nx) xb_add(&bar[XB_TOPGEN], 1u);
            else XB_SPIN(xb_ld(&bar[XB_TOPGEN]) == tg, bar);
            __builtin_amdgcn_fence(__ATOMIC_ACQUIRE, "agent");
            xb_add(&bar[XB_XGEN(b.x)], 1u);
            asm volatile("s_waitcnt vmcnt(0)" ::: "memory");
        } else {
            XB_SPIN(xb_ld(&bar[XB_XGEN(b.x)]) == gen, bar);
            __builtin_amdgcn_fence(__ATOMIC_ACQUIRE, "agent");
            asm volatile("s_waitcnt vmcnt(0)" ::: "memory");
        }
    }
    __syncthreads();
}

struct Frame {
    LAS unsigned char* lds; int tid, lane, wave, G, vcu;
    const float *x, *c; const int* pos; const float *w_ada, *b_ada, *g_pre, *g_post, *w_in, *pe_ck, *pe_cv, *w_ck1, *w_ck2, *w_cv1, *w_cv2, *w_br_a, *w_br_b, *w_out;
    unsigned char* ws; unsigned char* dout;
};
__device__ __forceinline__ float wave_sum(float v) {
#pragma unroll
    for (int o = 1; o < 64; o <<= 1) v += __shfl_xor(v, o);
    return v;
}
__device__ __forceinline__ void p0_ada(Frame& F) {
    float* ada = (float*)(F.ws + WS_ADA);
    LAS float* red = (LAS float*)F.lds;
    LAS float* cT = (LAS float*)(F.lds + 69632);
    int tid0 = threadIdx.x; asm volatile("" : "+v"(tid0));
    for (int i = tid0; i < 8 * DM; i += 512) cT[(i & (DM - 1)) * 8 + (i >> 11)] = F.c[i];
    __syncthreads();
    for (int cg = blockIdx.x; cg < 256; cg += F.G) {
        const int tid = tid0, kk = tid / 6, c4 = tid % 6; const bool on = tid < 510;
        f32x4_t acc[8];
#pragma unroll
        for (int b = 0; b < 8; ++b) acc[b] = (f32x4_t){0.f, 0.f, 0.f, 0.f};
        if (on) for (int k0 = kk; k0 < DM; k0 += 85 * 13) {
            f32x4_t w[13];
#pragma unroll
            for (int u = 0; u < 13; ++u) { const int k = k0 + 85 * u; w[u] = k < DM ? *(const f32x4_t*)(F.w_ada + (size_t)k * 6144 + 24 * cg + 4 * c4) : (f32x4_t){0.f, 0.f, 0.f, 0.f}; }
#pragma unroll
            for (int u = 0; u < 13; ++u) { const int k = k0 + 85 * u < DM ? k0 + 85 * u : 0;
                const f32x4_t ca = *(const LAS f32x4_t*)(cT + k * 8), cb = *(const LAS f32x4_t*)(cT + k * 8 + 4);
#pragma unroll
                for (int b = 0; b < 4; ++b) { acc[b] += w[u] * ca[b]; acc[4 + b] += w[u] * cb[b]; } }
        }
        if (on) {
#pragma unroll
            for (int b = 0; b < 8; ++b)
#pragma unroll
                for (int e = 0; e < 4; ++e) red[tid * 33 + b * 4 + e] = acc[b][e];
        }
        __syncthreads();
        if (tid < 192) { const int b = tid / 24, col = tid % 24, cc4 = col >> 2, e = col & 3; float s = 0.f;
            for (int q = 0; q < 85; ++q) s += red[(q * 6 + cc4) * 33 + b * 4 + e];
            ada[b * 6144 + 24 * cg + col] = s + F.b_ada[24 * cg + col]; }
        __syncthreads();
    }
}
template <bool REMAP> __device__ __forceinline__ int dst_row(int n) { if (!REMAP) return n; return n < 2560 ? n : (n < 2608 ? 11776 + (n - 2560) : n - 48); }
template <bool REMAP> __device__ __forceinline__ void p0_transpose_item(const float* W, int K, int N, bf16_t* WT, int ldt, int kofs, LAS float* scr, int item, int lane) {
    const int nblk = (N + 31) / 32, kb = item / nblk, nb = item % nblk, k0 = 64 * kb, n0 = 32 * nb;
    const bool cok = n0 + (lane & 31) < N;
    float tv[32];
#pragma unroll
    for (int i = 0; i < 32; ++i) { const int kk = 2 * i + (lane >> 5); tv[i] = cok ? W[(size_t)(k0 + kk) * N + n0 + (lane & 31)] : 0.f; }
#pragma unroll
    for (int i = 0; i < 32; ++i) { const int kk = 2 * i + (lane >> 5); scr[kk * 33 + (lane & 31)] = tv[i]; }
    LDS_WAIT(); asm volatile("" ::: "memory");
    const int c = lane & 7;
#pragma unroll
    for (int j = 0; j < 4; ++j) { const int n = (lane >> 3) + 8 * j; const LAS float* s = scr + (8 * c) * 33 + n;
        u32x4_t o; o.x = pk2(s[0 * 33], s[1 * 33]); o.y = pk2(s[2 * 33], s[3 * 33]); o.z = pk2(s[4 * 33], s[5 * 33]); o.w = pk2(s[6 * 33], s[7 * 33]);
        if (n0 + n < N) *(GAS u32x4_t*)(WT + (size_t)dst_row<REMAP>(n0 + n) * ldt + kofs + k0 + 8 * c) = o; }
    LDS_WAIT(); asm volatile("" ::: "memory");
}
__device__ __forceinline__ void p0_items(Frame& F) {
    LAS float* scr = (LAS float*)(F.lds + 68 * 1024 + F.wave * 8704);
    int tid_ = threadIdx.x; asm volatile("" : "+v"(tid_)); const int lane = tid_ & 63;
    const int gw = F.vcu * 8 + F.wave, NGW = F.G * 8;
    bf16_t* WinT = (bf16_t*)(F.ws + WS_WINT); bf16_t* WbrT = (bf16_t*)(F.ws + WS_WBRT); bf16_t* WoutT = (bf16_t*)(F.ws + WS_WOUTT);
    bf16_t* W1T = (bf16_t*)(F.ws + WS_W1T); bf16_t* W2T = (bf16_t*)(F.ws + WS_W2T);
    constexpr int I_IN = 32 * 370, I_BR = 16 * 64, I_OUT = 32 * 64, I_C1 = 32 * 8, I_C2 = 4 * 2;
    constexpr int I_ROPE = MTOK / 64, I_B1 = 128, I_Z = 13;
    constexpr int NITEMS = I_IN + 2 * I_BR + I_OUT + 2 * I_C1 + 2 * I_C2 + I_ROPE + I_B1 + I_Z;
    for (int it = gw; it < NITEMS; it += NGW) {
        int r = it;
        if (r < I_IN) { p0_transpose_item<true>(F.w_in, 2048, NIN, WinT, 2048, 0, scr, r, lane); continue; } r -= I_IN;
        if (r < I_BR) { p0_transpose_item<false>(F.w_br_a, 1024, 2048, WbrT, 2048, 0, scr, r, lane); continue; } r -= I_BR;
        if (r < I_BR) { p0_transpose_item<false>(F.w_br_b, 1024, 2048, WbrT, 2048, 1024, scr, r, lane); continue; } r -= I_BR;
        if (r < I_OUT) { p0_transpose_item<false>(F.w_out, 2048, 2048, WoutT, 2048, 0, scr, r, lane); continue; } r -= I_OUT;
        if (r < I_C1) { p0_transpose_item<false>(F.w_ck1, 2048, 256, W1T, 2048, 0, scr, r, lane); continue; } r -= I_C1;
        if (r < I_C1) { p0_transpose_item<false>(F.w_cv1, 2048, 256, W1T + 256 * 2048, 2048, 0, scr, r, lane); continue; } r -= I_C1;
        if (r < I_C2) { p0_transpose_item<false>(F.w_ck2, 256, 64, W2T, 256, 0, scr, r, lane); continue; } r -= I_C2;
        if (r < I_C2) { p0_transpose_item<false>(F.w_cv2, 256, 64, W2T + 64 * 256, 256, 0, scr, r, lane); continue; } r -= I_C2;
        if (r < I_ROPE) {
            const int m = r * 64 + lane; const float pf = (float)F.pos[m];
            const float myinv = (lane < 8) ? (float)pow(500000.0, -(double)(2 * lane) / 16.0) : (float)pow(500000.0, -(double)(2 * ((lane - 8) & 15)) / 32.0);
            float* t64 = (float*)(F.ws + WS_R64) + (size_t)m * 16; float* t128 = (float*)(F.ws + WS_R128) + (size_t)m * 32;
            for (int i = 0; i < 8; ++i) { const float inv = __shfl(myinv, i); const float ang = pf * inv; t64[i] = cosf(ang); t64[8 + i] = sinf(ang); }
            for (int i = 0; i < 16; ++i) { const float inv = __shfl(myinv, 8 + i); const float ang = pf * inv; t128[i] = cosf(ang); t128[16 + i] = sinf(ang); }
            continue; } r -= I_ROPE;
        if (r < I_B1) {
            const int kc = r & 15, cg = (r >> 4) & 3, kv = r >> 6, n = cg * 64 + lane; const float* pe = kv ? F.pe_cv : F.pe_ck; const float* w1 = kv ? F.w_cv1 : F.w_ck1; float s = 0.f;
#pragma unroll 16
            for (int k = 128 * kc; k < 128 * kc + 128; ++k) s += pe[k] * w1[(size_t)k * 256 + n];
            ((float*)(F.ws + WS_BIAS1))[(kc * 2 + kv) * 256 + n] = s; continue; } r -= I_B1;
        {
            for (int q = lane; q < 16 * 256; q += 64) *(GAS u32x4_t*)(WinT + (size_t)(11824 + r * 16) * 2048 + q * 8) = (u32x4_t){0u, 0u, 0u, 0u};
        }
    }
}
__device__ __forceinline__ void p0_xn(Frame& F) {
    int tid_ = threadIdx.x; asm volatile("" : "+v"(tid_)); const int lane = tid_ & 63;
    const int gw = F.vcu * 8 + F.wave, NGW = F.G * 8;
    const float* ada = (const float*)(F.ws + WS_ADA); bf16_t* XN = (bf16_t*)(F.ws + WS_XN);
    for (int m = gw; m < MTOK; m += NGW) {
        const int b = m >> 11; const f32x4_t* xr = (const f32x4_t*)(F.x + (size_t)m * DM) + lane;
        f32x4_t v[8]; float s = 0.f;
#pragma unroll
        for (int j = 0; j < 8; ++j) { v[j] = xr[64 * j]; s += (v[j][0] * v[j][0] + v[j][1] * v[j][1]) + (v[j][2] * v[j][2] + v[j][3] * v[j][3]); }
        const float rstd = rsqrtf(wave_sum(s) * (1.f / DM) + 1e-6f);
        u32x2_t* o8 = (u32x2_t*)(XN + (size_t)m * DM) + lane;
#pragma unroll
        for (int j = 0; j < 8; ++j) { const int k = 256 * j + 4 * lane;
            const f32x4_t g = *(const f32x4_t*)(F.g_pre + k), sc = *(const f32x4_t*)(ada + b * 6144 + 2048 + k), sh = *(const f32x4_t*)(ada + b * 6144 + k);
            const f32x4_t y = (v[j] * rstd * g) * (sc + 1.f) + sh;
            u32x2_t w; w.x = pk2(y[0], y[1]); w.y = pk2(y[2], y[3]); o8[64 * j] = w; }
    }
}
typedef short cbf16x8 __attribute__((ext_vector_type(8)));
typedef float cf32x16 __attribute__((ext_vector_type(16)));
__device__ __forceinline__ void compress_unit(Frame& F, int unit) {
    const int kv = unit >> 5, b = (unit >> 2) & 7, g = unit & 3;
    int tid = threadIdx.x; asm volatile("" : "+v"(tid));
    const int lane = tid & 63, r32 = lane & 31, hi = lane >> 5, wid = F.wave;
    const bf16_t* src = (const bf16_t*)(F.ws + WS_KC + (size_t)kv * 8 * MiB) + (size_t)b * SEQ * 256 + g * 64;
    const bf16_t* W1T = (const bf16_t*)(F.ws + WS_W1T) + (size_t)kv * 256 * 2048;
    const bf16_t* W2T = (const bf16_t*)(F.ws + WS_W2T) + (size_t)kv * 64 * 256;
    const float* bias1p = (const float*)(F.ws + WS_BIAS1) + kv * 256;
    bf16_t* dst = (bf16_t*)(F.ws + (kv ? WS_VCC : WS_KCC)) + (size_t)(b * 4 + g) * 128 * 64;
    LAS bf16_t* HID = (LAS bf16_t*)F.lds;
    constexpr int WSLOT = 32768, AOFF = 3 * WSLOT, ASLOT = 8 * 129 * 16;
    const unsigned lds0 = (unsigned)(size_t)F.lds;
    const bf16_t* wp = W1T + (size_t)(tid & 255) * 2048 + (tid >> 8) * 8;
    auto dma_w = [&](int l, int slot) {
#pragma unroll
        for (int j = 0; j < 4; ++j) att::glds16(wp + l * 64 + j * 16, (unsigned)__builtin_amdgcn_readfirstlane(lds0 + slot * WSLOT + (j * 512 + wid * 64) * 16)); };
    auto dma_a = [&](int l, int slot) {
#pragma unroll
        for (int j = 0; j < 2; ++j) { const int p = j * 512 + tid, kc = p >> 7, row = p & 127;
            att::glds16(src + (size_t)(16 * row + l) * 256 + kc * 8, (unsigned)__builtin_amdgcn_readfirstlane(lds0 + AOFF + slot * ASLOT + ((j * 4 + (wid >> 1)) * 129 + (wid & 1) * 64) * 16)); } };
    cf32x16 acc[4] = {cf32x16{}, cf32x16{}, cf32x16{}, cf32x16{}};
    dma_a(0, 0); dma_w(0, 0); dma_w(16, 1); att::wait_vm_bar<4>();
    int sc = 0;
#pragma unroll 1
    for (int it = 0; it < 16; ++it) {
#pragma unroll
        for (int hf = 0; hf < 2; ++hf) {
            const int s2 = sc == 0 ? 2 : sc - 1;
            if (hf == 0) { if (it + 1 < 16) { dma_a(it + 1, (it + 1) & 1); dma_w(it + 1, s2); } }
            else if (it + 1 < 16) dma_w(it + 17, s2);
            const LAS unsigned char* ab = F.lds + AOFF + (it & 1) * ASLOT + hi * (129 * 16) + (r32 + hf) * 16;
            const LAS unsigned char* wb = F.lds + sc * WSLOT + hi * 4096 + (32 * wid + r32) * 16;
#pragma unroll
            for (int ks = 0; ks < 4; ++ks) { const cbf16x8 bq = *(const LAS cbf16x8*)(wb + ks * 8192);
#pragma unroll
                for (int rq = 0; rq < 4; ++rq) { const cbf16x8 af = *(const LAS cbf16x8*)(ab + ks * (2 * 129 * 16) + rq * 512);
                    acc[rq] = __builtin_amdgcn_mfma_f32_32x32x16_bf16(af, bq, acc[rq], 0, 0, 0); } }
            if (it + 1 < 16) { if (hf == 0) att::wait_vm_bar<6>(); else att::wait_vm_bar<4>(); } else att::wait_vm_bar<0>();
            sc = sc == 2 ? 0 : sc + 1;
        }
    }
    {
        const int n = 32 * wid + r32; float bb = 0.f;
#pragma unroll
        for (int q = 0; q < 16; ++q) bb += bias1p[q * 512 + n];
#pragma unroll
        for (int rq = 0; rq < 4; ++rq)
#pragma unroll
            for (int r = 0; r < 16; ++r) { const float xv = acc[rq][r] + bb;
                const float u = 0.7978845608028654f * (xv + 0.044715f * xv * xv * xv);
                const float th = 1.f - 2.f * __builtin_amdgcn_rcpf(1.f + __builtin_amdgcn_exp2f(2.f * LOG2E * u));
                const float gl = 0.5f * xv * (1.f + th);
                HID[(32 * rq + (r & 3) + 8 * (r >> 2) + 4 * hi) * 264 + n] = (bf16_t)f2bf(gl); }
    }
    __syncthreads();
    {
        const int mi = wid >> 1, nd = wid & 1;
        cf32x16 o = cf32x16{};
#pragma unroll
        for (int ks = 0; ks < 16; ++ks) {
            const cbf16x8 a = *(const LAS cbf16x8*)(HID + (32 * mi + r32) * 264 + 16 * ks + 8 * hi);
            const cbf16x8 bq = *(const cbf16x8*)(W2T + (size_t)(32 * nd + r32) * 256 + 16 * ks + 8 * hi);
            o = __builtin_amdgcn_mfma_f32_32x32x16_bf16(a, bq, o, 0, 0, 0);
        }
        const int d = 32 * nd + r32;
#pragma unroll
        for (int r = 0; r < 16; ++r) { const int c = 32 * mi + (r & 3) + 8 * (r >> 2) + 4 * hi; float v = o[r];
            if (kv == 0 && nd == 0) {
                int trow = 16 * c + 31; trow = trow > 2047 ? 2047 : trow;
                const float* tb = (const float*)(F.ws + WS_R64) + ((size_t)b * SEQ + trow) * 16;
                const float pr = __shfl_xor(v, 8); const float cs = tb[r32 & 7], sn = tb[8 + (r32 & 7)];
                const float rot = v * cs + (r32 < 8 ? -pr : pr) * sn;
                v = r32 < 16 ? rot : v; }
            dst[(size_t)c * 64 + d] = (c == 127) ? (bf16_t)0 : (bf16_t)f2bf(v); }
    }
    __syncthreads();
}
__device__ __forceinline__ void p6_final(Frame& F) {
    int tid_ = threadIdx.x; asm volatile("" : "+v"(tid_)); const int lane = tid_ & 63;
    const int gw = F.vcu * 8 + F.wave, NGW = F.G * 8;
    const float* ada = (const float*)(F.ws + WS_ADA); const float* ssq = (const float*)(F.ws + WS_SSQ); float* out = (float*)F.dout; const bf16_t* pre = (const bf16_t*)(F.ws + WS_XN);
    for (int m = gw; m < MTOK; m += NGW) {
        const int b = m >> 11; float s = 0.f;
        for (int q = 0; q < 32; ++q) s += ssq[(size_t)m * 32 + q];
        const float rstd = rsqrtf(s * (1.f / DM) + 1e-6f);
        const f32x4_t* xr = (const f32x4_t*)(F.x + (size_t)m * DM) + lane; f32x4_t* orow = (f32x4_t*)(out + (size_t)m * DM) + lane; const u32x2_t* pr = (const u32x2_t*)(pre + (size_t)m * DM) + lane;
        f32x4_t xv[8]; u32x2_t pv[8];
#pragma unroll
        for (int j = 0; j < 8; ++j) { xv[j] = xr[64 * j]; pv[j] = pr[64 * j]; }
#pragma unroll
        for (int j = 0; j < 8; ++j) { const int k = 256 * j + 4 * lane;
            const f32x4_t gp = *(const f32x4_t*)(F.g_post + k), gt = *(const f32x4_t*)(ada + b * 6144 + 4096 + k);
            const f32x4_t o = {bflo(pv[j].x), bfhi(pv[j].x), bflo(pv[j].y), bfhi(pv[j].y)};
            orow[64 * j] = xv[j] + gt * (o * rstd * gp); }
    }
}
constexpr int LDS_BYTES = 147456;
constexpr int LDSCTL_OFF = 143360;
constexpr int CW_BAR = 4096, CW_PANEL = 16384, CW_CMP = 32768, CW_NSAQ = 33792, CW_G1A = 35008, CW_G1B = 35040, CW_MIXQ = 36864;
constexpr int NPHASE = 8;
#ifndef REP_MIXU
#define REP_MIXU 0
#endif
#ifndef REP_UNIT_N
#define REP_UNIT_N 0
#define REP_UNIT_I 0
#define REP_PMODE 0
#endif
#ifndef PROBE_NOREMAP
#define PROBE_NOREMAP 0
#endif
struct Args { const void* in[17]; float* out; unsigned char* ws; int ph_lo, ph_hi; };

__device__ __forceinline__ void touch_lines(const unsigned char* base, size_t row_pitch_bytes, int nrows, int lines_per_row, int tid) {
    const int n = nrows * lines_per_row;
    for (int i = tid; i < n; i += 512) { const unsigned char* p = base + (size_t)(i / lines_per_row) * row_pitch_bytes + (size_t)(i % lines_per_row) * 128; unsigned t;
        asm volatile("global_load_dword %0, %1, off" : "=v"(t) : "v"(p) : "memory"); }
    asm volatile("s_waitcnt vmcnt(0)" ::: "memory");
}
__global__ void __launch_bounds__(512, 2) mk_fwd(Args args) {
    extern __shared__ __attribute__((aligned(16))) unsigned char lds_raw[];
    Frame F;
    F.lds = (LAS unsigned char*)lds_raw;
    F.tid = threadIdx.x; F.lane = F.tid & 63; F.wave = __builtin_amdgcn_readfirstlane(F.tid >> 6);
    F.G = gridDim.x; { const int bx = blockIdx.x; F.vcu = (F.G % 8 == 0) ? (bx % 8) * (F.G / 8) + bx / 8 : bx; }
    F.x = (const float*)args.in[0]; F.c = (const float*)args.in[1]; F.pos = (const int*)args.in[2]; F.w_ada = (const float*)args.in[3]; F.b_ada = (const float*)args.in[4];
    F.g_pre = (const float*)args.in[5]; F.g_post = (const float*)args.in[6]; F.w_in = (const float*)args.in[7]; F.pe_ck = (const float*)args.in[8]; F.pe_cv = (const float*)args.in[9];
    F.w_ck1 = (const float*)args.in[10]; F.w_ck2 = (const float*)args.in[11]; F.w_cv1 = (const float*)args.in[12]; F.w_cv2 = (const float*)args.in[13];
    F.w_br_a = (const float*)args.in[14]; F.w_br_b = (const float*)args.in[15]; F.w_out = (const float*)args.in[16];
    F.ws = args.ws; F.dout = (unsigned char*)args.out;
    unsigned char* ws = args.ws;
    { int t0 = threadIdx.x; asm volatile("" : "+v"(t0));
      for (int u = t0; u < (LDS_BYTES - LDSCTL_OFF) / 4; u += 512) ((LAS unsigned*)(F.lds + LDSCTL_OFF))[u] = 0u; }
    __syncthreads();
    const int lo = args.ph_lo, hi = args.ph_hi;
#if STAMP
    unsigned long long ts_[10]; int nts_ = 0;
#define TS() do { ts_[nts_ < 9 ? nts_ : 9] = __builtin_amdgcn_s_memrealtime(); ++nts_; } while (0)
    TS();
#else
#define TS() do {} while (0)
#endif
    const bool multi = (hi - lo) > 1;
    XcdBarrier bar; bar.bar = (unsigned*)(ws + WS_CTL) + CW_BAR; bar.x = 0; bar.st = nullptr;
    if (multi) bar = xcd_barrier_post((unsigned*)(ws + WS_CTL) + CW_BAR, (volatile LAS unsigned*)(F.lds + LDSCTL_OFF + 32));
#ifndef PH_MASK
#define PH_MASK 0xff
#endif
#define IN(k) (((PH_MASK >> (k)) & 1) && lo <= (k) && (k) < hi)
#ifndef REP_MASK
#define REP_MASK 0
#endif
#define REPS(k) for (int rep_ = 0; rep_ < 1 + ((REP_MASK >> (k)) & 1); ++rep_)
#define SEAM(k) do { if (IN(k) && IN((k) + 1)) xcd_barrier(bar); } while (0)

    if (IN(0)) REPS(0) { p0_ada(F); }
    SEAM(0); TS();
    if (IN(1)) REPS(1) { p0_xn(F); p0_items(F); }
    SEAM(1); TS();
    if (IN(2)) REPS(2) {
        const int bx = (int)blockIdx.x, cs = (F.G == 256 && !PROBE_NOREMAP) ? (bx & 7) + 8 * ((((bx >> 3) & 7) << 2) + (bx >> 6)) : bx;
        pg8::Gemm g{(const bf16_t*)(ws + WS_XN), (const bf16_t*)(ws + WS_WINT), MTOK, NINP, 2048}; pg8::ProjOrder S; S.init(MTOK, NINP, F.G, cs);
        pg8::EpiProj E{ws, F.dout, (const float*)(ws + WS_R64), (const float*)(ws + WS_R128)};
        const int nf = S.count_first();
#pragma unroll 1
        for (int part = 0; part < 2; ++part) {
            S.i0 = part ? nf : 0; S.i1 = part ? (1 << 30) : nf;
            pg8::gemm_phase<pg8::EpiProj, pg8::ProjOrder, true, true>(F.lds, g, S, E);
            if (part == 0) { asm volatile("s_waitcnt vmcnt(0)" ::: "memory"); __syncthreads();
                if (threadIdx.x == 0) { __builtin_amdgcn_fence(__ATOMIC_RELEASE, "agent"); (void)xb_add((unsigned*)(ws + WS_CTL) + CW_G1A, (unsigned)nf); __builtin_amdgcn_s_waitcnt(0); } }
        }
        asm volatile("s_waitcnt vmcnt(0)" ::: "memory"); __syncthreads();
        if (threadIdx.x == 0) { __builtin_amdgcn_fence(__ATOMIC_RELEASE, "agent"); (void)xb_add((unsigned*)(ws + WS_CTL) + CW_G1B, 1u); __builtin_amdgcn_s_waitcnt(0); }
    }
#ifdef KEEP_SEAM2
    SEAM(2);
#endif
    TS();
    if (IN(3)) REPS(3) {
        att::MixPtrs MP{ws};
        if (threadIdx.x == 0) { unsigned* cw = (unsigned*)(ws + WS_CTL) + CW_G1A; while (xb_ld(cw) < (unsigned)(pg8::ProjOrder::NFIRST * (MTOK / 256))) __builtin_amdgcn_s_sleep(8);
            __builtin_amdgcn_fence(__ATOMIC_ACQUIRE, "agent"); }
        __syncthreads();
        for (int v = F.vcu; v < 256; v += F.G) {
            const int j = v & 7, bh = 2 * (v >> 3) + (j & 1), b_ = bh >> 3, h_ = bh & 7;
#ifdef USE_WARM
            { const size_t off = ((size_t)b_ * SEQ + 512 * (j >> 1)) * 2048 + h_ * 256;
              touch_lines(ws + WS_KB + off, 2048, 512, 2, F.tid); touch_lines(ws + WS_VB + off, 2048, 512, 2, F.tid); }
#endif
#ifndef REP_CMP
#define REP_CMP 0
#endif
            if (j < 2) { compress_unit(F, (v >> 3) * 2 + j);
                asm volatile("s_waitcnt vmcnt(0)" ::: "memory"); __syncthreads();
                if (threadIdx.x == 0) { __builtin_amdgcn_fence(__ATOMIC_RELEASE, "agent"); (void)xb_add((unsigned*)(ws + WS_CTL) + CW_CMP, 1u); } }
#ifndef NO_MIX
#ifdef MIX_QUEUE
            {
                unsigned* qc = (unsigned*)(ws + WS_CTL) + CW_MIXQ + 32 * (v >> 3); volatile LAS unsigned* qn = (volatile LAS unsigned*)(F.lds + LDSCTL_OFF + 80);
                if (threadIdx.x == 0) qn[0] = xb_add(qc, 1u);
                __syncthreads();
                unsigned k = qn[0];
#pragma unroll 1
                for (int par = 1; k < 16u; par ^= 1) {
                    if (threadIdx.x == 0) qn[par] = xb_add(qc, 1u);
                    const int bh2 = 2 * (v >> 3) + (int)(k & 1u);
                    att::mixb_unit(MP, bh2 >> 3, bh2 & 7, 7 - (int)(k >> 1), F.lds);
                    __syncthreads();
                    k = qn[par];
                }
            }
#else
            const int alist = j < 2 ? 0x4 : j < 4 ? 0x16 : j < 6 ? 0x25 : 0x037, na = j < 2 ? 1 : j < 6 ? 2 : 3;
#pragma unroll 1
            for (int i = 0; i < na + REP_MIXU; ++i) att::mixb_unit(MP, b_, h_, i < na ? ((alist >> (4 * i)) & 15) : 0, F.lds);
#endif
#endif
        }
    }
    TS();
    if (IN(4)) REPS(4) {
        att::NsaPtrs NP{ws};
        asm volatile("s_waitcnt vmcnt(0)" ::: "memory");
        if (threadIdx.x == 0) { unsigned* cw = (unsigned*)(ws + WS_CTL) + CW_CMP; while (xb_ld(cw) < 64u) __builtin_amdgcn_s_sleep(8);
            cw = (unsigned*)(ws + WS_CTL) + CW_G1B; while (xb_ld(cw) < (unsigned)F.G) __builtin_amdgcn_s_sleep(8);
            __builtin_amdgcn_fence(__ATOMIC_ACQUIRE, "agent"); }
        __syncthreads();
        for (int v = F.vcu; v < 256; v += F.G) {
#ifdef USE_WARM
            { const int bg = v >> 3, s = v & 7; const size_t off = ((size_t)(bg >> 2) * SEQ + 256 * s) * 512 + (bg & 3) * 128;
#pragma unroll 1
              for (int t = 2; t < 6; ++t) touch_lines(ws + WS_KC + (size_t)t * 8 * MiB + off, 512, 256, 1, F.tid); }
#endif
#ifndef NO_NSA
#ifdef NSA_QUEUE
            {
                const int bg = v >> 3; unsigned* qc = (unsigned*)(ws + WS_CTL) + CW_NSAQ + 32 * bg; volatile LAS unsigned* qn = (volatile LAS unsigned*)(F.lds + LDSCTL_OFF + 64);
                if (threadIdx.x == 0) qn[0] = xb_add(qc, 1u);
                __syncthreads();
                unsigned k = qn[0];
#pragma unroll 1
                for (int par = 1; k < 32u; par ^= 1) {
                    if (threadIdx.x == 0) qn[par] = xb_add(qc, 1u);
                    att::nsa_unit(NP, bg >> 2, bg & 3, 31 - (int)k, F.lds
#if DBG
                        , (unsigned*)(ws + WS_DBG + 101 * MiB)
#endif
                        );
                    __syncthreads();
                    k = qn[par];
                }
            }
#else
            { const int bg = v >> 3, s = v & 7;
#pragma unroll 1
              for (int i_ = 0; i_ < 4 + REP_UNIT_N; ++i_) { const int i = i_ < 4 ? i_ : REP_UNIT_I; const unsigned long long qtab = (i == 0) ? 0xcdb9beffdaull : (i == 1) ? 0xbd2b09ca38ull : (i == 2) ? 0x4ad4c6b90full : 0x21c66104a0ull;
                  const int qt = (int)((qtab >> (5 * s)) & 31ull); att::nsa_unit(NP, bg >> 2, bg & 3, qt, F.lds
#if DBG
                  , (unsigned*)(ws + WS_DBG + 101 * MiB)
#endif
                  ); } }
#endif
#endif
        }
    }
    SEAM(4); TS();
    if (IN(5)) REPS(5) {
        pg8::Gemm g{(const bf16_t*)(ws + WS_A2), (const bf16_t*)(ws + WS_WBRT), MTOK, 2048, 2048}; pg8::StaticOrder S; S.init(MTOK, 2048, F.G, (int)blockIdx.x);
        pg8::EpiMerge E{(const bf16_t*)(F.dout + DO_MA), (const bf16_t*)(F.dout + DO_MB), (bf16_t*)(ws + WS_MERGED)};
        pg8::gemm_phase<pg8::EpiMerge, pg8::StaticOrder, true, true>(F.lds, g, S, E);
    }
    SEAM(5); TS();
    if (IN(6)) REPS(6) {
        pg8::Gemm g{(const bf16_t*)(ws + WS_MERGED), (const bf16_t*)(ws + WS_WOUTT), MTOK, 2048, 2048}; pg8::StaticOrder S; S.init(MTOK, 2048, F.G, (int)blockIdx.x);
#ifndef FUSE_FINAL
        pg8::EpiOutB E{(bf16_t*)(ws + WS_XN), (float*)(ws + WS_SSQ)};
        pg8::gemm_phase<pg8::EpiOutB, pg8::StaticOrder, true, true>(F.lds, g, S, E);
#else
        pg8::EpiFinal E{F.x, (float*)F.dout, (float*)(ws + WS_SSQ), (unsigned*)(ws + WS_CTL) + CW_PANEL, (const float*)(ws + WS_ADA), F.g_post};
        pg8::PanelOrder PO; PO.init(MTOK, 2048, F.G, F.vcu);
        if ((F.G & 7) == 0) pg8::gemm_phase<pg8::EpiFinal, pg8::PanelOrder, true, true>(F.lds, g, PO, E);
#endif
    }
#ifndef FUSE_FINAL
    SEAM(6);
#endif
    TS();
#ifndef FUSE_FINAL
    if (IN(7)) { p6_final(F); }
#endif
    TS();
#if STAMP
    if (F.vcu == 0 && F.tid == 0) { VM_WAIT(); args.out[0] = (float)(ts_[STAMP_B] - ts_[STAMP_A]); }
#endif
#undef IN
#undef SEAM
}

#if DBG
namespace dbg {
constexpr int BD = DBG_BATCH;
constexpr size_t E_PROJ = 0, E_KC = 48 * MiB, E_VC = 48 * MiB + 256 * 1024, E_SEL = 48 * MiB + 512 * 1024, E_AA = 50 * MiB, E_AB = 58 * MiB, E_MG = 66 * MiB, E_OF = 82 * MiB, E_ADA = 98 * MiB, DIAG = 100 * MiB, SELOUT = 101 * MiB;
__global__ void k_f2b(const float* __restrict__ s, bf16_t* __restrict__ d, size_t n) { for (size_t i = (size_t)blockIdx.x * 256 + threadIdx.x; i < n; i += (size_t)gridDim.x * 256) d[i] = (bf16_t)f2bf(s[i]); }
__global__ void k_copy(const float* __restrict__ s, float* __restrict__ d, size_t n) { for (size_t i = (size_t)blockIdx.x * 256 + threadIdx.x; i < n; i += (size_t)gridDim.x * 256) d[i] = s[i]; }
template <class T> __device__ __forceinline__ float tof(T v);
template <> __device__ __forceinline__ float tof<float>(float v) { return v; }
template <> __device__ __forceinline__ float tof<bf16_t>(bf16_t v) { return bf2f(v); }
template <class FT, class ET, int XF> __global__ void k_cmp(const FT* __restrict__ f, int ldf, const ET* __restrict__ e, int lde, int rows, int cols, float fscale, float* __restrict__ acc) {
    __shared__ float sh[8];
    float num = 0.f, den = 0.f;
    for (size_t i = (size_t)blockIdx.x * 256 + threadIdx.x; i < (size_t)rows * cols; i += (size_t)gridDim.x * 256) { const int r = (int)(i / cols), c = (int)(i % cols);
        const float vf = tof<FT>(f[(size_t)r * ldf + c]) * fscale; float ve = tof<ET>(e[(size_t)r * lde + c]);
        if (XF == 1) ve = ve / (1.f + expf(-ve)); if (XF == 2) ve = 1.f / (1.f + expf(-ve));
        num += (vf - ve) * (vf - ve); den += ve * ve; }
    for (int o = 32; o > 0; o >>= 1) { num += __shfl_xor(num, o); den += __shfl_xor(den, o); }
    if ((threadIdx.x & 63) == 0) { sh[threadIdx.x >> 6] = num; sh[4 + (threadIdx.x >> 6)] = den; }
    __syncthreads();
    if (threadIdx.x == 0) { atomicAdd(acc, sh[0] + sh[1] + sh[2] + sh[3]); atomicAdd(acc + 1, sh[4] + sh[5] + sh[6] + sh[7]); }
}
__global__ void k_cmp_sel(const unsigned* __restrict__ f, const unsigned* __restrict__ e, float* __restrict__ acc) {
    const int idx = blockIdx.x * 256 + threadIdx.x; if (idx >= 2048 * 4) return; const int s = idx >> 2;
    const unsigned valid = (s >> 6) == 31 ? 0xffffffffu : ((2u << (s >> 6)) - 1u);
    const bool bad = ((f[idx] ^ e[idx]) & valid) != 0u;
    atomicAdd(acc, bad ? 1.f : 0.f); if (threadIdx.x == 0 && blockIdx.x == 0) atomicAdd(acc + 1, 8192.f);
}
constexpr int NCHK = 24;
__global__ void k_report(const float* __restrict__ diag, float* __restrict__ out, int sel) {
    if (threadIdx.x != 0) return;
    if (sel == 0) { for (int k = 1; k < NCHK; ++k) { const float num = diag[2 * k], den = diag[2 * k + 1]; if (den == 0.f) continue;
            const float err = (k == 19) ? num / den : sqrtf(num / den);
            const float tol = k == 1 ? 1e-4f : (k == 17 || k == 18 || k == 21) ? 3e-2f : k == 19 ? 0.12f : (k == 20 || k == 22 || k == 23) ? 0.1f : 2e-2f;
            if (!(err <= tol)) { out[0] = (float)k * 1.0e4f; return; } }
        out[0] = 7.7e7f; }
    else { const float num = diag[2 * sel], den = diag[2 * sel + 1]; const float err = (sel == 19) ? num / den : sqrtf(num / den); out[0] = err * 1.0e6f; }
}
}
#endif

extern "C" void kernel_launch(void* const* d_in, const int* in_sizes, int n_in, void* d_out, int out_size, void* d_ws, size_t ws_size, hipStream_t stream) {
    static int grid = 0;
    if (grid == 0) {
        int dev = 0, cus = 0;
        if (hipGetDevice(&dev) != hipSuccess || hipDeviceGetAttribute(&cus, hipDeviceAttributeMultiprocessorCount, dev) != hipSuccess) { fprintf(stderr, "kernel_launch: device query failed\n"); grid = -1; return; }
        if (hipFuncSetAttribute((const void*)mk_fwd, hipFuncAttributeMaxDynamicSharedMemorySize, LDS_BYTES) != hipSuccess) { fprintf(stderr, "kernel_launch: hipFuncSetAttribute failed\n"); grid = -1; return; }
        int per_cu = 0;
        if (hipOccupancyMaxActiveBlocksPerMultiprocessor(&per_cu, (const void*)mk_fwd, 512, LDS_BYTES) != hipSuccess || per_cu < 1) fprintf(stderr, "kernel_launch: occupancy query reports %d\n", per_cu);
        (void)hipGetLastError();
        grid = cus;
    }
    if (grid < 0) return;
    if (ws_size < WS_END) { fprintf(stderr, "kernel_launch: workspace too small (%zu < %zu bytes)\n", ws_size, (size_t)WS_END); return; }
    unsigned char* ws = (unsigned char*)d_ws;
#if DBG
    {
        ref::In I;
        I.x = (const float*)d_in[0]; I.c = (const float*)d_in[1]; I.pos = (const int*)d_in[2]; I.w_ada = (const float*)d_in[3]; I.b_ada = (const float*)d_in[4];
        I.g_pre = (const float*)d_in[5]; I.g_post = (const float*)d_in[6]; I.w_in = (const float*)d_in[7]; I.pe_ck = (const float*)d_in[8]; I.pe_cv = (const float*)d_in[9];
        I.w_ck1 = (const float*)d_in[10]; I.w_ck2 = (const float*)d_in[11]; I.w_cv1 = (const float*)d_in[12]; I.w_cv2 = (const float*)d_in[13];
        I.w_br_a = (const float*)d_in[14]; I.w_br_b = (const float*)d_in[15]; I.w_out = (const float*)d_in[16];
        ref::Bufs B = ref::carve((char*)d_ws);
        ref::run_ada(I, B, stream);
        ref::run_batch(I, B, dbg::BD, (float*)d_out, stream);
        unsigned char* E = ws + WS_DBG;
        dbg::k_f2b<<<2048, 256, 0, stream>>>(B.proj, (bf16_t*)(E + dbg::E_PROJ), (size_t)2048 * NIN);
        dbg::k_copy<<<64, 256, 0, stream>>>(B.kc, (float*)(E + dbg::E_KC), 512 * 64); dbg::k_copy<<<64, 256, 0, stream>>>(B.vc, (float*)(E + dbg::E_VC), 512 * 64);
        dbg::k_copy<<<32, 256, 0, stream>>>((const float*)B.selmask, (float*)(E + dbg::E_SEL), 2048 * 4);
        dbg::k_copy<<<1024, 256, 0, stream>>>(B.Aa, (float*)(E + dbg::E_AA), (size_t)2048 * 1024); dbg::k_copy<<<1024, 256, 0, stream>>>(B.Ab, (float*)(E + dbg::E_AB), (size_t)2048 * 1024);
        dbg::k_copy<<<1024, 256, 0, stream>>>(B.mg, (float*)(E + dbg::E_MG), (size_t)2048 * 2048); dbg::k_copy<<<1024, 256, 0, stream>>>(B.of, (float*)(E + dbg::E_OF), (size_t)2048 * 2048);
        dbg::k_copy<<<64, 256, 0, stream>>>(B.ada, (float*)(E + dbg::E_ADA), 8 * 6144);
        (void)hipMemsetAsync(E + dbg::DIAG, 0, 4096, stream);
    }
#endif
    if (hipMemsetAsync(ws + WS_CTL, 0, CTL_ZERO_BYTES, stream) != hipSuccess) { fprintf(stderr, "kernel_launch: memset failed\n"); return; }
    Args a{};
    for (int i = 0; i < 17; ++i) a.in[i] = d_in[i];
    a.out = (float*)d_out; a.ws = ws;
#if ONE_LAUNCH
    a.ph_lo = 0; a.ph_hi = NPHASE;
    { void* kargs[] = {&a}; const hipError_t e = hipLaunchCooperativeKernel((const void*)mk_fwd, dim3(grid), dim3(512), kargs, LDS_BYTES, stream);
      if (e != hipSuccess) fprintf(stderr, "kernel_launch: cooperative launch failed: %s (grid %d)\n", hipGetErrorString(e), grid); }
#else
    for (int p = 0; p < NPHASE && p <= DBG_STOP; ++p) { a.ph_lo = p; a.ph_hi = p + 1; hipLaunchKernelGGL(mk_fwd, dim3(grid), dim3(512), LDS_BYTES, stream, a); }
#endif
#if DBG
    {
        unsigned char* E = ws + WS_DBG; float* diag = (float*)(E + dbg::DIAG); const bf16_t* EP = (const bf16_t*)(E + dbg::E_PROJ);
        const size_t r0 = (size_t)dbg::BD * 2048;
#define CMPB(id, fastptr, ldf, ecol, cols, XF, fs) dbg::k_cmp<bf16_t, bf16_t, XF><<<512, 256, 0, stream>>>((const bf16_t*)(fastptr) + r0 * (ldf), ldf, EP + (ecol), NIN, 2048, cols, fs, diag + 2 * (id))
        dbg::k_cmp<float, float, 0><<<64, 256, 0, stream>>>((const float*)(ws + WS_ADA), 6144, (const float*)(E + dbg::E_ADA), 6144, 8, 6144, 1.f, diag + 2 * 1);
        CMPB(2, ws + WS_QA, 1024, ref::C_QA, 1024, 0, 1.f / QS64);
        CMPB(3, ws + WS_KC + 0 * 8 * MiB, 256, ref::C_KC, 256, 0, 1.f); CMPB(4, ws + WS_KC + 1 * 8 * MiB, 256, ref::C_VC, 256, 0, 1.f); CMPB(5, ws + WS_KC + 2 * 8 * MiB, 256, ref::C_KS, 256, 0, 1.f);
        CMPB(6, ws + WS_KC + 3 * 8 * MiB, 256, ref::C_VS, 256, 0, 1.f); CMPB(7, ws + WS_KC + 4 * 8 * MiB, 256, ref::C_KW, 256, 0, 1.f); CMPB(8, ws + WS_KC + 5 * 8 * MiB, 256, ref::C_VW, 256, 0, 1.f);
        CMPB(9, ws + WS_ZA, 1024, ref::C_ZA, 1024, 1, 1.f);
        if (DBG_STOP < 5) { CMPB(10, ws + WS_QB, 1024, ref::C_QB, 1024, 0, 1.f / QS128); CMPB(11, ws + WS_KB, 1024, ref::C_KB, 1024, 0, 1.f); }
        if (DBG_STOP < 6) { CMPB(14, (unsigned char*)d_out + DO_MA, 2048, ref::C_MA, 2048, 2, 1.f); CMPB(15, (unsigned char*)d_out + DO_MB, 2048, ref::C_MB, 2048, 2, 1.f); }
        if (DBG_STOP == 6) dbg::k_cmp<float, float, 0><<<512, 256, 0, stream>>>((const float*)d_out + r0 * 2048, 2048, (const float*)(E + dbg::E_OF), 2048, 2048, 2048, 1.f, diag + 2 * 23);
        CMPB(12, ws + WS_VB, 1024, ref::C_VB, 1024, 0, 1.f); CMPB(13, ws + WS_ZB, 1024, ref::C_ZB, 1024, 1, 1.f);
        CMPB(16, ws + WS_GA, 64, ref::C_GA, 48, 2, 1.f);
        if (DBG_STOP >= 3) {
        dbg::k_cmp<bf16_t, float, 0><<<64, 256, 0, stream>>>((const bf16_t*)(ws + WS_KCC) + (size_t)dbg::BD * 512 * 64, 64, (const float*)(E + dbg::E_KC), 64, 512, 64, 1.f, diag + 2 * 17);
        dbg::k_cmp<bf16_t, float, 0><<<64, 256, 0, stream>>>((const bf16_t*)(ws + WS_VCC) + (size_t)dbg::BD * 512 * 64, 64, (const float*)(E + dbg::E_VC), 64, 512, 64, 1.f, diag + 2 * 18); }
        if (DBG_STOP >= 4) {
        dbg::k_cmp_sel<<<32, 256, 0, stream>>>((const unsigned*)(E + dbg::SELOUT) + r0 * 4, (const unsigned*)(E + dbg::E_SEL), diag + 2 * 19);
        dbg::k_cmp<bf16_t, float, 0><<<512, 256, 0, stream>>>((const bf16_t*)(ws + WS_A2) + r0 * 2048, 2048, (const float*)(E + dbg::E_AA), 1024, 2048, 1024, 1.f, diag + 2 * 20);
        dbg::k_cmp<bf16_t, float, 0><<<512, 256, 0, stream>>>((const bf16_t*)(ws + WS_A2) + r0 * 2048 + 1024, 2048, (const float*)(E + dbg::E_AB), 1024, 2048, 1024, 1.f, diag + 2 * 21); }
        if (DBG_STOP >= 5)
        dbg::k_cmp<bf16_t, float, 0><<<512, 256, 0, stream>>>((const bf16_t*)(ws + WS_MERGED) + r0 * 2048, 2048, (const float*)(E + dbg::E_MG), 2048, 2048, 2048, 1.f, diag + 2 * 22);
#undef CMPB
        dbg::k_report<<<1, 64, 0, stream>>>(diag, (float*)d_out, DBG_SEL);
    }
#endif
}
```

```cpp
#define DBG 0
#define DBG_BATCH 5
#define DBG_SEL 0
#define ONE_LAUNCH 1
#define DBG_STOP 7
#define REP_MASK 0
#define STAMP 0
#define STAMP_A 0
#define STAMP_B 8
#define MAN_PV 1
#define NSA_QUEUE 1
#define MIX_QUEUE 1
#define MAX_STRIDE 4
#define DMA_LATE 1
#include <hip/hip_runtime.h>
#include <hip/hip_cooperative_groups.h>
#include <cmath>
#include <cstdio>
#include <cstdint>

constexpr int NB = 8, SEQ = 2048, DM = 2048, MTOK = NB * SEQ;
constexpr int NIN = 11824, NINP = 12032;
constexpr float LOG2E = 1.4426950408889634f;
constexpr float QS64 = 0.125f * LOG2E, QS128 = 0.08838834764831845f * LOG2E;
constexpr size_t MiB = 1u << 20;
constexpr size_t WS_CTL = 0, CTL_ZERO_BYTES = 1 * MiB;
constexpr size_t WS_ADA = 1 * MiB;
constexpr size_t WS_R64 = 2 * MiB;
constexpr size_t WS_R128 = 3 * MiB;
constexpr size_t WS_BIAS1 = 5 * MiB;
constexpr size_t WS_SSQ = 6 * MiB;
constexpr size_t WS_KCC = 8 * MiB, WS_VCC = 8 * MiB + 512 * 1024;
constexpr size_t WS_W2T = 9 * MiB;
constexpr size_t WS_W1T = 10 * MiB;
constexpr size_t WS_GA = 12 * MiB;
constexpr size_t WS_WBRT = 16 * MiB, WS_WOUTT = 24 * MiB;
constexpr size_t WS_WINT = 32 * MiB;
constexpr size_t WS_XN = 80 * MiB;
constexpr size_t WS_QA = 144 * MiB;
constexpr size_t WS_KC = 176 * MiB;
constexpr size_t WS_ZA = 224 * MiB, WS_QB = 256 * MiB, WS_KB = 288 * MiB, WS_VB = 320 * MiB, WS_ZB = 352 * MiB;
constexpr size_t WS_MERGED = 256 * MiB;
#if DBG
constexpr size_t WS_A2 = WS_XN;
#else
constexpr size_t WS_A2 = 384 * MiB;
#endif
constexpr size_t WS_END = 448 * MiB;
constexpr size_t WS_DBG = 384 * MiB;
constexpr size_t DO_MA = 0, DO_MB = 64 * MiB;

typedef unsigned short bf16_t;
#define LAS __attribute__((address_space(3)))
#define GAS __attribute__((address_space(1)))
typedef unsigned u32x4_t __attribute__((ext_vector_type(4)));
typedef unsigned u32x2_t __attribute__((ext_vector_type(2)));
typedef float f32x4_t __attribute__((ext_vector_type(4)));

__device__ __forceinline__ unsigned f2bf(float f) { unsigned u = __builtin_bit_cast(unsigned, f); return (u + 0x7fffu + ((u >> 16) & 1u)) >> 16; }
__device__ __forceinline__ unsigned pk2(float lo, float hi) { return f2bf(lo) | (f2bf(hi) << 16); }
__device__ __forceinline__ float bf2f(unsigned short h) { return __builtin_bit_cast(float, (unsigned)h << 16); }
__device__ __forceinline__ float bflo(unsigned w) { return __builtin_bit_cast(float, w << 16); }
__device__ __forceinline__ float bfhi(unsigned w) { return __builtin_bit_cast(float, w & 0xffff0000u); }
__device__ __forceinline__ float fast_sigmoid(float x) { return __builtin_amdgcn_rcpf(1.f + __builtin_amdgcn_exp2f(-x * LOG2E)); }
namespace pg8 {
#define PG8_LAS __attribute__((address_space(3)))
typedef unsigned short bf16_t;
typedef short bf16x8 __attribute__((ext_vector_type(8)));
typedef float f32x4 __attribute__((ext_vector_type(4)));
typedef unsigned u32x4 __attribute__((ext_vector_type(4)));
constexpr int BM = 256, BK = 64, HALF = 128, HTB = HALF * BK * 2  , STAGE_BYTES = 8 * HTB, NXCD = 8, WGM = 8;

__host__ __device__ __forceinline__ int lds_byte(int r, int c) { const int st = (r >> 4) * 2 + (c >> 5), rr = r & 15, cc = c & 31, ob = rr * 64 + cc * 2; return st * 1024 + (ob ^ (((ob >> 9) & 1) << 5)); }
__host__ __device__ __forceinline__ void stage_rc(int b, int& R, int& C) { const int st = b / 1024, sb = b % 1024, swz = sb ^ (((sb >> 9) & 1) << 5); R = (st >> 1) * 16 + swz / 64; C = (st & 1) * 32 + (swz % 64) / 2; }
__host__ __device__ __forceinline__ int perm32(int rho) { const int n = rho >> 4, i = rho & 15; return 8 * (i >> 2) + 4 * n + (i & 3); }

struct Unit { int pm, pn; };
struct Gemm { const bf16_t* A; const bf16_t* Bt; int M, N, K; };

struct StaticOrder {
    int nM, nN, nwg, G, c;
    __host__ __device__ void init(int M, int N, int G_, int c_) { nM = M / BM; nN = N / BM; nwg = nM * nN; G = G_; c = c_; }
    __host__ __device__ bool next(int i, Unit& u) const {
        const long L = (long)i * G + c; if (L >= nwg) return false;
        int wgid = (int)L; { const int q = nwg / NXCD, r = nwg % NXCD, xcd = wgid % NXCD, off = wgid / NXCD; wgid = (xcd < r ? xcd * (q + 1) : r * (q + 1) + (xcd - r) * q) + off; }
        const int nig = WGM * nN, gid = wgid / nig, fm = gid * WGM, gsz = (nM - fm) < WGM ? (nM - fm) : WGM;
        u.pm = fm + ((wgid % nig) % gsz); u.pn = (wgid % nig) / gsz; return true;
    }
    __device__ __forceinline__ void a_ready(const Unit&) const {}
    __device__ __forceinline__ void done(const Unit&) const {}
};
struct ProjOrder {
    int nM, nN, nwg, G, c, i0, i1;
    static constexpr int NFIRST = 18;
    __host__ __device__ void init(int M, int N, int G_, int c_) { nM = M / BM; nN = N / BM; nwg = nM * nN; G = G_; c = c_; i0 = 0; i1 = 1 << 30; }
    __host__ __device__ static int perm(int i) { return i < 2 ? 4 + i : i < 18 ? 12 + i : i < 22 ? i - 18 : i < 26 ? i - 16 : i < 30 ? i - 16 : i; }
    __host__ __device__ bool decode(int i, int& pm, int& pi) const {
        const long L = (long)i * G + c; if (L >= nwg) return false;
        int wgid = (int)L; { const int q = nwg / NXCD, r = nwg % NXCD, xcd = wgid % NXCD, off = wgid / NXCD; wgid = (xcd < r ? xcd * (q + 1) : r * (q + 1) + (xcd - r) * q) + off; }
        const int nig = WGM * nN, gid = wgid / nig, fm = gid * WGM, gsz = (nM - fm) < WGM ? (nM - fm) : WGM;
        pm = fm + ((wgid % nig) % gsz); pi = (wgid % nig) / gsz; return true; }
    __host__ __device__ int count_first() const { int n = 0, pm, pi; while (decode(n, pm, pi) && pi < NFIRST) ++n; return n; }
    __host__ __device__ bool next(int i, Unit& u) const { int pi; if (i0 + i >= i1 || !decode(i0 + i, u.pm, pi)) return false; u.pn = perm(pi); return true; }
    __device__ __forceinline__ void a_ready(const Unit&) const {}
    __device__ __forceinline__ void done(const Unit&) const {}
};

typedef float f32x2_cv __attribute__((ext_vector_type(2))); typedef __bf16 bf16x2_cv __attribute__((ext_vector_type(2)));
__device__ __forceinline__ unsigned cvt_pk_bf16(float lo, float hi) { f32x2_cv v = {lo, hi}; bf16x2_cv b = __builtin_convertvector(v, bf16x2_cv); return __builtin_bit_cast(unsigned, b); }

struct EpiProj {
    static constexpr bool PERM = true, AFTER_DRAIN = false, MIDHOOK = false;
    unsigned char* ws; unsigned char* dout; const float* r64; const float* r128;
    __device__ __forceinline__ void mid(f32x4 (&)[2][2][4][2], const Unit&, int, int, int, int) const {}
    __device__ __forceinline__ void operator()(const f32x4 (&acc)[2][2][4][2], const Unit& u, int wr, int wc, int fr, int fq) const {
        const int pn = u.pn;
        bf16_t* base; int ldc, colt, mode; float sc = 1.f;
        if (pn < 4)       { base = (bf16_t*)(ws + WS_QA); ldc = 1024; colt = 256 * pn; mode = 1; sc = QS64; }
        else if (pn < 10) { base = (bf16_t*)(ws + WS_KC + (size_t)(pn - 4) * 8 * MiB); ldc = 256; colt = 0; mode = (pn == 6 || pn == 8) ? 1 : 0; }
        else if (pn < 14) { base = (bf16_t*)(ws + WS_ZA); ldc = 1024; colt = 256 * (pn - 10); mode = 3; }
        else if (pn < 18) { base = (bf16_t*)(ws + WS_QB); ldc = 1024; colt = 256 * (pn - 14); mode = 2; sc = QS128; }
        else if (pn < 22) { base = (bf16_t*)(ws + WS_KB); ldc = 1024; colt = 256 * (pn - 18); mode = 2; }
        else if (pn < 26) { base = (bf16_t*)(ws + WS_VB); ldc = 1024; colt = 256 * (pn - 22); mode = 0; }
        else if (pn < 30) { base = (bf16_t*)(ws + WS_ZB); ldc = 1024; colt = 256 * (pn - 26); mode = 3; }
        else if (pn < 38) { base = (bf16_t*)(dout + DO_MA); ldc = 2048; colt = 256 * (pn - 30); mode = 4; }
        else if (pn < 46) { base = (bf16_t*)(dout + DO_MB); ldc = 2048; colt = 256 * (pn - 38); mode = 4; }
        else              { base = (bf16_t*)(ws + WS_GA); ldc = 64; colt = 0; mode = 5; }
        const int row0 = u.pm * BM + wr * 64 + fr;
        const int cb = wc * 32 + 8 * fq;
        const bool rope_wave = (mode == 1 && (wc & 1) == 0) || (mode == 2 && wc == 0);
#pragma unroll
        for (int ai = 0; ai < 2; ++ai)
#pragma unroll
            for (int m = 0; m < 4; ++m) {
                const int row = row0 + ai * HALF + m * 16;
                float v2[2][8];
#pragma unroll
                for (int bj = 0; bj < 2; ++bj)
#pragma unroll
                    for (int j = 0; j < 4; ++j) { v2[bj][j] = acc[ai][bj][m][0][j]; v2[bj][4 + j] = acc[ai][bj][m][1][j]; }
                if (rope_wave) {
                    float cs[8], sn[8];
                    if (mode == 1) { const f32x4* t = (const f32x4*)(r64 + (size_t)row * 16); const f32x4 c0 = t[0], c1 = t[1], s0 = t[2], s1 = t[3];
#pragma unroll
                        for (int j = 0; j < 4; ++j) { cs[j] = c0[j]; cs[4 + j] = c1[j]; sn[j] = s0[j]; sn[4 + j] = s1[j]; } }
                    else { const f32x4* t = (const f32x4*)(r128 + (size_t)row * 32 + 8 * (fq & 1)); const f32x4 c0 = t[0], c1 = t[1], s0 = t[4], s1 = t[5];
#pragma unroll
                        for (int j = 0; j < 4; ++j) { cs[j] = c0[j]; cs[4 + j] = c1[j]; sn[j] = s0[j]; sn[4 + j] = s1[j]; } }
                    const int xm = (mode == 1) ? 16 : 32;
                    const bool is_x1 = (mode == 1) ? (fq == 0) : (fq < 2);
                    const bool do_rot = (mode == 1) ? (fq < 2) : true;
#pragma unroll
                    for (int bj = 0; bj < 2; ++bj)
#pragma unroll
                        for (int j = 0; j < 8; ++j) { const float p = __shfl_xor(v2[bj][j], xm); const float r = v2[bj][j] * cs[j] + (is_x1 ? -p : p) * sn[j]; v2[bj][j] = do_rot ? r : v2[bj][j]; }
                }
#pragma unroll
                for (int bj = 0; bj < 2; ++bj) {
                    float v[8];
#pragma unroll
                    for (int j = 0; j < 8; ++j) v[j] = v2[bj][j];
                    if (mode == 3) {
#pragma unroll
                        for (int j = 0; j < 8; ++j) v[j] = v[j] * fast_sigmoid(v[j]);
                    } else if (mode >= 4) {
#pragma unroll
                        for (int j = 0; j < 8; ++j) v[j] = fast_sigmoid(v[j]);
                    } else {
#pragma unroll
                        for (int j = 0; j < 8; ++j) v[j] *= sc;
                    }
                    u32x4 w; w.x = cvt_pk_bf16(v[0], v[1]); w.y = cvt_pk_bf16(v[2], v[3]); w.z = cvt_pk_bf16(v[4], v[5]); w.w = cvt_pk_bf16(v[6], v[7]);
                    const int col = cb + bj * HALF;
                    if (mode != 5 || col < 48) *(u32x4*)(base + (size_t)row * ldc + colt + col) = w;
                }
            }
    }
};

struct EpiMerge {
    static constexpr bool PERM = true, AFTER_DRAIN = false, MIDHOOK = true;
    const bf16_t* sma; const bf16_t* smb; bf16_t* out;
    __device__ __forceinline__ void mid(f32x4 (&acc)[2][2][4][2], const Unit& u, int wr, int wc, int fr, int fq) const {
        asm volatile("" : "+v"(fr), "+v"(fq));
        const int row0 = u.pm * BM + wr * 64 + fr, col0 = u.pn * BM + wc * 32 + 8 * fq;
#pragma unroll
        for (int ai = 0; ai < 2; ++ai)
#pragma unroll
            for (int m = 0; m < 4; ++m)
#pragma unroll
                for (int bj = 0; bj < 2; ++bj) { const size_t off = (size_t)(row0 + ai * HALF + m * 16) * 2048 + col0 + bj * HALF;
                    const u32x4 a = *(const u32x4*)(sma + off), b = *(const u32x4*)(smb + off);
#pragma unroll
                    for (int q = 0; q < 4; ++q) { const float a0 = bflo(a[q]), a1 = bfhi(a[q]), b0 = bflo(b[q]), b1 = bfhi(b[q]);
                        acc[ai][bj][m][q >> 1][(q & 1) * 2 + 0] *= a0 * __builtin_amdgcn_rcpf(b0); acc[ai][bj][m][q >> 1][(q & 1) * 2 + 1] *= a1 * __builtin_amdgcn_rcpf(b1); }
                    if (bj == 1) asm volatile("" ::: "memory"); }
    }
    __device__ __forceinline__ void operator()(const f32x4 (&acc)[2][2][4][2], const Unit& u, int wr, int wc, int fr, int fq) const {
        const int row0 = u.pm * BM + wr * 64 + fr, col0 = u.pn * BM + wc * 32 + 8 * fq;
#pragma unroll
        for (int ai = 0; ai < 2; ++ai)
#pragma unroll
            for (int m = 0; m < 4; ++m)
#pragma unroll
                for (int bj = 0; bj < 2; ++bj) { const size_t off = (size_t)(row0 + ai * HALF + m * 16) * 2048 + col0 + bj * HALF;
                    const u32x4 b = *(const u32x4*)(smb + off); u32x4 w;
#pragma unroll
                    for (int q = 0; q < 4; ++q) w[q] = cvt_pk_bf16(acc[ai][bj][m][q >> 1][(q & 1) * 2 + 0] * bflo(b[q]), acc[ai][bj][m][q >> 1][(q & 1) * 2 + 1] * bfhi(b[q]));
                    *(u32x4*)(out + off) = w; if (bj == 1) asm volatile("" ::: "memory"); }
    }
};

struct EpiOut {
    static constexpr bool PERM = false, AFTER_DRAIN = false, MIDHOOK = false;
    float* C; float* ssq;
    __device__ __forceinline__ void mid(f32x4 (&)[2][2][4][2], const Unit&, int, int, int, int) const {}
    __device__ __forceinline__ void operator()(const f32x4 (&acc)[2][2][4][2], const Unit& u, int wr, int wc, int fr, int fq) const {
        const int row0 = u.pm * BM + wr * 64 + fr, col0 = u.pn * BM + wc * 32 + 4 * fq;
#pragma unroll
        for (int ai = 0; ai < 2; ++ai)
#pragma unroll
            for (int m = 0; m < 4; ++m) { const int row = row0 + ai * HALF + m * 16; float* rowp = C + (size_t)row * 2048 + col0; float s = 0.f;
#pragma unroll
                for (int bj = 0; bj < 2; ++bj)
#pragma unroll
                    for (int n = 0; n < 2; ++n) { const f32x4 x = acc[ai][bj][m][n]; *(f32x4*)(rowp + bj * HALF + n * 16) = x; s += (x[0] * x[0] + x[1] * x[1]) + (x[2] * x[2] + x[3] * x[3]); }
                s += __shfl_xor(s, 16); s += __shfl_xor(s, 32);
                if (fq == 0) ssq[(size_t)row * 32 + u.pn * 4 + wc] = s; }
    }
};

struct EpiOutB {
    static constexpr bool PERM = true, AFTER_DRAIN = false, MIDHOOK = false;
    bf16_t* C; float* ssq;
    __device__ __forceinline__ void mid(f32x4 (&)[2][2][4][2], const Unit&, int, int, int, int) const {}
    __device__ __forceinline__ void operator()(const f32x4 (&acc)[2][2][4][2], const Unit& u, int wr, int wc, int fr, int fq) const {
        const int row0 = u.pm * BM + wr * 64 + fr, col0 = u.pn * BM + wc * 32 + 8 * fq;
#pragma unroll
        for (int ai = 0; ai < 2; ++ai)
#pragma unroll
            for (int m = 0; m < 4; ++m) { const int row = row0 + ai * HALF + m * 16; bf16_t* rowp = C + (size_t)row * 2048 + col0; float s = 0.f;
#pragma unroll
                for (int bj = 0; bj < 2; ++bj) { const f32x4 x0 = acc[ai][bj][m][0], x1 = acc[ai][bj][m][1];
                    s += ((x0[0] * x0[0] + x0[1] * x0[1]) + (x0[2] * x0[2] + x0[3] * x0[3])) + ((x1[0] * x1[0] + x1[1] * x1[1]) + (x1[2] * x1[2] + x1[3] * x1[3]));
                    u32x4 w; w.x = cvt_pk_bf16(x0[0], x0[1]); w.y = cvt_pk_bf16(x0[2], x0[3]); w.z = cvt_pk_bf16(x1[0], x1[1]); w.w = cvt_pk_bf16(x1[2], x1[3]);
                    *(u32x4*)(rowp + bj * HALF) = w; }
                s += __shfl_xor(s, 16); s += __shfl_xor(s, 32);
                if (fq == 0) ssq[(size_t)row * 32 + u.pn * 4 + wc] = s; }
    }
};

struct EpiFinal {
    static constexpr bool PERM = false, AFTER_DRAIN = false, MIDHOOK = false;
    const float* x; float* out; float* ssq; unsigned* cnt; const float* ada; const float* gpost;
    __device__ __forceinline__ void mid(f32x4 (&)[2][2][4][2], const Unit&, int, int, int, int) const {}
    __device__ __forceinline__ void operator()(const f32x4 (&acc)[2][2][4][2], const Unit& u, int wr, int wc, int fr, int fq) const {
        const int row0 = u.pm * BM + wr * 64 + fr, col0 = u.pn * BM + wc * 32 + 4 * fq;
#pragma unroll
        for (int ai = 0; ai < 2; ++ai)
#pragma unroll
            for (int m = 0; m < 4; ++m) { const int row = row0 + ai * HALF + m * 16; float s = 0.f;
#pragma unroll
                for (int bj = 0; bj < 2; ++bj)
#pragma unroll
                    for (int n = 0; n < 2; ++n) { const f32x4 v = acc[ai][bj][m][n]; s += (v[0] * v[0] + v[1] * v[1]) + (v[2] * v[2] + v[3] * v[3]); }
                s += __shfl_xor(s, 16); s += __shfl_xor(s, 32);
                if (fq == 0) __hip_atomic_store(ssq + (size_t)row * 32 + u.pn * 4 + wc, s, __ATOMIC_RELAXED, __HIP_MEMORY_SCOPE_AGENT); }
        asm volatile("s_waitcnt vmcnt(0)" ::: "memory");
        unsigned* c = cnt + 64 * u.pm;
        if (fr == 0 && fq == 0) __hip_atomic_fetch_add(c, 1u, __ATOMIC_RELAXED, __HIP_MEMORY_SCOPE_AGENT);
        { unsigned spins = 0;
          while ((unsigned)__builtin_amdgcn_readfirstlane(__hip_atomic_load(c, __ATOMIC_RELAXED, __HIP_MEMORY_SCOPE_AGENT)) < 64u) { __builtin_amdgcn_s_sleep(2); if (++spins > (1u << 22)) break; } }
        const int b = (u.pm * BM) >> 11;
        f32x4 gg[2][2];
#pragma unroll
        for (int bj = 0; bj < 2; ++bj)
#pragma unroll
            for (int n = 0; n < 2; ++n) { const int col = col0 + bj * HALF + n * 16; gg[bj][n] = *(const f32x4*)(ada + b * 6144 + 4096 + col) * *(const f32x4*)(gpost + col); }
#pragma unroll
        for (int ai = 0; ai < 2; ++ai)
#pragma unroll
            for (int m = 0; m < 4; ++m) { const int row = row0 + ai * HALF + m * 16; const float* sp = ssq + (size_t)row * 32 + 8 * fq; float s = 0.f;
#pragma unroll
                for (int q = 0; q < 8; ++q) s += __hip_atomic_load(sp + q, __ATOMIC_RELAXED, __HIP_MEMORY_SCOPE_AGENT);
                s += __shfl_xor(s, 16); s += __shfl_xor(s, 32);
                const float rstd = rsqrtf(s * (1.f / 2048.f) + 1e-6f);
                const float* xr = x + (size_t)row * 2048 + col0; float* orow = out + (size_t)row * 2048 + col0;
#pragma unroll
                for (int bj = 0; bj < 2; ++bj)
#pragma unroll
                    for (int n = 0; n < 2; ++n) { const f32x4 xv = *(const f32x4*)(xr + bj * HALF + n * 16); *(f32x4*)(orow + bj * HALF + n * 16) = xv + gg[bj][n] * (acc[ai][bj][m][n] * rstd); }
                if (m & 1) asm volatile("" ::: "memory"); }
    }
};

struct PanelOrder {
    int nN, nwg, G, v;
    __host__ __device__ void init(int M, int N, int G_, int v_) { nN = N / BM; nwg = (M / BM) * nN; G = G_; v = v_; }
    __host__ __device__ bool next(int i, Unit& u) const { const long L = (long)i * G + v; if (L >= nwg) return false; u.pm = (int)(L / nN); u.pn = (int)(L % nN); return true; }
    __device__ __forceinline__ void a_ready(const Unit&) const {}
    __device__ __forceinline__ void done(const Unit&) const {}
};
template <class Epi, class Sched, bool ALIGN_EPI = false, bool SP2 = false>
__device__ __forceinline__ void gemm_phase(PG8_LAS unsigned char* lds, const Gemm g, const Sched& S, const Epi& E) {
    const int tid = threadIdx.x, wid = __builtin_amdgcn_readfirstlane(tid >> 6), lane = tid & 63, wr = wid >> 2, wc = wid & 3, fr = lane & 15, fq = lane >> 4;
    const int K = g.K, nt = K / BK;
    unsigned voffA[2], voffB[2];
#pragma unroll
    for (int i = 0; i < 2; ++i) { int R, C; stage_rc(tid * 16 + i * 8192, R, C); const int Rb = Epi::PERM ? ((R & ~31) + perm32(R & 31)) : R;
        voffA[i] = (unsigned)(R * K + C) * 2u; voffB[i] = (unsigned)(Rb * K + C) * 2u; }
    const size_t kstep = (size_t)(BK * 2);
    const size_t hstep = (size_t)HALF * K * 2;
    const size_t tstep = 2 * hstep;
    const unsigned ldsw = (unsigned)wid * 1024u;
    const int aoff = lds_byte(wr * 64 + fr, fq * 8), boff = lds_byte(wc * 32 + fr, fq * 8);
#define PG8_SA(b, h) (((b) * 2 + (h)) * HTB)
#define PG8_SB(b, h) ((4 + (b) * 2 + (h)) * HTB)
#define PG8_STAGE(bufoff, gbase, voff) do { _Pragma("unroll") for (int _i = 0; _i < 2; ++_i) \
        __builtin_amdgcn_global_load_lds((const unsigned*)((const char*)(gbase) + (voff)[_i]), (PG8_LAS unsigned*)(lds + (bufoff) + ldsw + _i * 8192), 16, 0, 0); } while (0)
#define PG8_LDA(dst, b, h) do { _Pragma("unroll") for (int m = 0; m < 4; ++m) _Pragma("unroll") for (int k = 0; k < 2; ++k) dst[m][k] = *(const PG8_LAS bf16x8*)(lds + PG8_SA(b, h) + aoff + m * 2048 + k * 1024); } while (0)
#define PG8_LDB(dst, b, h) do { _Pragma("unroll") for (int n = 0; n < 2; ++n) _Pragma("unroll") for (int k = 0; k < 2; ++k) dst[n][k] = *(const PG8_LAS bf16x8*)(lds + PG8_SB(b, h) + boff + n * 2048 + k * 1024); } while (0)
#define PG8_MMA(ai, bj, At, Bt) do { __builtin_amdgcn_s_setprio(1); _Pragma("unroll") for (int m = 0; m < 4; ++m) _Pragma("unroll") for (int n = 0; n < 2; ++n) _Pragma("unroll") for (int k = 0; k < 2; ++k) \
        acc[ai][bj][m][n] = __builtin_amdgcn_mfma_f32_16x16x32_bf16(Bt[n][k], At[m][k], acc[ai][bj][m][n], 0, 0, 0); __builtin_amdgcn_s_setprio(0); } while (0)
#define PG8_WAIT_V(n) asm volatile("s_waitcnt vmcnt(" #n ")" ::: "memory")
#define PG8_WAIT_L(n) asm volatile("s_waitcnt lgkmcnt(" #n ")" ::: "memory")
#define PG8_BAR __builtin_amdgcn_s_barrier()
#define PG8_SCHED __builtin_amdgcn_sched_barrier(0)
    Unit cur, nxt; int ui = 0;
    if (!S.next(0, cur)) return;
    f32x4 acc[2][2][4][2];
#pragma unroll
    for (int a = 0; a < 2; ++a)
#pragma unroll
        for (int b = 0; b < 2; ++b)
#pragma unroll
            for (int m = 0; m < 4; ++m)
#pragma unroll
                for (int n = 0; n < 2; ++n) acc[a][b][m][n] = (f32x4){0.f, 0.f, 0.f, 0.f};
    bf16x8 At[4][2], B0[2][2], B1[2][2];
    const char* cA = (const char*)g.A + (size_t)cur.pm * tstep; const char* cB = (const char*)g.Bt + (size_t)cur.pn * tstep;
    S.a_ready(cur);
    if constexpr (SP2) {
        PG8_STAGE(PG8_SB(0, 0), cB, voffB); PG8_STAGE(PG8_SB(0, 1), cB + hstep, voffB); PG8_STAGE(PG8_SA(0, 0), cA, voffA); PG8_STAGE(PG8_SA(0, 1), cA + hstep, voffA);
        if (wr == 1) PG8_BAR;
        PG8_WAIT_V(2); PG8_BAR;
        PG8_STAGE(PG8_SB(1, 0), cB + kstep, voffB); PG8_STAGE(PG8_SA(1, 0), cA + kstep, voffA); PG8_STAGE(PG8_SB(1, 1), cB + hstep + kstep, voffB);
        PG8_WAIT_V(6); PG8_BAR;
    } else {
        PG8_STAGE(PG8_SB(0, 0), cB, voffB); PG8_STAGE(PG8_SA(0, 0), cA, voffA); PG8_STAGE(PG8_SB(0, 1), cB + hstep, voffB); PG8_STAGE(PG8_SA(0, 1), cA + hstep, voffA);
        if (wr == 1) PG8_BAR;
        PG8_WAIT_V(4); PG8_BAR;
        PG8_STAGE(PG8_SB(1, 0), cB + kstep, voffB); PG8_STAGE(PG8_SA(1, 0), cA + kstep, voffA); PG8_STAGE(PG8_SB(1, 1), cB + hstep + kstep, voffB);
        PG8_WAIT_V(6); PG8_BAR;
    }
    for (;;) {
        const bool has_next = S.next(ui + 1, nxt);
        const char* nA = has_next ? (const char*)g.A + (size_t)nxt.pm * tstep : cA; const char* nB = has_next ? (const char*)g.Bt + (size_t)nxt.pn * tstep : cB;
        for (int t = 0; t < nt; t += 2) {
            const bool last = (t == nt - 2);
            if constexpr (Epi::MIDHOOK) { if (t == nt / 2) E.mid(acc, cur, wr, wc, fr, fq); }
            const char* a1 = cA + (size_t)(t + 1) * kstep;
            const char* a2 = last ? nA : cA + (size_t)(t + 2) * kstep; const char* b2 = last ? nB : cB + (size_t)(t + 2) * kstep;
            const char* a3 = a2 + kstep; const char* b3 = b2 + kstep;
            if (last && has_next) S.a_ready(nxt);
            if constexpr (SP2) {
            PG8_LDB(B0, 0, 0); PG8_LDB(B1, 0, 1); PG8_SCHED; PG8_LDA(At, 0, 0); PG8_STAGE(PG8_SA(1, 1), a1 + hstep, voffA);
            PG8_WAIT_V(8); PG8_WAIT_L(0); PG8_BAR; PG8_MMA(0, 0, At, B0); PG8_MMA(0, 1, At, B1); PG8_BAR; PG8_SCHED;
            PG8_LDA(At, 0, 1); PG8_STAGE(PG8_SB(0, 0), b2, voffB); PG8_STAGE(PG8_SB(0, 1), b2 + hstep, voffB); PG8_STAGE(PG8_SA(0, 0), a2, voffA);
            PG8_WAIT_V(8); PG8_WAIT_L(0); PG8_BAR; PG8_MMA(1, 0, At, B0); PG8_MMA(1, 1, At, B1); PG8_BAR; PG8_SCHED;
            PG8_LDB(B0, 1, 0); PG8_LDB(B1, 1, 1); PG8_SCHED; PG8_LDA(At, 1, 0); PG8_STAGE(PG8_SA(0, 1), a2 + hstep, voffA);
            PG8_WAIT_V(8); PG8_WAIT_L(0); PG8_BAR; PG8_MMA(0, 0, At, B0); PG8_MMA(0, 1, At, B1); PG8_BAR; PG8_SCHED;
            PG8_LDA(At, 1, 1); PG8_STAGE(PG8_SB(1, 0), b3, voffB); PG8_STAGE(PG8_SB(1, 1), b3 + hstep, voffB); PG8_STAGE(PG8_SA(1, 0), a3, voffA);
            PG8_WAIT_V(8); PG8_WAIT_L(0); PG8_BAR; PG8_MMA(1, 0, At, B0); PG8_MMA(1, 1, At, B1); PG8_BAR; PG8_SCHED;
            } else {
            PG8_LDB(B0, 0, 0); PG8_SCHED; PG8_LDA(At, 0, 0); PG8_STAGE(PG8_SA(1, 1), a1 + hstep, voffA);
            PG8_WAIT_L(8); PG8_BAR; PG8_WAIT_L(0); PG8_MMA(0, 0, At, B0); PG8_BAR; PG8_SCHED;
            PG8_LDB(B1, 0, 1); PG8_STAGE(PG8_SB(0, 0), b2, voffB);
            PG8_BAR; PG8_WAIT_L(0); PG8_MMA(0, 1, At, B1); PG8_BAR;
            PG8_LDA(At, 0, 1); PG8_STAGE(PG8_SA(0, 0), a2, voffA);
            PG8_BAR; PG8_WAIT_L(0); PG8_MMA(1, 0, At, B0); PG8_BAR; PG8_SCHED;
            PG8_STAGE(PG8_SB(0, 1), b2 + hstep, voffB);
            PG8_WAIT_V(6); PG8_BAR; PG8_MMA(1, 1, At, B1); PG8_BAR;
            PG8_LDB(B0, 1, 0); PG8_SCHED; PG8_LDA(At, 1, 0); PG8_STAGE(PG8_SA(0, 1), a2 + hstep, voffA);
            PG8_WAIT_L(8); PG8_BAR; PG8_WAIT_L(0); PG8_MMA(0, 0, At, B0); PG8_BAR; PG8_SCHED;
            PG8_LDB(B1, 1, 1); PG8_STAGE(PG8_SB(1, 0), b3, voffB);
            PG8_BAR; PG8_WAIT_L(0); PG8_MMA(0, 1, At, B1); PG8_BAR;
            PG8_LDA(At, 1, 1); PG8_STAGE(PG8_SA(1, 0), a3, voffA);
            PG8_BAR; PG8_WAIT_L(0); PG8_MMA(1, 0, At, B0); PG8_BAR; PG8_SCHED;
            PG8_STAGE(PG8_SB(1, 1), b3 + hstep, voffB);
            PG8_WAIT_V(6); PG8_BAR; PG8_MMA(1, 1, At, B1); PG8_BAR;
            }
        }
        if constexpr (ALIGN_EPI) { if (wr == 0) PG8_BAR; }
        if constexpr (!Epi::AFTER_DRAIN) { E(acc, cur, wr, wc, fr, fq); S.done(cur); }
        if (!has_next) break;
#pragma unroll
        for (int a = 0; a < 2; ++a)
#pragma unroll
            for (int b = 0; b < 2; ++b)
#pragma unroll
                for (int m = 0; m < 4; ++m)
#pragma unroll
                    for (int n = 0; n < 2; ++n) acc[a][b][m][n] = (f32x4){0.f, 0.f, 0.f, 0.f};
        cur = nxt; cA = nA; cB = nB; ++ui;
        if constexpr (ALIGN_EPI) { if (wr == 1) PG8_BAR; }
    }
    PG8_WAIT_V(0);
    if constexpr (!ALIGN_EPI) { if (wr == 0) PG8_BAR; }
    PG8_BAR;
    if constexpr (Epi::AFTER_DRAIN) { E.fused(acc, cur, wr, wc, fr, fq, lds, wid, lane); S.done(cur); }
#undef PG8_SA
#undef PG8_SB
#undef PG8_STAGE
#undef PG8_LDA
#undef PG8_LDB
#undef PG8_MMA
#undef PG8_WAIT_V
#undef PG8_WAIT_L
#undef PG8_BAR
#undef PG8_SCHED
}
}

namespace att {
typedef short bf16x8 __attribute__((ext_vector_type(8)));
typedef short s16x4 __attribute__((ext_vector_type(4)));
typedef short v4i16_t __attribute__((ext_vector_type(4)));
typedef float f32x16 __attribute__((ext_vector_type(16)));
constexpr float NEGINF = -__builtin_inff();

constexpr int L_K0 = 0, L_K1 = 16384, L_V0 = 32768, L_V1 = 49152;
template <int D> struct Tile { u32x4_t k[D / 64]; u32x4_t v[D / 64]; };
template <int D> __device__ __forceinline__ void tile_load(Tile<D>& T, const bf16_t* Kp, const bf16_t* Vp, int pitch, int wid, int lane) {
#pragma unroll
    for (int i = 0; i < D / 64; ++i) { const int pc = wid + 8 * i;
        T.k[i] = *(const u32x4_t*)(Kp + (size_t)lane * pitch + pc * 8);
        T.v[i] = *(const u32x4_t*)(Vp + (size_t)(16 * (pc & 3) + (lane >> 2)) * pitch + 32 * (pc >> 2) + 8 * (lane & 3)); }
}
template <int D> __device__ __forceinline__ void tile_store(const Tile<D>& T, LAS unsigned char* kbuf, LAS unsigned char* vbuf, int wid, int lane) {
#pragma unroll
    for (int i = 0; i < D / 64; ++i) { const int pc = wid + 8 * i;
        *(LAS u32x4_t*)(kbuf + pc * 1024 + lane * 16) = T.k[i]; *(LAS u32x4_t*)(vbuf + pc * 1024 + lane * 16) = T.v[i]; }
}
template <int D> __device__ __forceinline__ void k_load(Tile<D>& T, const bf16_t* Kp, int pitch, int wid, int lane) {
#pragma unroll
    for (int i = 0; i < D / 64; ++i) T.k[i] = *(const u32x4_t*)(Kp + (size_t)lane * pitch + (wid + 8 * i) * 8);
}
template <int D> __device__ __forceinline__ void v_load(Tile<D>& T, const bf16_t* Vp, int pitch, int wid, int lane) {
#pragma unroll
    for (int i = 0; i < D / 64; ++i) { const int pc = wid + 8 * i; T.v[i] = *(const u32x4_t*)(Vp + (size_t)(16 * (pc & 3) + (lane >> 2)) * pitch + 32 * (pc >> 2) + 8 * (lane & 3)); }
}
template <int D> __device__ __forceinline__ void k_store(const Tile<D>& T, LAS unsigned char* kbuf, int wid, int lane) {
#pragma unroll
    for (int i = 0; i < D / 64; ++i) *(LAS u32x4_t*)(kbuf + (wid + 8 * i) * 1024 + lane * 16) = T.k[i];
}
template <int D> __device__ __forceinline__ void v_store(const Tile<D>& T, LAS unsigned char* vbuf, int wid, int lane) {
#pragma unroll
    for (int i = 0; i < D / 64; ++i) *(LAS u32x4_t*)(vbuf + (wid + 8 * i) * 1024 + lane * 16) = T.v[i];
}
template <int D> __device__ __forceinline__ void qkt(f32x16& p0, f32x16& p1, const LAS unsigned char* kbuf, const bf16x8* qr, int r32, int hi) {
    p0 = f32x16{}; p1 = f32x16{};
    const LAS unsigned char* kb = kbuf + hi * 1024 + r32 * 16;
#pragma unroll
    for (int d0 = 0; d0 < D / 16; ++d0) {
        const bf16x8 b0 = *(const LAS bf16x8*)(kb + d0 * 2048), b1 = *(const LAS bf16x8*)(kb + d0 * 2048 + 512);
        p0 = __builtin_amdgcn_mfma_f32_32x32x16_bf16(b0, qr[d0], p0, 0, 0, 0);
        p1 = __builtin_amdgcn_mfma_f32_32x32x16_bf16(b1, qr[d0], p1, 0, 0, 0); }
}
__device__ __forceinline__ s16x4 vtr(const LAS unsigned char* p) { return __builtin_bit_cast(s16x4, __builtin_amdgcn_ds_read_tr16_b64_v4i16((LAS v4i16_t*)p)); }
template <int D> __device__ __forceinline__ void pv(f32x16* o, const LAS unsigned char* vbuf, const bf16x8* pa, int lane) {
    const LAS unsigned char* vb = vbuf + ((lane >> 4) & 1) * 32 + (lane & 3) * 8 + (4 * (lane >> 5) + ((lane & 15) >> 2)) * 64;
#pragma unroll
    for (int dp = 0; dp < D / 64; ++dp) {
        s16x4 lo[2][4], hh[2][4];
#pragma unroll
        for (int e = 0; e < 2; ++e)
#pragma unroll
            for (int ks = 0; ks < 4; ++ks) { lo[e][ks] = vtr(vb + (2 * dp + e) * 4096 + ks * 1024); hh[e][ks] = vtr(vb + (2 * dp + e) * 4096 + ks * 1024 + 512); }
        __builtin_amdgcn_sched_barrier(0);
#pragma unroll
        for (int e = 0; e < 2; ++e)
#pragma unroll
            for (int ks = 0; ks < 4; ++ks) { const bf16x8 vf = {lo[e][ks][0], lo[e][ks][1], lo[e][ks][2], lo[e][ks][3], hh[e][ks][0], hh[e][ks][1], hh[e][ks][2], hh[e][ks][3]};
                o[2 * dp + e] = __builtin_amdgcn_mfma_f32_32x32x16_bf16(vf, pa[ks], o[2 * dp + e], 0, 0, 0); }
    }
}
__device__ __forceinline__ float xhalf_max(float v) { auto rr = __builtin_amdgcn_permlane32_swap(__float_as_uint(v), __float_as_uint(v), false, false); return fmaxf(__uint_as_float(rr[0]), __uint_as_float(rr[1])); }
__device__ __forceinline__ float xhalf_sum(float v) { auto rr = __builtin_amdgcn_permlane32_swap(__float_as_uint(v), __float_as_uint(v), false, false); return __uint_as_float(rr[0]) + __uint_as_float(rr[1]); }
typedef float f32x2_cv __attribute__((ext_vector_type(2))); typedef __bf16 bf16x2_cv __attribute__((ext_vector_type(2)));
__device__ __forceinline__ unsigned cvtpk(float lo, float hi) { f32x2_cv v = {lo, hi}; bf16x2_cv b = __builtin_convertvector(v, bf16x2_cv); return __builtin_bit_cast(unsigned, b); }
__device__ __forceinline__ bf16x8 pack8(const f32x16& p, int b) { u32x4_t w = {cvtpk(p[b], p[b + 1]), cvtpk(p[b + 2], p[b + 3]), cvtpk(p[b + 4], p[b + 5]), cvtpk(p[b + 6], p[b + 7])}; return __builtin_bit_cast(bf16x8, w); }
__device__ __forceinline__ float rowmax32(const f32x16& p0, const f32x16& p1) {
    float a = fmaxf(p0[0], p1[0]);
#pragma unroll
    for (int r = 1; r < 16; ++r) a = fmaxf(a, fmaxf(p0[r], p1[r]));
    return xhalf_max(a);
}
__device__ __forceinline__ void mask_band(f32x16& p0, f32x16& p1, int dq, unsigned band) {
#pragma unroll
    for (int r = 0; r < 16; ++r) { const int c = (r & 3) + 8 * (r >> 2);
        if ((unsigned)(dq - c) > band) p0[r] = NEGINF;
        if ((unsigned)(dq - c - 32) > band) p1[r] = NEGINF; }
}
constexpr float THR = 10.f;
template <int D> struct State { float m; int cls, tc; f32x16 ci; f32x16 o[D / 32]; f32x16 ol; };
template <int D> __device__ __forceinline__ void state_reset(State<D>& st) { st.m = 0.f; st.cls = -1; st.tc = 0; st.ci = f32x16{}; st.ol = f32x16{};
#pragma unroll
    for (int i = 0; i < D / 32; ++i) st.o[i] = f32x16{}; }
__device__ __forceinline__ f32x16 mfma3(bf16x8 a, bf16x8 b, const f32x16& c) { f32x16 d; asm volatile("v_mfma_f32_32x32x16_bf16 %0, %1, %2, %3" : "=&v"(d) : "v"(a), "v"(b), "v"(c)); return d; }
template <int D> __device__ __forceinline__ void qkt_c(f32x16& p0, f32x16& p1, const LAS unsigned char* kbuf, const bf16x8* qr, int r32, int hi, const f32x16& c0, const f32x16& c1) {
    const LAS unsigned char* kb = kbuf + hi * 1024 + r32 * 16;
#pragma unroll
    for (int dc = 0; dc < D / 64; ++dc) {
        bf16x8 kf0[4], kf1[4];
#pragma unroll
        for (int e = 0; e < 4; ++e) { kf0[e] = *(const LAS bf16x8*)(kb + (4 * dc + e) * 2048); kf1[e] = *(const LAS bf16x8*)(kb + (4 * dc + e) * 2048 + 512); }
        __builtin_amdgcn_sched_barrier(0);
        __builtin_amdgcn_s_setprio(1);
#pragma unroll
        for (int e = 0; e < 4; ++e) { const int d0 = 4 * dc + e;
            if (d0 == 0) { p0 = mfma3(kf0[e], qr[d0], c0); p1 = mfma3(kf1[e], qr[d0], c1); }
            else { p0 = __builtin_amdgcn_mfma_f32_32x32x16_bf16(kf0[e], qr[d0], p0, 0, 0, 0); p1 = __builtin_amdgcn_mfma_f32_32x32x16_bf16(kf1[e], qr[d0], p1, 0, 0, 0); } }
        __builtin_amdgcn_s_setprio(0);
    }
}
__device__ __forceinline__ float rowmax32_3(const f32x16& p0, const f32x16& p1) {
    float a = fmaxf(fmaxf(p0[0], p0[1]), p1[0]), b = fmaxf(fmaxf(p0[2], p0[3]), p1[1]); a = fmaxf(fmaxf(a, p1[2]), p1[3]);
#pragma unroll
    for (int r = 4; r < 16; r += 4) { a = fmaxf(fmaxf(a, p0[r]), p0[r + 1]); b = fmaxf(fmaxf(b, p0[r + 2]), p0[r + 3]); a = fmaxf(fmaxf(a, p1[r]), p1[r + 1]); b = fmaxf(fmaxf(b, p1[r + 2]), p1[r + 3]); }
    return xhalf_max(fmaxf(a, b));
}
template <int D, class Pol> __device__ __forceinline__ void softmax_p(State<D>& st, const Pol& pol, f32x16& p0, f32x16& p1, bf16x8* pa) {
    const float mx = rowmax32_3(p0, p1);
    if (__builtin_expect(__any(mx > THR), 0)) {
        const float dl = fmaxf(mx, 0.f); st.m += dl; const float f = __builtin_amdgcn_exp2f(-dl);
#pragma unroll
        for (int r = 0; r < 16; ++r) { p0[r] -= dl; p1[r] -= dl; st.ol[r] *= f; }
#pragma unroll
        for (int i = 0; i < D / 32; ++i)
#pragma unroll
            for (int r = 0; r < 16; ++r) st.o[i][r] *= f;
        pol.build(st);
    }
#pragma unroll
    for (int r = 0; r < 16; ++r) { p0[r] = __builtin_amdgcn_exp2f(p0[r]); p1[r] = __builtin_amdgcn_exp2f(p1[r]); }
    pa[0] = pack8(p0, 0); pa[1] = pack8(p0, 8); pa[2] = pack8(p1, 0); pa[3] = pack8(p1, 8);
}
#ifndef SGB_XV
#define SGB_XV 0
#endif
template <int D, class Pol> __device__ __forceinline__ void softmax_head(State<D>& st, const Pol& pol, f32x16& p0, f32x16& p1) {
#ifdef MAX_STRIDE
    if ((st.tc++ & (MAX_STRIDE - 1)) != 0) return;
#endif
    const float mx = rowmax32_3(p0, p1);
    if (__builtin_expect(__any(mx > THR), 0)) {
        const float dl = fmaxf(mx, 0.f); st.m += dl; const float f = __builtin_amdgcn_exp2f(-dl);
#pragma unroll
        for (int r = 0; r < 16; ++r) { p0[r] -= dl; p1[r] -= dl; st.ol[r] *= f; }
#pragma unroll
        for (int i = 0; i < D / 32; ++i)
#pragma unroll
            for (int r = 0; r < 16; ++r) st.o[i][r] *= f;
        pol.build(st);
    }
}
template <int D, class Pol> __device__ __forceinline__ void exp_pv_manual(State<D>& st, const Pol& pol, int jc, f32x16& c0, f32x16& c1, const LAS unsigned char* vbuf, int lane) {
    constexpr int NE = D / 32, XE = 8 / NE;
    const LAS unsigned char* vb = vbuf + ((lane >> 4) & 1) * 32 + (lane & 3) * 8 + (4 * (lane >> 5) + ((lane & 15) >> 2)) * 64;
    const bf16x8 ones = {16256, 16256, 16256, 16256, 16256, 16256, 16256, 16256};
    s16x4 lo[2][NE], hh[2][NE];
#pragma unroll
    for (int e = 0; e < NE; ++e) { lo[0][e] = vtr(vb + e * 4096); hh[0][e] = vtr(vb + e * 4096 + 512); }
#pragma unroll
    for (int r = 0; r < 8; ++r) c0[r] = __builtin_amdgcn_exp2f(c0[r]);
    bf16x8 pk = pack8(c0, 0); pol.maskp1(jc, pk);
    __builtin_amdgcn_sched_barrier(0);
#pragma unroll
    for (int ks = 0; ks < 4; ++ks) {
        f32x16& src = (ks + 1) < 2 ? c0 : c1; const int base = 8 * ((ks + 1) & 1);
#pragma unroll
        for (int e = 0; e < NE; ++e) {
            const bf16x8 vf = {lo[ks & 1][e][0], lo[ks & 1][e][1], lo[ks & 1][e][2], lo[ks & 1][e][3], hh[ks & 1][e][0], hh[ks & 1][e][1], hh[ks & 1][e][2], hh[ks & 1][e][3]};
            st.o[e] = __builtin_amdgcn_mfma_f32_32x32x16_bf16(vf, pk, st.o[e], 0, 0, 0);
            if (ks < 3) { lo[(ks + 1) & 1][e] = vtr(vb + e * 4096 + (ks + 1) * 1024); hh[(ks + 1) & 1][e] = vtr(vb + e * 4096 + (ks + 1) * 1024 + 512);
#pragma unroll
                for (int x = 0; x < XE; ++x) src[base + e * XE + x] = __builtin_amdgcn_exp2f(src[base + e * XE + x]); }
            __builtin_amdgcn_sched_barrier(0);
        }
        st.ol = __builtin_amdgcn_mfma_f32_32x32x16_bf16(ones, pk, st.ol, 0, 0, 0);
        if (ks < 3) { pk = pack8(src, base); pol.maskp1(jc, pk); }
        __builtin_amdgcn_sched_barrier(0);
    }
}
template <int D> __device__ __forceinline__ void pv_all(State<D>& st, const bf16x8* pa, const LAS unsigned char* vbuf, int lane) {
    pv<D>(st.o, vbuf, pa, lane);
    const bf16x8 ones = {16256, 16256, 16256, 16256, 16256, 16256, 16256, 16256};
#pragma unroll
    for (int ks = 0; ks < 4; ++ks) st.ol = __builtin_amdgcn_mfma_f32_32x32x16_bf16(ones, pa[ks], st.ol, 0, 0, 0);
}
__device__ __forceinline__ void glds16(const void* gsrc, unsigned lds_dst) { unsigned keep;
    asm volatile("s_mov_b32 %0, m0\n\ts_mov_b32 m0, %2\n\ts_nop 0\n\tglobal_load_lds_dwordx4 %1, off\n\ts_mov_b32 m0, %0" : "=&s"(keep) : "v"(gsrc), "s"(lds_dst) : "memory"); }
template <int D> __device__ __forceinline__ void tile_dma(const bf16_t* Kp, const bf16_t* Vp, int pitch, unsigned kdst, unsigned vdst, int wid, int lane) {
#pragma unroll
    for (int i = 0; i < D / 64; ++i) { const int pc = wid + 8 * i;
        glds16(Kp + (size_t)lane * pitch + pc * 8, (unsigned)__builtin_amdgcn_readfirstlane(kdst + pc * 1024));
        glds16(Vp + (size_t)(16 * (pc & 3) + (lane >> 2)) * pitch + 32 * (pc >> 2) + 8 * (lane & 3), (unsigned)__builtin_amdgcn_readfirstlane(vdst + pc * 1024)); }
}
__device__ __forceinline__ void wait_lg_bar() { asm volatile("s_waitcnt lgkmcnt(0)\n\ts_barrier" ::: "memory"); }
template <int N> __device__ __forceinline__ void wait_vm_bar() { asm volatile("s_waitcnt vmcnt(%0) lgkmcnt(0)\n\ts_barrier" :: "i"(N) : "memory"); }
template <int D, class Pol> __device__ __forceinline__ void compute_tile(State<D>& st, const Pol& pol, int jc, const bf16x8* qr, const LAS unsigned char* kbuf, const LAS unsigned char* vbuf, int lane) {
    if (pol.active(jc)) {
        const int r32 = lane & 31, hi = lane >> 5;
        f32x16 c0, c1;
        pol.prep(jc, st);
        qkt_c<D>(c0, c1, kbuf, qr, r32, hi, st.ci, st.ci); pol.postmask(jc, c0, c1);
#ifdef MAN_PV
        softmax_head<D, Pol>(st, pol, c0, c1); exp_pv_manual<D, Pol>(st, pol, jc, c0, c1, vbuf, lane);
#else
        bf16x8 pa[4]; softmax_p<D, Pol>(st, pol, c0, c1, pa); pol.maskp(jc, pa); pv_all<D>(st, pa, vbuf, lane);
#endif
    }
}
template <int D, class Pol> __device__ __forceinline__ void run_branch(State<D>& st, const Pol& pol, const bf16x8* qr, LAS unsigned char* lds, int wid, int lane) {
    constexpr int SLOT = 256 * D, NI = 2 * (D / 64);
    const unsigned lds0 = (unsigned)(size_t)lds;
    int jc = pol.first(), jn = pol.next(jc), jnn = jn >= 0 ? pol.next(jn) : -1;
    tile_dma<D>(pol.kptr(jc), pol.vptr(jc), pol.pitch, lds0, lds0 + SLOT / 2, wid, lane);
    if (jn >= 0) { tile_dma<D>(pol.kptr(jn), pol.vptr(jn), pol.pitch, lds0 + SLOT, lds0 + SLOT + SLOT / 2, wid, lane); wait_vm_bar<NI>(); } else wait_vm_bar<0>();
    int sc = 0;
    for (;;) {
        const int s2 = sc == 0 ? 2 : sc - 1;
#ifdef DMA_LATE
        compute_tile<D, Pol>(st, pol, jc, qr, lds + sc * SLOT, lds + sc * SLOT + SLOT / 2, lane);
        if (jnn >= 0) tile_dma<D>(pol.kptr(jnn), pol.vptr(jnn), pol.pitch, lds0 + s2 * SLOT, lds0 + s2 * SLOT + SLOT / 2, wid, lane);
#else
        if (jnn >= 0) tile_dma<D>(pol.kptr(jnn), pol.vptr(jnn), pol.pitch, lds0 + s2 * SLOT, lds0 + s2 * SLOT + SLOT / 2, wid, lane);
        compute_tile<D, Pol>(st, pol, jc, qr, lds + sc * SLOT, lds + sc * SLOT + SLOT / 2, lane);
#endif
        if (jn < 0) { wait_vm_bar<0>(); break; }
        if (jnn >= 0) wait_vm_bar<NI>(); else wait_vm_bar<0>();
        sc = sc == 2 ? 0 : sc + 1; jc = jn; jn = jnn; jnn = jn >= 0 ? pol.next(jn) : -1;
    }
}
__device__ __forceinline__ f32x16 splat16(float v) { f32x16 c;
#pragma unroll
    for (int r = 0; r < 16; ++r) c[r] = v;
    return c; }

constexpr int L_IMPA = 65536, L_IMPB = L_IMPA + 4 * 64 * 33 * 4, L_SC = L_IMPB + 4 * 64 * 33 * 4, L_SELM = L_SC + 64 * 33 * 4, L_ORM = L_SELM + 256;
static_assert(L_ORM + 16 <= 143360, "attention LDS map");

struct NsaPtrs { unsigned char* ws;
    __device__ __forceinline__ const bf16_t* QA() const { return (const bf16_t*)(ws + WS_QA); }
    __device__ __forceinline__ const bf16_t* KS() const { return (const bf16_t*)(ws + WS_KC + 2 * 8 * MiB); }
    __device__ __forceinline__ const bf16_t* VS() const { return (const bf16_t*)(ws + WS_KC + 3 * 8 * MiB); }
    __device__ __forceinline__ const bf16_t* KW() const { return (const bf16_t*)(ws + WS_KC + 4 * 8 * MiB); }
    __device__ __forceinline__ const bf16_t* VW() const { return (const bf16_t*)(ws + WS_KC + 5 * 8 * MiB); }
    __device__ __forceinline__ const bf16_t* KCC() const { return (const bf16_t*)(ws + WS_KCC); }
    __device__ __forceinline__ const bf16_t* VCC() const { return (const bf16_t*)(ws + WS_VCC); }
    __device__ __forceinline__ const bf16_t* GA() const { return (const bf16_t*)(ws + WS_GA); }
    __device__ __forceinline__ const bf16_t* ZA() const { return (const bf16_t*)(ws + WS_ZA); }
    __device__ __forceinline__ bf16_t* A2() const { return (bf16_t*)(ws + WS_A2); } };

__device__ __forceinline__ void nsa_unit(const NsaPtrs& P, int b, int g, int qt, LAS unsigned char* lds
#if DBG
    , unsigned* selout
#endif
    ) {
    int tid = threadIdx.x; asm volatile("" : "+v"(tid));
    const int lane = tid & 63, r32 = lane & 31, hi = lane >> 5; const int wid = __builtin_amdgcn_readfirstlane(tid >> 6);
    const int hh = 4 * g + (wid & 3), th = wid >> 2;
    const int tok = 64 * qt + 32 * th + r32; const size_t mrow = (size_t)b * SEQ + tok;
    bf16x8 qr[4];
#pragma unroll
    for (int d0 = 0; d0 < 4; ++d0) qr[d0] = *(const bf16x8*)(P.QA() + mrow * 1024 + hh * 64 + d0 * 16 + hi * 8);
    const float g0 = bf2f(P.GA()[mrow * 64 + hh * 3 + 0]), g1 = bf2f(P.GA()[mrow * 64 + hh * 3 + 1]), g2 = bf2f(P.GA()[mrow * 64 + hh * 3 + 2]);
    f32x16 otot[2] = {f32x16{}, f32x16{}};
    Tile<64> T; State<64> st;
    LAS float* SC = (LAS float*)(lds + L_SC); LAS unsigned* SELM = (LAS unsigned*)(lds + L_SELM); LAS unsigned* ORM = (LAS unsigned*)(lds + L_ORM);
    {
        const bf16_t* Kc = P.KCC() + (size_t)(b * 4 + g) * 128 * 64; const bf16_t* Vc = P.VCC() + (size_t)(b * 4 + g) * 128 * 64;
        const bool two = qt >= 16;
        tile_load<64>(T, Kc, Vc, 64, wid, lane); tile_store<64>(T, (lds + L_K0), (lds + L_V0), wid, lane);
        if (two) { tile_load<64>(T, Kc + 64 * 64, Vc + 64 * 64, 64, wid, lane); tile_store<64>(T, (lds + L_K1), (lds + L_V1), wid, lane); }
        __syncthreads();
        f32x16 pA0, pA1, pB0, pB1;
        qkt<64>(pA0, pA1, (lds + L_K0), qr, r32, hi);
        const int cmax = (tok - 31) >> 4;
        mask_band(pA0, pA1, cmax - 4 * hi, 0x7fffffffu);
        float mx = rowmax32(pA0, pA1);
        if (two) { qkt<64>(pB0, pB1, (lds + L_K1), qr, r32, hi); mask_band(pB0, pB1, cmax - 64 - 4 * hi, 0x7fffffffu); mx = fmaxf(mx, rowmax32(pB0, pB1)); }
        if (mx == NEGINF) mx = 0.f;
        float s = 0.f;
#pragma unroll
        for (int r = 0; r < 16; ++r) { pA0[r] = __builtin_amdgcn_exp2f(pA0[r] - mx); pA1[r] = __builtin_amdgcn_exp2f(pA1[r] - mx); s += pA0[r] + pA1[r]; }
        if (two) {
#pragma unroll
            for (int r = 0; r < 16; ++r) { pB0[r] = __builtin_amdgcn_exp2f(pB0[r] - mx); pB1[r] = __builtin_amdgcn_exp2f(pB1[r] - mx); s += pB0[r] + pB1[r]; }
        }
        s = xhalf_sum(s);
        const float inv_l = s > 0.f ? 1.f / s : 0.f;
        if (two) {
        LAS float* IA = (LAS float*)(lds + L_IMPA) + ((wid & 3) * 64 + 32 * th + r32) * 33; LAS float* IB = (LAS float*)(lds + L_IMPB) + ((wid & 3) * 64 + 32 * th + r32) * 33;
#define IMP_ONE(PX, Tt, Pp) _Pragma("unroll") for (int u = 0; u < 4; ++u) { const int k = 16 * (Tt) + 8 * (Pp) + 2 * u + hi; const float h3 = 0.5f * PX[4 * u + 3]; \
            IA[k] = ((PX[4 * u] + PX[4 * u + 1]) + (PX[4 * u + 2] + h3)) * inv_l; IB[k] = h3 * inv_l; }
        IMP_ONE(pA0, 0, 0) IMP_ONE(pA1, 0, 1) IMP_ONE(pB0, 1, 0) IMP_ONE(pB1, 1, 1)
#undef IMP_ONE
        }
        { bf16x8 pa[4] = {pack8(pA0, 0), pack8(pA0, 8), pack8(pA1, 0), pack8(pA1, 8)}; pv<64>(otot, (lds + L_V0), pa, lane); }
        if (two) { bf16x8 pa[4] = {pack8(pB0, 0), pack8(pB0, 8), pack8(pB1, 0), pack8(pB1, 8)}; pv<64>(otot, (lds + L_V1), pa, lane); }
        const float w = g0 * inv_l;
#pragma unroll
        for (int i = 0; i < 2; ++i)
#pragma unroll
            for (int r = 0; r < 16; ++r) otot[i][r] *= w;
    }
    if (qt < 16) { __syncthreads(); }
    else { const int tt = tid & 63, jg = tid >> 6;
        if (jg == 0) SELM[tt] = 0u; if (tid == 0) ORM[0] = 0u;
        __syncthreads();
        const LAS float* IA = (const LAS float*)(lds + L_IMPA); const LAS float* IB = (const LAS float*)(lds + L_IMPB);
        const int T_ = 64 * qt + tt;
#pragma unroll
        for (int jj = 0; jj < 4; ++jj) { const int j = 4 * jg + jj; float imp = 0.f;
#pragma unroll
            for (int h = 0; h < 4; ++h) { float v = IA[(h * 64 + tt) * 33 + j]; if (j > 0) v += IB[(h * 64 + tt) * 33 + j - 1]; imp += v; }
            const bool valid = 64 * j <= T_; const bool forced = valid && (j == 0 || j == qt || j == qt - 1);
            SC[tt * 33 + j] = valid ? imp + (forced ? 1.0e4f : 0.f) : -1e30f; }
        __syncthreads();
        unsigned bits = 0u;
        {
            float sj[4]; int rank[4] = {0, 0, 0, 0}; unsigned eq[4] = {0u, 0u, 0u, 0u};
#pragma unroll
            for (int jj = 0; jj < 4; ++jj) sj[jj] = SC[tt * 33 + 4 * jg + jj];
#pragma unroll 1
            for (int kh = 0; kh < 4; ++kh) {
                float sk[8];
#pragma unroll
                for (int k = 0; k < 8; ++k) sk[k] = SC[tt * 33 + 8 * kh + k];
#pragma unroll
                for (int jj = 0; jj < 4; ++jj)
#pragma unroll
                    for (int k = 0; k < 8; ++k) { rank[jj] += (sk[k] > sj[jj]) ? 1 : 0; eq[jj] |= (sk[k] == sj[jj]) ? (1u << (8 * kh + k)) : 0u; }
            }
#pragma unroll
            for (int jj = 0; jj < 4; ++jj) { const int j = 4 * jg + jj; const unsigned lt = (1u << j) - 1u;
                if (rank[jj] + __builtin_popcount(eq[jj] & lt) < 16) bits |= 1u << j; }
        }
        atomicOr((unsigned*)&SELM[tt], bits); atomicOr((unsigned*)&ORM[0], bits);
        __syncthreads();
    }
    const unsigned causal_bits = (qt == 31) ? 0xffffffffu : ((2u << qt) - 1u);
    const unsigned selbits = qt < 16 ? causal_bits : SELM[32 * th + r32];
#if DBG
    if (tid < 64) selout[((size_t)b * SEQ + 64 * qt + tid) * 4 + g] = qt < 16 ? causal_bits : SELM[tid];
#endif
    unsigned need = qt < 16 ? causal_bits : ((unsigned)__builtin_amdgcn_readfirstlane(ORM[0]) & causal_bits);
    {
        struct SelPol { const bf16_t* Kg; const bf16_t* Vg; int pitch; unsigned need, selbits; int qt, tok4;
            __device__ __forceinline__ int first() const { return __builtin_ctz(need); }
            __device__ __forceinline__ int next(int j) const { const unsigned r = j >= 31 ? 0u : (need & ~((2u << j) - 1u)); return r ? __builtin_ctz(r) : -1; }
            __device__ __forceinline__ const bf16_t* kptr(int j) const { return Kg + (size_t)64 * j * 256; }
            __device__ __forceinline__ const bf16_t* vptr(int j) const { return Vg + (size_t)64 * j * 256; }
            __device__ __forceinline__ bool active(int j) const { return __any((selbits >> j) & 1u); }
            __device__ __forceinline__ void prep(int, State<64>&) const {}
            __device__ __forceinline__ void build(State<64>& st) const { st.ci = splat16(-st.m); }
            __device__ __forceinline__ void maskp(int j, bf16x8* pa) const { const unsigned km = ((selbits >> j) & 1u) ? 0xffffffffu : 0u;
#pragma unroll
                for (int k = 0; k < 4; ++k) { u32x4_t w = __builtin_bit_cast(u32x4_t, pa[k]); w &= km; pa[k] = __builtin_bit_cast(bf16x8, w); } }
            __device__ __forceinline__ void maskp1(int j, bf16x8& f) const { const unsigned km = ((selbits >> j) & 1u) ? 0xffffffffu : 0u; u32x4_t w = __builtin_bit_cast(u32x4_t, f); w &= km; f = __builtin_bit_cast(bf16x8, w); }
            __device__ __forceinline__ void postmask(int j, f32x16& p0, f32x16& p1) const { if (j == qt) mask_band(p0, p1, tok4 - 64 * j, 0x7fffffffu); } };
        SelPol pol{P.KS() + (size_t)b * SEQ * 256 + g * 64, P.VS() + (size_t)b * SEQ * 256 + g * 64, 256, need, selbits, qt, tok - 4 * hi};
        state_reset<64>(st);
        run_branch<64, SelPol>(st, pol, qr, lds, wid, lane);
        const float w = g1 / st.ol[0];
#pragma unroll
        for (int i = 0; i < 2; ++i)
#pragma unroll
            for (int r = 0; r < 16; ++r) otot[i][r] += st.o[i][r] * w;
    }
    {
        struct WinPol { const bf16_t* Kg; const bf16_t* Vg; int pitch; int qt, jlo, tok4;
            __device__ __forceinline__ int first() const { return jlo; }
            __device__ __forceinline__ int next(int j) const { return j < qt ? j + 1 : -1; }
            __device__ __forceinline__ const bf16_t* kptr(int j) const { return Kg + (size_t)64 * j * 256; }
            __device__ __forceinline__ const bf16_t* vptr(int j) const { return Vg + (size_t)64 * j * 256; }
            __device__ __forceinline__ bool active(int) const { return true; }
            __device__ __forceinline__ void prep(int, State<64>&) const {}
            __device__ __forceinline__ void build(State<64>& st) const { st.ci = splat16(-st.m); }
            __device__ __forceinline__ void maskp(int, bf16x8*) const {}
            __device__ __forceinline__ void maskp1(int, bf16x8&) const {}
            __device__ __forceinline__ void postmask(int j, f32x16& p0, f32x16& p1) const { if (j == qt || j == qt - 8) mask_band(p0, p1, tok4 - 64 * j, 511u); } };
        WinPol pol{P.KW() + (size_t)b * SEQ * 256 + g * 64, P.VW() + (size_t)b * SEQ * 256 + g * 64, 256, qt, qt >= 8 ? qt - 8 : 0, tok - 4 * hi};
        state_reset<64>(st);
        run_branch<64, WinPol>(st, pol, qr, lds, wid, lane);
        const float w = g2 / st.ol[0];
#pragma unroll
        for (int i = 0; i < 2; ++i)
#pragma unroll
            for (int r = 0; r < 16; ++r) otot[i][r] += st.o[i][r] * w;
    }
    {
        LAS float* stg = (LAS float*)(lds + 65536 + wid * 8192);
#pragma unroll
        for (int db = 0; db < 2; ++db)
#pragma unroll
            for (int u = 0; u < 4; ++u) { const int d = 32 * db + 8 * u + 4 * hi;
                *(LAS f32x4_t*)(stg + r32 * 64 + (d ^ ((r32 & 7) << 3))) = (f32x4_t){otot[db][4 * u], otot[db][4 * u + 1], otot[db][4 * u + 2], otot[db][4 * u + 3]}; }
        asm volatile("s_waitcnt lgkmcnt(0)" ::: "memory");
        const size_t row0 = (size_t)b * SEQ + 64 * qt + 32 * th;
#pragma unroll
        for (int i = 0; i < 4; ++i) { const int row = 8 * i + (lane >> 3), ch = lane & 7, d = 8 * ch;
            const f32x4_t a = *(const LAS f32x4_t*)(stg + row * 64 + (d ^ ((row & 7) << 3))), c = *(const LAS f32x4_t*)(stg + row * 64 + ((d + 4) ^ ((row & 7) << 3)));
            const u32x4_t z = *(const u32x4_t*)(P.ZA() + (row0 + row) * 1024 + hh * 64 + d);
            u32x4_t w; w.x = cvtpk(a[0] * bflo(z.x), a[1] * bfhi(z.x)); w.y = cvtpk(a[2] * bflo(z.y), a[3] * bfhi(z.y)); w.z = cvtpk(c[0] * bflo(z.z), c[1] * bfhi(z.z)); w.w = cvtpk(c[2] * bflo(z.w), c[3] * bfhi(z.w));
            *(u32x4_t*)(P.A2() + (row0 + row) * 2048 + hh * 64 + d) = w; }
    }
}

struct MixPtrs { unsigned char* ws;
    __device__ __forceinline__ const bf16_t* QB() const { return (const bf16_t*)(ws + WS_QB); }
    __device__ __forceinline__ const bf16_t* KB() const { return (const bf16_t*)(ws + WS_KB); }
    __device__ __forceinline__ const bf16_t* VB() const { return (const bf16_t*)(ws + WS_VB); }
    __device__ __forceinline__ const bf16_t* ZB() const { return (const bf16_t*)(ws + WS_ZB); }
    __device__ __forceinline__ bf16_t* A2() const { return (bf16_t*)(ws + WS_A2); } };
__device__ __forceinline__ void mixb_unit(const MixPtrs& P, int b, int h, int a, LAS unsigned char* lds) {
    int tid = threadIdx.x; asm volatile("" : "+v"(tid));
    const int lane = tid & 63, r32 = lane & 31, hi = lane >> 5; const int wid = __builtin_amdgcn_readfirstlane(tid >> 6);
    const int tok = 256 * a + 32 * wid + r32; const size_t mrow = (size_t)b * SEQ + tok;
    bf16x8 qr[8];
#pragma unroll
    for (int d0 = 0; d0 < 8; ++d0) qr[d0] = *(const bf16x8*)(P.QB() + mrow * 1024 + h * 128 + d0 * 16 + hi * 8);
    const int E16 = (tok - 4 * hi) & 15;
    bool is16[8], is4[4];
#pragma unroll
    for (int i = 0; i < 8; ++i) is16[i] = E16 == ((i & 3) + 8 * (i >> 2));
#pragma unroll
    for (int i = 0; i < 4; ++i) is4[i] = (E16 & 3) == i;
    const bf16_t* Kg = P.KB() + (size_t)b * SEQ * 1024 + h * 128; const bf16_t* Vg = P.VB() + (size_t)b * SEQ * 1024 + h * 128;
    State<128> st; state_reset<128>(st);
    struct MixPol { const bf16_t* Kg; const bf16_t* Vg; int pitch; int nt, wlast, wbase, tok4; bool i16[8], i4[4];
        __device__ __forceinline__ int first() const { return 0; }
        __device__ __forceinline__ int next(int j) const { return j + 1 < nt ? j + 1 : -1; }
        __device__ __forceinline__ const bf16_t* kptr(int j) const { return Kg + (size_t)64 * j * 1024; }
        __device__ __forceinline__ const bf16_t* vptr(int j) const { return Vg + (size_t)64 * j * 1024; }
        __device__ __forceinline__ bool active(int j) const { return j <= wlast; }
        __device__ __forceinline__ int cls(int j) const { const int wlo = wbase - 64 * j, dmin = wlo - 63, dmax = wlo + 31;
            return dmin > 512 ? 0 : (dmin > 128 && dmax <= 512) ? 1 : dmin < 0 ? 3 : dmax <= 128 ? 2 : dmax <= 512 ? 4 : 5; }
        __device__ __forceinline__ void build(State<128>& st) const { const int c = st.cls; const float m = st.m;
            if (c == 0) {
#pragma unroll
                for (int r = 0; r < 16; ++r) st.ci[r] = i16[(r & 3) + 4 * ((r >> 2) & 1)] ? -m : NEGINF;
            } else if (c == 1) {
#pragma unroll
                for (int r = 0; r < 16; ++r) st.ci[r] = i4[r & 3] ? (i16[(r & 3) + 4 * ((r >> 2) & 1)] ? 1.f - m : -m) : NEGINF;
            } else if (c == 2 || c == 3) {
#pragma unroll
                for (int r = 0; r < 16; ++r) st.ci[r] = i16[(r & 3) + 4 * ((r >> 2) & 1)] ? 1.5849625007f - m : (i4[r & 3] ? 1.f - m : -m);
            } else st.ci = splat16(-m); }
        __device__ __forceinline__ void prep(int j, State<128>& st) const { const int c = cls(j); if (c != st.cls) { st.cls = c; build(st); } }
        __device__ __forceinline__ void maskp(int, bf16x8*) const {}
        __device__ __forceinline__ void maskp1(int, bf16x8&) const {}
        __device__ __forceinline__ void postmask(int j, f32x16& p0, f32x16& p1) const {
            const int c = cls(j);
            if (c < 3) return;
            const int e = tok4 - 64 * j;
            if (c == 3) { mask_band(p0, p1, e, 0x7fffffffu); return; }
            const int thr = c == 4 ? 128 : 512;
#pragma unroll
            for (int r = 0; r < 16; ++r) { const bool b16 = i16[(r & 3) + 4 * ((r >> 2) & 1)], b4 = i4[r & 3]; const int cc = (r & 3) + 8 * (r >> 2);
                const float vnear = b16 ? 1.5849625007f : (b4 ? 1.f : 0.f), vmid = b4 ? (b16 ? 1.f : 0.f) : NEGINF, vfar = b16 ? 0.f : NEGINF;
                const float lo = c == 4 ? vnear : vmid, hi_ = c == 4 ? vmid : vfar;
                p0[r] += (e - cc <= thr) ? lo : hi_; p1[r] += (e - cc - 32 <= thr) ? lo : hi_; } } };
    MixPol pol{Kg, Vg, 1024, 4 * a + 4, 4 * a + (wid >> 1), 256 * a + 32 * wid, tok - 4 * hi, {is16[0], is16[1], is16[2], is16[3], is16[4], is16[5], is16[6], is16[7]}, {is4[0], is4[1], is4[2], is4[3]}};
    run_branch<128, MixPol>(st, pol, qr, lds, wid, lane);
    const float inv_l = 1.f / st.ol[0];
#pragma unroll
    for (int db = 0; db < 4; ++db)
#pragma unroll
        for (int u = 0; u < 4; ++u) { const int d = 32 * db + 8 * u + 4 * hi;
            const u32x2_t z = *(const u32x2_t*)(P.ZB() + mrow * 1024 + h * 128 + d);
            u32x2_t w; w.x = cvtpk(st.o[db][4 * u] * inv_l * bflo(z.x), st.o[db][4 * u + 1] * inv_l * bfhi(z.x)); w.y = cvtpk(st.o[db][4 * u + 2] * inv_l * bflo(z.y), st.o[db][4 * u + 3] * inv_l * bfhi(z.y));
            *(u32x2_t*)(P.A2() + mrow * 2048 + 1024 + h * 128 + d) = w; }
}
}
typedef GAS unsigned gu32;
#define RLX_AGENT __ATOMIC_RELAXED, __HIP_MEMORY_SCOPE_AGENT
#define LDS_WAIT() asm volatile("s_waitcnt lgkmcnt(0)" ::: "memory")
#define VM_WAIT() asm volatile("s_waitcnt vmcnt(0)" ::: "memory")
#define XB_TMO      128
#define XB_XCNT(j)  (256  + 64 * (j))
#define XB_XSUB(j)  (1280 + 64 * (j))
#define XB_XGEN(j)  (2304 + 64 * (j))
#define XB_TOP      3328
#define XB_TOPGEN   3392
#define XCD_BAR_WORDS 3456
#define XB_SPIN_CAP (1u << 18)
__device__ __forceinline__ unsigned xb_ld(unsigned* p)              { return __hip_atomic_load(p, __ATOMIC_RELAXED, __HIP_MEMORY_SCOPE_AGENT); }
__device__ __forceinline__ unsigned xb_add(unsigned* p, unsigned v) { return __hip_atomic_fetch_add(p, v, __ATOMIC_RELAXED, __HIP_MEMORY_SCOPE_AGENT); }
__device__ __forceinline__ unsigned xb_xcc_id() { return (unsigned)__builtin_amdgcn_s_getreg((3 << 11) | 20) & 0xFu; }
#define XB_SPIN(cond, bar) do { unsigned _sp = 0; while (cond) { __builtin_amdgcn_s_sleep(1); \
    if ((++_sp & 255u) == 0u) { if (xb_ld(&(bar)[XB_TMO])) break; if (_sp > XB_SPIN_CAP) { atomicAdd(&(bar)[XB_TMO], 1u); break; } } } } while (0)
struct XcdBarrier { unsigned* bar; unsigned x; volatile LAS unsigned* st; };
__device__ __forceinline__ XcdBarrier xcd_barrier_post(unsigned* bar, volatile LAS unsigned* st) {
    XcdBarrier b; b.bar = bar; b.x = xb_xcc_id(); b.st = st;
    if (threadIdx.x == 0) (void)xb_add(&bar[XB_XCNT(b.x)], 1u);
    return b;
}
__device__ __forceinline__ void xcd_barrier_complete(unsigned* bar, unsigned x, unsigned& nloc, unsigned& nx) {
    const unsigned G = gridDim.x * gridDim.y * gridDim.z;
    unsigned sum, cnt, mine, sp = 0u;
    for (;;) {
        sum = 0u; cnt = 0u; mine = 0u;
#pragma unroll
        for (unsigned j = 0; j < 16; ++j) { const unsigned c = xb_ld(&bar[XB_XCNT(j)]); sum += c; cnt += (c > 0u) ? 1u : 0u; mine = (j == x) ? c : mine; }
        if (sum == G) break;
        __builtin_amdgcn_s_sleep(1);
        if ((++sp & 255u) == 0u) { if (xb_ld(&bar[XB_TMO])) break; if (sp > XB_SPIN_CAP) { atomicAdd(&bar[XB_TMO], 1u); break; } }
    }
    nloc = mine > 0u ? mine : 1u; nx = cnt > 0u ? cnt : 1u;
}
__device__ __forceinline__ void xcd_barrier(const XcdBarrier& b) {
    asm volatile("s_waitcnt vmcnt(0)" ::: "memory");
    __syncthreads();
    if (threadIdx.x == 0) {
        unsigned* bar = b.bar;
        __builtin_amdgcn_s_waitcnt(0);
        unsigned nloc = b.st[0], nx = b.st[1];
        if (nloc == 0u) { xcd_barrier_complete(bar, b.x, nloc, nx); b.st[0] = nloc; b.st[1] = nx; }
        const unsigned old = xb_add(&bar[XB_XSUB(b.x)], 1u);
        const unsigned gen = old / nloc;
        if (old + 1u == (gen + 1u) * nloc) {
            __builtin_amdgcn_fence(__ATOMIC_RELEASE, "agent");
            asm volatile("s_waitcnt vmcnt(0)" ::: "memory");
            const unsigned og = xb_add(&bar[XB_TOP], 1u);
            const unsigned tg = og / nx;
            if (og + 1u == (tg + 1u) * nx) xb_add(&bar[XB_TOPGEN], 1u);
            else XB_SPIN(xb_ld(&bar[XB_TOPGEN]) == tg, bar);
            __builtin_amdgcn_fence(__ATOMIC_ACQUIRE, "agent");
            xb_add(&bar[XB_XGEN(b.x)], 1u);
            asm volatile("s_waitcnt vmcnt(0)" ::: "memory");
        } else {
            XB_SPIN(xb_ld(&bar[XB_XGEN(b.x)]) == gen, bar);
            __builtin_amdgcn_fence(__ATOMIC_ACQUIRE, "agent");
            asm volatile("s_waitcnt vmcnt(0)" ::: "memory");
        }
    }
    __syncthreads();
}

struct Frame {
    LAS unsigned char* lds; int tid, lane, wave, G, vcu;
    const float *x, *c; const int* pos; const float *w_ada, *b_ada, *g_pre, *g_post, *w_in, *pe_ck, *pe_cv, *w_ck1, *w_ck2, *w_cv1, *w_cv2, *w_br_a, *w_br_b, *w_out;
    unsigned char* ws; unsigned char* dout;
};
__device__ __forceinline__ float wave_sum(float v) {
#pragma unroll
    for (int o = 1; o < 64; o <<= 1) v += __shfl_xor(v, o);
    return v;
}
__device__ __forceinline__ void p0_ada(Frame& F) {
    float* ada = (float*)(F.ws + WS_ADA);
    LAS float* red = (LAS float*)F.lds;
    LAS float* cT = (LAS float*)(F.lds + 69632);
    int tid0 = threadIdx.x; asm volatile("" : "+v"(tid0));
    for (int i = tid0; i < 8 * DM; i += 512) cT[(i & (DM - 1)) * 8 + (i >> 11)] = F.c[i];
    __syncthreads();
    for (int cg = blockIdx.x; cg < 256; cg += F.G) {
        const int tid = tid0, kk = tid / 6, c4 = tid % 6; const bool on = tid < 510;
        f32x4_t acc[8];
#pragma unroll
        for (int b = 0; b < 8; ++b) acc[b] = (f32x4_t){0.f, 0.f, 0.f, 0.f};
        if (on) for (int k0 = kk; k0 < DM; k0 += 85 * 13) {
            f32x4_t w[13];
#pragma unroll
            for (int u = 0; u < 13; ++u) { const int k = k0 + 85 * u; w[u] = k < DM ? *(const f32x4_t*)(F.w_ada + (size_t)k * 6144 + 24 * cg + 4 * c4) : (f32x4_t){0.f, 0.f, 0.f, 0.f}; }
#pragma unroll
            for (int u = 0; u < 13; ++u) { const int k = k0 + 85 * u < DM ? k0 + 85 * u : 0;
                const f32x4_t ca = *(const LAS f32x4_t*)(cT + k * 8), cb = *(const LAS f32x4_t*)(cT + k * 8 + 4);
#pragma unroll
                for (int b = 0; b < 4; ++b) { acc[b] += w[u] * ca[b]; acc[4 + b] += w[u] * cb[b]; } }
        }
        if (on) {
#pragma unroll
            for (int b = 0; b < 8; ++b)
#pragma unroll
                for (int e = 0; e < 4; ++e) red[tid * 33 + b * 4 + e] = acc[b][e];
        }
        __syncthreads();
        if (tid < 192) { const int b = tid / 24, col = tid % 24, cc4 = col >> 2, e = col & 3; float s = 0.f;
            for (int q = 0; q < 85; ++q) s += red[(q * 6 + cc4) * 33 + b * 4 + e];
            ada[b * 6144 + 24 * cg + col] = s + F.b_ada[24 * cg + col]; }
        __syncthreads();
    }
}
template <bool REMAP> __device__ __forceinline__ int dst_row(int n) { if (!REMAP) return n; return n < 2560 ? n : (n < 2608 ? 11776 + (n - 2560) : n - 48); }
template <bool REMAP> __device__ __forceinline__ void p0_transpose_item(const float* W, int K, int N, bf16_t* WT, int ldt, int kofs, LAS float* scr, int item, int lane) {
    const int nblk = (N + 31) / 32, kb = item / nblk, nb = item % nblk, k0 = 64 * kb, n0 = 32 * nb;
    const bool cok = n0 + (lane & 31) < N;
    float tv[32];
#pragma unroll
    for (int i = 0; i < 32; ++i) { const int kk = 2 * i + (lane >> 5); tv[i] = cok ? W[(size_t)(k0 + kk) * N + n0 + (lane & 31)] : 0.f; }
#pragma unroll
    for (int i = 0; i < 32; ++i) { const int kk = 2 * i + (lane >> 5); scr[kk * 33 + (lane & 31)] = tv[i]; }
    LDS_WAIT(); asm volatile("" ::: "memory");
    const int c = lane & 7;
#pragma unroll
    for (int j = 0; j < 4; ++j) { const int n = (lane >> 3) + 8 * j; const LAS float* s = scr + (8 * c) * 33 + n;
        u32x4_t o; o.x = pk2(s[0 * 33], s[1 * 33]); o.y = pk2(s[2 * 33], s[3 * 33]); o.z = pk2(s[4 * 33], s[5 * 33]); o.w = pk2(s[6 * 33], s[7 * 33]);
        if (n0 + n < N) *(GAS u32x4_t*)(WT + (size_t)dst_row<REMAP>(n0 + n) * ldt + kofs + k0 + 8 * c) = o; }
    LDS_WAIT(); asm volatile("" ::: "memory");
}
__device__ __forceinline__ void p0_items(Frame& F) {
    LAS float* scr = (LAS float*)(F.lds + 68 * 1024 + F.wave * 8704);
    int tid_ = threadIdx.x; asm volatile("" : "+v"(tid_)); const int lane = tid_ & 63;
    const int gw = F.vcu * 8 + F.wave, NGW = F.G * 8;
    bf16_t* WinT = (bf16_t*)(F.ws + WS_WINT); bf16_t* WbrT = (bf16_t*)(F.ws + WS_WBRT); bf16_t* WoutT = (bf16_t*)(F.ws + WS_WOUTT);
    bf16_t* W1T = (bf16_t*)(F.ws + WS_W1T); bf16_t* W2T = (bf16_t*)(F.ws + WS_W2T);
    constexpr int I_IN = 32 * 370, I_BR = 16 * 64, I_OUT = 32 * 64, I_C1 = 32 * 8, I_C2 = 4 * 2;
    constexpr int I_ROPE = MTOK / 64, I_B1 = 128, I_Z = 13;
    constexpr int NITEMS = I_IN + 2 * I_BR + I_OUT + 2 * I_C1 + 2 * I_C2 + I_ROPE + I_B1 + I_Z;
    for (int it = gw; it < NITEMS; it += NGW) {
        int r = it;
        if (r < I_IN) { p0_transpose_item<true>(F.w_in, 2048, NIN, WinT, 2048, 0, scr, r, lane); continue; } r -= I_IN;
        if (r < I_BR) { p0_transpose_item<false>(F.w_br_a, 1024, 2048, WbrT, 2048, 0, scr, r, lane); continue; } r -= I_BR;
        if (r < I_BR) { p0_transpose_item<false>(F.w_br_b, 1024, 2048, WbrT, 2048, 1024, scr, r, lane); continue; } r -= I_BR;
        if (r < I_OUT) { p0_transpose_item<false>(F.w_out, 2048, 2048, WoutT, 2048, 0, scr, r, lane); continue; } r -= I_OUT;
        if (r < I_C1) { p0_transpose_item<false>(F.w_ck1, 2048, 256, W1T, 2048, 0, scr, r, lane); continue; } r -= I_C1;
        if (r < I_C1) { p0_transpose_item<false>(F.w_cv1, 2048, 256, W1T + 256 * 2048, 2048, 0, scr, r, lane); continue; } r -= I_C1;
        if (r < I_C2) { p0_transpose_item<false>(F.w_ck2, 256, 64, W2T, 256, 0, scr, r, lane); continue; } r -= I_C2;
        if (r < I_C2) { p0_transpose_item<false>(F.w_cv2, 256, 64, W2T + 64 * 256, 256, 0, scr, r, lane); continue; } r -= I_C2;
        if (r < I_ROPE) {
            const int m = r * 64 + lane; const float pf = (float)F.pos[m];
            const float myinv = (lane < 8) ? (float)pow(500000.0, -(double)(2 * lane) / 16.0) : (float)pow(500000.0, -(double)(2 * ((lane - 8) & 15)) / 32.0);
            float* t64 = (float*)(F.ws + WS_R64) + (size_t)m * 16; float* t128 = (float*)(F.ws + WS_R128) + (size_t)m * 32;
            for (int i = 0; i < 8; ++i) { const float inv = __shfl(myinv, i); const float ang = pf * inv; t64[i] = cosf(ang); t64[8 + i] = sinf(ang); }
            for (int i = 0; i < 16; ++i) { const float inv = __shfl(myinv, 8 + i); const float ang = pf * inv; t128[i] = cosf(ang); t128[16 + i] = sinf(ang); }
            continue; } r -= I_ROPE;
        if (r < I_B1) {
            const int kc = r & 15, cg = (r >> 4) & 3, kv = r >> 6, n = cg * 64 + lane; const float* pe = kv ? F.pe_cv : F.pe_ck; const float* w1 = kv ? F.w_cv1 : F.w_ck1; float s = 0.f;
#pragma unroll 16
            for (int k = 128 * kc; k < 128 * kc + 128; ++k) s += pe[k] * w1[(size_t)k * 256 + n];
            ((float*)(F.ws + WS_BIAS1))[(kc * 2 + kv) * 256 + n] = s; continue; } r -= I_B1;
        {
            for (int q = lane; q < 16 * 256; q += 64) *(GAS u32x4_t*)(WinT + (size_t)(11824 + r * 16) * 2048 + q * 8) = (u32x4_t){0u, 0u, 0u, 0u};
        }
    }
}
__device__ __forceinline__ void p0_xn(Frame& F) {
    int tid_ = threadIdx.x; asm volatile("" : "+v"(tid_)); const int lane = tid_ & 63;
    const int gw = F.vcu * 8 + F.wave, NGW = F.G * 8;
    const float* ada = (const float*)(F.ws + WS_ADA); bf16_t* XN = (bf16_t*)(F.ws + WS_XN);
    for (int m = gw; m < MTOK; m += NGW) {
        const int b = m >> 11; const f32x4_t* xr = (const f32x4_t*)(F.x + (size_t)m * DM) + lane;
        f32x4_t v[8]; float s = 0.f;
#pragma unroll
        for (int j = 0; j < 8; ++j) { v[j] = xr[64 * j]; s += (v[j][0] * v[j][0] + v[j][1] * v[j][1]) + (v[j][2] * v[j][2] + v[j][3] * v[j][3]); }
        const float rstd = rsqrtf(wave_sum(s) * (1.f / DM) + 1e-6f);
        u32x2_t* o8 = (u32x2_t*)(XN + (size_t)m * DM) + lane;
#pragma unroll
        for (int j = 0; j < 8; ++j) { const int k = 256 * j + 4 * lane;
            const f32x4_t g = *(const f32x4_t*)(F.g_pre + k), sc = *(const f32x4_t*)(ada + b * 6144 + 2048 + k), sh = *(const f32x4_t*)(ada + b * 6144 + k);
            const f32x4_t y = (v[j] * rstd * g) * (sc + 1.f) + sh;
            u32x2_t w; w.x = pk2(y[0], y[1]); w.y = pk2(y[2], y[3]); o8[64 * j] = w; }
    }
}
typedef short cbf16x8 __attribute__((ext_vector_type(8)));
typedef float cf32x16 __attribute__((ext_vector_type(16)));
__device__ __forceinline__ void compress_unit(Frame& F, int unit) {
    const int kv = unit >> 5, b = (unit >> 2) & 7, g = unit & 3;
    int tid = threadIdx.x; asm volatile("" : "+v"(tid));
    const int lane = tid & 63, r32 = lane & 31, hi = lane >> 5, wid = F.wave;
    const bf16_t* src = (const bf16_t*)(F.ws + WS_KC + (size_t)kv * 8 * MiB) + (size_t)b * SEQ * 256 + g * 64;
    const bf16_t* W1T = (const bf16_t*)(F.ws + WS_W1T) + (size_t)kv * 256 * 2048;
    const bf16_t* W2T = (const bf16_t*)(F.ws + WS_W2T) + (size_t)kv * 64 * 256;
    const float* bias1p = (const float*)(F.ws + WS_BIAS1) + kv * 256;
    bf16_t* dst = (bf16_t*)(F.ws + (kv ? WS_VCC : WS_KCC)) + (size_t)(b * 4 + g) * 128 * 64;
    LAS bf16_t* HID = (LAS bf16_t*)F.lds;
    constexpr int WSLOT = 32768, AOFF = 3 * WSLOT, ASLOT = 8 * 129 * 16;
    const unsigned lds0 = (unsigned)(size_t)F.lds;
    const bf16_t* wp = W1T + (size_t)(tid & 255) * 2048 + (tid >> 8) * 8;
    auto dma_w = [&](int l, int slot) {
#pragma unroll
        for (int j = 0; j < 4; ++j) att::glds16(wp + l * 64 + j * 16, (unsigned)__builtin_amdgcn_readfirstlane(lds0 + slot * WSLOT + (j * 512 + wid * 64) * 16)); };
    auto dma_a = [&](int l, int slot) {
#pragma unroll
        for (int j = 0; j < 2; ++j) { const int p = j * 512 + tid, kc = p >> 7, row = p & 127;
            att::glds16(src + (size_t)(16 * row + l) * 256 + kc * 8, (unsigned)__builtin_amdgcn_readfirstlane(lds0 + AOFF + slot * ASLOT + ((j * 4 + (wid >> 1)) * 129 + (wid & 1) * 64) * 16)); } };
    cf32x16 acc[4] = {cf32x16{}, cf32x16{}, cf32x16{}, cf32x16{}};
    dma_a(0, 0); dma_w(0, 0); dma_w(16, 1); att::wait_vm_bar<4>();
    int sc = 0;
#pragma unroll 1
    for (int it = 0; it < 16; ++it) {
#pragma unroll
        for (int hf = 0; hf < 2; ++hf) {
            const int s2 = sc == 0 ? 2 : sc - 1;
            if (hf == 0) { if (it + 1 < 16) { dma_a(it + 1, (it + 1) & 1); dma_w(it + 1, s2); } }
            else if (it + 1 < 16) dma_w(it + 17, s2);
            const LAS unsigned char* ab = F.lds + AOFF + (it & 1) * ASLOT + hi * (129 * 16) + (r32 + hf) * 16;
            const LAS unsigned char* wb = F.lds + sc * WSLOT + hi * 4096 + (32 * wid + r32) * 16;
#pragma unroll
            for (int ks = 0; ks < 4; ++ks) { const cbf16x8 bq = *(const LAS cbf16x8*)(wb + ks * 8192);
#pragma unroll
                for (int rq = 0; rq < 4; ++rq) { const cbf16x8 af = *(const LAS cbf16x8*)(ab + ks * (2 * 129 * 16) + rq * 512);
                    acc[rq] = __builtin_amdgcn_mfma_f32_32x32x16_bf16(af, bq, acc[rq], 0, 0, 0); } }
            if (it + 1 < 16) { if (hf == 0) att::wait_vm_bar<6>(); else att::wait_vm_bar<4>(); } else att::wait_vm_bar<0>();
            sc = sc == 2 ? 0 : sc + 1;
        }
    }
    {
        const int n = 32 * wid + r32; float bb = 0.f;
#pragma unroll
        for (int q = 0; q < 16; ++q) bb += bias1p[q * 512 + n];
#pragma unroll
        for (int rq = 0; rq < 4; ++rq)
#pragma unroll
            for (int r = 0; r < 16; ++r) { const float xv = acc[rq][r] + bb;
                const float u = 0.7978845608028654f * (xv + 0.044715f * xv * xv * xv);
                const float th = 1.f - 2.f * __builtin_amdgcn_rcpf(1.f + __builtin_amdgcn_exp2f(2.f * LOG2E * u));
                const float gl = 0.5f * xv * (1.f + th);
                HID[(32 * rq + (r & 3) + 8 * (r >> 2) + 4 * hi) * 264 + n] = (bf16_t)f2bf(gl); }
    }
    __syncthreads();
    {
        const int mi = wid >> 1, nd = wid & 1;
        cf32x16 o = cf32x16{};
#pragma unroll
        for (int ks = 0; ks < 16; ++ks) {
            const cbf16x8 a = *(const LAS cbf16x8*)(HID + (32 * mi + r32) * 264 + 16 * ks + 8 * hi);
            const cbf16x8 bq = *(const cbf16x8*)(W2T + (size_t)(32 * nd + r32) * 256 + 16 * ks + 8 * hi);
            o = __builtin_amdgcn_mfma_f32_32x32x16_bf16(a, bq, o, 0, 0, 0);
        }
        const int d = 32 * nd + r32;
#pragma unroll
        for (int r = 0; r < 16; ++r) { const int c = 32 * mi + (r & 3) + 8 * (r >> 2) + 4 * hi; float v = o[r];
            if (kv == 0 && nd == 0) {
                int trow = 16 * c + 31; trow = trow > 2047 ? 2047 : trow;
                const float* tb = (const float*)(F.ws + WS_R64) + ((size_t)b * SEQ + trow) * 16;
                const float pr = __shfl_xor(v, 8); const float cs = tb[r32 & 7], sn = tb[8 + (r32 & 7)];
                const float rot = v * cs + (r32 < 8 ? -pr : pr) * sn;
                v = r32 < 16 ? rot : v; }
            dst[(size_t)c * 64 + d] = (c == 127) ? (bf16_t)0 : (bf16_t)f2bf(v); }
    }
    __syncthreads();
}
__device__ __forceinline__ void p6_final(Frame& F) {
    int tid_ = threadIdx.x; asm volatile("" : "+v"(tid_)); const int lane = tid_ & 63;
    const int gw = F.vcu * 8 + F.wave, NGW = F.G * 8;
    const float* ada = (const float*)(F.ws + WS_ADA); const float* ssq = (const float*)(F.ws + WS_SSQ); float* out = (float*)F.dout; const bf16_t* pre = (const bf16_t*)(F.ws + WS_XN);
    for (int m = gw; m < MTOK; m += NGW) {
        const int b = m >> 11; float s = 0.f;
        for (int q = 0; q < 32; ++q) s += ssq[(size_t)m * 32 + q];
        const float rstd = rsqrtf(s * (1.f / DM) + 1e-6f);
        const f32x4_t* xr = (const f32x4_t*)(F.x + (size_t)m * DM) + lane; f32x4_t* orow = (f32x4_t*)(out + (size_t)m * DM) + lane; const u32x2_t* pr = (const u32x2_t*)(pre + (size_t)m * DM) + lane;
        f32x4_t xv[8]; u32x2_t pv[8];
#pragma unroll
        for (int j = 0; j < 8; ++j) { xv[j] = xr[64 * j]; pv[j] = pr[64 * j]; }
#pragma unroll
        for (int j = 0; j < 8; ++j) { const int k = 256 * j + 4 * lane;
            const f32x4_t gp = *(const f32x4_t*)(F.g_post + k), gt = *(const f32x4_t*)(ada + b * 6144 + 4096 + k);
            const f32x4_t o = {bflo(pv[j].x), bfhi(pv[j].x), bflo(pv[j].y), bfhi(pv[j].y)};
            orow[64 * j] = xv[j] + gt * (o * rstd * gp); }
    }
}
constexpr int LDS_BYTES = 147456;
constexpr int LDSCTL_OFF = 143360;
constexpr int CW_BAR = 4096, CW_PANEL = 16384, CW_CMP = 32768, CW_NSAQ = 33792, CW_G1A = 35008, CW_G1B = 35040, CW_MIXQ = 36864;
constexpr int NPHASE = 8;
#ifndef REP_MIXU
#define REP_MIXU 0
#endif
#ifndef REP_UNIT_N
#define REP_UNIT_N 0
#define REP_UNIT_I 0
#define REP_PMODE 0
#endif
#ifndef PROBE_NOREMAP
#define PROBE_NOREMAP 0
#endif
struct Args { const void* in[17]; float* out; unsigned char* ws; int ph_lo, ph_hi; };

__device__ __forceinline__ void touch_lines(const unsigned char* base, size_t row_pitch_bytes, int nrows, int lines_per_row, int tid) {
    const int n = nrows * lines_per_row;
    for (int i = tid; i < n; i += 512) { const unsigned char* p = base + (size_t)(i / lines_per_row) * row_pitch_bytes + (size_t)(i % lines_per_row) * 128; unsigned t;
        asm volatile("global_load_dword %0, %1, off" : "=v"(t) : "v"(p) : "memory"); }
    asm volatile("s_waitcnt vmcnt(0)" ::: "memory");
}
__global__ void __launch_bounds__(512, 2) mk_fwd(Args args) {
    extern __shared__ __attribute__((aligned(16))) unsigned char lds_raw[];
    Frame F;
    F.lds = (LAS unsigned char*)lds_raw;
    F.tid = threadIdx.x; F.lane = F.tid & 63; F.wave = __builtin_amdgcn_readfirstlane(F.tid >> 6);
    F.G = gridDim.x; { const int bx = blockIdx.x; F.vcu = (F.G % 8 == 0) ? (bx % 8) * (F.G / 8) + bx / 8 : bx; }
    F.x = (const float*)args.in[0]; F.c = (const float*)args.in[1]; F.pos = (const int*)args.in[2]; F.w_ada = (const float*)args.in[3]; F.b_ada = (const float*)args.in[4];
    F.g_pre = (const float*)args.in[5]; F.g_post = (const float*)args.in[6]; F.w_in = (const float*)args.in[7]; F.pe_ck = (const float*)args.in[8]; F.pe_cv = (const float*)args.in[9];
    F.w_ck1 = (const float*)args.in[10]; F.w_ck2 = (const float*)args.in[11]; F.w_cv1 = (const float*)args.in[12]; F.w_cv2 = (const float*)args.in[13];
    F.w_br_a = (const float*)args.in[14]; F.w_br_b = (const float*)args.in[15]; F.w_out = (const float*)args.in[16];
    F.ws = args.ws; F.dout = (unsigned char*)args.out;
    unsigned char* ws = args.ws;
    { int t0 = threadIdx.x; asm volatile("" : "+v"(t0));
      for (int u = t0; u < (LDS_BYTES - LDSCTL_OFF) / 4; u += 512) ((LAS unsigned*)(F.lds + LDSCTL_OFF))[u] = 0u; }
    __syncthreads();
    const int lo = args.ph_lo, hi = args.ph_hi;
#if STAMP
    unsigned long long ts_[10]; int nts_ = 0;
#define TS() do { ts_[nts_ < 9 ? nts_ : 9] = __builtin_amdgcn_s_memrealtime(); ++nts_; } while (0)
    TS();
#else
#define TS() do {} while (0)
#endif
    const bool multi = (hi - lo) > 1;
    XcdBarrier bar; bar.bar = (unsigned*)(ws + WS_CTL) + CW_BAR; bar.x = 0; bar.st = nullptr;
    if (multi) bar = xcd_barrier_post((unsigned*)(ws + WS_CTL) + CW_BAR, (volatile LAS unsigned*)(F.lds + LDSCTL_OFF + 32));
#ifndef PH_MASK
#define PH_MASK 0xff
#endif
#define IN(k) (((PH_MASK >> (k)) & 1) && lo <= (k) && (k) < hi)
#ifndef REP_MASK
#define REP_MASK 0
#endif
#define REPS(k) for (int rep_ = 0; rep_ < 1 + ((REP_MASK >> (k)) & 1); ++rep_)
#define SEAM(k) do { if (IN(k) && IN((k) + 1)) xcd_barrier(bar); } while (0)

    if (IN(0)) REPS(0) { p0_ada(F); }
    SEAM(0); TS();
    if (IN(1)) REPS(1) { p0_xn(F); p0_items(F); }
    SEAM(1); TS();
    if (IN(2)) REPS(2) {
        const int bx = (int)blockIdx.x, cs = (F.G == 256 && !PROBE_NOREMAP) ? (bx & 7) + 8 * ((((bx >> 3) & 7) << 2) + (bx >> 6)) : bx;
        pg8::Gemm g{(const bf16_t*)(ws + WS_XN), (const bf16_t*)(ws + WS_WINT), MTOK, NINP, 2048}; pg8::ProjOrder S; S.init(MTOK, NINP, F.G, cs);
        pg8::EpiProj E{ws, F.dout, (const float*)(ws + WS_R64), (const float*)(ws + WS_R128)};
        const int nf = S.count_first();
#pragma unroll 1
        for (int part = 0; part < 2; ++part) {
            S.i0 = part ? nf : 0; S.i1 = part ? (1 << 30) : nf;
            pg8::gemm_phase<pg8::EpiProj, pg8::ProjOrder, true, true>(F.lds, g, S, E);
            if (part == 0) { asm volatile("s_waitcnt vmcnt(0)" ::: "memory"); __syncthreads();
                if (threadIdx.x == 0) { __builtin_amdgcn_fence(__ATOMIC_RELEASE, "agent"); (void)xb_add((unsigned*)(ws + WS_CTL) + CW_G1A, (unsigned)nf); __builtin_amdgcn_s_waitcnt(0); } }
        }
        asm volatile("s_waitcnt vmcnt(0)" ::: "memory"); __syncthreads();
        if (threadIdx.x == 0) { __builtin_amdgcn_fence(__ATOMIC_RELEASE, "agent"); (void)xb_add((unsigned*)(ws + WS_CTL) + CW_G1B, 1u); __builtin_amdgcn_s_waitcnt(0); }
    }
#ifdef KEEP_SEAM2
    SEAM(2);
#endif
    TS();
    if (IN(3)) REPS(3) {
        att::MixPtrs MP{ws};
        if (threadIdx.x == 0) { unsigned* cw = (unsigned*)(ws + WS_CTL) + CW_G1A; while (xb_ld(cw) < (unsigned)(pg8::ProjOrder::NFIRST * (MTOK / 256))) __builtin_amdgcn_s_sleep(8);
            __builtin_amdgcn_fence(__ATOMIC_ACQUIRE, "agent"); }
        __syncthreads();
        for (int v = F.vcu; v < 256; v += F.G) {
            const int j = v & 7, bh = 2 * (v >> 3) + (j & 1), b_ = bh >> 3, h_ = bh & 7;
#ifdef USE_WARM
            { const size_t off = ((size_t)b_ * SEQ + 512 * (j >> 1)) * 2048 + h_ * 256;
              touch_lines(ws + WS_KB + off, 2048, 512, 2, F.tid); touch_lines(ws + WS_VB + off, 2048, 512, 2, F.tid); }
#endif
#ifndef REP_CMP
#define REP_CMP 0
#endif
            if (j < 2) { compress_unit(F, (v >> 3) * 2 + j);
                asm volatile("s_waitcnt vmcnt(0)" ::: "memory"); __syncthreads();
                if (threadIdx.x == 0) { __builtin_amdgcn_fence(__ATOMIC_RELEASE, "agent"); (void)xb_add((unsigned*)(ws + WS_CTL) + CW_CMP, 1u); } }
#ifndef NO_MIX
#ifdef MIX_QUEUE
            {
                unsigned* qc = (unsigned*)(ws + WS_CTL) + CW_MIXQ + 32 * (v >> 3); volatile LAS unsigned* qn = (volatile LAS unsigned*)(F.lds + LDSCTL_OFF + 80);
                if (threadIdx.x == 0) qn[0] = xb_add(qc, 1u);
                __syncthreads();
                unsigned k = qn[0];
#pragma unroll 1
                for (int par = 1; k < 16u; par ^= 1) {
                    if (threadIdx.x == 0) qn[par] = xb_add(qc, 1u);
                    const int bh2 = 2 * (v >> 3) + (int)(k & 1u);
                    att::mixb_unit(MP, bh2 >> 3, bh2 & 7, 7 - (int)(k >> 1), F.lds);
                    __syncthreads();
                    k = qn[par];
                }
            }
#else
            const int alist = j < 2 ? 0x4 : j < 4 ? 0x16 : j < 6 ? 0x25 : 0x037, na = j < 2 ? 1 : j < 6 ? 2 : 3;
#pragma unroll 1
            for (int i = 0; i < na + REP_MIXU; ++i) att::mixb_unit(MP, b_, h_, i < na ? ((alist >> (4 * i)) & 15) : 0, F.lds);
#endif
#endif
        }
    }
    TS();
    if (IN(4)) REPS(4) {
        att::NsaPtrs NP{ws};
        asm volatile("s_waitcnt vmcnt(0)" ::: "memory");
        if (threadIdx.x == 0) { unsigned* cw = (unsigned*)(ws + WS_CTL) + CW_CMP; while (xb_ld(cw) < 64u) __builtin_amdgcn_s_sleep(8);
            cw = (unsigned*)(ws + WS_CTL) + CW_G1B; while (xb_ld(cw) < (unsigned)F.G) __builtin_amdgcn_s_sleep(8);
            __builtin_amdgcn_fence(__ATOMIC_ACQUIRE, "agent"); }
        __syncthreads();
        for (int v = F.vcu; v < 256; v += F.G) {
#ifdef USE_WARM
            { const int bg = v >> 3, s = v & 7; const size_t off = ((size_t)(bg >> 2) * SEQ + 256 * s) * 512 + (bg & 3) * 128;
#pragma unroll 1
              for (int t = 2; t < 6; ++t) touch_lines(ws + WS_KC + (size_t)t * 8 * MiB + off, 512, 256, 1, F.tid); }
#endif
#ifndef NO_NSA
#ifdef NSA_QUEUE
            {
                const int bg = v >> 3; unsigned* qc = (unsigned*)(ws + WS_CTL) + CW_NSAQ + 32 * bg; volatile LAS unsigned* qn = (volatile LAS unsigned*)(F.lds + LDSCTL_OFF + 64);
                if (threadIdx.x == 0) qn[0] = xb_add(qc, 1u);
                __syncthreads();
                unsigned k = qn[0];
#pragma unroll 1
                for (int par = 1; k < 32u; par ^= 1) {
                    if (threadIdx.x == 0) qn[par] = xb_add(qc, 1u);
                    att::nsa_unit(NP, bg >> 2, bg & 3, 31 - (int)k, F.lds
#if DBG
                        , (unsigned*)(ws + WS_DBG + 101 * MiB)
#endif
                        );
                    __syncthreads();
                    k = qn[par];
                }
            }
#else
            { const int bg = v >> 3, s = v & 7;
#pragma unroll 1
              for (int i_ = 0; i_ < 4 + REP_UNIT_N; ++i_) { const int i = i_ < 4 ? i_ : REP_UNIT_I; const unsigned long long qtab = (i == 0) ? 0xcdb9beffdaull : (i == 1) ? 0xbd2b09ca38ull : (i == 2) ? 0x4ad4c6b90full : 0x21c66104a0ull;
                  const int qt = (int)((qtab >> (5 * s)) & 31ull); att::nsa_unit(NP, bg >> 2, bg & 3, qt, F.lds
#if DBG
                  , (unsigned*)(ws + WS_DBG + 101 * MiB)
#endif
                  ); } }
#endif
#endif
        }
    }
    SEAM(4); TS();
    if (IN(5)) REPS(5) {
        pg8::Gemm g{(const bf16_t*)(ws + WS_A2), (const bf16_t*)(ws + WS_WBRT), MTOK, 2048, 2048}; pg8::StaticOrder S; S.init(MTOK, 2048, F.G, (int)blockIdx.x);
        pg8::EpiMerge E{(const bf16_t*)(F.dout + DO_MA), (const bf16_t*)(F.dout + DO_MB), (bf16_t*)(ws + WS_MERGED)};
        pg8::gemm_phase<pg8::EpiMerge, pg8::StaticOrder, true, true>(F.lds, g, S, E);
    }
    SEAM(5); TS();
    if (IN(6)) REPS(6) {
        pg8::Gemm g{(const bf16_t*)(ws + WS_MERGED), (const bf16_t*)(ws + WS_WOUTT), MTOK, 2048, 2048}; pg8::StaticOrder S; S.init(MTOK, 2048, F.G, (int)blockIdx.x);
#ifndef FUSE_FINAL
        pg8::EpiOutB E{(bf16_t*)(ws + WS_XN), (float*)(ws + WS_SSQ)};
        pg8::gemm_phase<pg8::EpiOutB, pg8::StaticOrder, true, true>(F.lds, g, S, E);
#else
        pg8::EpiFinal E{F.x, (float*)F.dout, (float*)(ws + WS_SSQ), (unsigned*)(ws + WS_CTL) + CW_PANEL, (const float*)(ws + WS_ADA), F.g_post};
        pg8::PanelOrder PO; PO.init(MTOK, 2048, F.G, F.vcu);
        if ((F.G & 7) == 0) pg8::gemm_phase<pg8::EpiFinal, pg8::PanelOrder, true, true>(F.lds, g, PO, E);
#endif
    }
#ifndef FUSE_FINAL
    SEAM(6);
#endif
    TS();
#ifndef FUSE_FINAL
    if (IN(7)) { p6_final(F); }
#endif
    TS();
#if STAMP
    if (F.vcu == 0 && F.tid == 0) { VM_WAIT(); args.out[0] = (float)(ts_[STAMP_B] - ts_[STAMP_A]); }
#endif
#undef IN
#undef SEAM
}

#if DBG
namespace dbg {
constexpr int BD = DBG_BATCH;
constexpr size_t E_PROJ = 0, E_KC = 48 * MiB, E_VC = 48 * MiB + 256 * 1024, E_SEL = 48 * MiB + 512 * 1024, E_AA = 50 * MiB, E_AB = 58 * MiB, E_MG = 66 * MiB, E_OF = 82 * MiB, E_ADA = 98 * MiB, DIAG = 100 * MiB, SELOUT = 101 * MiB;
__global__ void k_f2b(const float* __restrict__ s, bf16_t* __restrict__ d, size_t n) { for (size_t i = (size_t)blockIdx.x * 256 + threadIdx.x; i < n; i += (size_t)gridDim.x * 256) d[i] = (bf16_t)f2bf(s[i]); }
__global__ void k_copy(const float* __restrict__ s, float* __restrict__ d, size_t n) { for (size_t i = (size_t)blockIdx.x * 256 + threadIdx.x; i < n; i += (size_t)gridDim.x * 256) d[i] = s[i]; }
template <class T> __device__ __forceinline__ float tof(T v);
template <> __device__ __forceinline__ float tof<float>(float v) { return v; }
template <> __device__ __forceinline__ float tof<bf16_t>(bf16_t v) { return bf2f(v); }
template <class FT, class ET, int XF> __global__ void k_cmp(const FT* __restrict__ f, int ldf, const ET* __restrict__ e, int lde, int rows, int cols, float fscale, float* __restrict__ acc) {
    __shared__ float sh[8];
    float num = 0.f, den = 0.f;
    for (size_t i = (size_t)blockIdx.x * 256 + threadIdx.x; i < (size_t)rows * cols; i += (size_t)gridDim.x * 256) { const int r = (int)(i / cols), c = (int)(i % cols);
        const float vf = tof<FT>(f[(size_t)r * ldf + c]) * fscale; float ve = tof<ET>(e[(size_t)r * lde + c]);
        if (XF == 1) ve = ve / (1.f + expf(-ve)); if (XF == 2) ve = 1.f / (1.f + expf(-ve));
        num += (vf - ve) * (vf - ve); den += ve * ve; }
    for (int o = 32; o > 0; o >>= 1) { num += __shfl_xor(num, o); den += __shfl_xor(den, o); }
    if ((threadIdx.x & 63) == 0) { sh[threadIdx.x >> 6] = num; sh[4 + (threadIdx.x >> 6)] = den; }
    __syncthreads();
    if (threadIdx.x == 0) { atomicAdd(acc, sh[0] + sh[1] + sh[2] + sh[3]); atomicAdd(acc + 1, sh[4] + sh[5] + sh[6] + sh[7]); }
}
__global__ void k_cmp_sel(const unsigned* __restrict__ f, const unsigned* __restrict__ e, float* __restrict__ acc) {
    const int idx = blockIdx.x * 256 + threadIdx.x; if (idx >= 2048 * 4) return; const int s = idx >> 2;
    const unsigned valid = (s >> 6) == 31 ? 0xffffffffu : ((2u << (s >> 6)) - 1u);
    const bool bad = ((f[idx] ^ e[idx]) & valid) != 0u;
    atomicAdd(acc, bad ? 1.f : 0.f); if (threadIdx.x == 0 && blockIdx.x == 0) atomicAdd(acc + 1, 8192.f);
}
constexpr int NCHK = 24;
__global__ void k_report(const float* __restrict__ diag, float* __restrict__ out, int sel) {
    if (threadIdx.x != 0) return;
    if (sel == 0) { for (int k = 1; k < NCHK; ++k) { const float num = diag[2 * k], den = diag[2 * k + 1]; if (den == 0.f) continue;
            const float err = (k == 19) ? num / den : sqrtf(num / den);
            const float tol = k == 1 ? 1e-4f : (k == 17 || k == 18 || k == 21) ? 3e-2f : k == 19 ? 0.12f : (k == 20 || k == 22 || k == 23) ? 0.1f : 2e-2f;
            if (!(err <= tol)) { out[0] = (float)k * 1.0e4f; return; } }
        out[0] = 7.7e7f; }
    else { const float num = diag[2 * sel], den = diag[2 * sel + 1]; const float err = (sel == 19) ? num / den : sqrtf(num / den); out[0] = err * 1.0e6f; }
}
}
#endif

extern "C" void kernel_launch(void* const* d_in, const int* in_sizes, int n_in, void* d_out, int out_size, void* d_ws, size_t ws_size, hipStream_t stream) {
    static int grid = 0;
    if (grid == 0) {
        int dev = 0, cus = 0;
        if (hipGetDevice(&dev) != hipSuccess || hipDeviceGetAttribute(&cus, hipDeviceAttributeMultiprocessorCount, dev) != hipSuccess) { fprintf(stderr, "kernel_launch: device query failed\n"); grid = -1; return; }
        if (hipFuncSetAttribute((const void*)mk_fwd, hipFuncAttributeMaxDynamicSharedMemorySize, LDS_BYTES) != hipSuccess) { fprintf(stderr, "kernel_launch: hipFuncSetAttribute failed\n"); grid = -1; return; }
        int per_cu = 0;
        if (hipOccupancyMaxActiveBlocksPerMultiprocessor(&per_cu, (const void*)mk_fwd, 512, LDS_BYTES) != hipSuccess || per_cu < 1) fprintf(stderr, "kernel_launch: occupancy query reports %d\n", per_cu);
        (void)hipGetLastError();
        grid = cus;
    }
    if (grid < 0) return;
    if (ws_size < WS_END) { fprintf(stderr, "kernel_launch: workspace too small (%zu < %zu bytes)\n", ws_size, (size_t)WS_END); return; }
    unsigned char* ws = (unsigned char*)d_ws;
#if DBG
    {
        ref::In I;
        I.x = (const float*)d_in[0]; I.c = (const float*)d_in[1]; I.pos = (const int*)d_in[2]; I.w_ada = (const float*)d_in[3]; I.b_ada = (const float*)d_in[4];
        I.g_pre = (const float*)d_in[5]; I.g_post = (const float*)d_in[6]; I.w_in = (const float*)d_in[7]; I.pe_ck = (const float*)d_in[8]; I.pe_cv = (const float*)d_in[9];
        I.w_ck1 = (const float*)d_in[10]; I.w_ck2 = (const float*)d_in[11]; I.w_cv1 = (const float*)d_in[12]; I.w_cv2 = (const float*)d_in[13];
        I.w_br_a = (const float*)d_in[14]; I.w_br_b = (const float*)d_in[15]; I.w_out = (const float*)d_in[16];
        ref::Bufs B = ref::carve((char*)d_ws);
        ref::run_ada(I, B, stream);
        ref::run_batch(I, B, dbg::BD, (float*)d_out, stream);
        unsigned char* E = ws + WS_DBG;
        dbg::k_f2b<<<2048, 256, 0, stream>>>(B.proj, (bf16_t*)(E + dbg::E_PROJ), (size_t)2048 * NIN);
        dbg::k_copy<<<64, 256, 0, stream>>>(B.kc, (float*)(E + dbg::E_KC), 512 * 64); dbg::k_copy<<<64, 256, 0, stream>>>(B.vc, (float*)(E + dbg::E_VC), 512 * 64);
        dbg::k_copy<<<32, 256, 0, stream>>>((const float*)B.selmask, (float*)(E + dbg::E_SEL), 2048 * 4);
        dbg::k_copy<<<1024, 256, 0, stream>>>(B.Aa, (float*)(E + dbg::E_AA), (size_t)2048 * 1024); dbg::k_copy<<<1024, 256, 0, stream>>>(B.Ab, (float*)(E + dbg::E_AB), (size_t)2048 * 1024);
        dbg::k_copy<<<1024, 256, 0, stream>>>(B.mg, (float*)(E + dbg::E_MG), (size_t)2048 * 2048); dbg::k_copy<<<1024, 256, 0, stream>>>(B.of, (float*)(E + dbg::E_OF), (size_t)2048 * 2048);
        dbg::k_copy<<<64, 256, 0, stream>>>(B.ada, (float*)(E + dbg::E_ADA), 8 * 6144);
        (void)hipMemsetAsync(E + dbg::DIAG, 0, 4096, stream);
    }
#endif
    if (hipMemsetAsync(ws + WS_CTL, 0, CTL_ZERO_BYTES, stream) != hipSuccess) { fprintf(stderr, "kernel_launch: memset failed\n"); return; }
    Args a{};
    for (int i = 0; i < 17; ++i) a.in[i] = d_in[i];
    a.out = (float*)d_out; a.ws = ws;
#if ONE_LAUNCH
    a.ph_lo = 0; a.ph_hi = NPHASE;
    { void* kargs[] = {&a}; const hipError_t e = hipLaunchCooperativeKernel((const void*)mk_fwd, dim3(grid), dim3(512), kargs, LDS_BYTES, stream);
      if (e != hipSuccess) fprintf(stderr, "kernel_launch: cooperative launch failed: %s (grid %d)\n", hipGetErrorString(e), grid); }
#else
    for (int p = 0; p < NPHASE && p <= DBG_STOP; ++p) { a.ph_lo = p; a.ph_hi = p + 1; hipLaunchKernelGGL(mk_fwd, dim3(grid), dim3(512), LDS_BYTES, stream, a); }
#endif
#if DBG
    {
        unsigned char* E = ws + WS_DBG; float* diag = (float*)(E + dbg::DIAG); const bf16_t* EP = (const bf16_t*)(E + dbg::E_PROJ);
        const size_t r0 = (size_t)dbg::BD * 2048;
#define CMPB(id, fastptr, ldf, ecol, cols, XF, fs) dbg::k_cmp<bf16_t, bf16_t, XF><<<512, 256, 0, stream>>>((const bf16_t*)(fastptr) + r0 * (ldf), ldf, EP + (ecol), NIN, 2048, cols, fs, diag + 2 * (id))
        dbg::k_cmp<float, float, 0><<<64, 256, 0, stream>>>((const float*)(ws + WS_ADA), 6144, (const float*)(E + dbg::E_ADA), 6144, 8, 6144, 1.f, diag + 2 * 1);
        CMPB(2, ws + WS_QA, 1024, ref::C_QA, 1024, 0, 1.f / QS64);
        CMPB(3, ws + WS_KC + 0 * 8 * MiB, 256, ref::C_KC, 256, 0, 1.f); CMPB(4, ws + WS_KC + 1 * 8 * MiB, 256, ref::C_VC, 256, 0, 1.f); CMPB(5, ws + WS_KC + 2 * 8 * MiB, 256, ref::C_KS, 256, 0, 1.f);
        CMPB(6, ws + WS_KC + 3 * 8 * MiB, 256, ref::C_VS, 256, 0, 1.f); CMPB(7, ws + WS_KC + 4 * 8 * MiB, 256, ref::C_KW, 256, 0, 1.f); CMPB(8, ws + WS_KC + 5 * 8 * MiB, 256, ref::C_VW, 256, 0, 1.f);
        CMPB(9, ws + WS_ZA, 1024, ref::C_ZA, 1024, 1, 1.f);
        if (DBG_STOP < 5) { CMPB(10, ws + WS_QB, 1024, ref::C_QB, 1024, 0, 1.f / QS128); CMPB(11, ws + WS_KB, 1024, ref::C_KB, 1024, 0, 1.f); }
        if (DBG_STOP < 6) { CMPB(14, (unsigned char*)d_out + DO_MA, 2048, ref::C_MA, 2048, 2, 1.f); CMPB(15, (unsigned char*)d_out + DO_MB, 2048, ref::C_MB, 2048, 2, 1.f); }
        if (DBG_STOP == 6) dbg::k_cmp<float, float, 0><<<512, 256, 0, stream>>>((const float*)d_out + r0 * 2048, 2048, (const float*)(E + dbg::E_OF), 2048, 2048, 2048, 1.f, diag + 2 * 23);
        CMPB(12, ws + WS_VB, 1024, ref::C_VB, 1024, 0, 1.f); CMPB(13, ws + WS_ZB, 1024, ref::C_ZB, 1024, 1, 1.f);
        CMPB(16, ws + WS_GA, 64, ref::C_GA, 48, 2, 1.f);
        if (DBG_STOP >= 3) {
        dbg::k_cmp<bf16_t, float, 0><<<64, 256, 0, stream>>>((const bf16_t*)(ws + WS_KCC) + (size_t)dbg::BD * 512 * 64, 64, (const float*)(E + dbg::E_KC), 64, 512, 64, 1.f, diag + 2 * 17);
        dbg::k_cmp<bf16_t, float, 0><<<64, 256, 0, stream>>>((const bf16_t*)(ws + WS_VCC) + (size_t)dbg::BD * 512 * 64, 64, (const float*)(E + dbg::E_VC), 64, 512, 64, 1.f, diag + 2 * 18); }
        if (DBG_STOP >= 4) {
        dbg::k_cmp_sel<<<32, 256, 0, stream>>>((const unsigned*)(E + dbg::SELOUT) + r0 * 4, (const unsigned*)(E + dbg::E_SEL), diag + 2 * 19);
        dbg::k_cmp<bf16_t, float, 0><<<512, 256, 0, stream>>>((const bf16_t*)(ws + WS_A2) + r0 * 2048, 2048, (const float*)(E + dbg::E_AA), 1024, 2048, 1024, 1.f, diag + 2 * 20);
        dbg::k_cmp<bf16_t, float, 0><<<512, 256, 0, stream>>>((const bf16_t*)(ws + WS_A2) + r0 * 2048 + 1024, 2048, (const float*)(E + dbg::E_AB), 1024, 2048, 1024, 1.f, diag + 2 * 21); }
        if (DBG_STOP >= 5)
        dbg::k_cmp<bf16_t, float, 0><<<512, 256, 0, stream>>>((const bf16_t*)(ws + WS_MERGED) + r0 * 2048, 2048, (const float*)(E + dbg::E_MG), 2048, 2048, 2048, 1.f, diag + 2 * 22);
#undef CMPB
        dbg::k_report<<<1, 64, 0, stream>>>(diag, (float*)d_out, DBG_SEL);
    }
#endif
}
```

```cpp
#define DBG 0
#define DBG_BATCH 5
#define DBG_SEL 0
#define ONE_LAUNCH 1
#define DBG_STOP 7
#define REP_MASK 0
#define STAMP 0
#define STAMP_A 0
#define STAMP_B 8
#define MAN_PV 1
#define NSA_QUEUE 1
#define MIX_QUEUE 1
#define MAX_STRIDE 4
#define DMA_LATE 1
#define FAST_ROPE 1
#include <hip/hip_runtime.h>
#include <hip/hip_cooperative_groups.h>
#include <cmath>
#include <cstdio>
#include <cstdint>

constexpr int NB = 8, SEQ = 2048, DM = 2048, MTOK = NB * SEQ;
constexpr int NIN = 11824, NINP = 12032;
constexpr float LOG2E = 1.4426950408889634f;
constexpr float QS64 = 0.125f * LOG2E, QS128 = 0.08838834764831845f * LOG2E;
constexpr size_t MiB = 1u << 20;
constexpr size_t WS_CTL = 0, CTL_ZERO_BYTES = 1 * MiB;
constexpr size_t WS_ADA = 1 * MiB;
constexpr size_t WS_R64 = 2 * MiB;
constexpr size_t WS_R128 = 3 * MiB;
constexpr size_t WS_BIAS1 = 5 * MiB;
constexpr size_t WS_SSQ = 6 * MiB;
constexpr size_t WS_KCC = 8 * MiB, WS_VCC = 8 * MiB + 512 * 1024;
constexpr size_t WS_W2T = 9 * MiB;
constexpr size_t WS_W1T = 10 * MiB;
constexpr size_t WS_GA = 12 * MiB;
constexpr size_t WS_WBRT = 16 * MiB, WS_WOUTT = 24 * MiB;
constexpr size_t WS_WINT = 32 * MiB;
constexpr size_t WS_XN = 80 * MiB;
constexpr size_t WS_QA = 144 * MiB;
constexpr size_t WS_KC = 176 * MiB;
constexpr size_t WS_ZA = 224 * MiB, WS_QB = 256 * MiB, WS_KB = 288 * MiB, WS_VB = 320 * MiB, WS_ZB = 352 * MiB;
constexpr size_t WS_MERGED = 256 * MiB;
#if DBG
constexpr size_t WS_A2 = WS_XN;
#else
constexpr size_t WS_A2 = 384 * MiB;
#endif
constexpr size_t WS_END = 448 * MiB;
constexpr size_t WS_DBG = 384 * MiB;
constexpr size_t DO_MA = 0, DO_MB = 64 * MiB;

typedef unsigned short bf16_t;
#define LAS __attribute__((address_space(3)))
#define GAS __attribute__((address_space(1)))
typedef unsigned u32x4_t __attribute__((ext_vector_type(4)));
typedef unsigned u32x2_t __attribute__((ext_vector_type(2)));
typedef float f32x4_t __attribute__((ext_vector_type(4)));

__device__ __forceinline__ unsigned f2bf(float f) { unsigned u = __builtin_bit_cast(unsigned, f); return (u + 0x7fffu + ((u >> 16) & 1u)) >> 16; }
__device__ __forceinline__ unsigned pk2(float lo, float hi) { return f2bf(lo) | (f2bf(hi) << 16); }
__device__ __forceinline__ float bf2f(unsigned short h) { return __builtin_bit_cast(float, (unsigned)h << 16); }
__device__ __forceinline__ float bflo(unsigned w) { return __builtin_bit_cast(float, w << 16); }
__device__ __forceinline__ float bfhi(unsigned w) { return __builtin_bit_cast(float, w & 0xffff0000u); }
__device__ __forceinline__ float fast_sigmoid(float x) { return __builtin_amdgcn_rcpf(1.f + __builtin_amdgcn_exp2f(-x * LOG2E)); }
namespace pg8 {
#define PG8_LAS __attribute__((address_space(3)))
typedef unsigned short bf16_t;
typedef short bf16x8 __attribute__((ext_vector_type(8)));
typedef float f32x4 __attribute__((ext_vector_type(4)));
typedef unsigned u32x4 __attribute__((ext_vector_type(4)));
constexpr int BM = 256, BK = 64, HALF = 128, HTB = HALF * BK * 2  , STAGE_BYTES = 8 * HTB, NXCD = 8, WGM = 8;

__host__ __device__ __forceinline__ int lds_byte(int r, int c) { const int st = (r >> 4) * 2 + (c >> 5), rr = r & 15, cc = c & 31, ob = rr * 64 + cc * 2; return st * 1024 + (ob ^ (((ob >> 9) & 1) << 5)); }
__host__ __device__ __forceinline__ void stage_rc(int b, int& R, int& C) { const int st = b / 1024, sb = b % 1024, swz = sb ^ (((sb >> 9) & 1) << 5); R = (st >> 1) * 16 + swz / 64; C = (st & 1) * 32 + (swz % 64) / 2; }
__host__ __device__ __forceinline__ int perm32(int rho) { const int n = rho >> 4, i = rho & 15; return 8 * (i >> 2) + 4 * n + (i & 3); }

struct Unit { int pm, pn; };
struct Gemm { const bf16_t* A; const bf16_t* Bt; int M, N, K; };

struct StaticOrder {
    int nM, nN, nwg, G, c;
    __host__ __device__ void init(int M, int N, int G_, int c_) { nM = M / BM; nN = N / BM; nwg = nM * nN; G = G_; c = c_; }
    __host__ __device__ bool next(int i, Unit& u) const {
        const long L = (long)i * G + c; if (L >= nwg) return false;
        int wgid = (int)L; { const int q = nwg / NXCD, r = nwg % NXCD, xcd = wgid % NXCD, off = wgid / NXCD; wgid = (xcd < r ? xcd * (q + 1) : r * (q + 1) + (xcd - r) * q) + off; }
        const int nig = WGM * nN, gid = wgid / nig, fm = gid * WGM, gsz = (nM - fm) < WGM ? (nM - fm) : WGM;
        u.pm = fm + ((wgid % nig) % gsz); u.pn = (wgid % nig) / gsz; return true;
    }
    __device__ __forceinline__ void a_ready(const Unit&) const {}
    __device__ __forceinline__ void done(const Unit&) const {}
};
struct ProjOrder {
    int nM, nN, nwg, G, c, i0, i1;
    static constexpr int NFIRST = 18;
    __host__ __device__ void init(int M, int N, int G_, int c_) { nM = M / BM; nN = N / BM; nwg = nM * nN; G = G_; c = c_; i0 = 0; i1 = 1 << 30; }
    __host__ __device__ static int perm(int i) { return i < 2 ? 4 + i : i < 18 ? 12 + i : i < 22 ? i - 18 : i < 26 ? i - 16 : i < 30 ? i - 16 : i; }
    __host__ __device__ bool decode(int i, int& pm, int& pi) const {
        const long L = (long)i * G + c; if (L >= nwg) return false;
        int wgid = (int)L; { const int q = nwg / NXCD, r = nwg % NXCD, xcd = wgid % NXCD, off = wgid / NXCD; wgid = (xcd < r ? xcd * (q + 1) : r * (q + 1) + (xcd - r) * q) + off; }
        const int nig = WGM * nN, gid = wgid / nig, fm = gid * WGM, gsz = (nM - fm) < WGM ? (nM - fm) : WGM;
        pm = fm + ((wgid % nig) % gsz); pi = (wgid % nig) / gsz; return true; }
    __host__ __device__ int count_first() const { int n = 0, pm, pi; while (decode(n, pm, pi) && pi < NFIRST) ++n; return n; }
    __host__ __device__ bool next(int i, Unit& u) const { int pi; if (i0 + i >= i1 || !decode(i0 + i, u.pm, pi)) return false; u.pn = perm(pi); return true; }
    __device__ __forceinline__ void a_ready(const Unit&) const {}
    __device__ __forceinline__ void done(const Unit&) const {}
};

typedef float f32x2_cv __attribute__((ext_vector_type(2))); typedef __bf16 bf16x2_cv __attribute__((ext_vector_type(2)));
__device__ __forceinline__ unsigned cvt_pk_bf16(float lo, float hi) { f32x2_cv v = {lo, hi}; bf16x2_cv b = __builtin_convertvector(v, bf16x2_cv); return __builtin_bit_cast(unsigned, b); }

struct EpiProj {
    static constexpr bool PERM = true, AFTER_DRAIN = false, MIDHOOK = false;
    unsigned char* ws; unsigned char* dout; const float* r64; const float* r128;
    __device__ __forceinline__ void mid(f32x4 (&)[2][2][4][2], const Unit&, int, int, int, int) const {}
    __device__ __forceinline__ void operator()(const f32x4 (&acc)[2][2][4][2], const Unit& u, int wr, int wc, int fr, int fq) const {
        const int pn = u.pn;
        bf16_t* base; int ldc, colt, mode; float sc = 1.f;
        if (pn < 4)       { base = (bf16_t*)(ws + WS_QA); ldc = 1024; colt = 256 * pn; mode = 1; sc = QS64; }
        else if (pn < 10) { base = (bf16_t*)(ws + WS_KC + (size_t)(pn - 4) * 8 * MiB); ldc = 256; colt = 0; mode = (pn == 6 || pn == 8) ? 1 : 0; }
        else if (pn < 14) { base = (bf16_t*)(ws + WS_ZA); ldc = 1024; colt = 256 * (pn - 10); mode = 3; }
        else if (pn < 18) { base = (bf16_t*)(ws + WS_QB); ldc = 1024; colt = 256 * (pn - 14); mode = 2; sc = QS128; }
        else if (pn < 22) { base = (bf16_t*)(ws + WS_KB); ldc = 1024; colt = 256 * (pn - 18); mode = 2; }
        else if (pn < 26) { base = (bf16_t*)(ws + WS_VB); ldc = 1024; colt = 256 * (pn - 22); mode = 0; }
        else if (pn < 30) { base = (bf16_t*)(ws + WS_ZB); ldc = 1024; colt = 256 * (pn - 26); mode = 3; }
        else if (pn < 38) { base = (bf16_t*)(dout + DO_MA); ldc = 2048; colt = 256 * (pn - 30); mode = 4; }
        else if (pn < 46) { base = (bf16_t*)(dout + DO_MB); ldc = 2048; colt = 256 * (pn - 38); mode = 4; }
        else              { base = (bf16_t*)(ws + WS_GA); ldc = 64; colt = 0; mode = 5; }
        const int row0 = u.pm * BM + wr * 64 + fr;
        const int cb = wc * 32 + 8 * fq;
        const bool rope_wave = (mode == 1 && (wc & 1) == 0) || (mode == 2 && wc == 0);
#pragma unroll
        for (int ai = 0; ai < 2; ++ai)
#pragma unroll
            for (int m = 0; m < 4; ++m) {
                const int row = row0 + ai * HALF + m * 16;
                float v2[2][8];
#pragma unroll
                for (int bj = 0; bj < 2; ++bj)
#pragma unroll
                    for (int j = 0; j < 4; ++j) { v2[bj][j] = acc[ai][bj][m][0][j]; v2[bj][4 + j] = acc[ai][bj][m][1][j]; }
                if (rope_wave) {
                    float cs[8], sn[8];
                    if (mode == 1) { const f32x4* t = (const f32x4*)(r64 + (size_t)row * 16); const f32x4 c0 = t[0], c1 = t[1], s0 = t[2], s1 = t[3];
#pragma unroll
                        for (int j = 0; j < 4; ++j) { cs[j] = c0[j]; cs[4 + j] = c1[j]; sn[j] = s0[j]; sn[4 + j] = s1[j]; } }
                    else { const f32x4* t = (const f32x4*)(r128 + (size_t)row * 32 + 8 * (fq & 1)); const f32x4 c0 = t[0], c1 = t[1], s0 = t[4], s1 = t[5];
#pragma unroll
                        for (int j = 0; j < 4; ++j) { cs[j] = c0[j]; cs[4 + j] = c1[j]; sn[j] = s0[j]; sn[4 + j] = s1[j]; } }
                    const int xm = (mode == 1) ? 16 : 32;
                    const bool is_x1 = (mode == 1) ? (fq == 0) : (fq < 2);
                    const bool do_rot = (mode == 1) ? (fq < 2) : true;
#pragma unroll
                    for (int bj = 0; bj < 2; ++bj)
#pragma unroll
                        for (int j = 0; j < 8; ++j) { const float p = __shfl_xor(v2[bj][j], xm); const float r = v2[bj][j] * cs[j] + (is_x1 ? -p : p) * sn[j]; v2[bj][j] = do_rot ? r : v2[bj][j]; }
                }
#pragma unroll
                for (int bj = 0; bj < 2; ++bj) {
                    float v[8];
#pragma unroll
                    for (int j = 0; j < 8; ++j) v[j] = v2[bj][j];
                    if (mode == 3) {
#pragma unroll
                        for (int j = 0; j < 8; ++j) v[j] = v[j] * fast_sigmoid(v[j]);
                    } else if (mode >= 4) {
#pragma unroll
                        for (int j = 0; j < 8; ++j) v[j] = fast_sigmoid(v[j]);
                    } else {
#pragma unroll
                        for (int j = 0; j < 8; ++j) v[j] *= sc;
                    }
                    u32x4 w; w.x = cvt_pk_bf16(v[0], v[1]); w.y = cvt_pk_bf16(v[2], v[3]); w.z = cvt_pk_bf16(v[4], v[5]); w.w = cvt_pk_bf16(v[6], v[7]);
                    const int col = cb + bj * HALF;
                    if (mode != 5 || col < 48) *(u32x4*)(base + (size_t)row * ldc + colt + col) = w;
                }
            }
    }
};

struct EpiMerge {
    static constexpr bool PERM = true, AFTER_DRAIN = false, MIDHOOK = true;
    const bf16_t* sma; const bf16_t* smb; bf16_t* out;
    __device__ __forceinline__ void mid(f32x4 (&acc)[2][2][4][2], const Unit& u, int wr, int wc, int fr, int fq) const {
        asm volatile("" : "+v"(fr), "+v"(fq));
        const int row0 = u.pm * BM + wr * 64 + fr, col0 = u.pn * BM + wc * 32 + 8 * fq;
#pragma unroll
        for (int ai = 0; ai < 2; ++ai)
#pragma unroll
            for (int m = 0; m < 4; ++m)
#pragma unroll
                for (int bj = 0; bj < 2; ++bj) { const size_t off = (size_t)(row0 + ai * HALF + m * 16) * 2048 + col0 + bj * HALF;
                    const u32x4 a = *(const u32x4*)(sma + off), b = *(const u32x4*)(smb + off);
#pragma unroll
                    for (int q = 0; q < 4; ++q) { const float a0 = bflo(a[q]), a1 = bfhi(a[q]), b0 = bflo(b[q]), b1 = bfhi(b[q]);
                        acc[ai][bj][m][q >> 1][(q & 1) * 2 + 0] *= a0 * __builtin_amdgcn_rcpf(b0); acc[ai][bj][m][q >> 1][(q & 1) * 2 + 1] *= a1 * __builtin_amdgcn_rcpf(b1); }
                    if (bj == 1) asm volatile("" ::: "memory"); }
    }
    __device__ __forceinline__ void operator()(const f32x4 (&acc)[2][2][4][2], const Unit& u, int wr, int wc, int fr, int fq) const {
        const int row0 = u.pm * BM + wr * 64 + fr, col0 = u.pn * BM + wc * 32 + 8 * fq;
#pragma unroll
        for (int ai = 0; ai < 2; ++ai)
#pragma unroll
            for (int m = 0; m < 4; ++m)
#pragma unroll
                for (int bj = 0; bj < 2; ++bj) { const size_t off = (size_t)(row0 + ai * HALF + m * 16) * 2048 + col0 + bj * HALF;
                    const u32x4 b = *(const u32x4*)(smb + off); u32x4 w;
#pragma unroll
                    for (int q = 0; q < 4; ++q) w[q] = cvt_pk_bf16(acc[ai][bj][m][q >> 1][(q & 1) * 2 + 0] * bflo(b[q]), acc[ai][bj][m][q >> 1][(q & 1) * 2 + 1] * bfhi(b[q]));
                    *(u32x4*)(out + off) = w; if (bj == 1) asm volatile("" ::: "memory"); }
    }
};

struct EpiOut {
    static constexpr bool PERM = false, AFTER_DRAIN = false, MIDHOOK = false;
    float* C; float* ssq;
    __device__ __forceinline__ void mid(f32x4 (&)[2][2][4][2], const Unit&, int, int, int, int) const {}
    __device__ __forceinline__ void operator()(const f32x4 (&acc)[2][2][4][2], const Unit& u, int wr, int wc, int fr, int fq) const {
        const int row0 = u.pm * BM + wr * 64 + fr, col0 = u.pn * BM + wc * 32 + 4 * fq;
#pragma unroll
        for (int ai = 0; ai < 2; ++ai)
#pragma unroll
            for (int m = 0; m < 4; ++m) { const int row = row0 + ai * HALF + m * 16; float* rowp = C + (size_t)row * 2048 + col0; float s = 0.f;
#pragma unroll
                for (int bj = 0; bj < 2; ++bj)
#pragma unroll
                    for (int n = 0; n < 2; ++n) { const f32x4 x = acc[ai][bj][m][n]; *(f32x4*)(rowp + bj * HALF + n * 16) = x; s += (x[0] * x[0] + x[1] * x[1]) + (x[2] * x[2] + x[3] * x[3]); }
                s += __shfl_xor(s, 16); s += __shfl_xor(s, 32);
                if (fq == 0) ssq[(size_t)row * 32 + u.pn * 4 + wc] = s; }
    }
};

struct EpiOutB {
    static constexpr bool PERM = true, AFTER_DRAIN = false, MIDHOOK = false;
    bf16_t* C; float* ssq;
    __device__ __forceinline__ void mid(f32x4 (&)[2][2][4][2], const Unit&, int, int, int, int) const {}
    __device__ __forceinline__ void operator()(const f32x4 (&acc)[2][2][4][2], const Unit& u, int wr, int wc, int fr, int fq) const {
        const int row0 = u.pm * BM + wr * 64 + fr, col0 = u.pn * BM + wc * 32 + 8 * fq;
#pragma unroll
        for (int ai = 0; ai < 2; ++ai)
#pragma unroll
            for (int m = 0; m < 4; ++m) { const int row = row0 + ai * HALF + m * 16; bf16_t* rowp = C + (size_t)row * 2048 + col0; float s = 0.f;
#pragma unroll
                for (int bj = 0; bj < 2; ++bj) { const f32x4 x0 = acc[ai][bj][m][0], x1 = acc[ai][bj][m][1];
                    s += ((x0[0] * x0[0] + x0[1] * x0[1]) + (x0[2] * x0[2] + x0[3] * x0[3])) + ((x1[0] * x1[0] + x1[1] * x1[1]) + (x1[2] * x1[2] + x1[3] * x1[3]));
                    u32x4 w; w.x = cvt_pk_bf16(x0[0], x0[1]); w.y = cvt_pk_bf16(x0[2], x0[3]); w.z = cvt_pk_bf16(x1[0], x1[1]); w.w = cvt_pk_bf16(x1[2], x1[3]);
                    *(u32x4*)(rowp + bj * HALF) = w; }
                s += __shfl_xor(s, 16); s += __shfl_xor(s, 32);
                if (fq == 0) ssq[(size_t)row * 32 + u.pn * 4 + wc] = s; }
    }
};

struct EpiFinal {
    static constexpr bool PERM = false, AFTER_DRAIN = false, MIDHOOK = false;
    const float* x; float* out; float* ssq; unsigned* cnt; const float* ada; const float* gpost;
    __device__ __forceinline__ void mid(f32x4 (&)[2][2][4][2], const Unit&, int, int, int, int) const {}
    __device__ __forceinline__ void operator()(const f32x4 (&acc)[2][2][4][2], const Unit& u, int wr, int wc, int fr, int fq) const {
        const int row0 = u.pm * BM + wr * 64 + fr, col0 = u.pn * BM + wc * 32 + 4 * fq;
#pragma unroll
        for (int ai = 0; ai < 2; ++ai)
#pragma unroll
            for (int m = 0; m < 4; ++m) { const int row = row0 + ai * HALF + m * 16; float s = 0.f;
#pragma unroll
                for (int bj = 0; bj < 2; ++bj)
#pragma unroll
                    for (int n = 0; n < 2; ++n) { const f32x4 v = acc[ai][bj][m][n]; s += (v[0] * v[0] + v[1] * v[1]) + (v[2] * v[2] + v[3] * v[3]); }
                s += __shfl_xor(s, 16); s += __shfl_xor(s, 32);
                if (fq == 0) __hip_atomic_store(ssq + (size_t)row * 32 + u.pn * 4 + wc, s, __ATOMIC_RELAXED, __HIP_MEMORY_SCOPE_AGENT); }
        asm volatile("s_waitcnt vmcnt(0)" ::: "memory");
        unsigned* c = cnt + 64 * u.pm;
        if (fr == 0 && fq == 0) __hip_atomic_fetch_add(c, 1u, __ATOMIC_RELAXED, __HIP_MEMORY_SCOPE_AGENT);
        { unsigned spins = 0;
          while ((unsigned)__builtin_amdgcn_readfirstlane(__hip_atomic_load(c, __ATOMIC_RELAXED, __HIP_MEMORY_SCOPE_AGENT)) < 64u) { __builtin_amdgcn_s_sleep(2); if (++spins > (1u << 22)) break; } }
        const int b = (u.pm * BM) >> 11;
        f32x4 gg[2][2];
#pragma unroll
        for (int bj = 0; bj < 2; ++bj)
#pragma unroll
            for (int n = 0; n < 2; ++n) { const int col = col0 + bj * HALF + n * 16; gg[bj][n] = *(const f32x4*)(ada + b * 6144 + 4096 + col) * *(const f32x4*)(gpost + col); }
#pragma unroll
        for (int ai = 0; ai < 2; ++ai)
#pragma unroll
            for (int m = 0; m < 4; ++m) { const int row = row0 + ai * HALF + m * 16; const float* sp = ssq + (size_t)row * 32 + 8 * fq; float s = 0.f;
#pragma unroll
                for (int q = 0; q < 8; ++q) s += __hip_atomic_load(sp + q, __ATOMIC_RELAXED, __HIP_MEMORY_SCOPE_AGENT);
                s += __shfl_xor(s, 16); s += __shfl_xor(s, 32);
                const float rstd = rsqrtf(s * (1.f / 2048.f) + 1e-6f);
                const float* xr = x + (size_t)row * 2048 + col0; float* orow = out + (size_t)row * 2048 + col0;
#pragma unroll
                for (int bj = 0; bj < 2; ++bj)
#pragma unroll
                    for (int n = 0; n < 2; ++n) { const f32x4 xv = *(const f32x4*)(xr + bj * HALF + n * 16); *(f32x4*)(orow + bj * HALF + n * 16) = xv + gg[bj][n] * (acc[ai][bj][m][n] * rstd); }
                if (m & 1) asm volatile("" ::: "memory"); }
    }
};

struct PanelOrder {
    int nN, nwg, G, v;
    __host__ __device__ void init(int M, int N, int G_, int v_) { nN = N / BM; nwg = (M / BM) * nN; G = G_; v = v_; }
    __host__ __device__ bool next(int i, Unit& u) const { const long L = (long)i * G + v; if (L >= nwg) return false; u.pm = (int)(L / nN); u.pn = (int)(L % nN); return true; }
    __device__ __forceinline__ void a_ready(const Unit&) const {}
    __device__ __forceinline__ void done(const Unit&) const {}
};
template <class Epi, class Sched, bool ALIGN_EPI = false, bool SP2 = false>
__device__ __forceinline__ void gemm_phase(PG8_LAS unsigned char* lds, const Gemm g, const Sched& S, const Epi& E) {
    const int tid = threadIdx.x, wid = __builtin_amdgcn_readfirstlane(tid >> 6), lane = tid & 63, wr = wid >> 2, wc = wid & 3, fr = lane & 15, fq = lane >> 4;
    const int K = g.K, nt = K / BK;
    unsigned voffA[2], voffB[2];
#pragma unroll
    for (int i = 0; i < 2; ++i) { int R, C; stage_rc(tid * 16 + i * 8192, R, C); const int Rb = Epi::PERM ? ((R & ~31) + perm32(R & 31)) : R;
        voffA[i] = (unsigned)(R * K + C) * 2u; voffB[i] = (unsigned)(Rb * K + C) * 2u; }
    const size_t kstep = (size_t)(BK * 2);
    const size_t hstep = (size_t)HALF * K * 2;
    const size_t tstep = 2 * hstep;
    const unsigned ldsw = (unsigned)wid * 1024u;
    const int aoff = lds_byte(wr * 64 + fr, fq * 8), boff = lds_byte(wc * 32 + fr, fq * 8);
#define PG8_SA(b, h) (((b) * 2 + (h)) * HTB)
#define PG8_SB(b, h) ((4 + (b) * 2 + (h)) * HTB)
#define PG8_STAGE(bufoff, gbase, voff) do { _Pragma("unroll") for (int _i = 0; _i < 2; ++_i) \
        __builtin_amdgcn_global_load_lds((const unsigned*)((const char*)(gbase) + (voff)[_i]), (PG8_LAS unsigned*)(lds + (bufoff) + ldsw + _i * 8192), 16, 0, 0); } while (0)
#define PG8_LDA(dst, b, h) do { _Pragma("unroll") for (int m = 0; m < 4; ++m) _Pragma("unroll") for (int k = 0; k < 2; ++k) dst[m][k] = *(const PG8_LAS bf16x8*)(lds + PG8_SA(b, h) + aoff + m * 2048 + k * 1024); } while (0)
#define PG8_LDB(dst, b, h) do { _Pragma("unroll") for (int n = 0; n < 2; ++n) _Pragma("unroll") for (int k = 0; k < 2; ++k) dst[n][k] = *(const PG8_LAS bf16x8*)(lds + PG8_SB(b, h) + boff + n * 2048 + k * 1024); } while (0)
#define PG8_MMA(ai, bj, At, Bt) do { __builtin_amdgcn_s_setprio(1); _Pragma("unroll") for (int m = 0; m < 4; ++m) _Pragma("unroll") for (int n = 0; n < 2; ++n) _Pragma("unroll") for (int k = 0; k < 2; ++k) \
        acc[ai][bj][m][n] = __builtin_amdgcn_mfma_f32_16x16x32_bf16(Bt[n][k], At[m][k], acc[ai][bj][m][n], 0, 0, 0); __builtin_amdgcn_s_setprio(0); } while (0)
#define PG8_WAIT_V(n) asm volatile("s_waitcnt vmcnt(" #n ")" ::: "memory")
#define PG8_WAIT_L(n) asm volatile("s_waitcnt lgkmcnt(" #n ")" ::: "memory")
#define PG8_BAR __builtin_amdgcn_s_barrier()
#define PG8_SCHED __builtin_amdgcn_sched_barrier(0)
    Unit cur, nxt; int ui = 0;
    if (!S.next(0, cur)) return;
    f32x4 acc[2][2][4][2];
#pragma unroll
    for (int a = 0; a < 2; ++a)
#pragma unroll
        for (int b = 0; b < 2; ++b)
#pragma unroll
            for (int m = 0; m < 4; ++m)
#pragma unroll
                for (int n = 0; n < 2; ++n) acc[a][b][m][n] = (f32x4){0.f, 0.f, 0.f, 0.f};
    bf16x8 At[4][2], B0[2][2], B1[2][2];
    const char* cA = (const char*)g.A + (size_t)cur.pm * tstep; const char* cB = (const char*)g.Bt + (size_t)cur.pn * tstep;
    S.a_ready(cur);
    if constexpr (SP2) {
        PG8_STAGE(PG8_SB(0, 0), cB, voffB); PG8_STAGE(PG8_SB(0, 1), cB + hstep, voffB); PG8_STAGE(PG8_SA(0, 0), cA, voffA); PG8_STAGE(PG8_SA(0, 1), cA + hstep, voffA);
        if (wr == 1) PG8_BAR;
        PG8_WAIT_V(2); PG8_BAR;
        PG8_STAGE(PG8_SB(1, 0), cB + kstep, voffB); PG8_STAGE(PG8_SA(1, 0), cA + kstep, voffA); PG8_STAGE(PG8_SB(1, 1), cB + hstep + kstep, voffB);
        PG8_WAIT_V(6); PG8_BAR;
    } else {
        PG8_STAGE(PG8_SB(0, 0), cB, voffB); PG8_STAGE(PG8_SA(0, 0), cA, voffA); PG8_STAGE(PG8_SB(0, 1), cB + hstep, voffB); PG8_STAGE(PG8_SA(0, 1), cA + hstep, voffA);
        if (wr == 1) PG8_BAR;
        PG8_WAIT_V(4); PG8_BAR;
        PG8_STAGE(PG8_SB(1, 0), cB + kstep, voffB); PG8_STAGE(PG8_SA(1, 0), cA + kstep, voffA); PG8_STAGE(PG8_SB(1, 1), cB + hstep + kstep, voffB);
        PG8_WAIT_V(6); PG8_BAR;
    }
    for (;;) {
        const bool has_next = S.next(ui + 1, nxt);
        const char* nA = has_next ? (const char*)g.A + (size_t)nxt.pm * tstep : cA; const char* nB = has_next ? (const char*)g.Bt + (size_t)nxt.pn * tstep : cB;
        for (int t = 0; t < nt; t += 2) {
            const bool last = (t == nt - 2);
            if constexpr (Epi::MIDHOOK) { if (t == nt / 2) E.mid(acc, cur, wr, wc, fr, fq); }
            const char* a1 = cA + (size_t)(t + 1) * kstep;
            const char* a2 = last ? nA : cA + (size_t)(t + 2) * kstep; const char* b2 = last ? nB : cB + (size_t)(t + 2) * kstep;
            const char* a3 = a2 + kstep; const char* b3 = b2 + kstep;
            if (last && has_next) S.a_ready(nxt);
            if constexpr (SP2) {
            PG8_LDB(B0, 0, 0); PG8_LDB(B1, 0, 1); PG8_SCHED; PG8_LDA(At, 0, 0); PG8_STAGE(PG8_SA(1, 1), a1 + hstep, voffA);
            PG8_WAIT_V(8); PG8_WAIT_L(0); PG8_BAR; PG8_MMA(0, 0, At, B0); PG8_MMA(0, 1, At, B1); PG8_BAR; PG8_SCHED;
            PG8_LDA(At, 0, 1); PG8_STAGE(PG8_SB(0, 0), b2, voffB); PG8_STAGE(PG8_SB(0, 1), b2 + hstep, voffB); PG8_STAGE(PG8_SA(0, 0), a2, voffA);
            PG8_WAIT_V(8); PG8_WAIT_L(0); PG8_BAR; PG8_MMA(1, 0, At, B0); PG8_MMA(1, 1, At, B1); PG8_BAR; PG8_SCHED;
            PG8_LDB(B0, 1, 0); PG8_LDB(B1, 1, 1); PG8_SCHED; PG8_LDA(At, 1, 0); PG8_STAGE(PG8_SA(0, 1), a2 + hstep, voffA);
            PG8_WAIT_V(8); PG8_WAIT_L(0); PG8_BAR; PG8_MMA(0, 0, At, B0); PG8_MMA(0, 1, At, B1); PG8_BAR; PG8_SCHED;
            PG8_LDA(At, 1, 1); PG8_STAGE(PG8_SB(1, 0), b3, voffB); PG8_STAGE(PG8_SB(1, 1), b3 + hstep, voffB); PG8_STAGE(PG8_SA(1, 0), a3, voffA);
            PG8_WAIT_V(8); PG8_WAIT_L(0); PG8_BAR; PG8_MMA(1, 0, At, B0); PG8_MMA(1, 1, At, B1); PG8_BAR; PG8_SCHED;
            } else {
            PG8_LDB(B0, 0, 0); PG8_SCHED; PG8_LDA(At, 0, 0); PG8_STAGE(PG8_SA(1, 1), a1 + hstep, voffA);
            PG8_WAIT_L(8); PG8_BAR; PG8_WAIT_L(0); PG8_MMA(0, 0, At, B0); PG8_BAR; PG8_SCHED;
            PG8_LDB(B1, 0, 1); PG8_STAGE(PG8_SB(0, 0), b2, voffB);
            PG8_BAR; PG8_WAIT_L(0); PG8_MMA(0, 1, At, B1); PG8_BAR;
            PG8_LDA(At, 0, 1); PG8_STAGE(PG8_SA(0, 0), a2, voffA);
            PG8_BAR; PG8_WAIT_L(0); PG8_MMA(1, 0, At, B0); PG8_BAR; PG8_SCHED;
            PG8_STAGE(PG8_SB(0, 1), b2 + hstep, voffB);
            PG8_WAIT_V(6); PG8_BAR; PG8_MMA(1, 1, At, B1); PG8_BAR;
            PG8_LDB(B0, 1, 0); PG8_SCHED; PG8_LDA(At, 1, 0); PG8_STAGE(PG8_SA(0, 1), a2 + hstep, voffA);
            PG8_WAIT_L(8); PG8_BAR; PG8_WAIT_L(0); PG8_MMA(0, 0, At, B0); PG8_BAR; PG8_SCHED;
            PG8_LDB(B1, 1, 1); PG8_STAGE(PG8_SB(1, 0), b3, voffB);
            PG8_BAR; PG8_WAIT_L(0); PG8_MMA(0, 1, At, B1); PG8_BAR;
            PG8_LDA(At, 1, 1); PG8_STAGE(PG8_SA(1, 0), a3, voffA);
            PG8_BAR; PG8_WAIT_L(0); PG8_MMA(1, 0, At, B0); PG8_BAR; PG8_SCHED;
            PG8_STAGE(PG8_SB(1, 1), b3 + hstep, voffB);
            PG8_WAIT_V(6); PG8_BAR; PG8_MMA(1, 1, At, B1); PG8_BAR;
            }
        }
        if constexpr (ALIGN_EPI) { if (wr == 0) PG8_BAR; }
        if constexpr (!Epi::AFTER_DRAIN) { E(acc, cur, wr, wc, fr, fq); S.done(cur); }
        if (!has_next) break;
#pragma unroll
        for (int a = 0; a < 2; ++a)
#pragma unroll
            for (int b = 0; b < 2; ++b)
#pragma unroll
                for (int m = 0; m < 4; ++m)
#pragma unroll
                    for (int n = 0; n < 2; ++n) acc[a][b][m][n] = (f32x4){0.f, 0.f, 0.f, 0.f};
        cur = nxt; cA = nA; cB = nB; ++ui;
        if constexpr (ALIGN_EPI) { if (wr == 1) PG8_BAR; }
    }
    PG8_WAIT_V(0);
    if constexpr (!ALIGN_EPI) { if (wr == 0) PG8_BAR; }
    PG8_BAR;
    if constexpr (Epi::AFTER_DRAIN) { E.fused(acc, cur, wr, wc, fr, fq, lds, wid, lane); S.done(cur); }
#undef PG8_SA
#undef PG8_SB
#undef PG8_STAGE
#undef PG8_LDA
#undef PG8_LDB
#undef PG8_MMA
#undef PG8_WAIT_V
#undef PG8_WAIT_L
#undef PG8_BAR
#undef PG8_SCHED
}
}

namespace att {
typedef short bf16x8 __attribute__((ext_vector_type(8)));
typedef short s16x4 __attribute__((ext_vector_type(4)));
typedef short v4i16_t __attribute__((ext_vector_type(4)));
typedef float f32x16 __attribute__((ext_vector_type(16)));
constexpr float NEGINF = -__builtin_inff();

constexpr int L_K0 = 0, L_K1 = 16384, L_V0 = 32768, L_V1 = 49152;
template <int D> struct Tile { u32x4_t k[D / 64]; u32x4_t v[D / 64]; };
template <int D> __device__ __forceinline__ void tile_load(Tile<D>& T, const bf16_t* Kp, const bf16_t* Vp, int pitch, int wid, int lane) {
#pragma unroll
    for (int i = 0; i < D / 64; ++i) { const int pc = wid + 8 * i;
        T.k[i] = *(const u32x4_t*)(Kp + (size_t)lane * pitch + pc * 8);
        T.v[i] = *(const u32x4_t*)(Vp + (size_t)(16 * (pc & 3) + (lane >> 2)) * pitch + 32 * (pc >> 2) + 8 * (lane & 3)); }
}
template <int D> __device__ __forceinline__ void tile_store(const Tile<D>& T, LAS unsigned char* kbuf, LAS unsigned char* vbuf, int wid, int lane) {
#pragma unroll
    for (int i = 0; i < D / 64; ++i) { const int pc = wid + 8 * i;
        *(LAS u32x4_t*)(kbuf + pc * 1024 + lane * 16) = T.k[i]; *(LAS u32x4_t*)(vbuf + pc * 1024 + lane * 16) = T.v[i]; }
}
template <int D> __device__ __forceinline__ void k_load(Tile<D>& T, const bf16_t* Kp, int pitch, int wid, int lane) {
#pragma unroll
    for (int i = 0; i < D / 64; ++i) T.k[i] = *(const u32x4_t*)(Kp + (size_t)lane * pitch + (wid + 8 * i) * 8);
}
template <int D> __device__ __forceinline__ void v_load(Tile<D>& T, const bf16_t* Vp, int pitch, int wid, int lane) {
#pragma unroll
    for (int i = 0; i < D / 64; ++i) { const int pc = wid + 8 * i; T.v[i] = *(const u32x4_t*)(Vp + (size_t)(16 * (pc & 3) + (lane >> 2)) * pitch + 32 * (pc >> 2) + 8 * (lane & 3)); }
}
template <int D> __device__ __forceinline__ void k_store(const Tile<D>& T, LAS unsigned char* kbuf, int wid, int lane) {
#pragma unroll
    for (int i = 0; i < D / 64; ++i) *(LAS u32x4_t*)(kbuf + (wid + 8 * i) * 1024 + lane * 16) = T.k[i];
}
template <int D> __device__ __forceinline__ void v_store(const Tile<D>& T, LAS unsigned char* vbuf, int wid, int lane) {
#pragma unroll
    for (int i = 0; i < D / 64; ++i) *(LAS u32x4_t*)(vbuf + (wid + 8 * i) * 1024 + lane * 16) = T.v[i];
}
template <int D> __device__ __forceinline__ void qkt(f32x16& p0, f32x16& p1, const LAS unsigned char* kbuf, const bf16x8* qr, int r32, int hi) {
    p0 = f32x16{}; p1 = f32x16{};
    const LAS unsigned char* kb = kbuf + hi * 1024 + r32 * 16;
#pragma unroll
    for (int d0 = 0; d0 < D / 16; ++d0) {
        const bf16x8 b0 = *(const LAS bf16x8*)(kb + d0 * 2048), b1 = *(const LAS bf16x8*)(kb + d0 * 2048 + 512);
        p0 = __builtin_amdgcn_mfma_f32_32x32x16_bf16(b0, qr[d0], p0, 0, 0, 0);
        p1 = __builtin_amdgcn_mfma_f32_32x32x16_bf16(b1, qr[d0], p1, 0, 0, 0); }
}
__device__ __forceinline__ s16x4 vtr(const LAS unsigned char* p) { return __builtin_bit_cast(s16x4, __builtin_amdgcn_ds_read_tr16_b64_v4i16((LAS v4i16_t*)p)); }
template <int D> __device__ __forceinline__ void pv(f32x16* o, const LAS unsigned char* vbuf, const bf16x8* pa, int lane) {
    const LAS unsigned char* vb = vbuf + ((lane >> 4) & 1) * 32 + (lane & 3) * 8 + (4 * (lane >> 5) + ((lane & 15) >> 2)) * 64;
#pragma unroll
    for (int dp = 0; dp < D / 64; ++dp) {
        s16x4 lo[2][4], hh[2][4];
#pragma unroll
        for (int e = 0; e < 2; ++e)
#pragma unroll
            for (int ks = 0; ks < 4; ++ks) { lo[e][ks] = vtr(vb + (2 * dp + e) * 4096 + ks * 1024); hh[e][ks] = vtr(vb + (2 * dp + e) * 4096 + ks * 1024 + 512); }
        __builtin_amdgcn_sched_barrier(0);
#pragma unroll
        for (int e = 0; e < 2; ++e)
#pragma unroll
            for (int ks = 0; ks < 4; ++ks) { const bf16x8 vf = {lo[e][ks][0], lo[e][ks][1], lo[e][ks][2], lo[e][ks][3], hh[e][ks][0], hh[e][ks][1], hh[e][ks][2], hh[e][ks][3]};
                o[2 * dp + e] = __builtin_amdgcn_mfma_f32_32x32x16_bf16(vf, pa[ks], o[2 * dp + e], 0, 0, 0); }
    }
}
__device__ __forceinline__ float xhalf_max(float v) { auto rr = __builtin_amdgcn_permlane32_swap(__float_as_uint(v), __float_as_uint(v), false, false); return fmaxf(__uint_as_float(rr[0]), __uint_as_float(rr[1])); }
__device__ __forceinline__ float xhalf_sum(float v) { auto rr = __builtin_amdgcn_permlane32_swap(__float_as_uint(v), __float_as_uint(v), false, false); return __uint_as_float(rr[0]) + __uint_as_float(rr[1]); }
typedef float f32x2_cv __attribute__((ext_vector_type(2))); typedef __bf16 bf16x2_cv __attribute__((ext_vector_type(2)));
__device__ __forceinline__ unsigned cvtpk(float lo, float hi) { f32x2_cv v = {lo, hi}; bf16x2_cv b = __builtin_convertvector(v, bf16x2_cv); return __builtin_bit_cast(unsigned, b); }
__device__ __forceinline__ bf16x8 pack8(const f32x16& p, int b) { u32x4_t w = {cvtpk(p[b], p[b + 1]), cvtpk(p[b + 2], p[b + 3]), cvtpk(p[b + 4], p[b + 5]), cvtpk(p[b + 6], p[b + 7])}; return __builtin_bit_cast(bf16x8, w); }
__device__ __forceinline__ float rowmax32(const f32x16& p0, const f32x16& p1) {
    float a = fmaxf(p0[0], p1[0]);
#pragma unroll
    for (int r = 1; r < 16; ++r) a = fmaxf(a, fmaxf(p0[r], p1[r]));
    return xhalf_max(a);
}
__device__ __forceinline__ void mask_band(f32x16& p0, f32x16& p1, int dq, unsigned band) {
#pragma unroll
    for (int r = 0; r < 16; ++r) { const int c = (r & 3) + 8 * (r >> 2);
        if ((unsigned)(dq - c) > band) p0[r] = NEGINF;
        if ((unsigned)(dq - c - 32) > band) p1[r] = NEGINF; }
}
constexpr float THR = 10.f;
template <int D> struct State { float m; int cls, tc; f32x16 ci; f32x16 o[D / 32]; f32x16 ol; };
template <int D> __device__ __forceinline__ void state_reset(State<D>& st) { st.m = 0.f; st.cls = -1; st.tc = 0; st.ci = f32x16{}; st.ol = f32x16{};
#pragma unroll
    for (int i = 0; i < D / 32; ++i) st.o[i] = f32x16{}; }
__device__ __forceinline__ f32x16 mfma3(bf16x8 a, bf16x8 b, const f32x16& c) { f32x16 d; asm volatile("v_mfma_f32_32x32x16_bf16 %0, %1, %2, %3" : "=&v"(d) : "v"(a), "v"(b), "v"(c)); return d; }
template <int D> __device__ __forceinline__ void qkt_c(f32x16& p0, f32x16& p1, const LAS unsigned char* kbuf, const bf16x8* qr, int r32, int hi, const f32x16& c0, const f32x16& c1) {
    const LAS unsigned char* kb = kbuf + hi * 1024 + r32 * 16;
#pragma unroll
    for (int dc = 0; dc < D / 64; ++dc) {
        bf16x8 kf0[4], kf1[4];
#pragma unroll
        for (int e = 0; e < 4; ++e) { kf0[e] = *(const LAS bf16x8*)(kb + (4 * dc + e) * 2048); kf1[e] = *(const LAS bf16x8*)(kb + (4 * dc + e) * 2048 + 512); }
        __builtin_amdgcn_sched_barrier(0);
        __builtin_amdgcn_s_setprio(1);
#pragma unroll
        for (int e = 0; e < 4; ++e) { const int d0 = 4 * dc + e;
            if (d0 == 0) { p0 = mfma3(kf0[e], qr[d0], c0); p1 = mfma3(kf1[e], qr[d0], c1); }
            else { p0 = __builtin_amdgcn_mfma_f32_32x32x16_bf16(kf0[e], qr[d0], p0, 0, 0, 0); p1 = __builtin_amdgcn_mfma_f32_32x32x16_bf16(kf1[e], qr[d0], p1, 0, 0, 0); } }
        __builtin_amdgcn_s_setprio(0);
    }
}
__device__ __forceinline__ float rowmax32_3(const f32x16& p0, const f32x16& p1) {
    float a = fmaxf(fmaxf(p0[0], p0[1]), p1[0]), b = fmaxf(fmaxf(p0[2], p0[3]), p1[1]); a = fmaxf(fmaxf(a, p1[2]), p1[3]);
#pragma unroll
    for (int r = 4; r < 16; r += 4) { a = fmaxf(fmaxf(a, p0[r]), p0[r + 1]); b = fmaxf(fmaxf(b, p0[r + 2]), p0[r + 3]); a = fmaxf(fmaxf(a, p1[r]), p1[r + 1]); b = fmaxf(fmaxf(b, p1[r + 2]), p1[r + 3]); }
    return xhalf_max(fmaxf(a, b));
}
template <int D, class Pol> __device__ __forceinline__ void softmax_p(State<D>& st, const Pol& pol, f32x16& p0, f32x16& p1, bf16x8* pa) {
    const float mx = rowmax32_3(p0, p1);
    if (__builtin_expect(__any(mx > THR), 0)) {
        const float dl = fmaxf(mx, 0.f); st.m += dl; const float f = __builtin_amdgcn_exp2f(-dl);
#pragma unroll
        for (int r = 0; r < 16; ++r) { p0[r] -= dl; p1[r] -= dl; st.ol[r] *= f; }
#pragma unroll
        for (int i = 0; i < D / 32; ++i)
#pragma unroll
            for (int r = 0; r < 16; ++r) st.o[i][r] *= f;
        pol.build(st);
    }
#pragma unroll
    for (int r = 0; r < 16; ++r) { p0[r] = __builtin_amdgcn_exp2f(p0[r]); p1[r] = __builtin_amdgcn_exp2f(p1[r]); }
    pa[0] = pack8(p0, 0); pa[1] = pack8(p0, 8); pa[2] = pack8(p1, 0); pa[3] = pack8(p1, 8);
}
#ifndef SGB_XV
#define SGB_XV 0
#endif
template <int D, class Pol> __device__ __forceinline__ void softmax_head(State<D>& st, const Pol& pol, f32x16& p0, f32x16& p1) {
#ifdef MAX_STRIDE
    if ((st.tc++ & (MAX_STRIDE - 1)) != 0) return;
#endif
    const float mx = rowmax32_3(p0, p1);
    if (__builtin_expect(__any(mx > THR), 0)) {
        const float dl = fmaxf(mx, 0.f); st.m += dl; const float f = __builtin_amdgcn_exp2f(-dl);
#pragma unroll
        for (int r = 0; r < 16; ++r) { p0[r] -= dl; p1[r] -= dl; st.ol[r] *= f; }
#pragma unroll
        for (int i = 0; i < D / 32; ++i)
#pragma unroll
            for (int r = 0; r < 16; ++r) st.o[i][r] *= f;
        pol.build(st);
    }
}
template <int D, class Pol> __device__ __forceinline__ void exp_pv_manual(State<D>& st, const Pol& pol, int jc, f32x16& c0, f32x16& c1, const LAS unsigned char* vbuf, int lane) {
    constexpr int NE = D / 32, XE = 8 / NE;
    const LAS unsigned char* vb = vbuf + ((lane >> 4) & 1) * 32 + (lane & 3) * 8 + (4 * (lane >> 5) + ((lane & 15) >> 2)) * 64;
    const bf16x8 ones = {16256, 16256, 16256, 16256, 16256, 16256, 16256, 16256};
    s16x4 lo[2][NE], hh[2][NE];
#pragma unroll
    for (int e = 0; e < NE; ++e) { lo[0][e] = vtr(vb + e * 4096); hh[0][e] = vtr(vb + e * 4096 + 512); }
#pragma unroll
    for (int r = 0; r < 8; ++r) c0[r] = __builtin_amdgcn_exp2f(c0[r]);
    bf16x8 pk = pack8(c0, 0); pol.maskp1(jc, pk);
    __builtin_amdgcn_sched_barrier(0);
#pragma unroll
    for (int ks = 0; ks < 4; ++ks) {
        f32x16& src = (ks + 1) < 2 ? c0 : c1; const int base = 8 * ((ks + 1) & 1);
#pragma unroll
        for (int e = 0; e < NE; ++e) {
            const bf16x8 vf = {lo[ks & 1][e][0], lo[ks & 1][e][1], lo[ks & 1][e][2], lo[ks & 1][e][3], hh[ks & 1][e][0], hh[ks & 1][e][1], hh[ks & 1][e][2], hh[ks & 1][e][3]};
            st.o[e] = __builtin_amdgcn_mfma_f32_32x32x16_bf16(vf, pk, st.o[e], 0, 0, 0);
            if (ks < 3) { lo[(ks + 1) & 1][e] = vtr(vb + e * 4096 + (ks + 1) * 1024); hh[(ks + 1) & 1][e] = vtr(vb + e * 4096 + (ks + 1) * 1024 + 512);
#pragma unroll
                for (int x = 0; x < XE; ++x) src[base + e * XE + x] = __builtin_amdgcn_exp2f(src[base + e * XE + x]); }
            __builtin_amdgcn_sched_barrier(0);
        }
        st.ol = __builtin_amdgcn_mfma_f32_32x32x16_bf16(ones, pk, st.ol, 0, 0, 0);
        if (ks < 3) { pk = pack8(src, base); pol.maskp1(jc, pk); }
        __builtin_amdgcn_sched_barrier(0);
    }
}
template <int D> __device__ __forceinline__ void pv_all(State<D>& st, const bf16x8* pa, const LAS unsigned char* vbuf, int lane) {
    pv<D>(st.o, vbuf, pa, lane);
    const bf16x8 ones = {16256, 16256, 16256, 16256, 16256, 16256, 16256, 16256};
#pragma unroll
    for (int ks = 0; ks < 4; ++ks) st.ol = __builtin_amdgcn_mfma_f32_32x32x16_bf16(ones, pa[ks], st.ol, 0, 0, 0);
}
__device__ __forceinline__ void glds16(const void* gsrc, unsigned lds_dst) { unsigned keep;
    asm volatile("s_mov_b32 %0, m0\n\ts_mov_b32 m0, %2\n\ts_nop 0\n\tglobal_load_lds_dwordx4 %1, off\n\ts_mov_b32 m0, %0" : "=&s"(keep) : "v"(gsrc), "s"(lds_dst) : "memory"); }
template <int D> __device__ __forceinline__ void tile_dma(const bf16_t* Kp, const bf16_t* Vp, int pitch, unsigned kdst, unsigned vdst, int wid, int lane) {
#pragma unroll
    for (int i = 0; i < D / 64; ++i) { const int pc = wid + 8 * i;
        glds16(Kp + (size_t)lane * pitch + pc * 8, (unsigned)__builtin_amdgcn_readfirstlane(kdst + pc * 1024));
        glds16(Vp + (size_t)(16 * (pc & 3) + (lane >> 2)) * pitch + 32 * (pc >> 2) + 8 * (lane & 3), (unsigned)__builtin_amdgcn_readfirstlane(vdst + pc * 1024)); }
}
__device__ __forceinline__ void wait_lg_bar() { asm volatile("s_waitcnt lgkmcnt(0)\n\ts_barrier" ::: "memory"); }
template <int N> __device__ __forceinline__ void wait_vm_bar() { asm volatile("s_waitcnt vmcnt(%0) lgkmcnt(0)\n\ts_barrier" :: "i"(N) : "memory"); }
template <int D, class Pol> __device__ __forceinline__ void compute_tile(State<D>& st, const Pol& pol, int jc, const bf16x8* qr, const LAS unsigned char* kbuf, const LAS unsigned char* vbuf, int lane) {
    if (pol.active(jc)) {
        const int r32 = lane & 31, hi = lane >> 5;
        f32x16 c0, c1;
        pol.prep(jc, st);
        qkt_c<D>(c0, c1, kbuf, qr, r32, hi, st.ci, st.ci); pol.postmask(jc, c0, c1);
#ifdef MAN_PV
        softmax_head<D, Pol>(st, pol, c0, c1); exp_pv_manual<D, Pol>(st, pol, jc, c0, c1, vbuf, lane);
#else
        bf16x8 pa[4]; softmax_p<D, Pol>(st, pol, c0, c1, pa); pol.maskp(jc, pa); pv_all<D>(st, pa, vbuf, lane);
#endif
    }
}
template <int D, class Pol> __device__ __forceinline__ void run_branch(State<D>& st, const Pol& pol, const bf16x8* qr, LAS unsigned char* lds, int wid, int lane) {
    constexpr int SLOT = 256 * D, NI = 2 * (D / 64);
    const unsigned lds0 = (unsigned)(size_t)lds;
    int jc = pol.first(), jn = pol.next(jc), jnn = jn >= 0 ? pol.next(jn) : -1;
    tile_dma<D>(pol.kptr(jc), pol.vptr(jc), pol.pitch, lds0, lds0 + SLOT / 2, wid, lane);
    if (jn >= 0) { tile_dma<D>(pol.kptr(jn), pol.vptr(jn), pol.pitch, lds0 + SLOT, lds0 + SLOT + SLOT / 2, wid, lane); wait_vm_bar<NI>(); } else wait_vm_bar<0>();
    int sc = 0;
    for (;;) {
        const int s2 = sc == 0 ? 2 : sc - 1;
#ifdef DMA_LATE
        compute_tile<D, Pol>(st, pol, jc, qr, lds + sc * SLOT, lds + sc * SLOT + SLOT / 2, lane);
        if (jnn >= 0) tile_dma<D>(pol.kptr(jnn), pol.vptr(jnn), pol.pitch, lds0 + s2 * SLOT, lds0 + s2 * SLOT + SLOT / 2, wid, lane);
#else
        if (jnn >= 0) tile_dma<D>(pol.kptr(jnn), pol.vptr(jnn), pol.pitch, lds0 + s2 * SLOT, lds0 + s2 * SLOT + SLOT / 2, wid, lane);
        compute_tile<D, Pol>(st, pol, jc, qr, lds + sc * SLOT, lds + sc * SLOT + SLOT / 2, lane);
#endif
        if (jn < 0) { wait_vm_bar<0>(); break; }
        if (jnn >= 0) wait_vm_bar<NI>(); else wait_vm_bar<0>();
        sc = sc == 2 ? 0 : sc + 1; jc = jn; jn = jnn; jnn = jn >= 0 ? pol.next(jn) : -1;
    }
}
__device__ __forceinline__ f32x16 splat16(float v) { f32x16 c;
#pragma unroll
    for (int r = 0; r < 16; ++r) c[r] = v;
    return c; }

constexpr int L_IMPA = 65536, L_IMPB = L_IMPA + 4 * 64 * 33 * 4, L_SC = L_IMPB + 4 * 64 * 33 * 4, L_SELM = L_SC + 64 * 33 * 4, L_ORM = L_SELM + 256;
static_assert(L_ORM + 16 <= 143360, "attention LDS map");

struct NsaPtrs { unsigned char* ws;
    __device__ __forceinline__ const bf16_t* QA() const { return (const bf16_t*)(ws + WS_QA); }
    __device__ __forceinline__ const bf16_t* KS() const { return (const bf16_t*)(ws + WS_KC + 2 * 8 * MiB); }
    __device__ __forceinline__ const bf16_t* VS() const { return (const bf16_t*)(ws + WS_KC + 3 * 8 * MiB); }
    __device__ __forceinline__ const bf16_t* KW() const { return (const bf16_t*)(ws + WS_KC + 4 * 8 * MiB); }
    __device__ __forceinline__ const bf16_t* VW() const { return (const bf16_t*)(ws + WS_KC + 5 * 8 * MiB); }
    __device__ __forceinline__ const bf16_t* KCC() const { return (const bf16_t*)(ws + WS_KCC); }
    __device__ __forceinline__ const bf16_t* VCC() const { return (const bf16_t*)(ws + WS_VCC); }
    __device__ __forceinline__ const bf16_t* GA() const { return (const bf16_t*)(ws + WS_GA); }
    __device__ __forceinline__ const bf16_t* ZA() const { return (const bf16_t*)(ws + WS_ZA); }
    __device__ __forceinline__ bf16_t* A2() const { return (bf16_t*)(ws + WS_A2); } };

__device__ __forceinline__ void nsa_unit(const NsaPtrs& P, int b, int g, int qt, LAS unsigned char* lds
#if DBG
    , unsigned* selout
#endif
    ) {
    int tid = threadIdx.x; asm volatile("" : "+v"(tid));
    const int lane = tid & 63, r32 = lane & 31, hi = lane >> 5; const int wid = __builtin_amdgcn_readfirstlane(tid >> 6);
    const int hh = 4 * g + (wid & 3), th = wid >> 2;
    const int tok = 64 * qt + 32 * th + r32; const size_t mrow = (size_t)b * SEQ + tok;
    bf16x8 qr[4];
#pragma unroll
    for (int d0 = 0; d0 < 4; ++d0) qr[d0] = *(const bf16x8*)(P.QA() + mrow * 1024 + hh * 64 + d0 * 16 + hi * 8);
    const float g0 = bf2f(P.GA()[mrow * 64 + hh * 3 + 0]), g1 = bf2f(P.GA()[mrow * 64 + hh * 3 + 1]), g2 = bf2f(P.GA()[mrow * 64 + hh * 3 + 2]);
    f32x16 otot[2] = {f32x16{}, f32x16{}};
    Tile<64> T; State<64> st;
    LAS float* SC = (LAS float*)(lds + L_SC); LAS unsigned* SELM = (LAS unsigned*)(lds + L_SELM); LAS unsigned* ORM = (LAS unsigned*)(lds + L_ORM);
    {
        const bf16_t* Kc = P.KCC() + (size_t)(b * 4 + g) * 128 * 64; const bf16_t* Vc = P.VCC() + (size_t)(b * 4 + g) * 128 * 64;
        const bool two = qt >= 16;
        tile_load<64>(T, Kc, Vc, 64, wid, lane); tile_store<64>(T, (lds + L_K0), (lds + L_V0), wid, lane);
        if (two) { tile_load<64>(T, Kc + 64 * 64, Vc + 64 * 64, 64, wid, lane); tile_store<64>(T, (lds + L_K1), (lds + L_V1), wid, lane); }
        __syncthreads();
        f32x16 pA0, pA1, pB0, pB1;
        qkt<64>(pA0, pA1, (lds + L_K0), qr, r32, hi);
        const int cmax = (tok - 31) >> 4;
        mask_band(pA0, pA1, cmax - 4 * hi, 0x7fffffffu);
        float mx = rowmax32(pA0, pA1);
        if (two) { qkt<64>(pB0, pB1, (lds + L_K1), qr, r32, hi); mask_band(pB0, pB1, cmax - 64 - 4 * hi, 0x7fffffffu); mx = fmaxf(mx, rowmax32(pB0, pB1)); }
        if (mx == NEGINF) mx = 0.f;
        float s = 0.f;
#pragma unroll
        for (int r = 0; r < 16; ++r) { pA0[r] = __builtin_amdgcn_exp2f(pA0[r] - mx); pA1[r] = __builtin_amdgcn_exp2f(pA1[r] - mx); s += pA0[r] + pA1[r]; }
        if (two) {
#pragma unroll
            for (int r = 0; r < 16; ++r) { pB0[r] = __builtin_amdgcn_exp2f(pB0[r] - mx); pB1[r] = __builtin_amdgcn_exp2f(pB1[r] - mx); s += pB0[r] + pB1[r]; }
        }
        s = xhalf_sum(s);
        const float inv_l = s > 0.f ? 1.f / s : 0.f;
        if (two) {
        LAS float* IA = (LAS float*)(lds + L_IMPA) + ((wid & 3) * 64 + 32 * th + r32) * 33; LAS float* IB = (LAS float*)(lds + L_IMPB) + ((wid & 3) * 64 + 32 * th + r32) * 33;
#define IMP_ONE(PX, Tt, Pp) _Pragma("unroll") for (int u = 0; u < 4; ++u) { const int k = 16 * (Tt) + 8 * (Pp) + 2 * u + hi; const float h3 = 0.5f * PX[4 * u + 3]; \
            IA[k] = ((PX[4 * u] + PX[4 * u + 1]) + (PX[4 * u + 2] + h3)) * inv_l; IB[k] = h3 * inv_l; }
        IMP_ONE(pA0, 0, 0) IMP_ONE(pA1, 0, 1) IMP_ONE(pB0, 1, 0) IMP_ONE(pB1, 1, 1)
#undef IMP_ONE
        }
        { bf16x8 pa[4] = {pack8(pA0, 0), pack8(pA0, 8), pack8(pA1, 0), pack8(pA1, 8)}; pv<64>(otot, (lds + L_V0), pa, lane); }
        if (two) { bf16x8 pa[4] = {pack8(pB0, 0), pack8(pB0, 8), pack8(pB1, 0), pack8(pB1, 8)}; pv<64>(otot, (lds + L_V1), pa, lane); }
        const float w = g0 * inv_l;
#pragma unroll
        for (int i = 0; i < 2; ++i)
#pragma unroll
            for (int r = 0; r < 16; ++r) otot[i][r] *= w;
    }
    if (qt < 16) { __syncthreads(); }
    else { const int tt = tid & 63, jg = tid >> 6;
        if (jg == 0) SELM[tt] = 0u; if (tid == 0) ORM[0] = 0u;
        __syncthreads();
        const LAS float* IA = (const LAS float*)(lds + L_IMPA); const LAS float* IB = (const LAS float*)(lds + L_IMPB);
        const int T_ = 64 * qt + tt;
#pragma unroll
        for (int jj = 0; jj < 4; ++jj) { const int j = 4 * jg + jj; float imp = 0.f;
#pragma unroll
            for (int h = 0; h < 4; ++h) { float v = IA[(h * 64 + tt) * 33 + j]; if (j > 0) v += IB[(h * 64 + tt) * 33 + j - 1]; imp += v; }
            const bool valid = 64 * j <= T_; const bool forced = valid && (j == 0 || j == qt || j == qt - 1);
            SC[tt * 33 + j] = valid ? imp + (forced ? 1.0e4f : 0.f) : -1e30f; }
        __syncthreads();
        unsigned bits = 0u;
        {
            float sj[4]; int rank[4] = {0, 0, 0, 0}; unsigned eq[4] = {0u, 0u, 0u, 0u};
#pragma unroll
            for (int jj = 0; jj < 4; ++jj) sj[jj] = SC[tt * 33 + 4 * jg + jj];
#pragma unroll 1
            for (int kh = 0; kh < 4; ++kh) {
                float sk[8];
#pragma unroll
                for (int k = 0; k < 8; ++k) sk[k] = SC[tt * 33 + 8 * kh + k];
#pragma unroll
                for (int jj = 0; jj < 4; ++jj)
#pragma unroll
                    for (int k = 0; k < 8; ++k) { rank[jj] += (sk[k] > sj[jj]) ? 1 : 0; eq[jj] |= (sk[k] == sj[jj]) ? (1u << (8 * kh + k)) : 0u; }
            }
#pragma unroll
            for (int jj = 0; jj < 4; ++jj) { const int j = 4 * jg + jj; const unsigned lt = (1u << j) - 1u;
                if (rank[jj] + __builtin_popcount(eq[jj] & lt) < 16) bits |= 1u << j; }
        }
        atomicOr((unsigned*)&SELM[tt], bits); atomicOr((unsigned*)&ORM[0], bits);
        __syncthreads();
    }
    const unsigned causal_bits = (qt == 31) ? 0xffffffffu : ((2u << qt) - 1u);
    const unsigned selbits = qt < 16 ? causal_bits : SELM[32 * th + r32];
#if DBG
    if (tid < 64) selout[((size_t)b * SEQ + 64 * qt + tid) * 4 + g] = qt < 16 ? causal_bits : SELM[tid];
#endif
    unsigned need = qt < 16 ? causal_bits : ((unsigned)__builtin_amdgcn_readfirstlane(ORM[0]) & causal_bits);
    {
        struct SelPol { const bf16_t* Kg; const bf16_t* Vg; int pitch; unsigned need, selbits; int qt, tok4;
            __device__ __forceinline__ int first() const { return __builtin_ctz(need); }
            __device__ __forceinline__ int next(int j) const { const unsigned r = j >= 31 ? 0u : (need & ~((2u << j) - 1u)); return r ? __builtin_ctz(r) : -1; }
            __device__ __forceinline__ const bf16_t* kptr(int j) const { return Kg + (size_t)64 * j * 256; }
            __device__ __forceinline__ const bf16_t* vptr(int j) const { return Vg + (size_t)64 * j * 256; }
            __device__ __forceinline__ bool active(int j) const { return __any((selbits >> j) & 1u); }
            __device__ __forceinline__ void prep(int, State<64>&) const {}
            __device__ __forceinline__ void build(State<64>& st) const { st.ci = splat16(-st.m); }
            __device__ __forceinline__ void maskp(int j, bf16x8* pa) const { const unsigned km = ((selbits >> j) & 1u) ? 0xffffffffu : 0u;
#pragma unroll
                for (int k = 0; k < 4; ++k) { u32x4_t w = __builtin_bit_cast(u32x4_t, pa[k]); w &= km; pa[k] = __builtin_bit_cast(bf16x8, w); } }
            __device__ __forceinline__ void maskp1(int j, bf16x8& f) const { const unsigned km = ((selbits >> j) & 1u) ? 0xffffffffu : 0u; u32x4_t w = __builtin_bit_cast(u32x4_t, f); w &= km; f = __builtin_bit_cast(bf16x8, w); }
            __device__ __forceinline__ void postmask(int j, f32x16& p0, f32x16& p1) const { if (j == qt) mask_band(p0, p1, tok4 - 64 * j, 0x7fffffffu); } };
        SelPol pol{P.KS() + (size_t)b * SEQ * 256 + g * 64, P.VS() + (size_t)b * SEQ * 256 + g * 64, 256, need, selbits, qt, tok - 4 * hi};
        state_reset<64>(st);
        run_branch<64, SelPol>(st, pol, qr, lds, wid, lane);
        const float w = g1 / st.ol[0];
#pragma unroll
        for (int i = 0; i < 2; ++i)
#pragma unroll
            for (int r = 0; r < 16; ++r) otot[i][r] += st.o[i][r] * w;
    }
    {
        struct WinPol { const bf16_t* Kg; const bf16_t* Vg; int pitch; int qt, jlo, tok4;
            __device__ __forceinline__ int first() const { return jlo; }
            __device__ __forceinline__ int next(int j) const { return j < qt ? j + 1 : -1; }
            __device__ __forceinline__ const bf16_t* kptr(int j) const { return Kg + (size_t)64 * j * 256; }
            __device__ __forceinline__ const bf16_t* vptr(int j) const { return Vg + (size_t)64 * j * 256; }
            __device__ __forceinline__ bool active(int) const { return true; }
            __device__ __forceinline__ void prep(int, State<64>&) const {}
            __device__ __forceinline__ void build(State<64>& st) const { st.ci = splat16(-st.m); }
            __device__ __forceinline__ void maskp(int, bf16x8*) const {}
            __device__ __forceinline__ void maskp1(int, bf16x8&) const {}
            __device__ __forceinline__ void postmask(int j, f32x16& p0, f32x16& p1) const { if (j == qt || j == qt - 8) mask_band(p0, p1, tok4 - 64 * j, 511u); } };
        WinPol pol{P.KW() + (size_t)b * SEQ * 256 + g * 64, P.VW() + (size_t)b * SEQ * 256 + g * 64, 256, qt, qt >= 8 ? qt - 8 : 0, tok - 4 * hi};
        state_reset<64>(st);
        run_branch<64, WinPol>(st, pol, qr, lds, wid, lane);
        const float w = g2 / st.ol[0];
#pragma unroll
        for (int i = 0; i < 2; ++i)
#pragma unroll
            for (int r = 0; r < 16; ++r) otot[i][r] += st.o[i][r] * w;
    }
    {
        LAS float* stg = (LAS float*)(lds + 65536 + wid * 8192);
#pragma unroll
        for (int db = 0; db < 2; ++db)
#pragma unroll
            for (int u = 0; u < 4; ++u) { const int d = 32 * db + 8 * u + 4 * hi;
                *(LAS f32x4_t*)(stg + r32 * 64 + (d ^ ((r32 & 7) << 3))) = (f32x4_t){otot[db][4 * u], otot[db][4 * u + 1], otot[db][4 * u + 2], otot[db][4 * u + 3]}; }
        asm volatile("s_waitcnt lgkmcnt(0)" ::: "memory");
        const size_t row0 = (size_t)b * SEQ + 64 * qt + 32 * th;
#pragma unroll
        for (int i = 0; i < 4; ++i) { const int row = 8 * i + (lane >> 3), ch = lane & 7, d = 8 * ch;
            const f32x4_t a = *(const LAS f32x4_t*)(stg + row * 64 + (d ^ ((row & 7) << 3))), c = *(const LAS f32x4_t*)(stg + row * 64 + ((d + 4) ^ ((row & 7) << 3)));
            const u32x4_t z = *(const u32x4_t*)(P.ZA() + (row0 + row) * 1024 + hh * 64 + d);
            u32x4_t w; w.x = cvtpk(a[0] * bflo(z.x), a[1] * bfhi(z.x)); w.y = cvtpk(a[2] * bflo(z.y), a[3] * bfhi(z.y)); w.z = cvtpk(c[0] * bflo(z.z), c[1] * bfhi(z.z)); w.w = cvtpk(c[2] * bflo(z.w), c[3] * bfhi(z.w));
            *(u32x4_t*)(P.A2() + (row0 + row) * 2048 + hh * 64 + d) = w; }
    }
}

struct MixPtrs { unsigned char* ws;
    __device__ __forceinline__ const bf16_t* QB() const { return (const bf16_t*)(ws + WS_QB); }
    __device__ __forceinline__ const bf16_t* KB() const { return (const bf16_t*)(ws + WS_KB); }
    __device__ __forceinline__ const bf16_t* VB() const { return (const bf16_t*)(ws + WS_VB); }
    __device__ __forceinline__ const bf16_t* ZB() const { return (const bf16_t*)(ws + WS_ZB); }
    __device__ __forceinline__ bf16_t* A2() const { return (bf16_t*)(ws + WS_A2); } };
__device__ __forceinline__ void mixb_unit(const MixPtrs& P, int b, int h, int a, LAS unsigned char* lds) {
    int tid = threadIdx.x; asm volatile("" : "+v"(tid));
    const int lane = tid & 63, r32 = lane & 31, hi = lane >> 5; const int wid = __builtin_amdgcn_readfirstlane(tid >> 6);
    const int tok = 256 * a + 32 * wid + r32; const size_t mrow = (size_t)b * SEQ + tok;
    bf16x8 qr[8];
#pragma unroll
    for (int d0 = 0; d0 < 8; ++d0) qr[d0] = *(const bf16x8*)(P.QB() + mrow * 1024 + h * 128 + d0 * 16 + hi * 8);
    const int E16 = (tok - 4 * hi) & 15;
    bool is16[8], is4[4];
#pragma unroll
    for (int i = 0; i < 8; ++i) is16[i] = E16 == ((i & 3) + 8 * (i >> 2));
#pragma unroll
    for (int i = 0; i < 4; ++i) is4[i] = (E16 & 3) == i;
    const bf16_t* Kg = P.KB() + (size_t)b * SEQ * 1024 + h * 128; const bf16_t* Vg = P.VB() + (size_t)b * SEQ * 1024 + h * 128;
    State<128> st; state_reset<128>(st);
    struct MixPol { const bf16_t* Kg; const bf16_t* Vg; int pitch; int nt, wlast, wbase, tok4; bool i16[8], i4[4];
        __device__ __forceinline__ int first() const { return 0; }
        __device__ __forceinline__ int next(int j) const { return j + 1 < nt ? j + 1 : -1; }
        __device__ __forceinline__ const bf16_t* kptr(int j) const { return Kg + (size_t)64 * j * 1024; }
        __device__ __forceinline__ const bf16_t* vptr(int j) const { return Vg + (size_t)64 * j * 1024; }
        __device__ __forceinline__ bool active(int j) const { return j <= wlast; }
        __device__ __forceinline__ int cls(int j) const { const int wlo = wbase - 64 * j, dmin = wlo - 63, dmax = wlo + 31;
            return dmin > 512 ? 0 : (dmin > 128 && dmax <= 512) ? 1 : dmin < 0 ? 3 : dmax <= 128 ? 2 : dmax <= 512 ? 4 : 5; }
        __device__ __forceinline__ void build(State<128>& st) const { const int c = st.cls; const float m = st.m;
            if (c == 0) {
#pragma unroll
                for (int r = 0; r < 16; ++r) st.ci[r] = i16[(r & 3) + 4 * ((r >> 2) & 1)] ? -m : NEGINF;
            } else if (c == 1) {
#pragma unroll
                for (int r = 0; r < 16; ++r) st.ci[r] = i4[r & 3] ? (i16[(r & 3) + 4 * ((r >> 2) & 1)] ? 1.f - m : -m) : NEGINF;
            } else if (c == 2 || c == 3) {
#pragma unroll
                for (int r = 0; r < 16; ++r) st.ci[r] = i16[(r & 3) + 4 * ((r >> 2) & 1)] ? 1.5849625007f - m : (i4[r & 3] ? 1.f - m : -m);
            } else st.ci = splat16(-m); }
        __device__ __forceinline__ void prep(int j, State<128>& st) const { const int c = cls(j); if (c != st.cls) { st.cls = c; build(st); } }
        __device__ __forceinline__ void maskp(int, bf16x8*) const {}
        __device__ __forceinline__ void maskp1(int, bf16x8&) const {}
        __device__ __forceinline__ void postmask(int j, f32x16& p0, f32x16& p1) const {
            const int c = cls(j);
            if (c < 3) return;
            const int e = tok4 - 64 * j;
            if (c == 3) { mask_band(p0, p1, e, 0x7fffffffu); return; }
            const int thr = c == 4 ? 128 : 512;
#pragma unroll
            for (int r = 0; r < 16; ++r) { const bool b16 = i16[(r & 3) + 4 * ((r >> 2) & 1)], b4 = i4[r & 3]; const int cc = (r & 3) + 8 * (r >> 2);
                const float vnear = b16 ? 1.5849625007f : (b4 ? 1.f : 0.f), vmid = b4 ? (b16 ? 1.f : 0.f) : NEGINF, vfar = b16 ? 0.f : NEGINF;
                const float lo = c == 4 ? vnear : vmid, hi_ = c == 4 ? vmid : vfar;
                p0[r] += (e - cc <= thr) ? lo : hi_; p1[r] += (e - cc - 32 <= thr) ? lo : hi_; } } };
    MixPol pol{Kg, Vg, 1024, 4 * a + 4, 4 * a + (wid >> 1), 256 * a + 32 * wid, tok - 4 * hi, {is16[0], is16[1], is16[2], is16[3], is16[4], is16[5], is16[6], is16[7]}, {is4[0], is4[1], is4[2], is4[3]}};
    run_branch<128, MixPol>(st, pol, qr, lds, wid, lane);
    const float inv_l = 1.f / st.ol[0];
#pragma unroll
    for (int db = 0; db < 4; ++db)
#pragma unroll
        for (int u = 0; u < 4; ++u) { const int d = 32 * db + 8 * u + 4 * hi;
            const u32x2_t z = *(const u32x2_t*)(P.ZB() + mrow * 1024 + h * 128 + d);
            u32x2_t w; w.x = cvtpk(st.o[db][4 * u] * inv_l * bflo(z.x), st.o[db][4 * u + 1] * inv_l * bfhi(z.x)); w.y = cvtpk(st.o[db][4 * u + 2] * inv_l * bflo(z.y), st.o[db][4 * u + 3] * inv_l * bfhi(z.y));
            *(u32x2_t*)(P.A2() + mrow * 2048 + 1024 + h * 128 + d) = w; }
}
}
typedef GAS unsigned gu32;
#define RLX_AGENT __ATOMIC_RELAXED, __HIP_MEMORY_SCOPE_AGENT
#define LDS_WAIT() asm volatile("s_waitcnt lgkmcnt(0)" ::: "memory")
#define VM_WAIT() asm volatile("s_waitcnt vmcnt(0)" ::: "memory")
#define XB_TMO      128
#define XB_XCNT(j)  (256  + 64 * (j))
#define XB_XSUB(j)  (1280 + 64 * (j))
#define XB_XGEN(j)  (2304 + 64 * (j))
#define XB_TOP      3328
#define XB_TOPGEN   3392
#define XCD_BAR_WORDS 3456
#define XB_SPIN_CAP (1u << 18)
__device__ __forceinline__ unsigned xb_ld(unsigned* p)              { return __hip_atomic_load(p, __ATOMIC_RELAXED, __HIP_MEMORY_SCOPE_AGENT); }
__device__ __forceinline__ unsigned xb_add(unsigned* p, unsigned v) { return __hip_atomic_fetch_add(p, v, __ATOMIC_RELAXED, __HIP_MEMORY_SCOPE_AGENT); }
__device__ __forceinline__ unsigned xb_xcc_id() { return (unsigned)__builtin_amdgcn_s_getreg((3 << 11) | 20) & 0xFu; }
#define XB_SPIN(cond, bar) do { unsigned _sp = 0; while (cond) { __builtin_amdgcn_s_sleep(1); \
    if ((++_sp & 255u) == 0u) { if (xb_ld(&(bar)[XB_TMO])) break; if (_sp > XB_SPIN_CAP) { atomicAdd(&(bar)[XB_TMO], 1u); break; } } } } while (0)
struct XcdBarrier { unsigned* bar; unsigned x; volatile LAS unsigned* st; };
__device__ __forceinline__ XcdBarrier xcd_barrier_post(unsigned* bar, volatile LAS unsigned* st) {
    XcdBarrier b; b.bar = bar; b.x = xb_xcc_id(); b.st = st;
    if (threadIdx.x == 0) (void)xb_add(&bar[XB_XCNT(b.x)], 1u);
    return b;
}
__device__ __forceinline__ void xcd_barrier_complete(unsigned* bar, unsigned x, unsigned& nloc, unsigned& nx) {
    const unsigned G = gridDim.x * gridDim.y * gridDim.z;
    unsigned sum, cnt, mine, sp = 0u;
    for (;;) {
        sum = 0u; cnt = 0u; mine = 0u;
#pragma unroll
        for (unsigned j = 0; j < 16; ++j) { const unsigned c = xb_ld(&bar[XB_XCNT(j)]); sum += c; cnt += (c > 0u) ? 1u : 0u; mine = (j == x) ? c : mine; }
        if (sum == G) break;
        __builtin_amdgcn_s_sleep(1);
        if ((++sp & 255u) == 0u) { if (xb_ld(&bar[XB_TMO])) break; if (sp > XB_SPIN_CAP) { atomicAdd(&bar[XB_TMO], 1u); break; } }
    }
    nloc = mine > 0u ? mine : 1u; nx = cnt > 0u ? cnt : 1u;
}
__device__ __forceinline__ void xcd_barrier(const XcdBarrier& b) {
    asm volatile("s_waitcnt vmcnt(0)" ::: "memory");
    __syncthreads();
    if (threadIdx.x == 0) {
        unsigned* bar = b.bar;
        __builtin_amdgcn_s_waitcnt(0);
        unsigned nloc = b.st[0], nx = b.st[1];
        if (nloc == 0u) { xcd_barrier_complete(bar, b.x, nloc, nx); b.st[0] = nloc; b.st[1] = nx; }
        const unsigned old = xb_add(&bar[XB_XSUB(b.x)], 1u);
        const unsigned gen = old / nloc;
        if (old + 1u == (gen + 1u) * nloc) {
            __builtin_amdgcn_fence(__ATOMIC_RELEASE, "agent");
            asm volatile("s_waitcnt vmcnt(0)" ::: "memory");
            const unsigned og = xb_add(&bar[XB_TOP], 1u);
            const unsigned tg = og / nx;
            if (og + 1u == (tg + 1u) * nx) xb_add(&bar[XB_TOPGEN], 1u);
            else XB_SPIN(xb_ld(&bar[XB_TOPGEN]) == tg, bar);
            __builtin_amdgcn_fence(__ATOMIC_ACQUIRE, "agent");
            xb_add(&bar[XB_XGEN(b.x)], 1u);
            asm volatile("s_waitcnt vmcnt(0)" ::: "memory");
        } else {
            XB_SPIN(xb_ld(&bar[XB_XGEN(b.x)]) == gen, bar);
            __builtin_amdgcn_fence(__ATOMIC_ACQUIRE, "agent");
            asm volatile("s_waitcnt vmcnt(0)" ::: "memory");
        }
    }
    __syncthreads();
}

struct Frame {
    LAS unsigned char* lds; int tid, lane, wave, G, vcu;
    const float *x, *c; const int* pos; const float *w_ada, *b_ada, *g_pre, *g_post, *w_in, *pe_ck, *pe_cv, *w_ck1, *w_ck2, *w_cv1, *w_cv2, *w_br_a, *w_br_b, *w_out;
    unsigned char* ws; unsigned char* dout;
};
__device__ __forceinline__ float wave_sum(float v) {
#pragma unroll
    for (int o = 1; o < 64; o <<= 1) v += __shfl_xor(v, o);
    return v;
}
__device__ __forceinline__ void p0_ada(Frame& F) {
    float* ada = (float*)(F.ws + WS_ADA);
    LAS float* red = (LAS float*)F.lds;
    LAS float* cT = (LAS float*)(F.lds + 69632);
    int tid0 = threadIdx.x; asm volatile("" : "+v"(tid0));
    for (int i = tid0; i < 8 * DM; i += 512) cT[(i & (DM - 1)) * 8 + (i >> 11)] = F.c[i];
    __syncthreads();
    for (int cg = blockIdx.x; cg < 256; cg += F.G) {
        const int tid = tid0, kk = tid / 6, c4 = tid % 6; const bool on = tid < 510;
        f32x4_t acc[8];
#pragma unroll
        for (int b = 0; b < 8; ++b) acc[b] = (f32x4_t){0.f, 0.f, 0.f, 0.f};
        if (on) for (int k0 = kk; k0 < DM; k0 += 85 * 13) {
            f32x4_t w[13];
#pragma unroll
            for (int u = 0; u < 13; ++u) { const int k = k0 + 85 * u; w[u] = k < DM ? *(const f32x4_t*)(F.w_ada + (size_t)k * 6144 + 24 * cg + 4 * c4) : (f32x4_t){0.f, 0.f, 0.f, 0.f}; }
#pragma unroll
            for (int u = 0; u < 13; ++u) { const int k = k0 + 85 * u < DM ? k0 + 85 * u : 0;
                const f32x4_t ca = *(const LAS f32x4_t*)(cT + k * 8), cb = *(const LAS f32x4_t*)(cT + k * 8 + 4);
#pragma unroll
                for (int b = 0; b < 4; ++b) { acc[b] += w[u] * ca[b]; acc[4 + b] += w[u] * cb[b]; } }
        }
        if (on) {
#pragma unroll
            for (int b = 0; b < 8; ++b)
#pragma unroll
                for (int e = 0; e < 4; ++e) red[tid * 33 + b * 4 + e] = acc[b][e];
        }
        __syncthreads();
        if (tid < 192) { const int b = tid / 24, col = tid % 24, cc4 = col >> 2, e = col & 3; float s = 0.f;
            for (int q = 0; q < 85; ++q) s += red[(q * 6 + cc4) * 33 + b * 4 + e];
            ada[b * 6144 + 24 * cg + col] = s + F.b_ada[24 * cg + col]; }
        __syncthreads();
    }
}
template <bool REMAP> __device__ __forceinline__ int dst_row(int n) { if (!REMAP) return n; return n < 2560 ? n : (n < 2608 ? 11776 + (n - 2560) : n - 48); }
template <bool REMAP> __device__ __forceinline__ void p0_transpose_item(const float* W, int K, int N, bf16_t* WT, int ldt, int kofs, LAS float* scr, int item, int lane) {
    const int nblk = (N + 31) / 32, kb = item / nblk, nb = item % nblk, k0 = 64 * kb, n0 = 32 * nb;
    const bool cok = n0 + (lane & 31) < N;
    float tv[32];
#pragma unroll
    for (int i = 0; i < 32; ++i) { const int kk = 2 * i + (lane >> 5); tv[i] = cok ? W[(size_t)(k0 + kk) * N + n0 + (lane & 31)] : 0.f; }
#pragma unroll
    for (int i = 0; i < 32; ++i) { const int kk = 2 * i + (lane >> 5); scr[kk * 33 + (lane & 31)] = tv[i]; }
    LDS_WAIT(); asm volatile("" ::: "memory");
    const int c = lane & 7;
#pragma unroll
    for (int j = 0; j < 4; ++j) { const int n = (lane >> 3) + 8 * j; const LAS float* s = scr + (8 * c) * 33 + n;
        u32x4_t o; o.x = pk2(s[0 * 33], s[1 * 33]); o.y = pk2(s[2 * 33], s[3 * 33]); o.z = pk2(s[4 * 33], s[5 * 33]); o.w = pk2(s[6 * 33], s[7 * 33]);
        if (n0 + n < N) *(GAS u32x4_t*)(WT + (size_t)dst_row<REMAP>(n0 + n) * ldt + kofs + k0 + 8 * c) = o; }
    LDS_WAIT(); asm volatile("" ::: "memory");
}
__device__ __forceinline__ void p0_items(Frame& F) {
    LAS float* scr = (LAS float*)(F.lds + 68 * 1024 + F.wave * 8704);
    int tid_ = threadIdx.x; asm volatile("" : "+v"(tid_)); const int lane = tid_ & 63;
    const int gw = F.vcu * 8 + F.wave, NGW = F.G * 8;
    bf16_t* WinT = (bf16_t*)(F.ws + WS_WINT); bf16_t* WbrT = (bf16_t*)(F.ws + WS_WBRT); bf16_t* WoutT = (bf16_t*)(F.ws + WS_WOUTT);
    bf16_t* W1T = (bf16_t*)(F.ws + WS_W1T); bf16_t* W2T = (bf16_t*)(F.ws + WS_W2T);
    constexpr int I_IN = 32 * 370, I_BR = 16 * 64, I_OUT = 32 * 64, I_C1 = 32 * 8, I_C2 = 4 * 2;
    constexpr int I_ROPE = MTOK / 64, I_B1 = 128, I_Z = 13;
    constexpr int NITEMS = I_IN + 2 * I_BR + I_OUT + 2 * I_C1 + 2 * I_C2 + I_ROPE + I_B1 + I_Z;
    for (int it = gw; it < NITEMS; it += NGW) {
        int r = it;
        if (r < I_IN) { p0_transpose_item<true>(F.w_in, 2048, NIN, WinT, 2048, 0, scr, r, lane); continue; } r -= I_IN;
        if (r < I_BR) { p0_transpose_item<false>(F.w_br_a, 1024, 2048, WbrT, 2048, 0, scr, r, lane); continue; } r -= I_BR;
        if (r < I_BR) { p0_transpose_item<false>(F.w_br_b, 1024, 2048, WbrT, 2048, 1024, scr, r, lane); continue; } r -= I_BR;
        if (r < I_OUT) { p0_transpose_item<false>(F.w_out, 2048, 2048, WoutT, 2048, 0, scr, r, lane); continue; } r -= I_OUT;
        if (r < I_C1) { p0_transpose_item<false>(F.w_ck1, 2048, 256, W1T, 2048, 0, scr, r, lane); continue; } r -= I_C1;
        if (r < I_C1) { p0_transpose_item<false>(F.w_cv1, 2048, 256, W1T + 256 * 2048, 2048, 0, scr, r, lane); continue; } r -= I_C1;
        if (r < I_C2) { p0_transpose_item<false>(F.w_ck2, 256, 64, W2T, 256, 0, scr, r, lane); continue; } r -= I_C2;
        if (r < I_C2) { p0_transpose_item<false>(F.w_cv2, 256, 64, W2T + 64 * 256, 256, 0, scr, r, lane); continue; } r -= I_C2;
        if (r < I_ROPE) {
            const int m = r * 64 + lane; const float pf = (float)F.pos[m];
#ifdef FAST_ROPE
            const float myinv = (lane < 8) ? exp2f(-(float)(2 * lane) * (18.931568569324174f / 16.f)) : exp2f(-(float)(2 * ((lane - 8) & 15)) * (18.931568569324174f / 32.f));
            float* t64 = (float*)(F.ws + WS_R64) + (size_t)m * 16; float* t128 = (float*)(F.ws + WS_R128) + (size_t)m * 32;
            for (int i = 0; i < 8; ++i) { const float inv = __shfl(myinv, i); const float rev = __builtin_amdgcn_fractf(pf * inv * 0.15915494309189535f); t64[i] = __builtin_amdgcn_cosf(rev); t64[8 + i] = __builtin_amdgcn_sinf(rev); }
            for (int i = 0; i < 16; ++i) { const float inv = __shfl(myinv, 8 + i); const float rev = __builtin_amdgcn_fractf(pf * inv * 0.15915494309189535f); t128[i] = __builtin_amdgcn_cosf(rev); t128[16 + i] = __builtin_amdgcn_sinf(rev); }
#else
            const float myinv = (lane < 8) ? (float)pow(500000.0, -(double)(2 * lane) / 16.0) : (float)pow(500000.0, -(double)(2 * ((lane - 8) & 15)) / 32.0);
            float* t64 = (float*)(F.ws + WS_R64) + (size_t)m * 16; float* t128 = (float*)(F.ws + WS_R128) + (size_t)m * 32;
            for (int i = 0; i < 8; ++i) { const float inv = __shfl(myinv, i); const float ang = pf * inv; t64[i] = cosf(ang); t64[8 + i] = sinf(ang); }
            for (int i = 0; i < 16; ++i) { const float inv = __shfl(myinv, 8 + i); const float ang = pf * inv; t128[i] = cosf(ang); t128[16 + i] = sinf(ang); }
#endif
            continue; } r -= I_ROPE;
        if (r < I_B1) {
            const int kc = r & 15, cg = (r >> 4) & 3, kv = r >> 6, n = cg * 64 + lane; const float* pe = kv ? F.pe_cv : F.pe_ck; const float* w1 = kv ? F.w_cv1 : F.w_ck1; float s = 0.f;
#pragma unroll 16
            for (int k = 128 * kc; k < 128 * kc + 128; ++k) s += pe[k] * w1[(size_t)k * 256 + n];
            ((float*)(F.ws + WS_BIAS1))[(kc * 2 + kv) * 256 + n] = s; continue; } r -= I_B1;
        {
            for (int q = lane; q < 16 * 256; q += 64) *(GAS u32x4_t*)(WinT + (size_t)(11824 + r * 16) * 2048 + q * 8) = (u32x4_t){0u, 0u, 0u, 0u};
        }
    }
}
__device__ __forceinline__ void p0_xn(Frame& F) {
    int tid_ = threadIdx.x; asm volatile("" : "+v"(tid_)); const int lane = tid_ & 63;
    const int gw = F.vcu * 8 + F.wave, NGW = F.G * 8;
    const float* ada = (const float*)(F.ws + WS_ADA); bf16_t* XN = (bf16_t*)(F.ws + WS_XN);
    for (int m = gw; m < MTOK; m += NGW) {
        const int b = m >> 11; const f32x4_t* xr = (const f32x4_t*)(F.x + (size_t)m * DM) + lane;
        f32x4_t v[8]; float s = 0.f;
#pragma unroll
        for (int j = 0; j < 8; ++j) { v[j] = xr[64 * j]; s += (v[j][0] * v[j][0] + v[j][1] * v[j][1]) + (v[j][2] * v[j][2] + v[j][3] * v[j][3]); }
        const float rstd = rsqrtf(wave_sum(s) * (1.f / DM) + 1e-6f);
        u32x2_t* o8 = (u32x2_t*)(XN + (size_t)m * DM) + lane;
#pragma unroll
        for (int j = 0; j < 8; ++j) { const int k = 256 * j + 4 * lane;
            const f32x4_t g = *(const f32x4_t*)(F.g_pre + k), sc = *(const f32x4_t*)(ada + b * 6144 + 2048 + k), sh = *(const f32x4_t*)(ada + b * 6144 + k);
            const f32x4_t y = (v[j] * rstd * g) * (sc + 1.f) + sh;
            u32x2_t w; w.x = pk2(y[0], y[1]); w.y = pk2(y[2], y[3]); o8[64 * j] = w; }
    }
}
typedef short cbf16x8 __attribute__((ext_vector_type(8)));
typedef float cf32x16 __attribute__((ext_vector_type(16)));
__device__ __forceinline__ void compress_unit(Frame& F, int unit) {
    const int kv = unit >> 5, b = (unit >> 2) & 7, g = unit & 3;
    int tid = threadIdx.x; asm volatile("" : "+v"(tid));
    const int lane = tid & 63, r32 = lane & 31, hi = lane >> 5, wid = F.wave;
    const bf16_t* src = (const bf16_t*)(F.ws + WS_KC + (size_t)kv * 8 * MiB) + (size_t)b * SEQ * 256 + g * 64;
    const bf16_t* W1T = (const bf16_t*)(F.ws + WS_W1T) + (size_t)kv * 256 * 2048;
    const bf16_t* W2T = (const bf16_t*)(F.ws + WS_W2T) + (size_t)kv * 64 * 256;
    const float* bias1p = (const float*)(F.ws + WS_BIAS1) + kv * 256;
    bf16_t* dst = (bf16_t*)(F.ws + (kv ? WS_VCC : WS_KCC)) + (size_t)(b * 4 + g) * 128 * 64;
    LAS bf16_t* HID = (LAS bf16_t*)F.lds;
    constexpr int WSLOT = 32768, AOFF = 3 * WSLOT, ASLOT = 8 * 129 * 16;
    const unsigned lds0 = (unsigned)(size_t)F.lds;
    const bf16_t* wp = W1T + (size_t)(tid & 255) * 2048 + (tid >> 8) * 8;
    auto dma_w = [&](int l, int slot) {
#pragma unroll
        for (int j = 0; j < 4; ++j) att::glds16(wp + l * 64 + j * 16, (unsigned)__builtin_amdgcn_readfirstlane(lds0 + slot * WSLOT + (j * 512 + wid * 64) * 16)); };
    auto dma_a = [&](int l, int slot) {
#pragma unroll
        for (int j = 0; j < 2; ++j) { const int p = j * 512 + tid, kc = p >> 7, row = p & 127;
            att::glds16(src + (size_t)(16 * row + l) * 256 + kc * 8, (unsigned)__builtin_amdgcn_readfirstlane(lds0 + AOFF + slot * ASLOT + ((j * 4 + (wid >> 1)) * 129 + (wid & 1) * 64) * 16)); } };
    cf32x16 acc[4] = {cf32x16{}, cf32x16{}, cf32x16{}, cf32x16{}};
    dma_a(0, 0); dma_w(0, 0); dma_w(16, 1); att::wait_vm_bar<4>();
    int sc = 0;
#pragma unroll 1
    for (int it = 0; it < 16; ++it) {
#pragma unroll
        for (int hf = 0; hf < 2; ++hf) {
            const int s2 = sc == 0 ? 2 : sc - 1;
            if (hf == 0) { if (it + 1 < 16) { dma_a(it + 1, (it + 1) & 1); dma_w(it + 1, s2); } }
            else if (it + 1 < 16) dma_w(it + 17, s2);
            const LAS unsigned char* ab = F.lds + AOFF + (it & 1) * ASLOT + hi * (129 * 16) + (r32 + hf) * 16;
            const LAS unsigned char* wb = F.lds + sc * WSLOT + hi * 4096 + (32 * wid + r32) * 16;
#pragma unroll
            for (int ks = 0; ks < 4; ++ks) { const cbf16x8 bq = *(const LAS cbf16x8*)(wb + ks * 8192);
#pragma unroll
                for (int rq = 0; rq < 4; ++rq) { const cbf16x8 af = *(const LAS cbf16x8*)(ab + ks * (2 * 129 * 16) + rq * 512);
                    acc[rq] = __builtin_amdgcn_mfma_f32_32x32x16_bf16(af, bq, acc[rq], 0, 0, 0); } }
            if (it + 1 < 16) { if (hf == 0) att::wait_vm_bar<6>(); else att::wait_vm_bar<4>(); } else att::wait_vm_bar<0>();
            sc = sc == 2 ? 0 : sc + 1;
        }
    }
    {
        const int n = 32 * wid + r32; float bb = 0.f;
#pragma unroll
        for (int q = 0; q < 16; ++q) bb += bias1p[q * 512 + n];
#pragma unroll
        for (int rq = 0; rq < 4; ++rq)
#pragma unroll
            for (int r = 0; r < 16; ++r) { const float xv = acc[rq][r] + bb;
                const float u = 0.7978845608028654f * (xv + 0.044715f * xv * xv * xv);
                const float th = 1.f - 2.f * __builtin_amdgcn_rcpf(1.f + __builtin_amdgcn_exp2f(2.f * LOG2E * u));
                const float gl = 0.5f * xv * (1.f + th);
                HID[(32 * rq + (r & 3) + 8 * (r >> 2) + 4 * hi) * 264 + n] = (bf16_t)f2bf(gl); }
    }
    __syncthreads();
    {
        const int mi = wid >> 1, nd = wid & 1;
        cf32x16 o = cf32x16{};
#pragma unroll
        for (int ks = 0; ks < 16; ++ks) {
            const cbf16x8 a = *(const LAS cbf16x8*)(HID + (32 * mi + r32) * 264 + 16 * ks + 8 * hi);
            const cbf16x8 bq = *(const cbf16x8*)(W2T + (size_t)(32 * nd + r32) * 256 + 16 * ks + 8 * hi);
            o = __builtin_amdgcn_mfma_f32_32x32x16_bf16(a, bq, o, 0, 0, 0);
        }
        const int d = 32 * nd + r32;
#pragma unroll
        for (int r = 0; r < 16; ++r) { const int c = 32 * mi + (r & 3) + 8 * (r >> 2) + 4 * hi; float v = o[r];
            if (kv == 0 && nd == 0) {
                int trow = 16 * c + 31; trow = trow > 2047 ? 2047 : trow;
                const float* tb = (const float*)(F.ws + WS_R64) + ((size_t)b * SEQ + trow) * 16;
                const float pr = __shfl_xor(v, 8); const float cs = tb[r32 & 7], sn = tb[8 + (r32 & 7)];
                const float rot = v * cs + (r32 < 8 ? -pr : pr) * sn;
                v = r32 < 16 ? rot : v; }
            dst[(size_t)c * 64 + d] = (c == 127) ? (bf16_t)0 : (bf16_t)f2bf(v); }
    }
    __syncthreads();
}
__device__ __forceinline__ void p6_final(Frame& F) {
    int tid_ = threadIdx.x; asm volatile("" : "+v"(tid_)); const int lane = tid_ & 63;
    const int gw = F.vcu * 8 + F.wave, NGW = F.G * 8;
    const float* ada = (const float*)(F.ws + WS_ADA); const float* ssq = (const float*)(F.ws + WS_SSQ); float* out = (float*)F.dout; const bf16_t* pre = (const bf16_t*)(F.ws + WS_XN);
    for (int m = gw; m < MTOK; m += NGW) {
        const int b = m >> 11; float s = 0.f;
        for (int q = 0; q < 32; ++q) s += ssq[(size_t)m * 32 + q];
        const float rstd = rsqrtf(s * (1.f / DM) + 1e-6f);
        const f32x4_t* xr = (const f32x4_t*)(F.x + (size_t)m * DM) + lane; f32x4_t* orow = (f32x4_t*)(out + (size_t)m * DM) + lane; const u32x2_t* pr = (const u32x2_t*)(pre + (size_t)m * DM) + lane;
        f32x4_t xv[8]; u32x2_t pv[8];
#pragma unroll
        for (int j = 0; j < 8; ++j) { xv[j] = xr[64 * j]; pv[j] = pr[64 * j]; }
#pragma unroll
        for (int j = 0; j < 8; ++j) { const int k = 256 * j + 4 * lane;
            const f32x4_t gp = *(const f32x4_t*)(F.g_post + k), gt = *(const f32x4_t*)(ada + b * 6144 + 4096 + k);
            const f32x4_t o = {bflo(pv[j].x), bfhi(pv[j].x), bflo(pv[j].y), bfhi(pv[j].y)};
            orow[64 * j] = xv[j] + gt * (o * rstd * gp); }
    }
}
constexpr int LDS_BYTES = 147456;
constexpr int LDSCTL_OFF = 143360;
constexpr int CW_BAR = 4096, CW_PANEL = 16384, CW_CMP = 32768, CW_NSAQ = 33792, CW_G1A = 35008, CW_G1B = 35040, CW_MIXQ = 36864;
constexpr int NPHASE = 8;
#ifndef REP_MIXU
#define REP_MIXU 0
#endif
#ifndef REP_UNIT_N
#define REP_UNIT_N 0
#define REP_UNIT_I 0
#define REP_PMODE 0
#endif
#ifndef PROBE_NOREMAP
#define PROBE_NOREMAP 0
#endif
struct Args { const void* in[17]; float* out; unsigned char* ws; int ph_lo, ph_hi; };

__device__ __forceinline__ void touch_lines(const unsigned char* base, size_t row_pitch_bytes, int nrows, int lines_per_row, int tid) {
    const int n = nrows * lines_per_row;
    for (int i = tid; i < n; i += 512) { const unsigned char* p = base + (size_t)(i / lines_per_row) * row_pitch_bytes + (size_t)(i % lines_per_row) * 128; unsigned t;
        asm volatile("global_load_dword %0, %1, off" : "=v"(t) : "v"(p) : "memory"); }
    asm volatile("s_waitcnt vmcnt(0)" ::: "memory");
}
__global__ void __launch_bounds__(512, 2) mk_fwd(Args args) {
    extern __shared__ __attribute__((aligned(16))) unsigned char lds_raw[];
    Frame F;
    F.lds = (LAS unsigned char*)lds_raw;
    F.tid = threadIdx.x; F.lane = F.tid & 63; F.wave = __builtin_amdgcn_readfirstlane(F.tid >> 6);
    F.G = gridDim.x; { const int bx = blockIdx.x; F.vcu = (F.G % 8 == 0) ? (bx % 8) * (F.G / 8) + bx / 8 : bx; }
    F.x = (const float*)args.in[0]; F.c = (const float*)args.in[1]; F.pos = (const int*)args.in[2]; F.w_ada = (const float*)args.in[3]; F.b_ada = (const float*)args.in[4];
    F.g_pre = (const float*)args.in[5]; F.g_post = (const float*)args.in[6]; F.w_in = (const float*)args.in[7]; F.pe_ck = (const float*)args.in[8]; F.pe_cv = (const float*)args.in[9];
    F.w_ck1 = (const float*)args.in[10]; F.w_ck2 = (const float*)args.in[11]; F.w_cv1 = (const float*)args.in[12]; F.w_cv2 = (const float*)args.in[13];
    F.w_br_a = (const float*)args.in[14]; F.w_br_b = (const float*)args.in[15]; F.w_out = (const float*)args.in[16];
    F.ws = args.ws; F.dout = (unsigned char*)args.out;
    unsigned char* ws = args.ws;
    { int t0 = threadIdx.x; asm volatile("" : "+v"(t0));
      for (int u = t0; u < (LDS_BYTES - LDSCTL_OFF) / 4; u += 512) ((LAS unsigned*)(F.lds + LDSCTL_OFF))[u] = 0u; }
    __syncthreads();
    const int lo = args.ph_lo, hi = args.ph_hi;
#if STAMP
    unsigned long long ts_[10]; int nts_ = 0;
#define TS() do { ts_[nts_ < 9 ? nts_ : 9] = __builtin_amdgcn_s_memrealtime(); ++nts_; } while (0)
    TS();
#else
#define TS() do {} while (0)
#endif
    const bool multi = (hi - lo) > 1;
    XcdBarrier bar; bar.bar = (unsigned*)(ws + WS_CTL) + CW_BAR; bar.x = 0; bar.st = nullptr;
    if (multi) bar = xcd_barrier_post((unsigned*)(ws + WS_CTL) + CW_BAR, (volatile LAS unsigned*)(F.lds + LDSCTL_OFF + 32));
#ifndef PH_MASK
#define PH_MASK 0xff
#endif
#define IN(k) (((PH_MASK >> (k)) & 1) && lo <= (k) && (k) < hi)
#ifndef REP_MASK
#define REP_MASK 0
#endif
#define REPS(k) for (int rep_ = 0; rep_ < 1 + ((REP_MASK >> (k)) & 1); ++rep_)
#define SEAM(k) do { if (IN(k) && IN((k) + 1)) xcd_barrier(bar); } while (0)

    if (IN(0)) REPS(0) { p0_ada(F); }
    SEAM(0); TS();
    if (IN(1)) REPS(1) { p0_xn(F); p0_items(F); }
    SEAM(1); TS();
    if (IN(2)) REPS(2) {
        const int bx = (int)blockIdx.x, cs = (F.G == 256 && !PROBE_NOREMAP) ? (bx & 7) + 8 * ((((bx >> 3) & 7) << 2) + (bx >> 6)) : bx;
        pg8::Gemm g{(const bf16_t*)(ws + WS_XN), (const bf16_t*)(ws + WS_WINT), MTOK, NINP, 2048}; pg8::ProjOrder S; S.init(MTOK, NINP, F.G, cs);
        pg8::EpiProj E{ws, F.dout, (const float*)(ws + WS_R64), (const float*)(ws + WS_R128)};
        const int nf = S.count_first();
#pragma unroll 1
        for (int part = 0; part < 2; ++part) {
            S.i0 = part ? nf : 0; S.i1 = part ? (1 << 30) : nf;
            pg8::gemm_phase<pg8::EpiProj, pg8::ProjOrder, true, true>(F.lds, g, S, E);
            if (part == 0) { asm volatile("s_waitcnt vmcnt(0)" ::: "memory"); __syncthreads();
                if (threadIdx.x == 0) { __builtin_amdgcn_fence(__ATOMIC_RELEASE, "agent"); (void)xb_add((unsigned*)(ws + WS_CTL) + CW_G1A, (unsigned)nf); __builtin_amdgcn_s_waitcnt(0); } }
        }
        asm volatile("s_waitcnt vmcnt(0)" ::: "memory"); __syncthreads();
        if (threadIdx.x == 0) { __builtin_amdgcn_fence(__ATOMIC_RELEASE, "agent"); (void)xb_add((unsigned*)(ws + WS_CTL) + CW_G1B, 1u); __builtin_amdgcn_s_waitcnt(0); }
    }
#ifdef KEEP_SEAM2
    SEAM(2);
#endif
    TS();
    if (IN(3)) REPS(3) {
        att::MixPtrs MP{ws};
        if (threadIdx.x == 0) { unsigned* cw = (unsigned*)(ws + WS_CTL) + CW_G1A; while (xb_ld(cw) < (unsigned)(pg8::ProjOrder::NFIRST * (MTOK / 256))) __builtin_amdgcn_s_sleep(8);
            __builtin_amdgcn_fence(__ATOMIC_ACQUIRE, "agent"); }
        __syncthreads();
        for (int v = F.vcu; v < 256; v += F.G) {
            const int j = v & 7, bh = 2 * (v >> 3) + (j & 1), b_ = bh >> 3, h_ = bh & 7;
#ifdef USE_WARM
            { const size_t off = ((size_t)b_ * SEQ + 512 * (j >> 1)) * 2048 + h_ * 256;
              touch_lines(ws + WS_KB + off, 2048, 512, 2, F.tid); touch_lines(ws + WS_VB + off, 2048, 512, 2, F.tid); }
#endif
#ifndef REP_CMP
#define REP_CMP 0
#endif
            if (j < 2) { compress_unit(F, (v >> 3) * 2 + j);
                asm volatile("s_waitcnt vmcnt(0)" ::: "memory"); __syncthreads();
                if (threadIdx.x == 0) { __builtin_amdgcn_fence(__ATOMIC_RELEASE, "agent"); (void)xb_add((unsigned*)(ws + WS_CTL) + CW_CMP, 1u); } }
#ifndef NO_MIX
#ifdef MIX_QUEUE
            {
                unsigned* qc = (unsigned*)(ws + WS_CTL) + CW_MIXQ + 32 * (v >> 3); volatile LAS unsigned* qn = (volatile LAS unsigned*)(F.lds + LDSCTL_OFF + 80);
                if (threadIdx.x == 0) qn[0] = xb_add(qc, 1u);
                __syncthreads();
                unsigned k = qn[0];
#pragma unroll 1
                for (int par = 1; k < 16u; par ^= 1) {
                    if (threadIdx.x == 0) qn[par] = xb_add(qc, 1u);
                    const int bh2 = 2 * (v >> 3) + (int)(k & 1u);
                    att::mixb_unit(MP, bh2 >> 3, bh2 & 7, 7 - (int)(k >> 1), F.lds);
                    __syncthreads();
                    k = qn[par];
                }
            }
#else
            const int alist = j < 2 ? 0x4 : j < 4 ? 0x16 : j < 6 ? 0x25 : 0x037, na = j < 2 ? 1 : j < 6 ? 2 : 3;
#pragma unroll 1
            for (int i = 0; i < na + REP_MIXU; ++i) att::mixb_unit(MP, b_, h_, i < na ? ((alist >> (4 * i)) & 15) : 0, F.lds);
#endif
#endif
        }
    }
    TS();
    if (IN(4)) REPS(4) {
        att::NsaPtrs NP{ws};
        asm volatile("s_waitcnt vmcnt(0)" ::: "memory");
        if (threadIdx.x == 0) { unsigned* cw = (unsigned*)(ws + WS_CTL) + CW_CMP; while (xb_ld(cw) < 64u) __builtin_amdgcn_s_sleep(8);
            cw = (unsigned*)(ws + WS_CTL) + CW_G1B; while (xb_ld(cw) < (unsigned)F.G) __builtin_amdgcn_s_sleep(8);
            __builtin_amdgcn_fence(__ATOMIC_ACQUIRE, "agent"); }
        __syncthreads();
        for (int v = F.vcu; v < 256; v += F.G) {
#ifdef USE_WARM
            { const int bg = v >> 3, s = v & 7; const size_t off = ((size_t)(bg >> 2) * SEQ + 256 * s) * 512 + (bg & 3) * 128;
#pragma unroll 1
              for (int t = 2; t < 6; ++t) touch_lines(ws + WS_KC + (size_t)t * 8 * MiB + off, 512, 256, 1, F.tid); }
#endif
#ifndef NO_NSA
#ifdef NSA_QUEUE
            {
                const int bg = v >> 3; unsigned* qc = (unsigned*)(ws + WS_CTL) + CW_NSAQ + 32 * bg; volatile LAS unsigned* qn = (volatile LAS unsigned*)(F.lds + LDSCTL_OFF + 64);
                if (threadIdx.x == 0) qn[0] = xb_add(qc, 1u);
                __syncthreads();
                unsigned k = qn[0];
#pragma unroll 1
                for (int par = 1; k < 32u; par ^= 1) {
                    if (threadIdx.x == 0) qn[par] = xb_add(qc, 1u);
                    att::nsa_unit(NP, bg >> 2, bg & 3, 31 - (int)k, F.lds
#if DBG
                        , (unsigned*)(ws + WS_DBG + 101 * MiB)
#endif
                        );
                    __syncthreads();
                    k = qn[par];
                }
            }
#else
            { const int bg = v >> 3, s = v & 7;
#pragma unroll 1
              for (int i_ = 0; i_ < 4 + REP_UNIT_N; ++i_) { const int i = i_ < 4 ? i_ : REP_UNIT_I; const unsigned long long qtab = (i == 0) ? 0xcdb9beffdaull : (i == 1) ? 0xbd2b09ca38ull : (i == 2) ? 0x4ad4c6b90full : 0x21c66104a0ull;
                  const int qt = (int)((qtab >> (5 * s)) & 31ull); att::nsa_unit(NP, bg >> 2, bg & 3, qt, F.lds
#if DBG
                  , (unsigned*)(ws + WS_DBG + 101 * MiB)
#endif
                  ); } }
#endif
#endif
        }
    }
    SEAM(4); TS();
    if (IN(5)) REPS(5) {
        pg8::Gemm g{(const bf16_t*)(ws + WS_A2), (const bf16_t*)(ws + WS_WBRT), MTOK, 2048, 2048}; pg8::StaticOrder S; S.init(MTOK, 2048, F.G, (int)blockIdx.x);
        pg8::EpiMerge E{(const bf16_t*)(F.dout + DO_MA), (const bf16_t*)(F.dout + DO_MB), (bf16_t*)(ws + WS_MERGED)};
        pg8::gemm_phase<pg8::EpiMerge, pg8::StaticOrder, true, true>(F.lds, g, S, E);
    }
    SEAM(5); TS();
    if (IN(6)) REPS(6) {
        pg8::Gemm g{(const bf16_t*)(ws + WS_MERGED), (const bf16_t*)(ws + WS_WOUTT), MTOK, 2048, 2048}; pg8::StaticOrder S; S.init(MTOK, 2048, F.G, (int)blockIdx.x);
#ifndef FUSE_FINAL
        pg8::EpiOutB E{(bf16_t*)(ws + WS_XN), (float*)(ws + WS_SSQ)};
        pg8::gemm_phase<pg8::EpiOutB, pg8::StaticOrder, true, true>(F.lds, g, S, E);
#else
        pg8::EpiFinal E{F.x, (float*)F.dout, (float*)(ws + WS_SSQ), (unsigned*)(ws + WS_CTL) + CW_PANEL, (const float*)(ws + WS_ADA), F.g_post};
        pg8::PanelOrder PO; PO.init(MTOK, 2048, F.G, F.vcu);
        if ((F.G & 7) == 0) pg8::gemm_phase<pg8::EpiFinal, pg8::PanelOrder, true, true>(F.lds, g, PO, E);
#endif
    }
#ifndef FUSE_FINAL
    SEAM(6);
#endif
    TS();
#ifndef FUSE_FINAL
    if (IN(7)) { p6_final(F); }
#endif
    TS();
#if STAMP
    if (F.vcu == 0 && F.tid == 0) { VM_WAIT(); args.out[0] = (float)(ts_[STAMP_B] - ts_[STAMP_A]); }
#endif
#undef IN
#undef SEAM
}

#if DBG
namespace dbg {
constexpr int BD = DBG_BATCH;
constexpr size_t E_PROJ = 0, E_KC = 48 * MiB, E_VC = 48 * MiB + 256 * 1024, E_SEL = 48 * MiB + 512 * 1024, E_AA = 50 * MiB, E_AB = 58 * MiB, E_MG = 66 * MiB, E_OF = 82 * MiB, E_ADA = 98 * MiB, DIAG = 100 * MiB, SELOUT = 101 * MiB;
__global__ void k_f2b(const float* __restrict__ s, bf16_t* __restrict__ d, size_t n) { for (size_t i = (size_t)blockIdx.x * 256 + threadIdx.x; i < n; i += (size_t)gridDim.x * 256) d[i] = (bf16_t)f2bf(s[i]); }
__global__ void k_copy(const float* __restrict__ s, float* __restrict__ d, size_t n) { for (size_t i = (size_t)blockIdx.x * 256 + threadIdx.x; i < n; i += (size_t)gridDim.x * 256) d[i] = s[i]; }
template <class T> __device__ __forceinline__ float tof(T v);
template <> __device__ __forceinline__ float tof<float>(float v) { return v; }
template <> __device__ __forceinline__ float tof<bf16_t>(bf16_t v) { return bf2f(v); }
template <class FT, class ET, int XF> __global__ void k_cmp(const FT* __restrict__ f, int ldf, const ET* __restrict__ e, int lde, int rows, int cols, float fscale, float* __restrict__ acc) {
    __shared__ float sh[8];
    float num = 0.f, den = 0.f;
    for (size_t i = (size_t)blockIdx.x * 256 + threadIdx.x; i < (size_t)rows * cols; i += (size_t)gridDim.x * 256) { const int r = (int)(i / cols), c = (int)(i % cols);
        const float vf = tof<FT>(f[(size_t)r * ldf + c]) * fscale; float ve = tof<ET>(e[(size_t)r * lde + c]);
        if (XF == 1) ve = ve / (1.f + expf(-ve)); if (XF == 2) ve = 1.f / (1.f + expf(-ve));
        num += (vf - ve) * (vf - ve); den += ve * ve; }
    for (int o = 32; o > 0; o >>= 1) { num += __shfl_xor(num, o); den += __shfl_xor(den, o); }
    if ((threadIdx.x & 63) == 0) { sh[threadIdx.x >> 6] = num; sh[4 + (threadIdx.x >> 6)] = den; }
    __syncthreads();
    if (threadIdx.x == 0) { atomicAdd(acc, sh[0] + sh[1] + sh[2] + sh[3]); atomicAdd(acc + 1, sh[4] + sh[5] + sh[6] + sh[7]); }
}
__global__ void k_cmp_sel(const unsigned* __restrict__ f, const unsigned* __restrict__ e, float* __restrict__ acc) {
    const int idx = blockIdx.x * 256 + threadIdx.x; if (idx >= 2048 * 4) return; const int s = idx >> 2;
    const unsigned valid = (s >> 6) == 31 ? 0xffffffffu : ((2u << (s >> 6)) - 1u);
    const bool bad = ((f[idx] ^ e[idx]) & valid) != 0u;
    atomicAdd(acc, bad ? 1.f : 0.f); if (threadIdx.x == 0 && blockIdx.x == 0) atomicAdd(acc + 1, 8192.f);
}
constexpr int NCHK = 24;
__global__ void k_report(const float* __restrict__ diag, float* __restrict__ out, int sel) {
    if (threadIdx.x != 0) return;
    if (sel == 0) { for (int k = 1; k < NCHK; ++k) { const float num = diag[2 * k], den = diag[2 * k + 1]; if (den == 0.f) continue;
            const float err = (k == 19) ? num / den : sqrtf(num / den);
            const float tol = k == 1 ? 1e-4f : (k == 17 || k == 18 || k == 21) ? 3e-2f : k == 19 ? 0.12f : (k == 20 || k == 22 || k == 23) ? 0.1f : 2e-2f;
            if (!(err <= tol)) { out[0] = (float)k * 1.0e4f; return; } }
        out[0] = 7.7e7f; }
    else { const float num = diag[2 * sel], den = diag[2 * sel + 1]; const float err = (sel == 19) ? num / den : sqrtf(num / den); out[0] = err * 1.0e6f; }
}
}
#endif

extern "C" void kernel_launch(void* const* d_in, const int* in_sizes, int n_in, void* d_out, int out_size, void* d_ws, size_t ws_size, hipStream_t stream) {
    static int grid = 0;
    if (grid == 0) {
        int dev = 0, cus = 0;
        if (hipGetDevice(&dev) != hipSuccess || hipDeviceGetAttribute(&cus, hipDeviceAttributeMultiprocessorCount, dev) != hipSuccess) { fprintf(stderr, "kernel_launch: device query failed\n"); grid = -1; return; }
        if (hipFuncSetAttribute((const void*)mk_fwd, hipFuncAttributeMaxDynamicSharedMemorySize, LDS_BYTES) != hipSuccess) { fprintf(stderr, "kernel_launch: hipFuncSetAttribute failed\n"); grid = -1; return; }
        int per_cu = 0;
        if (hipOccupancyMaxActiveBlocksPerMultiprocessor(&per_cu, (const void*)mk_fwd, 512, LDS_BYTES) != hipSuccess || per_cu < 1) fprintf(stderr, "kernel_launch: occupancy query reports %d\n", per_cu);
        (void)hipGetLastError();
        grid = cus;
    }
    if (grid < 0) return;
    if (ws_size < WS_END) { fprintf(stderr, "kernel_launch: workspace too small (%zu < %zu bytes)\n", ws_size, (size_t)WS_END); return; }
    unsigned char* ws = (unsigned char*)d_ws;
#if DBG
    {
        ref::In I;
        I.x = (const float*)d_in[0]; I.c = (const float*)d_in[1]; I.pos = (const int*)d_in[2]; I.w_ada = (const float*)d_in[3]; I.b_ada = (const float*)d_in[4];
        I.g_pre = (const float*)d_in[5]; I.g_post = (const float*)d_in[6]; I.w_in = (const float*)d_in[7]; I.pe_ck = (const float*)d_in[8]; I.pe_cv = (const float*)d_in[9];
        I.w_ck1 = (const float*)d_in[10]; I.w_ck2 = (const float*)d_in[11]; I.w_cv1 = (const float*)d_in[12]; I.w_cv2 = (const float*)d_in[13];
        I.w_br_a = (const float*)d_in[14]; I.w_br_b = (const float*)d_in[15]; I.w_out = (const float*)d_in[16];
        ref::Bufs B = ref::carve((char*)d_ws);
        ref::run_ada(I, B, stream);
        ref::run_batch(I, B, dbg::BD, (float*)d_out, stream);
        unsigned char* E = ws + WS_DBG;
        dbg::k_f2b<<<2048, 256, 0, stream>>>(B.proj, (bf16_t*)(E + dbg::E_PROJ), (size_t)2048 * NIN);
        dbg::k_copy<<<64, 256, 0, stream>>>(B.kc, (float*)(E + dbg::E_KC), 512 * 64); dbg::k_copy<<<64, 256, 0, stream>>>(B.vc, (float*)(E + dbg::E_VC), 512 * 64);
        dbg::k_copy<<<32, 256, 0, stream>>>((const float*)B.selmask, (float*)(E + dbg::E_SEL), 2048 * 4);
        dbg::k_copy<<<1024, 256, 0, stream>>>(B.Aa, (float*)(E + dbg::E_AA), (size_t)2048 * 1024); dbg::k_copy<<<1024, 256, 0, stream>>>(B.Ab, (float*)(E + dbg::E_AB), (size_t)2048 * 1024);
        dbg::k_copy<<<1024, 256, 0, stream>>>(B.mg, (float*)(E + dbg::E_MG), (size_t)2048 * 2048); dbg::k_copy<<<1024, 256, 0, stream>>>(B.of, (float*)(E + dbg::E_OF), (size_t)2048 * 2048);
        dbg::k_copy<<<64, 256, 0, stream>>>(B.ada, (float*)(E + dbg::E_ADA), 8 * 6144);
        (void)hipMemsetAsync(E + dbg::DIAG, 0, 4096, stream);
    }
#endif
    if (hipMemsetAsync(ws + WS_CTL, 0, CTL_ZERO_BYTES, stream) != hipSuccess) { fprintf(stderr, "kernel_launch: memset failed\n"); return; }
    Args a{};
    for (int i = 0; i < 17; ++i) a.in[i] = d_in[i];
    a.out = (float*)d_out; a.ws = ws;
#if ONE_LAUNCH
    a.ph_lo = 0; a.ph_hi = NPHASE;
    { void* kargs[] = {&a}; const hipError_t e = hipLaunchCooperativeKernel((const void*)mk_fwd, dim3(grid), dim3(512), kargs, LDS_BYTES, stream);
      if (e != hipSuccess) fprintf(stderr, "kernel_launch: cooperative launch failed: %s (grid %d)\n", hipGetErrorString(e), grid); }
#else
    for (int p = 0; p < NPHASE && p <= DBG_STOP; ++p) { a.ph_lo = p; a.ph_hi = p + 1; hipLaunchKernelGGL(mk_fwd, dim3(grid), dim3(512), LDS_BYTES, stream, a); }
#endif
#if DBG
    {
        unsigned char* E = ws + WS_DBG; float* diag = (float*)(E + dbg::DIAG); const bf16_t* EP = (const bf16_t*)(E + dbg::E_PROJ);
        const size_t r0 = (size_t)dbg::BD * 2048;
#define CMPB(id, fastptr, ldf, ecol, cols, XF, fs) dbg::k_cmp<bf16_t, bf16_t, XF><<<512, 256, 0, stream>>>((const bf16_t*)(fastptr) + r0 * (ldf), ldf, EP + (ecol), NIN, 2048, cols, fs, diag + 2 * (id))
        dbg::k_cmp<float, float, 0><<<64, 256, 0, stream>>>((const float*)(ws + WS_ADA), 6144, (const float*)(E + dbg::E_ADA), 6144, 8, 6144, 1.f, diag + 2 * 1);
        CMPB(2, ws + WS_QA, 1024, ref::C_QA, 1024, 0, 1.f / QS64);
        CMPB(3, ws + WS_KC + 0 * 8 * MiB, 256, ref::C_KC, 256, 0, 1.f); CMPB(4, ws + WS_KC + 1 * 8 * MiB, 256, ref::C_VC, 256, 0, 1.f); CMPB(5, ws + WS_KC + 2 * 8 * MiB, 256, ref::C_KS, 256, 0, 1.f);
        CMPB(6, ws + WS_KC + 3 * 8 * MiB, 256, ref::C_VS, 256, 0, 1.f); CMPB(7, ws + WS_KC + 4 * 8 * MiB, 256, ref::C_KW, 256, 0, 1.f); CMPB(8, ws + WS_KC + 5 * 8 * MiB, 256, ref::C_VW, 256, 0, 1.f);
        CMPB(9, ws + WS_ZA, 1024, ref::C_ZA, 1024, 1, 1.f);
        if (DBG_STOP < 5) { CMPB(10, ws + WS_QB, 1024, ref::C_QB, 1024, 0, 1.f / QS128); CMPB(11, ws + WS_KB, 1024, ref::C_KB, 1024, 0, 1.f); }
        if (DBG_STOP < 6) { CMPB(14, (unsigned char*)d_out + DO_MA, 2048, ref::C_MA, 2048, 2, 1.f); CMPB(15, (unsigned char*)d_out + DO_MB, 2048, ref::C_MB, 2048, 2, 1.f); }
        if (DBG_STOP == 6) dbg::k_cmp<float, float, 0><<<512, 256, 0, stream>>>((const float*)d_out + r0 * 2048, 2048, (const float*)(E + dbg::E_OF), 2048, 2048, 2048, 1.f, diag + 2 * 23);
        CMPB(12, ws + WS_VB, 1024, ref::C_VB, 1024, 0, 1.f); CMPB(13, ws + WS_ZB, 1024, ref::C_ZB, 1024, 1, 1.f);
        CMPB(16, ws + WS_GA, 64, ref::C_GA, 48, 2, 1.f);
        if (DBG_STOP >= 3) {
        dbg::k_cmp<bf16_t, float, 0><<<64, 256, 0, stream>>>((const bf16_t*)(ws + WS_KCC) + (size_t)dbg::BD * 512 * 64, 64, (const float*)(E + dbg::E_KC), 64, 512, 64, 1.f, diag + 2 * 17);
        dbg::k_cmp<bf16_t, float, 0><<<64, 256, 0, stream>>>((const bf16_t*)(ws + WS_VCC) + (size_t)dbg::BD * 512 * 64, 64, (const float*)(E + dbg::E_VC), 64, 512, 64, 1.f, diag + 2 * 18); }
        if (DBG_STOP >= 4) {
        dbg::k_cmp_sel<<<32, 256, 0, stream>>>((const unsigned*)(E + dbg::SELOUT) + r0 * 4, (const unsigned*)(E + dbg::E_SEL), diag + 2 * 19);
        dbg::k_cmp<bf16_t, float, 0><<<512, 256, 0, stream>>>((const bf16_t*)(ws + WS_A2) + r0 * 2048, 2048, (const float*)(E + dbg::E_AA), 1024, 2048, 1024, 1.f, diag + 2 * 20);
        dbg::k_cmp<bf16_t, float, 0><<<512, 256, 0, stream>>>((const bf16_t*)(ws + WS_A2) + r0 * 2048 + 1024, 2048, (const float*)(E + dbg::E_AB), 1024, 2048, 1024, 1.f, diag + 2 * 21); }
        if (DBG_STOP >= 5)
        dbg::k_cmp<bf16_t, float, 0><<<512, 256, 0, stream>>>((const bf16_t*)(ws + WS_MERGED) + r0 * 2048, 2048, (const float*)(E + dbg::E_MG), 2048, 2048, 2048, 1.f, diag + 2 * 22);
#undef CMPB
        dbg::k_report<<<1, 64, 0, stream>>>(diag, (float*)d_out, DBG_SEL);
    }
#endif
}
```

```cpp
#define DBG 0
#define DBG_BATCH 5
#define DBG_SEL 0
#define ONE_LAUNCH 1
#define DBG_STOP 7
#define REP_MASK 0
#define STAMP 0
#define STAMP_A 0
#define STAMP_B 8
#define MAN_PV 1
#define NSA_QUEUE 1
#define MIX_QUEUE 1
#define MAX_STRIDE 4
#define DMA_LATE 1
#define FAST_ROPE 1
#define LATE_CONV 1
#define ADA_VCU 1
#define ROPE_COAL 1
#define ITEM_SPREAD 1
#define BIAS_FUSED 1
#define EPI_SWAP 1
#define PAIR_COLS 1
#define PAIR_ALL 1
#define PRE_SSQ 1
#define EPI_SPEC 1
#define SMALL_ZERO 1
#include <hip/hip_runtime.h>
#include <hip/hip_cooperative_groups.h>
#include <cmath>
#include <cstdio>
#include <cstdint>

constexpr int NB = 8, SEQ = 2048, DM = 2048, MTOK = NB * SEQ;
constexpr int NIN = 11824, NINP = 12032;
constexpr float LOG2E = 1.4426950408889634f;
constexpr float QS64 = 0.125f * LOG2E, QS128 = 0.08838834764831845f * LOG2E;
constexpr size_t MiB = 1u << 20;
#ifdef SMALL_ZERO
constexpr size_t WS_CTL = 0, CTL_ZERO_BYTES = 256 * 1024;
#else
constexpr size_t WS_CTL = 0, CTL_ZERO_BYTES = 1 * MiB;
#endif
constexpr size_t WS_ADA = 1 * MiB;
constexpr size_t WS_R64 = 2 * MiB;
constexpr size_t WS_R128 = 3 * MiB;
constexpr size_t WS_BIAS1 = 5 * MiB;
constexpr size_t WS_SSQ = 6 * MiB;
constexpr size_t WS_KCC = 8 * MiB, WS_VCC = 8 * MiB + 512 * 1024;
constexpr size_t WS_W2T = 9 * MiB;
constexpr size_t WS_W1T = 10 * MiB;
constexpr size_t WS_GA = 12 * MiB;
constexpr size_t WS_WBRT = 16 * MiB, WS_WOUTT = 24 * MiB;
constexpr size_t WS_WINT = 32 * MiB;
constexpr size_t WS_XN = 80 * MiB;
constexpr size_t WS_QA = 144 * MiB;
constexpr size_t WS_KC = 176 * MiB;
constexpr size_t WS_ZA = 224 * MiB, WS_QB = 256 * MiB, WS_KB = 288 * MiB, WS_VB = 320 * MiB, WS_ZB = 352 * MiB;
constexpr size_t WS_MERGED = 256 * MiB;
#if DBG
constexpr size_t WS_A2 = WS_XN;
#else
constexpr size_t WS_A2 = 384 * MiB;
#endif
constexpr size_t WS_END = 448 * MiB;
constexpr size_t WS_DBG = 384 * MiB;
constexpr size_t DO_MA = 0, DO_MB = 64 * MiB;

typedef unsigned short bf16_t;
#define LAS __attribute__((address_space(3)))
#define GAS __attribute__((address_space(1)))
typedef unsigned u32x4_t __attribute__((ext_vector_type(4)));
typedef unsigned u32x2_t __attribute__((ext_vector_type(2)));
typedef float f32x4_t __attribute__((ext_vector_type(4)));

__device__ __forceinline__ unsigned f2bf(float f) { unsigned u = __builtin_bit_cast(unsigned, f); return (u + 0x7fffu + ((u >> 16) & 1u)) >> 16; }
__device__ __forceinline__ unsigned pk2(float lo, float hi) { return f2bf(lo) | (f2bf(hi) << 16); }
__device__ __forceinline__ float bf2f(unsigned short h) { return __builtin_bit_cast(float, (unsigned)h << 16); }
__device__ __forceinline__ float bflo(unsigned w) { return __builtin_bit_cast(float, w << 16); }
__device__ __forceinline__ float bfhi(unsigned w) { return __builtin_bit_cast(float, w & 0xffff0000u); }
__device__ __forceinline__ float fast_sigmoid(float x) { return __builtin_amdgcn_rcpf(1.f + __builtin_amdgcn_exp2f(-x * LOG2E)); }
namespace pg8 {
#define PG8_LAS __attribute__((address_space(3)))
typedef unsigned short bf16_t;
typedef short bf16x8 __attribute__((ext_vector_type(8)));
typedef float f32x4 __attribute__((ext_vector_type(4)));
typedef unsigned u32x4 __attribute__((ext_vector_type(4)));
constexpr int BM = 256, BK = 64, HALF = 128, HTB = HALF * BK * 2  , STAGE_BYTES = 8 * HTB, NXCD = 8, WGM = 8;

__host__ __device__ __forceinline__ int lds_byte(int r, int c) { const int st = (r >> 4) * 2 + (c >> 5), rr = r & 15, cc = c & 31, ob = rr * 64 + cc * 2; return st * 1024 + (ob ^ (((ob >> 9) & 1) << 5)); }
__host__ __device__ __forceinline__ void stage_rc(int b, int& R, int& C) { const int st = b / 1024, sb = b % 1024, swz = sb ^ (((sb >> 9) & 1) << 5); R = (st >> 1) * 16 + swz / 64; C = (st & 1) * 32 + (swz % 64) / 2; }
__host__ __device__ __forceinline__ int perm32(int rho) { const int n = rho >> 4, i = rho & 15; return 8 * (i >> 2) + 4 * n + (i & 3); }

struct Unit { int pm, pn; };
struct Gemm { const bf16_t* A; const bf16_t* Bt; int M, N, K; };

struct StaticOrder {
    int nM, nN, nwg, G, c;
    __host__ __device__ void init(int M, int N, int G_, int c_) { nM = M / BM; nN = N / BM; nwg = nM * nN; G = G_; c = c_; }
    __host__ __device__ bool next(int i, Unit& u) const {
        const long L = (long)i * G + c; if (L >= nwg) return false;
        int wgid = (int)L; { const int q = nwg / NXCD, r = nwg % NXCD, xcd = wgid % NXCD, off = wgid / NXCD; wgid = (xcd < r ? xcd * (q + 1) : r * (q + 1) + (xcd - r) * q) + off; }
        const int nig = WGM * nN, gid = wgid / nig, fm = gid * WGM, gsz = (nM - fm) < WGM ? (nM - fm) : WGM;
        u.pm = fm + ((wgid % nig) % gsz); u.pn = (wgid % nig) / gsz; return true;
    }
    __device__ __forceinline__ void a_ready(const Unit&) const {}
    __device__ __forceinline__ void done(const Unit&) const {}
};
struct ProjOrder {
    int nM, nN, nwg, G, c, i0, i1;
    static constexpr int NFIRST = 18;
    __host__ __device__ void init(int M, int N, int G_, int c_) { nM = M / BM; nN = N / BM; nwg = nM * nN; G = G_; c = c_; i0 = 0; i1 = 1 << 30; }
    __host__ __device__ static int perm(int i) { return i < 2 ? 4 + i : i < 18 ? 12 + i : i < 22 ? i - 18 : i < 26 ? i - 16 : i < 30 ? i - 16 : i; }
    __host__ __device__ bool decode(int i, int& pm, int& pi) const {
        const long L = (long)i * G + c; if (L >= nwg) return false;
        int wgid = (int)L; { const int q = nwg / NXCD, r = nwg % NXCD, xcd = wgid % NXCD, off = wgid / NXCD; wgid = (xcd < r ? xcd * (q + 1) : r * (q + 1) + (xcd - r) * q) + off; }
        const int nig = WGM * nN, gid = wgid / nig, fm = gid * WGM, gsz = (nM - fm) < WGM ? (nM - fm) : WGM;
        pm = fm + ((wgid % nig) % gsz); pi = (wgid % nig) / gsz; return true; }
    __host__ __device__ int count_first() const { int n = 0, pm, pi; while (decode(n, pm, pi) && pi < NFIRST) ++n; return n; }
    __host__ __device__ bool next(int i, Unit& u) const { int pi; if (i0 + i >= i1 || !decode(i0 + i, u.pm, pi)) return false; u.pn = perm(pi); return true; }
    __device__ __forceinline__ void a_ready(const Unit&) const {}
    __device__ __forceinline__ void done(const Unit&) const {}
};

typedef float f32x2_cv __attribute__((ext_vector_type(2))); typedef __bf16 bf16x2_cv __attribute__((ext_vector_type(2)));
__device__ __forceinline__ unsigned cvt_pk_bf16(float lo, float hi) { f32x2_cv v = {lo, hi}; bf16x2_cv b = __builtin_convertvector(v, bf16x2_cv); return __builtin_bit_cast(unsigned, b); }

#ifdef PAIR_COLS
#define EPI_C0(wc, fq) ((wc) * 64 + 8 * (fq))
#define EPI_BJ 32
#else
#define EPI_C0(wc, fq) ((wc) * 32 + 8 * (fq))
#define EPI_BJ HALF
#endif
#ifdef PAIR_COLS
__device__ __forceinline__ void pair_rows(const u32x4& w0, const u32x4& w1, u32x4& f1, u32x4& f2) {
#pragma unroll
    for (int q = 0; q < 4; ++q) { f1[q] = (unsigned)__builtin_amdgcn_update_dpp((int)w0[q], (int)w1[q], 0x128, 0xF, 0xC, false);
                                  f2[q] = (unsigned)__builtin_amdgcn_update_dpp((int)w1[q], (int)w0[q], 0x128, 0xF, 0x3, false); }
}
#endif
struct EpiProj {
    static constexpr bool PERM = true, AFTER_DRAIN = false, MIDHOOK = false;
    unsigned char* ws; unsigned char* dout; const float* r64; const float* r128;
    __device__ __forceinline__ void mid(f32x4 (&)[2][2][4][2], const Unit&, int, int, int, int) const {}
#ifdef EPI_SPEC
    template <int MODE> __device__ __forceinline__ void run(const f32x4 (&acc)[2][2][4][2], const Unit& u, int wr, int wc, int fr, int fq, bf16_t* base, int ldc, int colt, float sc) const {
        constexpr int mode = MODE;
        const int row0 = u.pm * BM + wr * 64 + fr;
        const int cb = EPI_C0(wc, fq);
#ifdef PAIR_COLS
        const bool rope_wave = (mode == 1) || (mode == 2 && (wc & 1) == 0);
        constexpr int NBJ_ROPE = 1;
#else
        const bool rope_wave = (mode == 1 && (wc & 1) == 0) || (mode == 2 && wc == 0);
        constexpr int NBJ_ROPE = 2;
#endif
#pragma unroll
        for (int ai = 0; ai < 2; ++ai)
#pragma unroll
            for (int m = 0; m < 4; ++m) {
                const int row = row0 + ai * HALF + m * 16;
                float v2[2][8];
#pragma unroll
                for (int bj = 0; bj < 2; ++bj)
#pragma unroll
                    for (int j = 0; j < 4; ++j) { v2[bj][j] = acc[ai][bj][m][0][j]; v2[bj][4 + j] = acc[ai][bj][m][1][j]; }
                if (rope_wave) {
                    float cs[8], sn[8];
                    if (mode == 1) { const f32x4* t = (const f32x4*)(r64 + (size_t)row * 16); const f32x4 c0 = t[0], c1 = t[1], s0 = t[2], s1 = t[3];
#pragma unroll
                        for (int j = 0; j < 4; ++j) { cs[j] = c0[j]; cs[4 + j] = c1[j]; sn[j] = s0[j]; sn[4 + j] = s1[j]; } }
                    else { const f32x4* t = (const f32x4*)(r128 + (size_t)row * 32 + 8 * (fq & 1)); const f32x4 c0 = t[0], c1 = t[1], s0 = t[4], s1 = t[5];
#pragma unroll
                        for (int j = 0; j < 4; ++j) { cs[j] = c0[j]; cs[4 + j] = c1[j]; sn[j] = s0[j]; sn[4 + j] = s1[j]; } }
                    const int xm = (mode == 1) ? 16 : 32;
                    const bool is_x1 = (mode == 1) ? (fq == 0) : (fq < 2);
                    const bool do_rot = (mode == 1) ? (fq < 2) : true;
#pragma unroll
                    for (int bj = 0; bj < NBJ_ROPE; ++bj)
#pragma unroll
                        for (int j = 0; j < 8; ++j) { const float p = __shfl_xor(v2[bj][j], xm); const float r = v2[bj][j] * cs[j] + (is_x1 ? -p : p) * sn[j]; v2[bj][j] = do_rot ? r : v2[bj][j]; }
                }
                u32x4 wq[2];
#pragma unroll
                for (int bj = 0; bj < 2; ++bj) {
                    float v[8];
#pragma unroll
                    for (int j = 0; j < 8; ++j) v[j] = v2[bj][j];
                    if (mode == 3) {
#pragma unroll
                        for (int j = 0; j < 8; ++j) v[j] = v[j] * fast_sigmoid(v[j]);
                    } else if (mode == 6) {
#pragma unroll
                        for (int j = 0; j < 8; ++j) v[j] = 1.f + __builtin_amdgcn_exp2f(-v[j] * LOG2E);
                    } else if (mode >= 4) {
#pragma unroll
                        for (int j = 0; j < 8; ++j) v[j] = fast_sigmoid(v[j]);
                    } else {
#pragma unroll
                        for (int j = 0; j < 8; ++j) v[j] *= sc;
                    }
                    u32x4 w; w.x = cvt_pk_bf16(v[0], v[1]); w.y = cvt_pk_bf16(v[2], v[3]); w.z = cvt_pk_bf16(v[4], v[5]); w.w = cvt_pk_bf16(v[6], v[7]);
                    wq[bj] = w;
#ifndef PAIR_COLS
                    const int col = cb + bj * EPI_BJ;
                    if (mode != 5 || col < 48) *(u32x4*)(base + (size_t)row * ldc + colt + col) = w;
#endif
                }
#ifdef PAIR_COLS
                {
                    u32x4 f1, f2;
#pragma unroll
                    for (int q = 0; q < 4; ++q) { f1[q] = (unsigned)__builtin_amdgcn_update_dpp((int)wq[0][q], (int)wq[1][q], 0x128, 0xF, 0xC, false);
                                                  f2[q] = (unsigned)__builtin_amdgcn_update_dpp((int)wq[1][q], (int)wq[0][q], 0x128, 0xF, 0x3, false); }
                    const int r1 = row - fr + (fr & 7), colp = wc * 64 + (fr >> 3) * 32 + 8 * fq;
                    if (mode != 5 || colp < 48) { *(u32x4*)(base + (size_t)r1 * ldc + colt + colp) = f1; *(u32x4*)(base + (size_t)(r1 + 8) * ldc + colt + colp) = f2; }
                }
#endif
            }
    }
#endif
    __device__ __forceinline__ void operator()(const f32x4 (&acc)[2][2][4][2], const Unit& u, int wr, int wc, int fr, int fq) const {
        const int pn = u.pn;
        bf16_t* base; int ldc, colt, mode; float sc = 1.f;
        if (pn < 4)       { base = (bf16_t*)(ws + WS_QA); ldc = 1024; colt = 256 * pn; mode = 1; sc = QS64; }
        else if (pn < 10) { base = (bf16_t*)(ws + WS_KC + (size_t)(pn - 4) * 8 * MiB); ldc = 256; colt = 0; mode = (pn == 6 || pn == 8) ? 1 : 0; }
        else if (pn < 14) { base = (bf16_t*)(ws + WS_ZA); ldc = 1024; colt = 256 * (pn - 10); mode = 3; }
        else if (pn < 18) { base = (bf16_t*)(ws + WS_QB); ldc = 1024; colt = 256 * (pn - 14); mode = 2; sc = QS128; }
        else if (pn < 22) { base = (bf16_t*)(ws + WS_KB); ldc = 1024; colt = 256 * (pn - 18); mode = 2; }
        else if (pn < 26) { base = (bf16_t*)(ws + WS_VB); ldc = 1024; colt = 256 * (pn - 22); mode = 0; }
        else if (pn < 30) { base = (bf16_t*)(ws + WS_ZB); ldc = 1024; colt = 256 * (pn - 26); mode = 3; }
#ifdef EA_GATE
        else if (pn < 38) { base = (bf16_t*)(dout + DO_MA); ldc = 2048; colt = 256 * (pn - 30); mode = 6; }
#else
        else if (pn < 38) { base = (bf16_t*)(dout + DO_MA); ldc = 2048; colt = 256 * (pn - 30); mode = 4; }
#endif
#ifdef EB_GATE
        else if (pn < 46) { base = (bf16_t*)(dout + DO_MB); ldc = 2048; colt = 256 * (pn - 38); mode = 6; }
#else
        else if (pn < 46) { base = (bf16_t*)(dout + DO_MB); ldc = 2048; colt = 256 * (pn - 38); mode = 4; }
#endif
        else              { base = (bf16_t*)(ws + WS_GA); ldc = 64; colt = 0; mode = 5; }
#ifdef EPI_SPEC
        switch (mode) { case 0: run<0>(acc, u, wr, wc, fr, fq, base, ldc, colt, sc); break; case 1: run<1>(acc, u, wr, wc, fr, fq, base, ldc, colt, sc); break;
                        case 2: run<2>(acc, u, wr, wc, fr, fq, base, ldc, colt, sc); break; case 3: run<3>(acc, u, wr, wc, fr, fq, base, ldc, colt, sc); break;
                        case 4: run<4>(acc, u, wr, wc, fr, fq, base, ldc, colt, sc); break; case 5: run<5>(acc, u, wr, wc, fr, fq, base, ldc, colt, sc); break;
                        default: run<6>(acc, u, wr, wc, fr, fq, base, ldc, colt, sc); break; }
        return;
#endif
        const int row0 = u.pm * BM + wr * 64 + fr;
        const int cb = EPI_C0(wc, fq);
#ifdef PAIR_COLS
        const bool rope_wave = (mode == 1) || (mode == 2 && (wc & 1) == 0);
        constexpr int NBJ_ROPE = 1;
#else
        const bool rope_wave = (mode == 1 && (wc & 1) == 0) || (mode == 2 && wc == 0);
        constexpr int NBJ_ROPE = 2;
#endif
#pragma unroll
        for (int ai = 0; ai < 2; ++ai)
#pragma unroll
            for (int m = 0; m < 4; ++m) {
                const int row = row0 + ai * HALF + m * 16;
                float v2[2][8];
#pragma unroll
                for (int bj = 0; bj < 2; ++bj)
#pragma unroll
                    for (int j = 0; j < 4; ++j) { v2[bj][j] = acc[ai][bj][m][0][j]; v2[bj][4 + j] = acc[ai][bj][m][1][j]; }
                if (rope_wave) {
                    float cs[8], sn[8];
                    if (mode == 1) { const f32x4* t = (const f32x4*)(r64 + (size_t)row * 16); const f32x4 c0 = t[0], c1 = t[1], s0 = t[2], s1 = t[3];
#pragma unroll
                        for (int j = 0; j < 4; ++j) { cs[j] = c0[j]; cs[4 + j] = c1[j]; sn[j] = s0[j]; sn[4 + j] = s1[j]; } }
                    else { const f32x4* t = (const f32x4*)(r128 + (size_t)row * 32 + 8 * (fq & 1)); const f32x4 c0 = t[0], c1 = t[1], s0 = t[4], s1 = t[5];
#pragma unroll
                        for (int j = 0; j < 4; ++j) { cs[j] = c0[j]; cs[4 + j] = c1[j]; sn[j] = s0[j]; sn[4 + j] = s1[j]; } }
                    const int xm = (mode == 1) ? 16 : 32;
                    const bool is_x1 = (mode == 1) ? (fq == 0) : (fq < 2);
                    const bool do_rot = (mode == 1) ? (fq < 2) : true;
#pragma unroll
                    for (int bj = 0; bj < NBJ_ROPE; ++bj)
#pragma unroll
                        for (int j = 0; j < 8; ++j) { const float p = __shfl_xor(v2[bj][j], xm); const float r = v2[bj][j] * cs[j] + (is_x1 ? -p : p) * sn[j]; v2[bj][j] = do_rot ? r : v2[bj][j]; }
                }
                u32x4 wq[2];
#pragma unroll
                for (int bj = 0; bj < 2; ++bj) {
                    float v[8];
#pragma unroll
                    for (int j = 0; j < 8; ++j) v[j] = v2[bj][j];
                    if (mode == 3) {
#pragma unroll
                        for (int j = 0; j < 8; ++j) v[j] = v[j] * fast_sigmoid(v[j]);
                    } else if (mode == 6) {
#pragma unroll
                        for (int j = 0; j < 8; ++j) v[j] = 1.f + __builtin_amdgcn_exp2f(-v[j] * LOG2E);
                    } else if (mode >= 4) {
#pragma unroll
                        for (int j = 0; j < 8; ++j) v[j] = fast_sigmoid(v[j]);
                    } else {
#pragma unroll
                        for (int j = 0; j < 8; ++j) v[j] *= sc;
                    }
                    u32x4 w; w.x = cvt_pk_bf16(v[0], v[1]); w.y = cvt_pk_bf16(v[2], v[3]); w.z = cvt_pk_bf16(v[4], v[5]); w.w = cvt_pk_bf16(v[6], v[7]);
                    wq[bj] = w;
#ifndef PAIR_COLS
                    const int col = cb + bj * EPI_BJ;
                    if (mode != 5 || col < 48) *(u32x4*)(base + (size_t)row * ldc + colt + col) = w;
#endif
                }
#ifdef PAIR_COLS
                {
                    u32x4 f1, f2;
#pragma unroll
                    for (int q = 0; q < 4; ++q) { f1[q] = (unsigned)__builtin_amdgcn_update_dpp((int)wq[0][q], (int)wq[1][q], 0x128, 0xF, 0xC, false);
                                                  f2[q] = (unsigned)__builtin_amdgcn_update_dpp((int)wq[1][q], (int)wq[0][q], 0x128, 0xF, 0x3, false); }
                    const int r1 = row - fr + (fr & 7), colp = wc * 64 + (fr >> 3) * 32 + 8 * fq;
                    if (mode != 5 || colp < 48) { *(u32x4*)(base + (size_t)r1 * ldc + colt + colp) = f1; *(u32x4*)(base + (size_t)(r1 + 8) * ldc + colt + colp) = f2; }
                }
#endif
            }
    }
};

struct EpiMerge {
    static constexpr bool PERM = true, AFTER_DRAIN = false, MIDHOOK = true;
    const bf16_t* sma; const bf16_t* smb; bf16_t* out;
#ifdef MID_TOUCH
    __device__ __forceinline__ void pre(const Unit& u, int wr, int wc, int which) const {
        int lane = (int)(threadIdx.x & 63u); asm volatile("" : "+v"(lane));
        const unsigned voff = (unsigned)(lane >> 1) * 4096u + (unsigned)(lane & 1) * 256u;
        const size_t e0 = (size_t)(u.pm * BM + wr * 64) * 2048 + u.pn * BM + wc * 32;
#pragma unroll
        for (int q = 0; q < 4; ++q) { const size_t eq = e0 + (size_t)((q >> 1) * HALF + 32 * (q & 1)) * 2048; unsigned t0;
            asm volatile("global_load_dword %0, %1, %2" : "=v"(t0) : "v"(voff), "s"(smb + eq) : "memory");
            if (which == 0) { unsigned t1; asm volatile("global_load_dword %0, %1, %2" : "=v"(t1) : "v"(voff), "s"(sma + eq) : "memory"); } }
    }
#endif
    __device__ __forceinline__ void mid(f32x4 (&acc)[2][2][4][2], const Unit& u, int wr, int wc, int fr, int fq) const {
        asm volatile("" : "+v"(fr), "+v"(fq));
#ifdef PAIR_ALL
        {   const int r1 = u.pm * BM + wr * 64 + (fr & 7), colp = u.pn * BM + wc * 64 + (fr >> 3) * 32 + 8 * fq;
#pragma unroll
            for (int ai = 0; ai < 2; ++ai)
#pragma unroll
                for (int m = 0; m < 4; ++m) { const size_t off = (size_t)(r1 + ai * HALF + m * 16) * 2048 + colp;
                    const u32x4 a1 = *(const u32x4*)(sma + off), a2 = *(const u32x4*)(sma + off + 8 * 2048), b1 = *(const u32x4*)(smb + off), b2 = *(const u32x4*)(smb + off + 8 * 2048);
                    u32x4 av[2], bv[2]; pair_rows(a1, a2, av[0], av[1]); pair_rows(b1, b2, bv[0], bv[1]);
#pragma unroll
                    for (int bj = 0; bj < 2; ++bj)
#pragma unroll
                        for (int q = 0; q < 4; ++q) { const float a0 = bflo(av[bj][q]), a1f = bfhi(av[bj][q]), b0 = bflo(bv[bj][q]), b1f = bfhi(bv[bj][q]);

#if defined(EB_GATE)
                            acc[ai][bj][m][q >> 1][(q & 1) * 2 + 0] *= a0 * b0; acc[ai][bj][m][q >> 1][(q & 1) * 2 + 1] *= a1f * b1f; }
#elif defined(EA_GATE)
                            acc[ai][bj][m][q >> 1][(q & 1) * 2 + 0] *= __builtin_amdgcn_rcpf(a0 * b0); acc[ai][bj][m][q >> 1][(q & 1) * 2 + 1] *= __builtin_amdgcn_rcpf(a1f * b1f); }
#else
                            acc[ai][bj][m][q >> 1][(q & 1) * 2 + 0] *= a0 * __builtin_amdgcn_rcpf(b0); acc[ai][bj][m][q >> 1][(q & 1) * 2 + 1] *= a1f * __builtin_amdgcn_rcpf(b1f); }
#endif
#ifdef PAIR_MIDW
                    if (m & 1) asm volatile("" ::: "memory"); }
#else
                    asm volatile("" ::: "memory"); }
#endif
            return; }
#endif
        const int row0 = u.pm * BM + wr * 64 + fr, col0 = u.pn * BM + EPI_C0(wc, fq);
#pragma unroll
        for (int ai = 0; ai < 2; ++ai)
#pragma unroll
            for (int m = 0; m < 4; ++m)
#pragma unroll
                for (int bj = 0; bj < 2; ++bj) { const size_t off = (size_t)(row0 + ai * HALF + m * 16) * 2048 + col0 + bj * EPI_BJ;
                    const u32x4 a = *(const u32x4*)(sma + off), b = *(const u32x4*)(smb + off);
#pragma unroll
                    for (int q = 0; q < 4; ++q) { const float a0 = bflo(a[q]), a1 = bfhi(a[q]), b0 = bflo(b[q]), b1 = bfhi(b[q]);
                        acc[ai][bj][m][q >> 1][(q & 1) * 2 + 0] *= a0 * __builtin_amdgcn_rcpf(b0); acc[ai][bj][m][q >> 1][(q & 1) * 2 + 1] *= a1 * __builtin_amdgcn_rcpf(b1); }
#ifdef MID_WIDE
                    if (bj == 1 && ((m & (MID_WIDE)) == (MID_WIDE))) asm volatile("" ::: "memory"); }
#else
                    if (bj == 1) asm volatile("" ::: "memory"); }
#endif
    }
    __device__ __forceinline__ void operator()(const f32x4 (&acc)[2][2][4][2], const Unit& u, int wr, int wc, int fr, int fq) const {
#ifdef PAIR_ALL
        {   const int r1 = u.pm * BM + wr * 64 + (fr & 7), colp = u.pn * BM + wc * 64 + (fr >> 3) * 32 + 8 * fq;
#pragma unroll
            for (int ai = 0; ai < 2; ++ai)
#pragma unroll
                for (int m = 0; m < 4; ++m) { const size_t off = (size_t)(r1 + ai * HALF + m * 16) * 2048 + colp;
                    const u32x4 b1 = *(const u32x4*)(smb + off), b2 = *(const u32x4*)(smb + off + 8 * 2048);
                    u32x4 bv[2], w[2], f1, f2; pair_rows(b1, b2, bv[0], bv[1]);
#pragma unroll
                    for (int bj = 0; bj < 2; ++bj)
#pragma unroll

#ifdef EB_GATE
                        for (int q = 0; q < 4; ++q) w[bj][q] = cvt_pk_bf16(acc[ai][bj][m][q >> 1][(q & 1) * 2 + 0] * __builtin_amdgcn_rcpf(bflo(bv[bj][q])), acc[ai][bj][m][q >> 1][(q & 1) * 2 + 1] * __builtin_amdgcn_rcpf(bfhi(bv[bj][q])));
#else
                        for (int q = 0; q < 4; ++q) w[bj][q] = cvt_pk_bf16(acc[ai][bj][m][q >> 1][(q & 1) * 2 + 0] * bflo(bv[bj][q]), acc[ai][bj][m][q >> 1][(q & 1) * 2 + 1] * bfhi(bv[bj][q]));
#endif
                    pair_rows(w[0], w[1], f1, f2);
#ifdef PAIR_EPIW
                    *(u32x4*)(out + off) = f1; *(u32x4*)(out + off + 8 * 2048) = f2; if ((m & (PAIR_EPIW)) == (PAIR_EPIW)) asm volatile("" ::: "memory"); }
#else
                    *(u32x4*)(out + off) = f1; *(u32x4*)(out + off + 8 * 2048) = f2; asm volatile("" ::: "memory"); }
#endif
            return; }
#endif
        const int row0 = u.pm * BM + wr * 64 + fr, col0 = u.pn * BM + EPI_C0(wc, fq);
#pragma unroll
        for (int ai = 0; ai < 2; ++ai)
#pragma unroll
            for (int m = 0; m < 4; ++m)
#pragma unroll
                for (int bj = 0; bj < 2; ++bj) { const size_t off = (size_t)(row0 + ai * HALF + m * 16) * 2048 + col0 + bj * EPI_BJ;
                    const u32x4 b = *(const u32x4*)(smb + off); u32x4 w;
#pragma unroll
                    for (int q = 0; q < 4; ++q) w[q] = cvt_pk_bf16(acc[ai][bj][m][q >> 1][(q & 1) * 2 + 0] * bflo(b[q]), acc[ai][bj][m][q >> 1][(q & 1) * 2 + 1] * bfhi(b[q]));
#ifdef EPI_WIDE
                    *(u32x4*)(out + off) = w; if (bj == 1 && ((m & (EPI_WIDE)) == (EPI_WIDE))) asm volatile("" ::: "memory"); }
#else
                    *(u32x4*)(out + off) = w; if (bj == 1) asm volatile("" ::: "memory"); }
#endif
    }
};

struct EpiOut {
    static constexpr bool PERM = false, AFTER_DRAIN = false, MIDHOOK = false;
    float* C; float* ssq;
    __device__ __forceinline__ void mid(f32x4 (&)[2][2][4][2], const Unit&, int, int, int, int) const {}
    __device__ __forceinline__ void operator()(const f32x4 (&acc)[2][2][4][2], const Unit& u, int wr, int wc, int fr, int fq) const {
        const int row0 = u.pm * BM + wr * 64 + fr, col0 = u.pn * BM + wc * 32 + 4 * fq;
#pragma unroll
        for (int ai = 0; ai < 2; ++ai)
#pragma unroll
            for (int m = 0; m < 4; ++m) { const int row = row0 + ai * HALF + m * 16; float* rowp = C + (size_t)row * 2048 + col0; float s = 0.f;
#pragma unroll
                for (int bj = 0; bj < 2; ++bj)
#pragma unroll
                    for (int n = 0; n < 2; ++n) { const f32x4 x = acc[ai][bj][m][n]; *(f32x4*)(rowp + bj * HALF + n * 16) = x; s += (x[0] * x[0] + x[1] * x[1]) + (x[2] * x[2] + x[3] * x[3]); }
                s += __shfl_xor(s, 16); s += __shfl_xor(s, 32);
                if (fq == 0) ssq[(size_t)row * 32 + u.pn * 4 + wc] = s; }
    }
};

struct EpiOutB {
    static constexpr bool PERM = true, AFTER_DRAIN = false, MIDHOOK = false;
    bf16_t* C; float* ssq;
    __device__ __forceinline__ void mid(f32x4 (&)[2][2][4][2], const Unit&, int, int, int, int) const {}
    __device__ __forceinline__ void operator()(const f32x4 (&acc)[2][2][4][2], const Unit& u, int wr, int wc, int fr, int fq) const {
        const int row0 = u.pm * BM + wr * 64 + fr, col0 = u.pn * BM + EPI_C0(wc, fq);
        float sarr[2][4]; (void)sarr;
#pragma unroll
        for (int ai = 0; ai < 2; ++ai)
#pragma unroll
            for (int m = 0; m < 4; ++m) { const int row = row0 + ai * HALF + m * 16; bf16_t* rowp = C + (size_t)row * 2048 + col0; float s = 0.f; u32x4 wq[2]; (void)rowp; (void)wq;
#pragma unroll
                for (int bj = 0; bj < 2; ++bj) { const f32x4 x0 = acc[ai][bj][m][0], x1 = acc[ai][bj][m][1];
                    s += ((x0[0] * x0[0] + x0[1] * x0[1]) + (x0[2] * x0[2] + x0[3] * x0[3])) + ((x1[0] * x1[0] + x1[1] * x1[1]) + (x1[2] * x1[2] + x1[3] * x1[3]));
                    u32x4 w; w.x = cvt_pk_bf16(x0[0], x0[1]); w.y = cvt_pk_bf16(x0[2], x0[3]); w.z = cvt_pk_bf16(x1[0], x1[1]); w.w = cvt_pk_bf16(x1[2], x1[3]);
#ifdef PAIR_ALL
                    wq[bj] = w; }
                { u32x4 f1, f2; pair_rows(wq[0], wq[1], f1, f2);
                  bf16_t* pp = C + (size_t)(row - fr + (fr & 7)) * 2048 + u.pn * BM + wc * 64 + (fr >> 3) * 32 + 8 * fq; *(u32x4*)pp = f1; *(u32x4*)(pp + 8 * 2048) = f2; }
#else
                    *(u32x4*)(rowp + bj * EPI_BJ) = w; }
#endif
#ifdef PRE_SSQ
                (void)s; }
        if (false) { float s = 0.f; const int row = 0; const int ai = 0, m = 0; (void)ai; (void)m;
#endif
                s += __shfl_xor(s, 16); s += __shfl_xor(s, 32);
#ifdef SSQ_T
                sarr[ai][m] = s; }
#pragma unroll
        for (int ai = 0; ai < 2; ++ai) { const float v = fq == 0 ? sarr[ai][0] : fq == 1 ? sarr[ai][1] : fq == 2 ? sarr[ai][2] : sarr[ai][3];
            ssq[(size_t)(u.pn * 4 + wc) * 16384 + u.pm * BM + wr * 64 + ai * HALF + fq * 16 + fr] = v; }
#else
                if (fq == 0) ssq[(size_t)row * 32 + u.pn * 4 + wc] = s; }
#endif
    }
};

struct EpiFinal {
    static constexpr bool PERM = false, AFTER_DRAIN = false, MIDHOOK = false;
    const float* x; float* out; float* ssq; unsigned* cnt; const float* ada; const float* gpost;
    __device__ __forceinline__ void mid(f32x4 (&)[2][2][4][2], const Unit&, int, int, int, int) const {}
    __device__ __forceinline__ void operator()(const f32x4 (&acc)[2][2][4][2], const Unit& u, int wr, int wc, int fr, int fq) const {
        const int row0 = u.pm * BM + wr * 64 + fr, col0 = u.pn * BM + wc * 32 + 4 * fq;
#pragma unroll
        for (int ai = 0; ai < 2; ++ai)
#pragma unroll
            for (int m = 0; m < 4; ++m) { const int row = row0 + ai * HALF + m * 16; float s = 0.f;
#pragma unroll
                for (int bj = 0; bj < 2; ++bj)
#pragma unroll
                    for (int n = 0; n < 2; ++n) { const f32x4 v = acc[ai][bj][m][n]; s += (v[0] * v[0] + v[1] * v[1]) + (v[2] * v[2] + v[3] * v[3]); }
                s += __shfl_xor(s, 16); s += __shfl_xor(s, 32);
                if (fq == 0) __hip_atomic_store(ssq + (size_t)row * 32 + u.pn * 4 + wc, s, __ATOMIC_RELAXED, __HIP_MEMORY_SCOPE_AGENT); }
        asm volatile("s_waitcnt vmcnt(0)" ::: "memory");
        unsigned* c = cnt + 64 * u.pm;
        if (fr == 0 && fq == 0) __hip_atomic_fetch_add(c, 1u, __ATOMIC_RELAXED, __HIP_MEMORY_SCOPE_AGENT);
        { unsigned spins = 0;
          while ((unsigned)__builtin_amdgcn_readfirstlane(__hip_atomic_load(c, __ATOMIC_RELAXED, __HIP_MEMORY_SCOPE_AGENT)) < 64u) { __builtin_amdgcn_s_sleep(2); if (++spins > (1u << 22)) break; } }
        const int b = (u.pm * BM) >> 11;
        f32x4 gg[2][2];
#pragma unroll
        for (int bj = 0; bj < 2; ++bj)
#pragma unroll
            for (int n = 0; n < 2; ++n) { const int col = col0 + bj * HALF + n * 16; gg[bj][n] = *(const f32x4*)(ada + b * 6144 + 4096 + col) * *(const f32x4*)(gpost + col); }
#pragma unroll
        for (int ai = 0; ai < 2; ++ai)
#pragma unroll
            for (int m = 0; m < 4; ++m) { const int row = row0 + ai * HALF + m * 16; const float* sp = ssq + (size_t)row * 32 + 8 * fq; float s = 0.f;
#pragma unroll
                for (int q = 0; q < 8; ++q) s += __hip_atomic_load(sp + q, __ATOMIC_RELAXED, __HIP_MEMORY_SCOPE_AGENT);
                s += __shfl_xor(s, 16); s += __shfl_xor(s, 32);
                const float rstd = rsqrtf(s * (1.f / 2048.f) + 1e-6f);
                const float* xr = x + (size_t)row * 2048 + col0; float* orow = out + (size_t)row * 2048 + col0;
#pragma unroll
                for (int bj = 0; bj < 2; ++bj)
#pragma unroll
                    for (int n = 0; n < 2; ++n) { const f32x4 xv = *(const f32x4*)(xr + bj * HALF + n * 16); *(f32x4*)(orow + bj * HALF + n * 16) = xv + gg[bj][n] * (acc[ai][bj][m][n] * rstd); }
                if (m & 1) asm volatile("" ::: "memory"); }
    }
};

struct PanelOrder {
    int nN, nwg, G, v;
    __host__ __device__ void init(int M, int N, int G_, int v_) { nN = N / BM; nwg = (M / BM) * nN; G = G_; v = v_; }
    __host__ __device__ bool next(int i, Unit& u) const { const long L = (long)i * G + v; if (L >= nwg) return false; u.pm = (int)(L / nN); u.pn = (int)(L % nN); return true; }
    __device__ __forceinline__ void a_ready(const Unit&) const {}
    __device__ __forceinline__ void done(const Unit&) const {}
};
template <class Epi, class Sched, bool ALIGN_EPI = false, bool SP2 = false>
__device__ __forceinline__ void gemm_phase(PG8_LAS unsigned char* lds, const Gemm g, const Sched& S, const Epi& E) {
    const int tid = threadIdx.x, wid = __builtin_amdgcn_readfirstlane(tid >> 6), lane = tid & 63, wr = wid >> 2, wc = wid & 3, fr = lane & 15, fq = lane >> 4;
    const int K = g.K, nt = K / BK;
    unsigned voffA[2], voffB[2];
#pragma unroll
#ifdef PAIR_COLS
    for (int i = 0; i < 2; ++i) { int R, C; stage_rc(tid * 16 + i * 8192, R, C); const int Rb = Epi::PERM ? ((R >> 5) * 64 + perm32(R & 31)) : R;
        voffA[i] = (unsigned)(R * K + C) * 2u; voffB[i] = (unsigned)(Rb * K + C) * 2u; }
#else
    for (int i = 0; i < 2; ++i) { int R, C; stage_rc(tid * 16 + i * 8192, R, C); const int Rb = Epi::PERM ? ((R & ~31) + perm32(R & 31)) : R;
        voffA[i] = (unsigned)(R * K + C) * 2u; voffB[i] = (unsigned)(Rb * K + C) * 2u; }
#endif
    const size_t kstep = (size_t)(BK * 2);
    const size_t hstep = (size_t)HALF * K * 2;
#ifdef PAIR_COLS
    const size_t hstepB = Epi::PERM ? (size_t)32 * K * 2 : hstep;
#else
    const size_t hstepB = hstep;
#endif
    const size_t tstep = 2 * hstep;
    const unsigned ldsw = (unsigned)wid * 1024u;
    const int aoff = lds_byte(wr * 64 + fr, fq * 8), boff = lds_byte(wc * 32 + fr, fq * 8);
#define PG8_SA(b, h) (((b) * 2 + (h)) * HTB)
#define PG8_SB(b, h) ((4 + (b) * 2 + (h)) * HTB)
#define PG8_STAGE(bufoff, gbase, voff) do { _Pragma("unroll") for (int _i = 0; _i < 2; ++_i) \
        __builtin_amdgcn_global_load_lds((const unsigned*)((const char*)(gbase) + (voff)[_i]), (PG8_LAS unsigned*)(lds + (bufoff) + ldsw + _i * 8192), 16, 0, 0); } while (0)
#define PG8_LDA(dst, b, h) do { _Pragma("unroll") for (int m = 0; m < 4; ++m) _Pragma("unroll") for (int k = 0; k < 2; ++k) dst[m][k] = *(const PG8_LAS bf16x8*)(lds + PG8_SA(b, h) + aoff + m * 2048 + k * 1024); } while (0)
#define PG8_LDB(dst, b, h) do { _Pragma("unroll") for (int n = 0; n < 2; ++n) _Pragma("unroll") for (int k = 0; k < 2; ++k) dst[n][k] = *(const PG8_LAS bf16x8*)(lds + PG8_SB(b, h) + boff + n * 2048 + k * 1024); } while (0)
#define PG8_MMA(ai, bj, At, Bt) do { __builtin_amdgcn_s_setprio(1); _Pragma("unroll") for (int m = 0; m < 4; ++m) _Pragma("unroll") for (int n = 0; n < 2; ++n) _Pragma("unroll") for (int k = 0; k < 2; ++k) \
        acc[ai][bj][m][n] = __builtin_amdgcn_mfma_f32_16x16x32_bf16(Bt[n][k], At[m][k], acc[ai][bj][m][n], 0, 0, 0); __builtin_amdgcn_s_setprio(0); } while (0)
#define PG8_WAIT_V(n) asm volatile("s_waitcnt vmcnt(" #n ")" ::: "memory")
#define PG8_WAIT_L(n) asm volatile("s_waitcnt lgkmcnt(" #n ")" ::: "memory")
#define PG8_BAR __builtin_amdgcn_s_barrier()
#define PG8_SCHED __builtin_amdgcn_sched_barrier(0)
    Unit cur, nxt; int ui = 0;
    if (!S.next(0, cur)) return;
    f32x4 acc[2][2][4][2];
#pragma unroll
    for (int a = 0; a < 2; ++a)
#pragma unroll
        for (int b = 0; b < 2; ++b)
#pragma unroll
            for (int m = 0; m < 4; ++m)
#pragma unroll
                for (int n = 0; n < 2; ++n) acc[a][b][m][n] = (f32x4){0.f, 0.f, 0.f, 0.f};
    bf16x8 At[4][2], B0[2][2], B1[2][2];
    const char* cA = (const char*)g.A + (size_t)cur.pm * tstep; const char* cB = (const char*)g.Bt + (size_t)cur.pn * tstep;
    S.a_ready(cur);
    if constexpr (SP2) {
        PG8_STAGE(PG8_SB(0, 0), cB, voffB); PG8_STAGE(PG8_SB(0, 1), cB + hstepB, voffB); PG8_STAGE(PG8_SA(0, 0), cA, voffA); PG8_STAGE(PG8_SA(0, 1), cA + hstep, voffA);
        if (wr == 1) PG8_BAR;
        PG8_WAIT_V(2); PG8_BAR;
        PG8_STAGE(PG8_SB(1, 0), cB + kstep, voffB); PG8_STAGE(PG8_SA(1, 0), cA + kstep, voffA); PG8_STAGE(PG8_SB(1, 1), cB + hstepB + kstep, voffB);
        PG8_WAIT_V(6); PG8_BAR;
    } else {
        PG8_STAGE(PG8_SB(0, 0), cB, voffB); PG8_STAGE(PG8_SA(0, 0), cA, voffA); PG8_STAGE(PG8_SB(0, 1), cB + hstepB, voffB); PG8_STAGE(PG8_SA(0, 1), cA + hstep, voffA);
        if (wr == 1) PG8_BAR;
        PG8_WAIT_V(4); PG8_BAR;
        PG8_STAGE(PG8_SB(1, 0), cB + kstep, voffB); PG8_STAGE(PG8_SA(1, 0), cA + kstep, voffA); PG8_STAGE(PG8_SB(1, 1), cB + hstepB + kstep, voffB);
        PG8_WAIT_V(6); PG8_BAR;
    }
    for (;;) {
        const bool has_next = S.next(ui + 1, nxt);
        const char* nA = has_next ? (const char*)g.A + (size_t)nxt.pm * tstep : cA; const char* nB = has_next ? (const char*)g.Bt + (size_t)nxt.pn * tstep : cB;
        for (int t = 0; t < nt; t += 2) {
            const bool last = (t == nt - 2);
#ifdef MID_TOUCH
            if constexpr (Epi::MIDHOOK) { if (t == nt / 2 - 4) E.pre(cur, wr, wc, 0); if (t == nt - 4) E.pre(cur, wr, wc, 1); }
#endif
            if constexpr (Epi::MIDHOOK) { if (t == nt / 2) E.mid(acc, cur, wr, wc, fr, fq); }
            const char* a1 = cA + (size_t)(t + 1) * kstep;
            const char* a2 = last ? nA : cA + (size_t)(t + 2) * kstep; const char* b2 = last ? nB : cB + (size_t)(t + 2) * kstep;
            const char* a3 = a2 + kstep; const char* b3 = b2 + kstep;
            if (last && has_next) S.a_ready(nxt);
            if constexpr (SP2) {
            PG8_LDB(B0, 0, 0); PG8_LDB(B1, 0, 1); PG8_SCHED; PG8_LDA(At, 0, 0); PG8_STAGE(PG8_SA(1, 1), a1 + hstep, voffA);
            PG8_WAIT_V(8); PG8_WAIT_L(0); PG8_BAR; PG8_MMA(0, 0, At, B0); PG8_MMA(0, 1, At, B1); PG8_BAR; PG8_SCHED;
            PG8_LDA(At, 0, 1); PG8_STAGE(PG8_SB(0, 0), b2, voffB); PG8_STAGE(PG8_SB(0, 1), b2 + hstepB, voffB); PG8_STAGE(PG8_SA(0, 0), a2, voffA);
            PG8_WAIT_V(8); PG8_WAIT_L(0); PG8_BAR; PG8_MMA(1, 0, At, B0); PG8_MMA(1, 1, At, B1); PG8_BAR; PG8_SCHED;
            PG8_LDB(B0, 1, 0); PG8_LDB(B1, 1, 1); PG8_SCHED; PG8_LDA(At, 1, 0); PG8_STAGE(PG8_SA(0, 1), a2 + hstep, voffA);
            PG8_WAIT_V(8); PG8_WAIT_L(0); PG8_BAR; PG8_MMA(0, 0, At, B0); PG8_MMA(0, 1, At, B1); PG8_BAR; PG8_SCHED;
            PG8_LDA(At, 1, 1); PG8_STAGE(PG8_SB(1, 0), b3, voffB); PG8_STAGE(PG8_SB(1, 1), b3 + hstepB, voffB); PG8_STAGE(PG8_SA(1, 0), a3, voffA);
            PG8_WAIT_V(8); PG8_WAIT_L(0); PG8_BAR; PG8_MMA(1, 0, At, B0); PG8_MMA(1, 1, At, B1); PG8_BAR; PG8_SCHED;
            } else {
            PG8_LDB(B0, 0, 0); PG8_SCHED; PG8_LDA(At, 0, 0); PG8_STAGE(PG8_SA(1, 1), a1 + hstep, voffA);
            PG8_WAIT_L(8); PG8_BAR; PG8_WAIT_L(0); PG8_MMA(0, 0, At, B0); PG8_BAR; PG8_SCHED;
            PG8_LDB(B1, 0, 1); PG8_STAGE(PG8_SB(0, 0), b2, voffB);
            PG8_BAR; PG8_WAIT_L(0); PG8_MMA(0, 1, At, B1); PG8_BAR;
            PG8_LDA(At, 0, 1); PG8_STAGE(PG8_SA(0, 0), a2, voffA);
            PG8_BAR; PG8_WAIT_L(0); PG8_MMA(1, 0, At, B0); PG8_BAR; PG8_SCHED;
            PG8_STAGE(PG8_SB(0, 1), b2 + hstepB, voffB);
            PG8_WAIT_V(6); PG8_BAR; PG8_MMA(1, 1, At, B1); PG8_BAR;
            PG8_LDB(B0, 1, 0); PG8_SCHED; PG8_LDA(At, 1, 0); PG8_STAGE(PG8_SA(0, 1), a2 + hstep, voffA);
            PG8_WAIT_L(8); PG8_BAR; PG8_WAIT_L(0); PG8_MMA(0, 0, At, B0); PG8_BAR; PG8_SCHED;
            PG8_LDB(B1, 1, 1); PG8_STAGE(PG8_SB(1, 0), b3, voffB);
            PG8_BAR; PG8_WAIT_L(0); PG8_MMA(0, 1, At, B1); PG8_BAR;
            PG8_LDA(At, 1, 1); PG8_STAGE(PG8_SA(1, 0), a3, voffA);
            PG8_BAR; PG8_WAIT_L(0); PG8_MMA(1, 0, At, B0); PG8_BAR; PG8_SCHED;
            PG8_STAGE(PG8_SB(1, 1), b3 + hstepB, voffB);
            PG8_WAIT_V(6); PG8_BAR; PG8_MMA(1, 1, At, B1); PG8_BAR;
            }
        }
        if constexpr (ALIGN_EPI) { if (wr == 0) PG8_BAR; }
        if constexpr (!Epi::AFTER_DRAIN) { E(acc, cur, wr, wc, fr, fq); S.done(cur); }
        if (!has_next) break;
#pragma unroll
        for (int a = 0; a < 2; ++a)
#pragma unroll
            for (int b = 0; b < 2; ++b)
#pragma unroll
                for (int m = 0; m < 4; ++m)
#pragma unroll
                    for (int n = 0; n < 2; ++n) acc[a][b][m][n] = (f32x4){0.f, 0.f, 0.f, 0.f};
        cur = nxt; cA = nA; cB = nB; ++ui;
        if constexpr (ALIGN_EPI) { if (wr == 1) PG8_BAR; }
    }
    PG8_WAIT_V(0);
    if constexpr (!ALIGN_EPI) { if (wr == 0) PG8_BAR; }
    PG8_BAR;
    if constexpr (Epi::AFTER_DRAIN) { E.fused(acc, cur, wr, wc, fr, fq, lds, wid, lane); S.done(cur); }
#undef PG8_SA
#undef PG8_SB
#undef PG8_STAGE
#undef PG8_LDA
#undef PG8_LDB
#undef PG8_MMA
#undef PG8_WAIT_V
#undef PG8_WAIT_L
#undef PG8_BAR
#undef PG8_SCHED
}
}

namespace att {
typedef short bf16x8 __attribute__((ext_vector_type(8)));
typedef short s16x4 __attribute__((ext_vector_type(4)));
typedef short v4i16_t __attribute__((ext_vector_type(4)));
typedef float f32x16 __attribute__((ext_vector_type(16)));
constexpr float NEGINF = -__builtin_inff();

constexpr int L_K0 = 0, L_K1 = 16384, L_V0 = 32768, L_V1 = 49152;
template <int D> struct Tile { u32x4_t k[D / 64]; u32x4_t v[D / 64]; };
template <int D> __device__ __forceinline__ void tile_load(Tile<D>& T, const bf16_t* Kp, const bf16_t* Vp, int pitch, int wid, int lane) {
#pragma unroll
    for (int i = 0; i < D / 64; ++i) { const int pc = wid + 8 * i;
        T.k[i] = *(const u32x4_t*)(Kp + (size_t)lane * pitch + pc * 8);
        T.v[i] = *(const u32x4_t*)(Vp + (size_t)(16 * (pc & 3) + (lane >> 2)) * pitch + 32 * (pc >> 2) + 8 * (lane & 3)); }
}
template <int D> __device__ __forceinline__ void tile_store(const Tile<D>& T, LAS unsigned char* kbuf, LAS unsigned char* vbuf, int wid, int lane) {
#pragma unroll
    for (int i = 0; i < D / 64; ++i) { const int pc = wid + 8 * i;
        *(LAS u32x4_t*)(kbuf + pc * 1024 + lane * 16) = T.k[i]; *(LAS u32x4_t*)(vbuf + pc * 1024 + lane * 16) = T.v[i]; }
}
#ifdef CMP_COAL
__device__ __forceinline__ void tile_load_c(Tile<64>& T, const bf16_t* Kp, const bf16_t* Vp, int wid, int lane) {
    T.k[0] = *(const u32x4_t*)(Kp + (size_t)(wid * 64 + lane) * 8); T.v[0] = *(const u32x4_t*)(Vp + (size_t)(wid * 64 + lane) * 8);
}
__device__ __forceinline__ void tile_store_c(const Tile<64>& T, LAS unsigned char* kbuf, LAS unsigned char* vbuf, int wid, int lane) {
    const int R = 8 * wid + (lane >> 3), C = lane & 7;
    *(LAS u32x4_t*)(kbuf + C * 1024 + R * 16) = T.k[0];
    *(LAS u32x4_t*)(vbuf + ((R >> 4) + 4 * (C >> 2)) * 1024 + ((R & 15) * 4 + (C & 3)) * 16) = T.v[0];
}
#endif
template <int D> __device__ __forceinline__ void k_load(Tile<D>& T, const bf16_t* Kp, int pitch, int wid, int lane) {
#pragma unroll
    for (int i = 0; i < D / 64; ++i) T.k[i] = *(const u32x4_t*)(Kp + (size_t)lane * pitch + (wid + 8 * i) * 8);
}
template <int D> __device__ __forceinline__ void v_load(Tile<D>& T, const bf16_t* Vp, int pitch, int wid, int lane) {
#pragma unroll
    for (int i = 0; i < D / 64; ++i) { const int pc = wid + 8 * i; T.v[i] = *(const u32x4_t*)(Vp + (size_t)(16 * (pc & 3) + (lane >> 2)) * pitch + 32 * (pc >> 2) + 8 * (lane & 3)); }
}
template <int D> __device__ __forceinline__ void k_store(const Tile<D>& T, LAS unsigned char* kbuf, int wid, int lane) {
#pragma unroll
    for (int i = 0; i < D / 64; ++i) *(LAS u32x4_t*)(kbuf + (wid + 8 * i) * 1024 + lane * 16) = T.k[i];
}
template <int D> __device__ __forceinline__ void v_store(const Tile<D>& T, LAS unsigned char* vbuf, int wid, int lane) {
#pragma unroll
    for (int i = 0; i < D / 64; ++i) *(LAS u32x4_t*)(vbuf + (wid + 8 * i) * 1024 + lane * 16) = T.v[i];
}
template <int D> __device__ __forceinline__ void qkt(f32x16& p0, f32x16& p1, const LAS unsigned char* kbuf, const bf16x8* qr, int r32, int hi) {
    p0 = f32x16{}; p1 = f32x16{};
    const LAS unsigned char* kb = kbuf + hi * 1024 + r32 * 16;
#pragma unroll
    for (int d0 = 0; d0 < D / 16; ++d0) {
        const bf16x8 b0 = *(const LAS bf16x8*)(kb + d0 * 2048), b1 = *(const LAS bf16x8*)(kb + d0 * 2048 + 512);
        p0 = __builtin_amdgcn_mfma_f32_32x32x16_bf16(b0, qr[d0], p0, 0, 0, 0);
        p1 = __builtin_amdgcn_mfma_f32_32x32x16_bf16(b1, qr[d0], p1, 0, 0, 0); }
}
__device__ __forceinline__ s16x4 vtr(const LAS unsigned char* p) { return __builtin_bit_cast(s16x4, __builtin_amdgcn_ds_read_tr16_b64_v4i16((LAS v4i16_t*)p)); }
template <int D> __device__ __forceinline__ void pv(f32x16* o, const LAS unsigned char* vbuf, const bf16x8* pa, int lane) {
    const LAS unsigned char* vb = vbuf + ((lane >> 4) & 1) * 32 + (lane & 3) * 8 + (4 * (lane >> 5) + ((lane & 15) >> 2)) * 64;
#pragma unroll
    for (int dp = 0; dp < D / 64; ++dp) {
        s16x4 lo[2][4], hh[2][4];
#pragma unroll
        for (int e = 0; e < 2; ++e)
#pragma unroll
            for (int ks = 0; ks < 4; ++ks) { lo[e][ks] = vtr(vb + (2 * dp + e) * 4096 + ks * 1024); hh[e][ks] = vtr(vb + (2 * dp + e) * 4096 + ks * 1024 + 512); }
        __builtin_amdgcn_sched_barrier(0);
#pragma unroll
        for (int e = 0; e < 2; ++e)
#pragma unroll
            for (int ks = 0; ks < 4; ++ks) { const bf16x8 vf = {lo[e][ks][0], lo[e][ks][1], lo[e][ks][2], lo[e][ks][3], hh[e][ks][0], hh[e][ks][1], hh[e][ks][2], hh[e][ks][3]};
                o[2 * dp + e] = __builtin_amdgcn_mfma_f32_32x32x16_bf16(vf, pa[ks], o[2 * dp + e], 0, 0, 0); }
    }
}
__device__ __forceinline__ float xhalf_max(float v) { auto rr = __builtin_amdgcn_permlane32_swap(__float_as_uint(v), __float_as_uint(v), false, false); return fmaxf(__uint_as_float(rr[0]), __uint_as_float(rr[1])); }
__device__ __forceinline__ float xhalf_sum(float v) { auto rr = __builtin_amdgcn_permlane32_swap(__float_as_uint(v), __float_as_uint(v), false, false); return __uint_as_float(rr[0]) + __uint_as_float(rr[1]); }
typedef float f32x2_cv __attribute__((ext_vector_type(2))); typedef __bf16 bf16x2_cv __attribute__((ext_vector_type(2)));
__device__ __forceinline__ unsigned cvtpk(float lo, float hi) { f32x2_cv v = {lo, hi}; bf16x2_cv b = __builtin_convertvector(v, bf16x2_cv); return __builtin_bit_cast(unsigned, b); }
__device__ __forceinline__ bf16x8 pack8(const f32x16& p, int b) { u32x4_t w = {cvtpk(p[b], p[b + 1]), cvtpk(p[b + 2], p[b + 3]), cvtpk(p[b + 4], p[b + 5]), cvtpk(p[b + 6], p[b + 7])}; return __builtin_bit_cast(bf16x8, w); }
__device__ __forceinline__ float rowmax32(const f32x16& p0, const f32x16& p1) {
    float a = fmaxf(p0[0], p1[0]);
#pragma unroll
    for (int r = 1; r < 16; ++r) a = fmaxf(a, fmaxf(p0[r], p1[r]));
    return xhalf_max(a);
}
__device__ __forceinline__ void mask_band(f32x16& p0, f32x16& p1, int dq, unsigned band) {
#pragma unroll
    for (int r = 0; r < 16; ++r) { const int c = (r & 3) + 8 * (r >> 2);
        if ((unsigned)(dq - c) > band) p0[r] = NEGINF;
        if ((unsigned)(dq - c - 32) > band) p1[r] = NEGINF; }
}
constexpr float THR = 10.f;
template <int D> struct State { float m; int cls, tc; f32x16 ci; f32x16 o[D / 32]; f32x16 ol; };
template <int D> __device__ __forceinline__ void state_reset(State<D>& st) { st.m = 0.f; st.cls = -1; st.tc = 0; st.ci = f32x16{}; st.ol = f32x16{};
#pragma unroll
    for (int i = 0; i < D / 32; ++i) st.o[i] = f32x16{}; }
__device__ __forceinline__ f32x16 mfma3(bf16x8 a, bf16x8 b, const f32x16& c) { f32x16 d; asm volatile("v_mfma_f32_32x32x16_bf16 %0, %1, %2, %3" : "=&v"(d) : "v"(a), "v"(b), "v"(c)); return d; }
template <int D> __device__ __forceinline__ void qkt_c(f32x16& p0, f32x16& p1, const LAS unsigned char* kbuf, const bf16x8* qr, int r32, int hi, const f32x16& c0, const f32x16& c1) {
    const LAS unsigned char* kb = kbuf + hi * 1024 + r32 * 16;
#pragma unroll
    for (int dc = 0; dc < D / 64; ++dc) {
        bf16x8 kf0[4], kf1[4];
#pragma unroll
        for (int e = 0; e < 4; ++e) { kf0[e] = *(const LAS bf16x8*)(kb + (4 * dc + e) * 2048); kf1[e] = *(const LAS bf16x8*)(kb + (4 * dc + e) * 2048 + 512); }
        __builtin_amdgcn_sched_barrier(0);
        __builtin_amdgcn_s_setprio(1);
#pragma unroll
        for (int e = 0; e < 4; ++e) { const int d0 = 4 * dc + e;
            if (d0 == 0) { p0 = mfma3(kf0[e], qr[d0], c0); p1 = mfma3(kf1[e], qr[d0], c1); }
            else { p0 = __builtin_amdgcn_mfma_f32_32x32x16_bf16(kf0[e], qr[d0], p0, 0, 0, 0); p1 = __builtin_amdgcn_mfma_f32_32x32x16_bf16(kf1[e], qr[d0], p1, 0, 0, 0); } }
        __builtin_amdgcn_s_setprio(0);
    }
}
__device__ __forceinline__ float rowmax32_3(const f32x16& p0, const f32x16& p1) {
    float a = fmaxf(fmaxf(p0[0], p0[1]), p1[0]), b = fmaxf(fmaxf(p0[2], p0[3]), p1[1]); a = fmaxf(fmaxf(a, p1[2]), p1[3]);
#pragma unroll
    for (int r = 4; r < 16; r += 4) { a = fmaxf(fmaxf(a, p0[r]), p0[r + 1]); b = fmaxf(fmaxf(b, p0[r + 2]), p0[r + 3]); a = fmaxf(fmaxf(a, p1[r]), p1[r + 1]); b = fmaxf(fmaxf(b, p1[r + 2]), p1[r + 3]); }
    return xhalf_max(fmaxf(a, b));
}
template <int D, class Pol> __device__ __forceinline__ void softmax_p(State<D>& st, const Pol& pol, f32x16& p0, f32x16& p1, bf16x8* pa) {
    const float mx = rowmax32_3(p0, p1);
    if (__builtin_expect(__any(mx > THR), 0)) {
        const float dl = fmaxf(mx, 0.f); st.m += dl; const float f = __builtin_amdgcn_exp2f(-dl);
#pragma unroll
        for (int r = 0; r < 16; ++r) { p0[r] -= dl; p1[r] -= dl; st.ol[r] *= f; }
#pragma unroll
        for (int i = 0; i < D / 32; ++i)
#pragma unroll
            for (int r = 0; r < 16; ++r) st.o[i][r] *= f;
        pol.build(st);
    }
#pragma unroll
    for (int r = 0; r < 16; ++r) { p0[r] = __builtin_amdgcn_exp2f(p0[r]); p1[r] = __builtin_amdgcn_exp2f(p1[r]); }
    pa[0] = pack8(p0, 0); pa[1] = pack8(p0, 8); pa[2] = pack8(p1, 0); pa[3] = pack8(p1, 8);
}
#ifndef SGB_XV
#define SGB_XV 0
#endif
template <int D, class Pol> __device__ __forceinline__ void softmax_head(State<D>& st, const Pol& pol, f32x16& p0, f32x16& p1) {
#ifdef MAX_STRIDE
    if ((st.tc++ & (MAX_STRIDE - 1)) != 0) return;
#endif
    const float mx = rowmax32_3(p0, p1);
    if (__builtin_expect(__any(mx > THR), 0)) {
        const float dl = fmaxf(mx, 0.f); st.m += dl; const float f = __builtin_amdgcn_exp2f(-dl);
#pragma unroll
        for (int r = 0; r < 16; ++r) { p0[r] -= dl; p1[r] -= dl; st.ol[r] *= f; }
#pragma unroll
        for (int i = 0; i < D / 32; ++i)
#pragma unroll
            for (int r = 0; r < 16; ++r) st.o[i][r] *= f;
        pol.build(st);
    }
}
template <int D, class Pol> __device__ __forceinline__ void exp_pv_manual(State<D>& st, const Pol& pol, int jc, f32x16& c0, f32x16& c1, const LAS unsigned char* vbuf, int lane) {
    constexpr int NE = D / 32, XE = 8 / NE;
    const LAS unsigned char* vb = vbuf + ((lane >> 4) & 1) * 32 + (lane & 3) * 8 + (4 * (lane >> 5) + ((lane & 15) >> 2)) * 64;
    const bf16x8 ones = {16256, 16256, 16256, 16256, 16256, 16256, 16256, 16256};
    s16x4 lo[2][NE], hh[2][NE];
#pragma unroll
    for (int e = 0; e < NE; ++e) { lo[0][e] = vtr(vb + e * 4096); hh[0][e] = vtr(vb + e * 4096 + 512); }
#pragma unroll
    for (int r = 0; r < 8; ++r) c0[r] = __builtin_amdgcn_exp2f(c0[r]);
    bf16x8 pk = pack8(c0, 0); pol.maskp1(jc, pk);
    __builtin_amdgcn_sched_barrier(0);
#pragma unroll
    for (int ks = 0; ks < 4; ++ks) {
        f32x16& src = (ks + 1) < 2 ? c0 : c1; const int base = 8 * ((ks + 1) & 1);
#pragma unroll
        for (int e = 0; e < NE; ++e) {
            const bf16x8 vf = {lo[ks & 1][e][0], lo[ks & 1][e][1], lo[ks & 1][e][2], lo[ks & 1][e][3], hh[ks & 1][e][0], hh[ks & 1][e][1], hh[ks & 1][e][2], hh[ks & 1][e][3]};
            st.o[e] = __builtin_amdgcn_mfma_f32_32x32x16_bf16(vf, pk, st.o[e], 0, 0, 0);
            if (ks < 3) { lo[(ks + 1) & 1][e] = vtr(vb + e * 4096 + (ks + 1) * 1024); hh[(ks + 1) & 1][e] = vtr(vb + e * 4096 + (ks + 1) * 1024 + 512);
#pragma unroll
                for (int x = 0; x < XE; ++x) src[base + e * XE + x] = __builtin_amdgcn_exp2f(src[base + e * XE + x]); }
            __builtin_amdgcn_sched_barrier(0);
        }
        st.ol = __builtin_amdgcn_mfma_f32_32x32x16_bf16(ones, pk, st.ol, 0, 0, 0);
        if (ks < 3) { pk = pack8(src, base); pol.maskp1(jc, pk); }
        __builtin_amdgcn_sched_barrier(0);
    }
}
template <int D> __device__ __forceinline__ void pv_all(State<D>& st, const bf16x8* pa, const LAS unsigned char* vbuf, int lane) {
    pv<D>(st.o, vbuf, pa, lane);
    const bf16x8 ones = {16256, 16256, 16256, 16256, 16256, 16256, 16256, 16256};
#pragma unroll
    for (int ks = 0; ks < 4; ++ks) st.ol = __builtin_amdgcn_mfma_f32_32x32x16_bf16(ones, pa[ks], st.ol, 0, 0, 0);
}
__device__ __forceinline__ void glds16(const void* gsrc, unsigned lds_dst) { unsigned keep;
    asm volatile("s_mov_b32 %0, m0\n\ts_mov_b32 m0, %2\n\ts_nop 0\n\tglobal_load_lds_dwordx4 %1, off\n\ts_mov_b32 m0, %0" : "=&s"(keep) : "v"(gsrc), "s"(lds_dst) : "memory"); }
template <int D> __device__ __forceinline__ void tile_dma(const bf16_t* Kp, const bf16_t* Vp, int pitch, unsigned kdst, unsigned vdst, int wid, int lane) {
#pragma unroll
    for (int i = 0; i < D / 64; ++i) { const int pc = wid + 8 * i;
        glds16(Kp + (size_t)lane * pitch + pc * 8, (unsigned)__builtin_amdgcn_readfirstlane(kdst + pc * 1024));
        glds16(Vp + (size_t)(16 * (pc & 3) + (lane >> 2)) * pitch + 32 * (pc >> 2) + 8 * (lane & 3), (unsigned)__builtin_amdgcn_readfirstlane(vdst + pc * 1024)); }
}
__device__ __forceinline__ void wait_lg_bar() { asm volatile("s_waitcnt lgkmcnt(0)\n\ts_barrier" ::: "memory"); }
template <int N> __device__ __forceinline__ void wait_vm_bar() { asm volatile("s_waitcnt vmcnt(%0) lgkmcnt(0)\n\ts_barrier" :: "i"(N) : "memory"); }
template <int D, class Pol> __device__ __forceinline__ void compute_tile(State<D>& st, const Pol& pol, int jc, const bf16x8* qr, const LAS unsigned char* kbuf, const LAS unsigned char* vbuf, int lane) {
    if (pol.active(jc)) {
        const int r32 = lane & 31, hi = lane >> 5;
        f32x16 c0, c1;
        pol.prep(jc, st);
        qkt_c<D>(c0, c1, kbuf, qr, r32, hi, st.ci, st.ci); pol.postmask(jc, c0, c1);
#ifdef MAN_PV
        softmax_head<D, Pol>(st, pol, c0, c1); exp_pv_manual<D, Pol>(st, pol, jc, c0, c1, vbuf, lane);
#else
        bf16x8 pa[4]; softmax_p<D, Pol>(st, pol, c0, c1, pa); pol.maskp(jc, pa); pv_all<D>(st, pa, vbuf, lane);
#endif
    }
}
template <int D, class Pol> __device__ __forceinline__ void run_branch(State<D>& st, const Pol& pol, const bf16x8* qr, LAS unsigned char* lds, int wid, int lane) {
    constexpr int SLOT = 256 * D, NI = 2 * (D / 64);
    const unsigned lds0 = (unsigned)(size_t)lds;
    int jc = pol.first(), jn = pol.next(jc), jnn = jn >= 0 ? pol.next(jn) : -1;
    tile_dma<D>(pol.kptr(jc), pol.vptr(jc), pol.pitch, lds0, lds0 + SLOT / 2, wid, lane);
    if (jn >= 0) { tile_dma<D>(pol.kptr(jn), pol.vptr(jn), pol.pitch, lds0 + SLOT, lds0 + SLOT + SLOT / 2, wid, lane); wait_vm_bar<NI>(); } else wait_vm_bar<0>();
    int sc = 0;
    for (;;) {
        const int s2 = sc == 0 ? 2 : sc - 1;
#ifdef DMA_LATE
        compute_tile<D, Pol>(st, pol, jc, qr, lds + sc * SLOT, lds + sc * SLOT + SLOT / 2, lane);
        if (jnn >= 0) tile_dma<D>(pol.kptr(jnn), pol.vptr(jnn), pol.pitch, lds0 + s2 * SLOT, lds0 + s2 * SLOT + SLOT / 2, wid, lane);
#else
        if (jnn >= 0) tile_dma<D>(pol.kptr(jnn), pol.vptr(jnn), pol.pitch, lds0 + s2 * SLOT, lds0 + s2 * SLOT + SLOT / 2, wid, lane);
        compute_tile<D, Pol>(st, pol, jc, qr, lds + sc * SLOT, lds + sc * SLOT + SLOT / 2, lane);
#endif
        if (jn < 0) { wait_vm_bar<0>(); break; }
        if (jnn >= 0) wait_vm_bar<NI>(); else wait_vm_bar<0>();
        sc = sc == 2 ? 0 : sc + 1; jc = jn; jn = jnn; jnn = jn >= 0 ? pol.next(jn) : -1;
    }
}
__device__ __forceinline__ f32x16 splat16(float v) { f32x16 c;
#pragma unroll
    for (int r = 0; r < 16; ++r) c[r] = v;
    return c; }

constexpr int L_IMPA = 65536, L_IMPB = L_IMPA + 4 * 64 * 33 * 4, L_SC = L_IMPB + 4 * 64 * 33 * 4, L_SELM = L_SC + 64 * 33 * 4, L_ORM = L_SELM + 256;
static_assert(L_ORM + 16 <= 143360, "attention LDS map");

struct NsaPtrs { unsigned char* ws;
    __device__ __forceinline__ const bf16_t* QA() const { return (const bf16_t*)(ws + WS_QA); }
    __device__ __forceinline__ const bf16_t* KS() const { return (const bf16_t*)(ws + WS_KC + 2 * 8 * MiB); }
    __device__ __forceinline__ const bf16_t* VS() const { return (const bf16_t*)(ws + WS_KC + 3 * 8 * MiB); }
    __device__ __forceinline__ const bf16_t* KW() const { return (const bf16_t*)(ws + WS_KC + 4 * 8 * MiB); }
    __device__ __forceinline__ const bf16_t* VW() const { return (const bf16_t*)(ws + WS_KC + 5 * 8 * MiB); }
    __device__ __forceinline__ const bf16_t* KCC() const { return (const bf16_t*)(ws + WS_KCC); }
    __device__ __forceinline__ const bf16_t* VCC() const { return (const bf16_t*)(ws + WS_VCC); }
    __device__ __forceinline__ const bf16_t* GA() const { return (const bf16_t*)(ws + WS_GA); }
    __device__ __forceinline__ const bf16_t* ZA() const { return (const bf16_t*)(ws + WS_ZA); }
    __device__ __forceinline__ bf16_t* A2() const { return (bf16_t*)(ws + WS_A2); } };

__device__ __forceinline__ void nsa_unit(const NsaPtrs& P, int b, int g, int qt, LAS unsigned char* lds
#if DBG
    , unsigned* selout
#endif
    ) {
    int tid = threadIdx.x; asm volatile("" : "+v"(tid));
    const int lane = tid & 63, r32 = lane & 31, hi = lane >> 5; const int wid = __builtin_amdgcn_readfirstlane(tid >> 6);
    const int hh = 4 * g + (wid & 3), th = wid >> 2;
    const int tok = 64 * qt + 32 * th + r32; const size_t mrow = (size_t)b * SEQ + tok;
    bf16x8 qr[4];
#pragma unroll
    for (int d0 = 0; d0 < 4; ++d0) qr[d0] = *(const bf16x8*)(P.QA() + mrow * 1024 + hh * 64 + d0 * 16 + hi * 8);
    const float g0 = bf2f(P.GA()[mrow * 64 + hh * 3 + 0]), g1 = bf2f(P.GA()[mrow * 64 + hh * 3 + 1]), g2 = bf2f(P.GA()[mrow * 64 + hh * 3 + 2]);
    f32x16 otot[2] = {f32x16{}, f32x16{}};
    Tile<64> T; State<64> st;
    LAS float* SC = (LAS float*)(lds + L_SC); LAS unsigned* SELM = (LAS unsigned*)(lds + L_SELM); LAS unsigned* ORM = (LAS unsigned*)(lds + L_ORM);
    {
        const bf16_t* Kc = P.KCC() + (size_t)(b * 4 + g) * 128 * 64; const bf16_t* Vc = P.VCC() + (size_t)(b * 4 + g) * 128 * 64;
        const bool two = qt >= 16;
#ifdef CMP_COAL
        tile_load_c(T, Kc, Vc, wid, lane); tile_store_c(T, (lds + L_K0), (lds + L_V0), wid, lane);
        if (two) { tile_load_c(T, Kc + 64 * 64, Vc + 64 * 64, wid, lane); tile_store_c(T, (lds + L_K1), (lds + L_V1), wid, lane); }
#else
        tile_load<64>(T, Kc, Vc, 64, wid, lane); tile_store<64>(T, (lds + L_K0), (lds + L_V0), wid, lane);
        if (two) { tile_load<64>(T, Kc + 64 * 64, Vc + 64 * 64, 64, wid, lane); tile_store<64>(T, (lds + L_K1), (lds + L_V1), wid, lane); }
#endif
        __syncthreads();
        f32x16 pA0, pA1, pB0, pB1;
        qkt<64>(pA0, pA1, (lds + L_K0), qr, r32, hi);
        const int cmax = (tok - 31) >> 4;
        mask_band(pA0, pA1, cmax - 4 * hi, 0x7fffffffu);
        float mx = rowmax32(pA0, pA1);
        if (two) { qkt<64>(pB0, pB1, (lds + L_K1), qr, r32, hi); mask_band(pB0, pB1, cmax - 64 - 4 * hi, 0x7fffffffu); mx = fmaxf(mx, rowmax32(pB0, pB1)); }
        if (mx == NEGINF) mx = 0.f;
        float s = 0.f;
#pragma unroll
        for (int r = 0; r < 16; ++r) { pA0[r] = __builtin_amdgcn_exp2f(pA0[r] - mx); pA1[r] = __builtin_amdgcn_exp2f(pA1[r] - mx); s += pA0[r] + pA1[r]; }
        if (two) {
#pragma unroll
            for (int r = 0; r < 16; ++r) { pB0[r] = __builtin_amdgcn_exp2f(pB0[r] - mx); pB1[r] = __builtin_amdgcn_exp2f(pB1[r] - mx); s += pB0[r] + pB1[r]; }
        }
        s = xhalf_sum(s);
        const float inv_l = s > 0.f ? 1.f / s : 0.f;
        if (two) {
        LAS float* IA = (LAS float*)(lds + L_IMPA) + ((wid & 3) * 64 + 32 * th + r32) * 33; LAS float* IB = (LAS float*)(lds + L_IMPB) + ((wid & 3) * 64 + 32 * th + r32) * 33;
#define IMP_ONE(PX, Tt, Pp) _Pragma("unroll") for (int u = 0; u < 4; ++u) { const int k = 16 * (Tt) + 8 * (Pp) + 2 * u + hi; const float h3 = 0.5f * PX[4 * u + 3]; \
            IA[k] = ((PX[4 * u] + PX[4 * u + 1]) + (PX[4 * u + 2] + h3)) * inv_l; IB[k] = h3 * inv_l; }
        IMP_ONE(pA0, 0, 0) IMP_ONE(pA1, 0, 1) IMP_ONE(pB0, 1, 0) IMP_ONE(pB1, 1, 1)
#undef IMP_ONE
        }
        { bf16x8 pa[4] = {pack8(pA0, 0), pack8(pA0, 8), pack8(pA1, 0), pack8(pA1, 8)}; pv<64>(otot, (lds + L_V0), pa, lane); }
        if (two) { bf16x8 pa[4] = {pack8(pB0, 0), pack8(pB0, 8), pack8(pB1, 0), pack8(pB1, 8)}; pv<64>(otot, (lds + L_V1), pa, lane); }
        const float w = g0 * inv_l;
#pragma unroll
        for (int i = 0; i < 2; ++i)
#pragma unroll
            for (int r = 0; r < 16; ++r) otot[i][r] *= w;
    }
    if (qt < 16) { __syncthreads(); }
    else { const int tt = tid & 63, jg = tid >> 6;
        if (jg == 0) SELM[tt] = 0u; if (tid == 0) ORM[0] = 0u;
        __syncthreads();
        const LAS float* IA = (const LAS float*)(lds + L_IMPA); const LAS float* IB = (const LAS float*)(lds + L_IMPB);
        const int T_ = 64 * qt + tt;
#pragma unroll
        for (int jj = 0; jj < 4; ++jj) { const int j = 4 * jg + jj; float imp = 0.f;
#pragma unroll
            for (int h = 0; h < 4; ++h) { float v = IA[(h * 64 + tt) * 33 + j]; if (j > 0) v += IB[(h * 64 + tt) * 33 + j - 1]; imp += v; }
            const bool valid = 64 * j <= T_; const bool forced = valid && (j == 0 || j == qt || j == qt - 1);
            SC[tt * 33 + j] = valid ? imp + (forced ? 1.0e4f : 0.f) : -1e30f; }
        __syncthreads();
        unsigned bits = 0u;
        {
            float sj[4]; int rank[4] = {0, 0, 0, 0}; unsigned eq[4] = {0u, 0u, 0u, 0u};
#pragma unroll
            for (int jj = 0; jj < 4; ++jj) sj[jj] = SC[tt * 33 + 4 * jg + jj];
#pragma unroll 1
            for (int kh = 0; kh < 4; ++kh) {
                float sk[8];
#pragma unroll
                for (int k = 0; k < 8; ++k) sk[k] = SC[tt * 33 + 8 * kh + k];
#pragma unroll
                for (int jj = 0; jj < 4; ++jj)
#pragma unroll
                    for (int k = 0; k < 8; ++k) { rank[jj] += (sk[k] > sj[jj]) ? 1 : 0; eq[jj] |= (sk[k] == sj[jj]) ? (1u << (8 * kh + k)) : 0u; }
            }
#pragma unroll
            for (int jj = 0; jj < 4; ++jj) { const int j = 4 * jg + jj; const unsigned lt = (1u << j) - 1u;
                if (rank[jj] + __builtin_popcount(eq[jj] & lt) < 16) bits |= 1u << j; }
        }
        atomicOr((unsigned*)&SELM[tt], bits); atomicOr((unsigned*)&ORM[0], bits);
        __syncthreads();
    }
    const unsigned causal_bits = (qt == 31) ? 0xffffffffu : ((2u << qt) - 1u);
    const unsigned selbits = qt < 16 ? causal_bits : SELM[32 * th + r32];
#if DBG
    if (tid < 64) selout[((size_t)b * SEQ + 64 * qt + tid) * 4 + g] = qt < 16 ? causal_bits : SELM[tid];
#endif
    unsigned need = qt < 16 ? causal_bits : ((unsigned)__builtin_amdgcn_readfirstlane(ORM[0]) & causal_bits);
    {
        struct SelPol { const bf16_t* Kg; const bf16_t* Vg; int pitch; unsigned need, selbits; int qt, tok4;
            __device__ __forceinline__ int first() const { return __builtin_ctz(need); }
            __device__ __forceinline__ int next(int j) const { const unsigned r = j >= 31 ? 0u : (need & ~((2u << j) - 1u)); return r ? __builtin_ctz(r) : -1; }
            __device__ __forceinline__ const bf16_t* kptr(int j) const { return Kg + (size_t)64 * j * 256; }
            __device__ __forceinline__ const bf16_t* vptr(int j) const { return Vg + (size_t)64 * j * 256; }
            __device__ __forceinline__ bool active(int j) const { return __any((selbits >> j) & 1u); }
            __device__ __forceinline__ void prep(int, State<64>&) const {}
            __device__ __forceinline__ void build(State<64>& st) const { st.ci = splat16(-st.m); }
            __device__ __forceinline__ void maskp(int j, bf16x8* pa) const { const unsigned km = ((selbits >> j) & 1u) ? 0xffffffffu : 0u;
#pragma unroll
                for (int k = 0; k < 4; ++k) { u32x4_t w = __builtin_bit_cast(u32x4_t, pa[k]); w &= km; pa[k] = __builtin_bit_cast(bf16x8, w); } }
            __device__ __forceinline__ void maskp1(int j, bf16x8& f) const { const unsigned km = ((selbits >> j) & 1u) ? 0xffffffffu : 0u; u32x4_t w = __builtin_bit_cast(u32x4_t, f); w &= km; f = __builtin_bit_cast(bf16x8, w); }
            __device__ __forceinline__ void postmask(int j, f32x16& p0, f32x16& p1) const { if (j == qt) mask_band(p0, p1, tok4 - 64 * j, 0x7fffffffu); } };
        SelPol pol{P.KS() + (size_t)b * SEQ * 256 + g * 64, P.VS() + (size_t)b * SEQ * 256 + g * 64, 256, need, selbits, qt, tok - 4 * hi};
        state_reset<64>(st);
        run_branch<64, SelPol>(st, pol, qr, lds, wid, lane);
        const float w = g1 / st.ol[0];
#pragma unroll
        for (int i = 0; i < 2; ++i)
#pragma unroll
            for (int r = 0; r < 16; ++r) otot[i][r] += st.o[i][r] * w;
    }
    {
        struct WinPol { const bf16_t* Kg; const bf16_t* Vg; int pitch; int qt, jlo, tok4;
            __device__ __forceinline__ int first() const { return jlo; }
            __device__ __forceinline__ int next(int j) const { return j < qt ? j + 1 : -1; }
            __device__ __forceinline__ const bf16_t* kptr(int j) const { return Kg + (size_t)64 * j * 256; }
            __device__ __forceinline__ const bf16_t* vptr(int j) const { return Vg + (size_t)64 * j * 256; }
            __device__ __forceinline__ bool active(int) const { return true; }
            __device__ __forceinline__ void prep(int, State<64>&) const {}
            __device__ __forceinline__ void build(State<64>& st) const { st.ci = splat16(-st.m); }
            __device__ __forceinline__ void maskp(int, bf16x8*) const {}
            __device__ __forceinline__ void maskp1(int, bf16x8&) const {}
            __device__ __forceinline__ void postmask(int j, f32x16& p0, f32x16& p1) const { if (j == qt || j == qt - 8) mask_band(p0, p1, tok4 - 64 * j, 511u); } };
        WinPol pol{P.KW() + (size_t)b * SEQ * 256 + g * 64, P.VW() + (size_t)b * SEQ * 256 + g * 64, 256, qt, qt >= 8 ? qt - 8 : 0, tok - 4 * hi};
        state_reset<64>(st);
        run_branch<64, WinPol>(st, pol, qr, lds, wid, lane);
        const float w = g2 / st.ol[0];
#pragma unroll
        for (int i = 0; i < 2; ++i)
#pragma unroll
            for (int r = 0; r < 16; ++r) otot[i][r] += st.o[i][r] * w;
    }
    {
        LAS float* stg = (LAS float*)(lds + 65536 + wid * 8192);
#pragma unroll
        for (int db = 0; db < 2; ++db)
#pragma unroll
            for (int u = 0; u < 4; ++u) { const int d = 32 * db + 8 * u + 4 * hi;
                *(LAS f32x4_t*)(stg + r32 * 64 + (d ^ ((r32 & 7) << 3))) = (f32x4_t){otot[db][4 * u], otot[db][4 * u + 1], otot[db][4 * u + 2], otot[db][4 * u + 3]}; }
        asm volatile("s_waitcnt lgkmcnt(0)" ::: "memory");
        const size_t row0 = (size_t)b * SEQ + 64 * qt + 32 * th;
#pragma unroll
        for (int i = 0; i < 4; ++i) { const int row = 8 * i + (lane >> 3), ch = lane & 7, d = 8 * ch;
            const f32x4_t a = *(const LAS f32x4_t*)(stg + row * 64 + (d ^ ((row & 7) << 3))), c = *(const LAS f32x4_t*)(stg + row * 64 + ((d + 4) ^ ((row & 7) << 3)));
            const u32x4_t z = *(const u32x4_t*)(P.ZA() + (row0 + row) * 1024 + hh * 64 + d);
            u32x4_t w; w.x = cvtpk(a[0] * bflo(z.x), a[1] * bfhi(z.x)); w.y = cvtpk(a[2] * bflo(z.y), a[3] * bfhi(z.y)); w.z = cvtpk(c[0] * bflo(z.z), c[1] * bfhi(z.z)); w.w = cvtpk(c[2] * bflo(z.w), c[3] * bfhi(z.w));
            *(u32x4_t*)(P.A2() + (row0 + row) * 2048 + hh * 64 + d) = w; }
    }
}

struct MixPtrs { unsigned char* ws;
    __device__ __forceinline__ const bf16_t* QB() const { return (const bf16_t*)(ws + WS_QB); }
    __device__ __forceinline__ const bf16_t* KB() const { return (const bf16_t*)(ws + WS_KB); }
    __device__ __forceinline__ const bf16_t* VB() const { return (const bf16_t*)(ws + WS_VB); }
    __device__ __forceinline__ const bf16_t* ZB() const { return (const bf16_t*)(ws + WS_ZB); }
    __device__ __forceinline__ bf16_t* A2() const { return (bf16_t*)(ws + WS_A2); } };
__device__ __forceinline__ void mixb_unit(const MixPtrs& P, int b, int h, int a, LAS unsigned char* lds) {
    int tid = threadIdx.x; asm volatile("" : "+v"(tid));
    const int lane = tid & 63, r32 = lane & 31, hi = lane >> 5; const int wid = __builtin_amdgcn_readfirstlane(tid >> 6);
    const int tok = 256 * a + 32 * wid + r32; const size_t mrow = (size_t)b * SEQ + tok;
    bf16x8 qr[8];
#pragma unroll
    for (int d0 = 0; d0 < 8; ++d0) qr[d0] = *(const bf16x8*)(P.QB() + mrow * 1024 + h * 128 + d0 * 16 + hi * 8);
    const int E16 = (tok - 4 * hi) & 15;
    bool is16[8], is4[4];
#pragma unroll
    for (int i = 0; i < 8; ++i) is16[i] = E16 == ((i & 3) + 8 * (i >> 2));
#pragma unroll
    for (int i = 0; i < 4; ++i) is4[i] = (E16 & 3) == i;
    const bf16_t* Kg = P.KB() + (size_t)b * SEQ * 1024 + h * 128; const bf16_t* Vg = P.VB() + (size_t)b * SEQ * 1024 + h * 128;
    State<128> st; state_reset<128>(st);
    struct MixPol { const bf16_t* Kg; const bf16_t* Vg; int pitch; int nt, wlast, wbase, tok4; bool i16[8], i4[4];
        __device__ __forceinline__ int first() const { return 0; }
        __device__ __forceinline__ int next(int j) const { return j + 1 < nt ? j + 1 : -1; }
        __device__ __forceinline__ const bf16_t* kptr(int j) const { return Kg + (size_t)64 * j * 1024; }
        __device__ __forceinline__ const bf16_t* vptr(int j) const { return Vg + (size_t)64 * j * 1024; }
        __device__ __forceinline__ bool active(int j) const { return j <= wlast; }
        __device__ __forceinline__ int cls(int j) const { const int wlo = wbase - 64 * j, dmin = wlo - 63, dmax = wlo + 31;
            return dmin > 512 ? 0 : (dmin > 128 && dmax <= 512) ? 1 : dmin < 0 ? 3 : dmax <= 128 ? 2 : dmax <= 512 ? 4 : 5; }
        __device__ __forceinline__ void build(State<128>& st) const { const int c = st.cls; const float m = st.m;
            if (c == 0) {
#pragma unroll
                for (int r = 0; r < 16; ++r) st.ci[r] = i16[(r & 3) + 4 * ((r >> 2) & 1)] ? -m : NEGINF;
            } else if (c == 1) {
#pragma unroll
                for (int r = 0; r < 16; ++r) st.ci[r] = i4[r & 3] ? (i16[(r & 3) + 4 * ((r >> 2) & 1)] ? 1.f - m : -m) : NEGINF;
            } else if (c == 2 || c == 3) {
#pragma unroll
                for (int r = 0; r < 16; ++r) st.ci[r] = i16[(r & 3) + 4 * ((r >> 2) & 1)] ? 1.5849625007f - m : (i4[r & 3] ? 1.f - m : -m);
            } else st.ci = splat16(-m); }
        __device__ __forceinline__ void prep(int j, State<128>& st) const { const int c = cls(j); if (c != st.cls) { st.cls = c; build(st); } }
        __device__ __forceinline__ void maskp(int, bf16x8*) const {}
        __device__ __forceinline__ void maskp1(int, bf16x8&) const {}
        __device__ __forceinline__ void postmask(int j, f32x16& p0, f32x16& p1) const {
            const int c = cls(j);
            if (c < 3) return;
            const int e = tok4 - 64 * j;
            if (c == 3) { mask_band(p0, p1, e, 0x7fffffffu); return; }
            const int thr = c == 4 ? 128 : 512;
#pragma unroll
            for (int r = 0; r < 16; ++r) { const bool b16 = i16[(r & 3) + 4 * ((r >> 2) & 1)], b4 = i4[r & 3]; const int cc = (r & 3) + 8 * (r >> 2);
                const float vnear = b16 ? 1.5849625007f : (b4 ? 1.f : 0.f), vmid = b4 ? (b16 ? 1.f : 0.f) : NEGINF, vfar = b16 ? 0.f : NEGINF;
                const float lo = c == 4 ? vnear : vmid, hi_ = c == 4 ? vmid : vfar;
                p0[r] += (e - cc <= thr) ? lo : hi_; p1[r] += (e - cc - 32 <= thr) ? lo : hi_; } } };
    MixPol pol{Kg, Vg, 1024, 4 * a + 4, 4 * a + (wid >> 1), 256 * a + 32 * wid, tok - 4 * hi, {is16[0], is16[1], is16[2], is16[3], is16[4], is16[5], is16[6], is16[7]}, {is4[0], is4[1], is4[2], is4[3]}};
    run_branch<128, MixPol>(st, pol, qr, lds, wid, lane);
    const float inv_l = 1.f / st.ol[0];
#ifdef MIXB_STAGE
    __syncthreads();
    {
        LAS float* stg = (LAS float*)(lds + wid * 8192);
        const size_t row0 = (size_t)b * SEQ + 256 * a + 32 * wid;
#pragma unroll
        for (int dh = 0; dh < 2; ++dh) {
#pragma unroll
            for (int db = 0; db < 2; ++db)
#pragma unroll
                for (int u = 0; u < 4; ++u) { const int d = 32 * db + 8 * u + 4 * hi;
                    *(LAS f32x4_t*)(stg + r32 * 64 + (d ^ ((r32 & 7) << 3))) = (f32x4_t){st.o[2 * dh + db][4 * u] * inv_l, st.o[2 * dh + db][4 * u + 1] * inv_l, st.o[2 * dh + db][4 * u + 2] * inv_l, st.o[2 * dh + db][4 * u + 3] * inv_l}; }
            asm volatile("s_waitcnt lgkmcnt(0)" ::: "memory");
#pragma unroll
            for (int i = 0; i < 4; ++i) { const int row = 8 * i + (lane >> 3), ch = lane & 7, d = 8 * ch;
                const f32x4_t x = *(const LAS f32x4_t*)(stg + row * 64 + (d ^ ((row & 7) << 3))), c = *(const LAS f32x4_t*)(stg + row * 64 + ((d + 4) ^ ((row & 7) << 3)));
                const u32x4_t z = *(const u32x4_t*)(P.ZB() + (row0 + row) * 1024 + h * 128 + 64 * dh + d);
                u32x4_t w; w.x = cvtpk(x[0] * bflo(z.x), x[1] * bfhi(z.x)); w.y = cvtpk(x[2] * bflo(z.y), x[3] * bfhi(z.y)); w.z = cvtpk(c[0] * bflo(z.z), c[1] * bfhi(z.z)); w.w = cvtpk(c[2] * bflo(z.w), c[3] * bfhi(z.w));
                *(u32x4_t*)(P.A2() + (row0 + row) * 2048 + 1024 + h * 128 + 64 * dh + d) = w; }
            asm volatile("s_waitcnt lgkmcnt(0)" ::: "memory");
        }
    }
#elif defined(EPI_SWAP)
#pragma unroll
    for (int db = 0; db < 4; ++db)
#pragma unroll
        for (int up = 0; up < 2; ++up) { const int dq = 32 * db + 16 * up + 8 * hi;
            const u32x4_t z16 = *(const u32x4_t*)(P.ZB() + mrow * 1024 + h * 128 + dq);
            const auto zx = __builtin_amdgcn_permlane32_swap(z16.x, z16.z, false, false); const auto zy = __builtin_amdgcn_permlane32_swap(z16.y, z16.w, false, false);
            const unsigned za0 = zx[0], za1 = zy[0], zb0 = zx[1], zb1 = zy[1];
            const int u0 = 2 * up, u1 = 2 * up + 1;
            const unsigned a0 = cvtpk(st.o[db][4 * u0] * inv_l * bflo(za0), st.o[db][4 * u0 + 1] * inv_l * bfhi(za0)), a1 = cvtpk(st.o[db][4 * u0 + 2] * inv_l * bflo(za1), st.o[db][4 * u0 + 3] * inv_l * bfhi(za1));
            const unsigned b0 = cvtpk(st.o[db][4 * u1] * inv_l * bflo(zb0), st.o[db][4 * u1 + 1] * inv_l * bfhi(zb0)), b1 = cvtpk(st.o[db][4 * u1 + 2] * inv_l * bflo(zb1), st.o[db][4 * u1 + 3] * inv_l * bfhi(zb1));
            const auto wx = __builtin_amdgcn_permlane32_swap(a0, b0, false, false); const auto wy = __builtin_amdgcn_permlane32_swap(a1, b1, false, false);
            u32x4_t w; w.x = wx[0]; w.y = wy[0]; w.z = wx[1]; w.w = wy[1];
            *(u32x4_t*)(P.A2() + mrow * 2048 + 1024 + h * 128 + dq) = w; }
#else
#pragma unroll
    for (int db = 0; db < 4; ++db)
#pragma unroll
        for (int u = 0; u < 4; ++u) { const int d = 32 * db + 8 * u + 4 * hi;
            const u32x2_t z = *(const u32x2_t*)(P.ZB() + mrow * 1024 + h * 128 + d);
            u32x2_t w; w.x = cvtpk(st.o[db][4 * u] * inv_l * bflo(z.x), st.o[db][4 * u + 1] * inv_l * bfhi(z.x)); w.y = cvtpk(st.o[db][4 * u + 2] * inv_l * bflo(z.y), st.o[db][4 * u + 3] * inv_l * bfhi(z.y));
            *(u32x2_t*)(P.A2() + mrow * 2048 + 1024 + h * 128 + d) = w; }
#endif
}
}
typedef GAS unsigned gu32;
#define RLX_AGENT __ATOMIC_RELAXED, __HIP_MEMORY_SCOPE_AGENT
#define LDS_WAIT() asm volatile("s_waitcnt lgkmcnt(0)" ::: "memory")
#define VM_WAIT() asm volatile("s_waitcnt vmcnt(0)" ::: "memory")
#define XB_TMO      128
#define XB_XCNT(j)  (256  + 64 * (j))
#define XB_XSUB(j)  (1280 + 64 * (j))
#define XB_XGEN(j)  (2304 + 64 * (j))
#define XB_TOP      3328
#define XB_TOPGEN   3392
#define XCD_BAR_WORDS 3456
#define XB_SPIN_CAP (1u << 18)
__device__ __forceinline__ unsigned xb_ld(unsigned* p)              { return __hip_atomic_load(p, __ATOMIC_RELAXED, __HIP_MEMORY_SCOPE_AGENT); }
__device__ __forceinline__ unsigned xb_add(unsigned* p, unsigned v) { return __hip_atomic_fetch_add(p, v, __ATOMIC_RELAXED, __HIP_MEMORY_SCOPE_AGENT); }
__device__ __forceinline__ unsigned xb_xcc_id() { return (unsigned)__builtin_amdgcn_s_getreg((3 << 11) | 20) & 0xFu; }
#define XB_SPIN(cond, bar) do { unsigned _sp = 0; while (cond) { __builtin_amdgcn_s_sleep(1); \
    if ((++_sp & 255u) == 0u) { if (xb_ld(&(bar)[XB_TMO])) break; if (_sp > XB_SPIN_CAP) { atomicAdd(&(bar)[XB_TMO], 1u); break; } } } } while (0)
struct XcdBarrier { unsigned* bar; unsigned x; volatile LAS unsigned* st; };
__device__ __forceinline__ XcdBarrier xcd_barrier_post(unsigned* bar, volatile LAS unsigned* st) {
    XcdBarrier b; b.bar = bar; b.x = xb_xcc_id(); b.st = st;
    if (threadIdx.x == 0) (void)xb_add(&bar[XB_XCNT(b.x)], 1u);
    return b;
}
__device__ __forceinline__ void xcd_barrier_complete(unsigned* bar, unsigned x, unsigned& nloc, unsigned& nx) {
    const unsigned G = gridDim.x * gridDim.y * gridDim.z;
    unsigned sum, cnt, mine, sp = 0u;
    for (;;) {
        sum = 0u; cnt = 0u; mine = 0u;
#pragma unroll
        for (unsigned j = 0; j < 16; ++j) { const unsigned c = xb_ld(&bar[XB_XCNT(j)]); sum += c; cnt += (c > 0u) ? 1u : 0u; mine = (j == x) ? c : mine; }
        if (sum == G) break;
        __builtin_amdgcn_s_sleep(1);
        if ((++sp & 255u) == 0u) { if (xb_ld(&bar[XB_TMO])) break; if (sp > XB_SPIN_CAP) { atomicAdd(&bar[XB_TMO], 1u); break; } }
    }
    nloc = mine > 0u ? mine : 1u; nx = cnt > 0u ? cnt : 1u;
}
__device__ __forceinline__ void xcd_barrier(const XcdBarrier& b) {
    asm volatile("s_waitcnt vmcnt(0)" ::: "memory");
    __syncthreads();
    if (threadIdx.x == 0) {
        unsigned* bar = b.bar;
        __builtin_amdgcn_s_waitcnt(0);
        unsigned nloc = b.st[0], nx = b.st[1];
        if (nloc == 0u) { xcd_barrier_complete(bar, b.x, nloc, nx); b.st[0] = nloc; b.st[1] = nx; }
        const unsigned old = xb_add(&bar[XB_XSUB(b.x)], 1u);
        const unsigned gen = old / nloc;
        if (old + 1u == (gen + 1u) * nloc) {
            __builtin_amdgcn_fence(__ATOMIC_RELEASE, "agent");
            asm volatile("s_waitcnt vmcnt(0)" ::: "memory");
            const unsigned og = xb_add(&bar[XB_TOP], 1u);
            const unsigned tg = og / nx;
            if (og + 1u == (tg + 1u) * nx) xb_add(&bar[XB_TOPGEN], 1u);
            else XB_SPIN(xb_ld(&bar[XB_TOPGEN]) == tg, bar);
            __builtin_amdgcn_fence(__ATOMIC_ACQUIRE, "agent");
            xb_add(&bar[XB_XGEN(b.x)], 1u);
            asm volatile("s_waitcnt vmcnt(0)" ::: "memory");
        } else {
            XB_SPIN(xb_ld(&bar[XB_XGEN(b.x)]) == gen, bar);
            __builtin_amdgcn_fence(__ATOMIC_ACQUIRE, "agent");
            asm volatile("s_waitcnt vmcnt(0)" ::: "memory");
        }
    }
    __syncthreads();
}
struct GrpBarrier { unsigned* ctr; unsigned* tmo; unsigned n, target; };
__device__ __forceinline__ void grp_barrier(GrpBarrier& gb) {
    asm volatile("s_waitcnt vmcnt(0)" ::: "memory");
    __syncthreads();
    gb.target += gb.n;
    if (threadIdx.x == 0) {
        __builtin_amdgcn_s_waitcnt(0);
        __builtin_amdgcn_fence(__ATOMIC_RELEASE, "agent");
        (void)xb_add(gb.ctr, 1u);
        XB_SPIN(xb_ld(gb.ctr) < gb.target, gb.tmo - XB_TMO);
        __builtin_amdgcn_fence(__ATOMIC_ACQUIRE, "agent");
        asm volatile("s_waitcnt vmcnt(0)" ::: "memory");
    }
    __syncthreads();
}

struct Frame {
    LAS unsigned char* lds; int tid, lane, wave, G, vcu;
    const float *x, *c; const int* pos; const float *w_ada, *b_ada, *g_pre, *g_post, *w_in, *pe_ck, *pe_cv, *w_ck1, *w_ck2, *w_cv1, *w_cv2, *w_br_a, *w_br_b, *w_out;
    unsigned char* ws; unsigned char* dout;
};
__device__ __forceinline__ float wave_sum(float v) {
#pragma unroll
    for (int o = 1; o < 64; o <<= 1) v += __shfl_xor(v, o);
    return v;
}
__device__ __forceinline__ void p0_ada(Frame& F) {
    float* ada = (float*)(F.ws + WS_ADA);
    LAS float* red = (LAS float*)F.lds;
    LAS float* cT = (LAS float*)(F.lds + 69632);
    int tid0 = threadIdx.x; asm volatile("" : "+v"(tid0));
    for (int i = tid0; i < 8 * DM; i += 512) cT[(i & (DM - 1)) * 8 + (i >> 11)] = F.c[i];
    __syncthreads();
#ifdef ADA_VCU
    for (int cg = F.vcu; cg < 256; cg += F.G) {
#else
    for (int cg = blockIdx.x; cg < 256; cg += F.G) {
#endif
        const int tid = tid0, kk = tid / 6, c4 = tid % 6; const bool on = tid < 510;
        f32x4_t acc[8];
#pragma unroll
        for (int b = 0; b < 8; ++b) acc[b] = (f32x4_t){0.f, 0.f, 0.f, 0.f};
        if (on) for (int k0 = kk; k0 < DM; k0 += 85 * 13) {
            f32x4_t w[13];
#pragma unroll
            for (int u = 0; u < 13; ++u) { const int k = k0 + 85 * u; w[u] = k < DM ? *(const f32x4_t*)(F.w_ada + (size_t)k * 6144 + 24 * cg + 4 * c4) : (f32x4_t){0.f, 0.f, 0.f, 0.f}; }
#pragma unroll
            for (int u = 0; u < 13; ++u) { const int k = k0 + 85 * u < DM ? k0 + 85 * u : 0;
                const f32x4_t ca = *(const LAS f32x4_t*)(cT + k * 8), cb = *(const LAS f32x4_t*)(cT + k * 8 + 4);
#pragma unroll
                for (int b = 0; b < 4; ++b) { acc[b] += w[u] * ca[b]; acc[4 + b] += w[u] * cb[b]; } }
        }
        if (on) {
#pragma unroll
            for (int b = 0; b < 8; ++b)
#pragma unroll
                for (int e = 0; e < 4; ++e) red[tid * 33 + b * 4 + e] = acc[b][e];
        }
        __syncthreads();
        if (tid < 192) { const int b = tid / 24, col = tid % 24, cc4 = col >> 2, e = col & 3; float s = 0.f;
            for (int q = 0; q < 85; ++q) s += red[(q * 6 + cc4) * 33 + b * 4 + e];
            ada[b * 6144 + 24 * cg + col] = s + F.b_ada[24 * cg + col]; }
        __syncthreads();
    }
}
template <bool REMAP> __device__ __forceinline__ int dst_row(int n) { if (!REMAP) return n; return n < 2560 ? n : (n < 2608 ? 11776 + (n - 2560) : n - 48); }
template <bool REMAP, bool BIAS = false> __device__ __forceinline__ void p0_transpose_item(const float* W, int K, int N, bf16_t* WT, int ldt, int kofs, LAS float* scr, int item, int lane,
                                                                                      const float* pe = nullptr, float* pout = nullptr) {
#ifdef ITEM_NMAJOR
    const int nkb = K / 64, nb = item / nkb, kb = item % nkb, k0 = 64 * kb, n0 = 32 * nb;
#else
    const int nblk = (N + 31) / 32, kb = item / nblk, nb = item % nblk, k0 = 64 * kb, n0 = 32 * nb;
#endif
    const bool cok = n0 + (lane & 31) < N;
    float tv[32];
    float pel = 0.f; if constexpr (BIAS) pel = pe[k0 + lane];
#pragma unroll
    for (int i = 0; i < 32; ++i) { const int kk = 2 * i + (lane >> 5); tv[i] = cok ? W[(size_t)(k0 + kk) * N + n0 + (lane & 31)] : 0.f; }
    if constexpr (BIAS) {
        float sb = 0.f;
#pragma unroll
        for (int i = 0; i < 32; ++i) sb += __shfl(pel, 2 * i + (lane >> 5)) * tv[i];
        sb += __shfl_xor(sb, 32);
        if (lane < 32) pout[kb * 512 + n0 + lane] = sb;
    }
#pragma unroll
    for (int i = 0; i < 32; ++i) { const int kk = 2 * i + (lane >> 5); scr[kk * 33 + (lane & 31)] = tv[i]; }
    LDS_WAIT(); asm volatile("" ::: "memory");
    const int c = lane & 7;
#pragma unroll
    for (int j = 0; j < 4; ++j) { const int n = (lane >> 3) + 8 * j; const LAS float* s = scr + (8 * c) * 33 + n;
        u32x4_t o; o.x = pk2(s[0 * 33], s[1 * 33]); o.y = pk2(s[2 * 33], s[3 * 33]); o.z = pk2(s[4 * 33], s[5 * 33]); o.w = pk2(s[6 * 33], s[7 * 33]);
        if (n0 + n < N) *(GAS u32x4_t*)(WT + (size_t)dst_row<REMAP>(n0 + n) * ldt + kofs + k0 + 8 * c) = o; }
    LDS_WAIT(); asm volatile("" ::: "memory");
}
template <int MODE> __device__ __forceinline__ void p0_items(Frame& F, int rank, int nrank) {
    LAS float* scr = (LAS float*)(F.lds + 68 * 1024 + F.wave * 8704);
    int tid_ = threadIdx.x; asm volatile("" : "+v"(tid_)); const int lane = tid_ & 63;
#ifdef ITEM_SPREAD
    const int gw = F.wave * nrank + rank, NGW = nrank * 8;
#else
    const int gw = rank * 8 + F.wave, NGW = nrank * 8;
#endif
    bf16_t* WinT = (bf16_t*)(F.ws + WS_WINT); bf16_t* WbrT = (bf16_t*)(F.ws + WS_WBRT); bf16_t* WoutT = (bf16_t*)(F.ws + WS_WOUTT);
    bf16_t* W1T = (bf16_t*)(F.ws + WS_W1T); bf16_t* W2T = (bf16_t*)(F.ws + WS_W2T);
    constexpr int I_IN = MODE == 2 ? 0 : 32 * 370, I_BR = MODE == 1 ? 0 : 16 * 64, I_OUT = MODE == 1 ? 0 : 32 * 64, I_C1 = MODE == 2 ? 0 : 32 * 8, I_C2 = MODE == 2 ? 0 : 4 * 2;
#ifdef BIAS_FUSED
    constexpr int I_ROPE = MODE == 2 ? 0 : MTOK / 64, I_B1 = 0, I_Z = MODE == 2 ? 0 : 13;
#else
    constexpr int I_ROPE = MODE == 2 ? 0 : MTOK / 64, I_B1 = MODE == 2 ? 0 : 128, I_Z = MODE == 2 ? 0 : 13;
#endif
    constexpr int NITEMS = I_IN + 2 * I_BR + I_OUT + 2 * I_C1 + 2 * I_C2 + I_ROPE + I_B1 + I_Z;
    for (int it = gw; it < NITEMS; it += NGW) {
        int r = it;
#ifdef SLOW_FIRST
        if (r < I_ROPE) {
            const int m = r * 64 + lane; const float pf = (float)F.pos[m];
#if defined(FAST_ROPE) && defined(ROPE_COAL)
            { const float pfl = pf; const int m0 = r * 64;
              float* t64 = (float*)(F.ws + WS_R64) + (size_t)m0 * 16; float* t128 = (float*)(F.ws + WS_R128) + (size_t)m0 * 32;
              { const int idx = lane & 15; const float inv = exp2f(-(float)(2 * (idx & 7)) * (18.931568569324174f / 16.f)); const bool sn = idx >= 8;
                for (int j = 0; j < 16; ++j) { const float p = __shfl(pfl, (lane >> 4) + 4 * j); const float rev = __builtin_amdgcn_fractf(p * inv * 0.15915494309189535f);
                    const float cv = __builtin_amdgcn_cosf(rev), sv = __builtin_amdgcn_sinf(rev); t64[lane + 64 * j] = sn ? sv : cv; } }
              { const int idx = lane & 31; const float inv = exp2f(-(float)(2 * (idx & 15)) * (18.931568569324174f / 32.f)); const bool sn = idx >= 16;
                for (int j = 0; j < 32; ++j) { const float p = __shfl(pfl, (lane >> 5) + 2 * j); const float rev = __builtin_amdgcn_fractf(p * inv * 0.15915494309189535f);
                    const float cv = __builtin_amdgcn_cosf(rev), sv = __builtin_amdgcn_sinf(rev); t128[lane + 64 * j] = sn ? sv : cv; } } }
#elif defined(FAST_ROPE)
            const float myinv = (lane < 8) ? exp2f(-(float)(2 * lane) * (18.931568569324174f / 16.f)) : exp2f(-(float)(2 * ((lane - 8) & 15)) * (18.931568569324174f / 32.f));
            float* t64 = (float*)(F.ws + WS_R64) + (size_t)m * 16; float* t128 = (float*)(F.ws + WS_R128) + (size_t)m * 32;
            for (int i = 0; i < 8; ++i) { const float inv = __shfl(myinv, i); const float rev = __builtin_amdgcn_fractf(pf * inv * 0.15915494309189535f); t64[i] = __builtin_amdgcn_cosf(rev); t64[8 + i] = __builtin_amdgcn_sinf(rev); }
            for (int i = 0; i < 16; ++i) { const float inv = __shfl(myinv, 8 + i); const float rev = __builtin_amdgcn_fractf(pf * inv * 0.15915494309189535f); t128[i] = __builtin_amdgcn_cosf(rev); t128[16 + i] = __builtin_amdgcn_sinf(rev); }
#else
            const float myinv = (lane < 8) ? (float)pow(500000.0, -(double)(2 * lane) / 16.0) : (float)pow(500000.0, -(double)(2 * ((lane - 8) & 15)) / 32.0);
            float* t64 = (float*)(F.ws + WS_R64) + (size_t)m * 16; float* t128 = (float*)(F.ws + WS_R128) + (size_t)m * 32;
            for (int i = 0; i < 8; ++i) { const float inv = __shfl(myinv, i); const float ang = pf * inv; t64[i] = cosf(ang); t64[8 + i] = sinf(ang); }
            for (int i = 0; i < 16; ++i) { const float inv = __shfl(myinv, 8 + i); const float ang = pf * inv; t128[i] = cosf(ang); t128[16 + i] = sinf(ang); }
#endif
            continue; } r -= I_ROPE;
        if (r < I_B1) {
            const int kc = r & 15, cg = (r >> 4) & 3, kv = r >> 6, n = cg * 64 + lane; const float* pe = kv ? F.pe_cv : F.pe_ck; const float* w1 = kv ? F.w_cv1 : F.w_ck1; float s = 0.f;
#ifdef B1_UNROLL
#pragma unroll B1_UNROLL
#else
#pragma unroll 16
#endif
            for (int k = 128 * kc; k < 128 * kc + 128; ++k) s += pe[k] * w1[(size_t)k * 256 + n];
            ((float*)(F.ws + WS_BIAS1))[(kc * 2 + kv) * 256 + n] = s; continue; } r -= I_B1;
        if (r < I_Z) {
            for (int q = lane; q < 16 * 256; q += 64) *(GAS u32x4_t*)(WinT + (size_t)(11824 + r * 16) * 2048 + q * 8) = (u32x4_t){0u, 0u, 0u, 0u};
            continue; } r -= I_Z;
        if (r < I_IN) { p0_transpose_item<true>(F.w_in, 2048, NIN, WinT, 2048, 0, scr, r, lane); continue; } r -= I_IN;
        if (r < I_BR) { p0_transpose_item<false>(F.w_br_a, 1024, 2048, WbrT, 2048, 0, scr, r, lane); continue; } r -= I_BR;
        if (r < I_BR) { p0_transpose_item<false>(F.w_br_b, 1024, 2048, WbrT, 2048, 1024, scr, r, lane); continue; } r -= I_BR;
        if (r < I_OUT) { p0_transpose_item<false>(F.w_out, 2048, 2048, WoutT, 2048, 0, scr, r, lane); continue; } r -= I_OUT;
#ifdef BIAS_FUSED
        if (r < I_C1) { p0_transpose_item<false, true>(F.w_ck1, 2048, 256, W1T, 2048, 0, scr, r, lane, F.pe_ck, (float*)(F.ws + WS_BIAS1)); continue; } r -= I_C1;
        if (r < I_C1) { p0_transpose_item<false, true>(F.w_cv1, 2048, 256, W1T + 256 * 2048, 2048, 0, scr, r, lane, F.pe_cv, (float*)(F.ws + WS_BIAS1) + 256); continue; } r -= I_C1;
#else
        if (r < I_C1) { p0_transpose_item<false>(F.w_ck1, 2048, 256, W1T, 2048, 0, scr, r, lane); continue; } r -= I_C1;
        if (r < I_C1) { p0_transpose_item<false>(F.w_cv1, 2048, 256, W1T + 256 * 2048, 2048, 0, scr, r, lane); continue; } r -= I_C1;
#endif
        if (r < I_C2) { p0_transpose_item<false>(F.w_ck2, 256, 64, W2T, 256, 0, scr, r, lane); continue; } r -= I_C2;
        if (r < I_C2) { p0_transpose_item<false>(F.w_cv2, 256, 64, W2T + 64 * 256, 256, 0, scr, r, lane); continue; } r -= I_C2;
#else
        if (r < I_IN) { p0_transpose_item<true>(F.w_in, 2048, NIN, WinT, 2048, 0, scr, r, lane); continue; } r -= I_IN;
        if (r < I_BR) { p0_transpose_item<false>(F.w_br_a, 1024, 2048, WbrT, 2048, 0, scr, r, lane); continue; } r -= I_BR;
        if (r < I_BR) { p0_transpose_item<false>(F.w_br_b, 1024, 2048, WbrT, 2048, 1024, scr, r, lane); continue; } r -= I_BR;
        if (r < I_OUT) { p0_transpose_item<false>(F.w_out, 2048, 2048, WoutT, 2048, 0, scr, r, lane); continue; } r -= I_OUT;
#ifdef BIAS_FUSED
        if (r < I_C1) { p0_transpose_item<false, true>(F.w_ck1, 2048, 256, W1T, 2048, 0, scr, r, lane, F.pe_ck, (float*)(F.ws + WS_BIAS1)); continue; } r -= I_C1;
        if (r < I_C1) { p0_transpose_item<false, true>(F.w_cv1, 2048, 256, W1T + 256 * 2048, 2048, 0, scr, r, lane, F.pe_cv, (float*)(F.ws + WS_BIAS1) + 256); continue; } r -= I_C1;
#else
        if (r < I_C1) { p0_transpose_item<false>(F.w_ck1, 2048, 256, W1T, 2048, 0, scr, r, lane); continue; } r -= I_C1;
        if (r < I_C1) { p0_transpose_item<false>(F.w_cv1, 2048, 256, W1T + 256 * 2048, 2048, 0, scr, r, lane); continue; } r -= I_C1;
#endif
        if (r < I_C2) { p0_transpose_item<false>(F.w_ck2, 256, 64, W2T, 256, 0, scr, r, lane); continue; } r -= I_C2;
        if (r < I_C2) { p0_transpose_item<false>(F.w_cv2, 256, 64, W2T + 64 * 256, 256, 0, scr, r, lane); continue; } r -= I_C2;
        if (r < I_ROPE) {
            const int m = r * 64 + lane; const float pf = (float)F.pos[m];
#if defined(FAST_ROPE) && defined(ROPE_COAL)
            { const float pfl = pf; const int m0 = r * 64;
              float* t64 = (float*)(F.ws + WS_R64) + (size_t)m0 * 16; float* t128 = (float*)(F.ws + WS_R128) + (size_t)m0 * 32;
              { const int idx = lane & 15; const float inv = exp2f(-(float)(2 * (idx & 7)) * (18.931568569324174f / 16.f)); const bool sn = idx >= 8;
                for (int j = 0; j < 16; ++j) { const float p = __shfl(pfl, (lane >> 4) + 4 * j); const float rev = __builtin_amdgcn_fractf(p * inv * 0.15915494309189535f);
                    const float cv = __builtin_amdgcn_cosf(rev), sv = __builtin_amdgcn_sinf(rev); t64[lane + 64 * j] = sn ? sv : cv; } }
              { const int idx = lane & 31; const float inv = exp2f(-(float)(2 * (idx & 15)) * (18.931568569324174f / 32.f)); const bool sn = idx >= 16;
                for (int j = 0; j < 32; ++j) { const float p = __shfl(pfl, (lane >> 5) + 2 * j); const float rev = __builtin_amdgcn_fractf(p * inv * 0.15915494309189535f);
                    const float cv = __builtin_amdgcn_cosf(rev), sv = __builtin_amdgcn_sinf(rev); t128[lane + 64 * j] = sn ? sv : cv; } } }
#elif defined(FAST_ROPE)
            const float myinv = (lane < 8) ? exp2f(-(float)(2 * lane) * (18.931568569324174f / 16.f)) : exp2f(-(float)(2 * ((lane - 8) & 15)) * (18.931568569324174f / 32.f));
            float* t64 = (float*)(F.ws + WS_R64) + (size_t)m * 16; float* t128 = (float*)(F.ws + WS_R128) + (size_t)m * 32;
            for (int i = 0; i < 8; ++i) { const float inv = __shfl(myinv, i); const float rev = __builtin_amdgcn_fractf(pf * inv * 0.15915494309189535f); t64[i] = __builtin_amdgcn_cosf(rev); t64[8 + i] = __builtin_amdgcn_sinf(rev); }
            for (int i = 0; i < 16; ++i) { const float inv = __shfl(myinv, 8 + i); const float rev = __builtin_amdgcn_fractf(pf * inv * 0.15915494309189535f); t128[i] = __builtin_amdgcn_cosf(rev); t128[16 + i] = __builtin_amdgcn_sinf(rev); }
#else
            const float myinv = (lane < 8) ? (float)pow(500000.0, -(double)(2 * lane) / 16.0) : (float)pow(500000.0, -(double)(2 * ((lane - 8) & 15)) / 32.0);
            float* t64 = (float*)(F.ws + WS_R64) + (size_t)m * 16; float* t128 = (float*)(F.ws + WS_R128) + (size_t)m * 32;
            for (int i = 0; i < 8; ++i) { const float inv = __shfl(myinv, i); const float ang = pf * inv; t64[i] = cosf(ang); t64[8 + i] = sinf(ang); }
            for (int i = 0; i < 16; ++i) { const float inv = __shfl(myinv, 8 + i); const float ang = pf * inv; t128[i] = cosf(ang); t128[16 + i] = sinf(ang); }
#endif
            continue; } r -= I_ROPE;
        if (r < I_B1) {
            const int kc = r & 15, cg = (r >> 4) & 3, kv = r >> 6, n = cg * 64 + lane; const float* pe = kv ? F.pe_cv : F.pe_ck; const float* w1 = kv ? F.w_cv1 : F.w_ck1; float s = 0.f;
#ifdef B1_UNROLL
#pragma unroll B1_UNROLL
#else
#pragma unroll 16
#endif
            for (int k = 128 * kc; k < 128 * kc + 128; ++k) s += pe[k] * w1[(size_t)k * 256 + n];
            ((float*)(F.ws + WS_BIAS1))[(kc * 2 + kv) * 256 + n] = s; continue; } r -= I_B1;
        {
            for (int q = lane; q < 16 * 256; q += 64) *(GAS u32x4_t*)(WinT + (size_t)(11824 + r * 16) * 2048 + q * 8) = (u32x4_t){0u, 0u, 0u, 0u};
        }
#endif
    }
}
__device__ __forceinline__ void p0_xn(Frame& F) {
    int tid_ = threadIdx.x; asm volatile("" : "+v"(tid_)); const int lane = tid_ & 63;
    const int gw = F.vcu * 8 + F.wave, NGW = F.G * 8;
    const float* ada = (const float*)(F.ws + WS_ADA); bf16_t* XN = (bf16_t*)(F.ws + WS_XN);
    for (int m = gw; m < MTOK; m += NGW) {
        const int b = m >> 11; const f32x4_t* xr = (const f32x4_t*)(F.x + (size_t)m * DM) + lane;
        f32x4_t v[8]; float s = 0.f;
#pragma unroll
        for (int j = 0; j < 8; ++j) { v[j] = xr[64 * j]; s += (v[j][0] * v[j][0] + v[j][1] * v[j][1]) + (v[j][2] * v[j][2] + v[j][3] * v[j][3]); }
        const float rstd = rsqrtf(wave_sum(s) * (1.f / DM) + 1e-6f);
        u32x2_t* o8 = (u32x2_t*)(XN + (size_t)m * DM) + lane;
#pragma unroll
        for (int j = 0; j < 8; ++j) { const int k = 256 * j + 4 * lane;
            const f32x4_t g = *(const f32x4_t*)(F.g_pre + k), sc = *(const f32x4_t*)(ada + b * 6144 + 2048 + k), sh = *(const f32x4_t*)(ada + b * 6144 + k);
            const f32x4_t y = (v[j] * rstd * g) * (sc + 1.f) + sh;
            u32x2_t w; w.x = pk2(y[0], y[1]); w.y = pk2(y[2], y[3]); o8[64 * j] = w; }
    }
}
typedef short cbf16x8 __attribute__((ext_vector_type(8)));
typedef float cf32x16 __attribute__((ext_vector_type(16)));
__device__ __forceinline__ void compress_unit(Frame& F, int unit) {
    const int kv = unit >> 5, b = (unit >> 2) & 7, g = unit & 3;
    int tid = threadIdx.x; asm volatile("" : "+v"(tid));
    const int lane = tid & 63, r32 = lane & 31, hi = lane >> 5, wid = F.wave;
    const bf16_t* src = (const bf16_t*)(F.ws + WS_KC + (size_t)kv * 8 * MiB) + (size_t)b * SEQ * 256 + g * 64;
    const bf16_t* W1T = (const bf16_t*)(F.ws + WS_W1T) + (size_t)kv * 256 * 2048;
    const bf16_t* W2T = (const bf16_t*)(F.ws + WS_W2T) + (size_t)kv * 64 * 256;
    const float* bias1p = (const float*)(F.ws + WS_BIAS1) + kv * 256;
    bf16_t* dst = (bf16_t*)(F.ws + (kv ? WS_VCC : WS_KCC)) + (size_t)(b * 4 + g) * 128 * 64;
    LAS bf16_t* HID = (LAS bf16_t*)F.lds;
    constexpr int WSLOT = 32768, AOFF = 3 * WSLOT, ASLOT = 8 * 129 * 16;
    const unsigned lds0 = (unsigned)(size_t)F.lds;
    const bf16_t* wp = W1T + (size_t)(tid & 255) * 2048 + (tid >> 8) * 8;
    auto dma_w = [&](int l, int slot) {
#pragma unroll
        for (int j = 0; j < 4; ++j) att::glds16(wp + l * 64 + j * 16, (unsigned)__builtin_amdgcn_readfirstlane(lds0 + slot * WSLOT + (j * 512 + wid * 64) * 16)); };
    auto dma_a = [&](int l, int slot) {
#pragma unroll
        for (int j = 0; j < 2; ++j) { const int p = j * 512 + tid, kc = p >> 7, row = p & 127;
            att::glds16(src + (size_t)(16 * row + l) * 256 + kc * 8, (unsigned)__builtin_amdgcn_readfirstlane(lds0 + AOFF + slot * ASLOT + ((j * 4 + (wid >> 1)) * 129 + (wid & 1) * 64) * 16)); } };
    cf32x16 acc[4] = {cf32x16{}, cf32x16{}, cf32x16{}, cf32x16{}};
    dma_a(0, 0); dma_w(0, 0); dma_w(16, 1); att::wait_vm_bar<4>();
    int sc = 0;
#pragma unroll 1
    for (int it = 0; it < 16; ++it) {
#pragma unroll
        for (int hf = 0; hf < 2; ++hf) {
            const int s2 = sc == 0 ? 2 : sc - 1;
            if (hf == 0) { if (it + 1 < 16) { dma_a(it + 1, (it + 1) & 1); dma_w(it + 1, s2); } }
            else if (it + 1 < 16) dma_w(it + 17, s2);
            const LAS unsigned char* ab = F.lds + AOFF + (it & 1) * ASLOT + hi * (129 * 16) + (r32 + hf) * 16;
            const LAS unsigned char* wb = F.lds + sc * WSLOT + hi * 4096 + (32 * wid + r32) * 16;
#pragma unroll
            for (int ks = 0; ks < 4; ++ks) { const cbf16x8 bq = *(const LAS cbf16x8*)(wb + ks * 8192);
#pragma unroll
                for (int rq = 0; rq < 4; ++rq) { const cbf16x8 af = *(const LAS cbf16x8*)(ab + ks * (2 * 129 * 16) + rq * 512);
                    acc[rq] = __builtin_amdgcn_mfma_f32_32x32x16_bf16(af, bq, acc[rq], 0, 0, 0); } }
            if (it + 1 < 16) { if (hf == 0) att::wait_vm_bar<6>(); else att::wait_vm_bar<4>(); } else att::wait_vm_bar<0>();
            sc = sc == 2 ? 0 : sc + 1;
        }
    }
    {
        const int n = 32 * wid + r32; float bb = 0.f;
#pragma unroll
#ifdef BIAS_FUSED
        for (int q = 0; q < 32; ++q) bb += bias1p[q * 512 + n];
#else
        for (int q = 0; q < 16; ++q) bb += bias1p[q * 512 + n];
#endif
#pragma unroll
        for (int rq = 0; rq < 4; ++rq)
#pragma unroll
            for (int r = 0; r < 16; ++r) { const float xv = acc[rq][r] + bb;
                const float u = 0.7978845608028654f * (xv + 0.044715f * xv * xv * xv);
                const float th = 1.f - 2.f * __builtin_amdgcn_rcpf(1.f + __builtin_amdgcn_exp2f(2.f * LOG2E * u));
                const float gl = 0.5f * xv * (1.f + th);
                HID[(32 * rq + (r & 3) + 8 * (r >> 2) + 4 * hi) * 264 + n] = (bf16_t)f2bf(gl); }
    }
    __syncthreads();
    {
        const int mi = wid >> 1, nd = wid & 1;
        cf32x16 o = cf32x16{};
#pragma unroll
        for (int ks = 0; ks < 16; ++ks) {
            const cbf16x8 a = *(const LAS cbf16x8*)(HID + (32 * mi + r32) * 264 + 16 * ks + 8 * hi);
            const cbf16x8 bq = *(const cbf16x8*)(W2T + (size_t)(32 * nd + r32) * 256 + 16 * ks + 8 * hi);
            o = __builtin_amdgcn_mfma_f32_32x32x16_bf16(a, bq, o, 0, 0, 0);
        }
        const int d = 32 * nd + r32;
#pragma unroll
        for (int r = 0; r < 16; ++r) { const int c = 32 * mi + (r & 3) + 8 * (r >> 2) + 4 * hi; float v = o[r];
            if (kv == 0 && nd == 0) {
                int trow = 16 * c + 31; trow = trow > 2047 ? 2047 : trow;
                const float* tb = (const float*)(F.ws + WS_R64) + ((size_t)b * SEQ + trow) * 16;
                const float pr = __shfl_xor(v, 8); const float cs = tb[r32 & 7], sn = tb[8 + (r32 & 7)];
                const float rot = v * cs + (r32 < 8 ? -pr : pr) * sn;
                v = r32 < 16 ? rot : v; }
            dst[(size_t)c * 64 + d] = (c == 127) ? (bf16_t)0 : (bf16_t)f2bf(v); }
    }
    __syncthreads();
}
__device__ __forceinline__ void p6_final(Frame& F, bool local) {
    int tid_ = threadIdx.x; asm volatile("" : "+v"(tid_)); const int lane = tid_ & 63;
    const int bx_ = (int)blockIdx.x;
    const int gw = local ? 2048 * (bx_ & 7) + (bx_ >> 3) * 8 + F.wave : F.vcu * 8 + F.wave, NGW = local ? 256 : F.G * 8;
    const int mend = local ? 2048 * (bx_ & 7) + 2048 : MTOK;
    const float* ada = (const float*)(F.ws + WS_ADA); const float* ssq = (const float*)(F.ws + WS_SSQ); float* out = (float*)F.dout; const bf16_t* pre = (const bf16_t*)(F.ws + WS_XN);
#ifdef FINAL_HOIST
    if (local) {
        const int b = bx_ & 7; f32x4_t gg[8];
#pragma unroll
        for (int j = 0; j < 8; ++j) { const int k = 256 * j + 4 * lane; gg[j] = *(const f32x4_t*)(F.g_post + k) * *(const f32x4_t*)(ada + b * 6144 + 4096 + k); }
#ifdef FINAL_PF
#define FIN_LOAD(M, XV, PV, SV) { const f32x4_t* xr = (const f32x4_t*)(F.x + (size_t)(M) * DM) + lane; const u32x2_t* pr = (const u32x2_t*)(pre + (size_t)(M) * DM) + lane; \
            SV = ssq[(size_t)(M) * 32 + (lane & 31)]; \
            _Pragma("unroll") for (int j = 0; j < 8; ++j) { XV[j] = xr[64 * j]; PV[j] = pr[64 * j]; } }
#define FIN_PROC(M, XV, PV, SV) { const float s = wave_sum(lane < 32 ? SV : 0.f); const float rstd = rsqrtf(s * (1.f / DM) + 1e-6f); \
            f32x4_t* orow = (f32x4_t*)(out + (size_t)(M) * DM) + lane; \
            _Pragma("unroll") for (int j = 0; j < 8; ++j) { const f32x4_t o = {bflo(PV[j].x), bfhi(PV[j].x), bflo(PV[j].y), bfhi(PV[j].y)}; orow[64 * j] = XV[j] + gg[j] * (o * rstd); } }
        f32x4_t xa[8], xb[8]; u32x2_t pa[8], pb[8]; float sa = 0.f, sb = 0.f;
        int m = gw;
        FIN_LOAD(m, xa, pa, sa)
#pragma unroll 1
        for (;;) {
            const int m1 = m + 256; if (m1 < mend) FIN_LOAD(m1, xb, pb, sb)
            FIN_PROC(m, xa, pa, sa)
            if (m1 >= mend) break;
            const int m2 = m1 + 256; if (m2 < mend) FIN_LOAD(m2, xa, pa, sa)
            FIN_PROC(m1, xb, pb, sb)
            if (m2 >= mend) break;
            m = m2;
        }
#undef FIN_LOAD
#undef FIN_PROC
        return;
#else
#pragma unroll 1
        for (int m = gw; m < mend; m += 256) {
            float s = 0.f;
            for (int q = 0; q < 32; ++q) s += ssq[(size_t)m * 32 + q];
            const float rstd = rsqrtf(s * (1.f / DM) + 1e-6f);
            const f32x4_t* xr = (const f32x4_t*)(F.x + (size_t)m * DM) + lane; f32x4_t* orow = (f32x4_t*)(out + (size_t)m * DM) + lane; const u32x2_t* pr = (const u32x2_t*)(pre + (size_t)m * DM) + lane;
            f32x4_t xv[8]; u32x2_t pv[8];
#pragma unroll
            for (int j = 0; j < 8; ++j) { xv[j] = xr[64 * j]; pv[j] = pr[64 * j]; }
#pragma unroll
            for (int j = 0; j < 8; ++j) { const f32x4_t o = {bflo(pv[j].x), bfhi(pv[j].x), bflo(pv[j].y), bfhi(pv[j].y)}; orow[64 * j] = xv[j] + gg[j] * (o * rstd); }
        }
        return;
#endif
    }
#endif
    for (int m = gw; m < mend; m += NGW) {
        const int b = m >> 11; float s = 0.f;
#ifdef PRE_SSQ
        const f32x4_t* xr = (const f32x4_t*)(F.x + (size_t)m * DM) + lane; f32x4_t* orow = (f32x4_t*)(out + (size_t)m * DM) + lane; const u32x2_t* pr = (const u32x2_t*)(pre + (size_t)m * DM) + lane;
        f32x4_t xv[8]; u32x2_t pv[8];
#pragma unroll
        for (int j = 0; j < 8; ++j) pv[j] = pr[64 * j];
#pragma unroll
        for (int j = 0; j < 8; ++j) xv[j] = xr[64 * j];
#pragma unroll
        for (int j = 0; j < 8; ++j) { const float o0 = bflo(pv[j].x), o1 = bfhi(pv[j].x), o2 = bflo(pv[j].y), o3 = bfhi(pv[j].y); s += (o0 * o0 + o1 * o1) + (o2 * o2 + o3 * o3); }
        const float rstd = rsqrtf(wave_sum(s) * (1.f / DM) + 1e-6f);
#else
#ifdef SSQ_T
        for (int q = 0; q < 32; ++q) s += ssq[(size_t)q * MTOK + m];
#else
        for (int q = 0; q < 32; ++q) s += ssq[(size_t)m * 32 + q];
#endif
        const float rstd = rsqrtf(s * (1.f / DM) + 1e-6f);
        const f32x4_t* xr = (const f32x4_t*)(F.x + (size_t)m * DM) + lane; f32x4_t* orow = (f32x4_t*)(out + (size_t)m * DM) + lane; const u32x2_t* pr = (const u32x2_t*)(pre + (size_t)m * DM) + lane;
        f32x4_t xv[8]; u32x2_t pv[8];
#pragma unroll
        for (int j = 0; j < 8; ++j) { xv[j] = xr[64 * j]; pv[j] = pr[64 * j]; }
#endif
#pragma unroll
        for (int j = 0; j < 8; ++j) { const int k = 256 * j + 4 * lane;
            const f32x4_t gp = *(const f32x4_t*)(F.g_post + k), gt = *(const f32x4_t*)(ada + b * 6144 + 4096 + k);
            const f32x4_t o = {bflo(pv[j].x), bfhi(pv[j].x), bflo(pv[j].y), bfhi(pv[j].y)};
            orow[64 * j] = xv[j] + gt * (o * rstd * gp); }
    }
}
constexpr int LDS_BYTES = 147456;
constexpr int LDSCTL_OFF = 143360;
constexpr int CW_BAR = 4096, CW_PANEL = 16384, CW_CMP = 32768, CW_NSAQ = 33792, CW_G1A = 35008, CW_G1B = 35040, CW_CONV = 35072, CW_ADA = 35104, CW_MIXQ = 36864, CW_GRP = 40960;
constexpr int NPHASE = 8;
#ifndef REP_MIXU
#define REP_MIXU 0
#endif
#ifndef REP_UNIT_N
#define REP_UNIT_N 0
#define REP_UNIT_I 0
#define REP_PMODE 0
#endif
#ifndef PROBE_NOREMAP
#define PROBE_NOREMAP 0
#endif
struct Args { const void* in[17]; float* out; unsigned char* ws; int ph_lo, ph_hi; };

__device__ __forceinline__ void touch_lines(const unsigned char* base, size_t row_pitch_bytes, int nrows, int lines_per_row, int tid) {
    const int n = nrows * lines_per_row;
    for (int i = tid; i < n; i += 512) { const unsigned char* p = base + (size_t)(i / lines_per_row) * row_pitch_bytes + (size_t)(i % lines_per_row) * 128; unsigned t;
        asm volatile("global_load_dword %0, %1, off" : "=v"(t) : "v"(p) : "memory"); }
    asm volatile("s_waitcnt vmcnt(0)" ::: "memory");
}
__global__ void __launch_bounds__(512, 2) mk_fwd(Args args) {
    extern __shared__ __attribute__((aligned(16))) unsigned char lds_raw[];
    Frame F;
    F.lds = (LAS unsigned char*)lds_raw;
    F.tid = threadIdx.x; F.lane = F.tid & 63; F.wave = __builtin_amdgcn_readfirstlane(F.tid >> 6);
    F.G = gridDim.x; { const int bx = blockIdx.x; F.vcu = (F.G % 8 == 0) ? (bx % 8) * (F.G / 8) + bx / 8 : bx; }
    F.x = (const float*)args.in[0]; F.c = (const float*)args.in[1]; F.pos = (const int*)args.in[2]; F.w_ada = (const float*)args.in[3]; F.b_ada = (const float*)args.in[4];
    F.g_pre = (const float*)args.in[5]; F.g_post = (const float*)args.in[6]; F.w_in = (const float*)args.in[7]; F.pe_ck = (const float*)args.in[8]; F.pe_cv = (const float*)args.in[9];
    F.w_ck1 = (const float*)args.in[10]; F.w_ck2 = (const float*)args.in[11]; F.w_cv1 = (const float*)args.in[12]; F.w_cv2 = (const float*)args.in[13];
    F.w_br_a = (const float*)args.in[14]; F.w_br_b = (const float*)args.in[15]; F.w_out = (const float*)args.in[16];
    F.ws = args.ws; F.dout = (unsigned char*)args.out;
    unsigned char* ws = args.ws;
    { int t0 = threadIdx.x; asm volatile("" : "+v"(t0));
      for (int u = t0; u < (LDS_BYTES - LDSCTL_OFF) / 4; u += 512) ((LAS unsigned*)(F.lds + LDSCTL_OFF))[u] = 0u; }
    __syncthreads();
    const int lo = args.ph_lo, hi = args.ph_hi;
#if STAMP
    unsigned long long ts_[10]; int nts_ = 0;
#define TS() do { ts_[nts_ < 9 ? nts_ : 9] = __builtin_amdgcn_s_memrealtime(); ++nts_; } while (0)
    TS();
#else
#define TS() do {} while (0)
#endif
    const bool multi = (hi - lo) > 1;
    XcdBarrier bar; bar.bar = (unsigned*)(ws + WS_CTL) + CW_BAR; bar.x = 0; bar.st = nullptr;
    if (multi) bar = xcd_barrier_post((unsigned*)(ws + WS_CTL) + CW_BAR, (volatile LAS unsigned*)(F.lds + LDSCTL_OFF + 32));
#ifndef PH_MASK
#define PH_MASK 0xff
#endif
#define IN(k) (((PH_MASK >> (k)) & 1) && lo <= (k) && (k) < hi)
#ifndef REP_MASK
#define REP_MASK 0
#endif
#define REPS(k) for (int rep_ = 0; rep_ < 1 + ((REP_MASK >> (k)) & 1); ++rep_)
#define SEAM(k) do { if (IN(k) && IN((k) + 1)) xcd_barrier(bar); } while (0)
#ifdef LOCAL_SEAMS
    const bool locseam = (F.G == 256);
    GrpBarrier gbar; gbar.ctr = (unsigned*)(ws + WS_CTL) + CW_GRP + 64 * ((int)blockIdx.x & 7); gbar.tmo = (unsigned*)(ws + WS_CTL) + CW_BAR + XB_TMO; gbar.n = 32u; gbar.target = 0u;
#define SEAML(k) do { if (IN(k) && IN((k) + 1)) { if (locseam) grp_barrier(gbar); else xcd_barrier(bar); } } while (0)
#else
    const bool locseam = false;
#define SEAML(k) SEAM(k)
#endif

#ifdef ADA_CNT
    if (IN(0)) REPS(0) { p0_ada(F);
        asm volatile("s_waitcnt vmcnt(0)" ::: "memory"); __syncthreads();
        if (threadIdx.x == 0) { __builtin_amdgcn_fence(__ATOMIC_RELEASE, "agent"); (void)xb_add((unsigned*)(ws + WS_CTL) + CW_ADA, 1u); __builtin_amdgcn_s_waitcnt(0); } }
    TS();
    if (IN(1)) REPS(1) { p0_items<1>(F, F.vcu, F.G);
        if (threadIdx.x == 0) { unsigned* cw = (unsigned*)(ws + WS_CTL) + CW_ADA; while (xb_ld(cw) < (unsigned)F.G) __builtin_amdgcn_s_sleep(4);
            __builtin_amdgcn_fence(__ATOMIC_ACQUIRE, "agent"); __builtin_amdgcn_s_waitcnt(0); }
        __syncthreads();
        p0_xn(F); }
#elif defined(LATE_CONV)
    if (IN(0)) REPS(0) { p0_ada(F); }
    SEAM(0); TS();
#ifdef ITEMS_FIRST
    if (IN(1)) REPS(1) { p0_items<1>(F, F.vcu, F.G); p0_xn(F); }
#else
    if (IN(1)) REPS(1) { p0_xn(F); p0_items<1>(F, F.vcu, F.G); }
#endif
#else
    if (IN(0)) REPS(0) { p0_ada(F); }
    SEAM(0); TS();
    if (IN(1)) REPS(1) { p0_xn(F); p0_items<0>(F, F.vcu, F.G); }
#endif
    SEAM(1); TS();
    if (IN(2)) REPS(2) {
        const int bx = (int)blockIdx.x, cs = (F.G == 256 && !PROBE_NOREMAP) ? (bx & 7) + 8 * ((((bx >> 3) & 7) << 2) + (bx >> 6)) : bx;
#ifdef FREE_CU
        const int GG = (F.G == 256) ? FREE_CU : F.G;
#else
        const int GG = F.G;
#endif
        pg8::Gemm g{(const bf16_t*)(ws + WS_XN), (const bf16_t*)(ws + WS_WINT), MTOK, NINP, 2048}; pg8::ProjOrder S; S.init(MTOK, NINP, GG, cs);
        pg8::EpiProj E{ws, F.dout, (const float*)(ws + WS_R64), (const float*)(ws + WS_R128)};
        const int nf = (cs < GG) ? S.count_first() : 0;
#pragma unroll 1
        for (int part = 0; part < 2; ++part) {
            S.i0 = part ? nf : 0; S.i1 = part ? (1 << 30) : nf;
#ifdef G1_NOALIGN
            if (cs < GG) pg8::gemm_phase<pg8::EpiProj, pg8::ProjOrder, false, true>(F.lds, g, S, E);
#else
            if (cs < GG) pg8::gemm_phase<pg8::EpiProj, pg8::ProjOrder, true, true>(F.lds, g, S, E);
#endif
            if (part == 0) { asm volatile("s_waitcnt vmcnt(0)" ::: "memory"); __syncthreads();
                if (threadIdx.x == 0) { __builtin_amdgcn_fence(__ATOMIC_RELEASE, "agent"); (void)xb_add((unsigned*)(ws + WS_CTL) + CW_G1A, (unsigned)nf); __builtin_amdgcn_s_waitcnt(0); } }
        }
        asm volatile("s_waitcnt vmcnt(0)" ::: "memory"); __syncthreads();
        if (threadIdx.x == 0) { __builtin_amdgcn_fence(__ATOMIC_RELEASE, "agent"); (void)xb_add((unsigned*)(ws + WS_CTL) + CW_G1B, 1u); __builtin_amdgcn_s_waitcnt(0); }
#ifdef LATE_CONV
#ifdef FREE_CU
        if (F.G == 256) { if (cs >= GG) p0_items<2>(F, (bx & 7) * ((256 - FREE_CU) >> 3) + ((cs - GG) >> 3), 256 - FREE_CU); }
#else
        if (F.G == 256) { if (cs >= 192) { p0_items<2>(F, (bx & 7) * 8 + ((cs >> 3) - 24), 64);
                asm volatile("s_waitcnt vmcnt(0)" ::: "memory"); __syncthreads();
                if (threadIdx.x == 0) { __builtin_amdgcn_fence(__ATOMIC_RELEASE, "agent"); (void)xb_add((unsigned*)(ws + WS_CTL) + CW_CONV, 1u); __builtin_amdgcn_s_waitcnt(0); } } }
#endif
        else p0_items<2>(F, F.vcu, F.G);
#endif
    }
#ifdef KEEP_SEAM2
    SEAM(2);
#endif
    TS();
    if (IN(3)) REPS(3) {
        att::MixPtrs MP{ws};
        if (threadIdx.x == 0) { unsigned* cw = (unsigned*)(ws + WS_CTL) + CW_G1A; while (xb_ld(cw) < (unsigned)(pg8::ProjOrder::NFIRST * (MTOK / 256))) __builtin_amdgcn_s_sleep(8);
            __builtin_amdgcn_fence(__ATOMIC_ACQUIRE, "agent"); }
        __syncthreads();
        for (int v = F.vcu; v < 256; v += F.G) {
            const int j = v & 7, bh = 2 * (v >> 3) + (j & 1), b_ = bh >> 3, h_ = bh & 7;
#ifdef USE_WARM
            { const size_t off = ((size_t)b_ * SEQ + 512 * (j >> 1)) * 2048 + h_ * 256;
              touch_lines(ws + WS_KB + off, 2048, 512, 2, F.tid); touch_lines(ws + WS_VB + off, 2048, 512, 2, F.tid); }
#endif
#ifndef REP_CMP
#define REP_CMP 0
#endif
#ifdef FREE_CU
            const int ncmp = (F.G == 256) ? (j == 7 ? 2 : 0) : (j < 2 ? 1 : 0);
#else
            const int ncmp = j < 2 ? 1 : 0;
#endif
#pragma unroll 1
            for (int cu = 0; cu < ncmp; ++cu) { compress_unit(F, (v >> 3) * 2 + (ncmp == 2 ? cu : j));
                asm volatile("s_waitcnt vmcnt(0)" ::: "memory"); __syncthreads();
                if (threadIdx.x == 0) { __builtin_amdgcn_fence(__ATOMIC_RELEASE, "agent"); (void)xb_add((unsigned*)(ws + WS_CTL) + CW_CMP, 1u); } }
#ifndef NO_MIX
#ifdef MIX_QUEUE
            {
                unsigned* qc = (unsigned*)(ws + WS_CTL) + CW_MIXQ + 32 * (v >> 3); volatile LAS unsigned* qn = (volatile LAS unsigned*)(F.lds + LDSCTL_OFF + 80);
                if (threadIdx.x == 0) qn[0] = xb_add(qc, 1u);
                __syncthreads();
                unsigned k = qn[0];
#pragma unroll 1
                for (int par = 1; k < 16u; par ^= 1) {
                    if (threadIdx.x == 0) qn[par] = xb_add(qc, 1u);
                    const int bh2 = 2 * (v >> 3) + (int)(k & 1u);
                    att::mixb_unit(MP, bh2 >> 3, bh2 & 7, 7 - (int)(k >> 1), F.lds);
                    __syncthreads();
                    k = qn[par];
                }
            }
#else
            const int alist = j < 2 ? 0x4 : j < 4 ? 0x16 : j < 6 ? 0x25 : 0x037, na = j < 2 ? 1 : j < 6 ? 2 : 3;
#pragma unroll 1
            for (int i = 0; i < na + REP_MIXU; ++i) att::mixb_unit(MP, b_, h_, i < na ? ((alist >> (4 * i)) & 15) : 0, F.lds);
#endif
#endif
        }
    }
    TS();
    if (IN(4)) REPS(4) {
        att::NsaPtrs NP{ws};
        asm volatile("s_waitcnt vmcnt(0)" ::: "memory");
        if (threadIdx.x == 0) { unsigned* cw = (unsigned*)(ws + WS_CTL) + CW_CMP; while (xb_ld(cw) < 64u) __builtin_amdgcn_s_sleep(8);
            cw = (unsigned*)(ws + WS_CTL) + CW_G1B; while (xb_ld(cw) < (unsigned)F.G) __builtin_amdgcn_s_sleep(8);
            __builtin_amdgcn_fence(__ATOMIC_ACQUIRE, "agent"); }
        __syncthreads();
        for (int v = F.vcu; v < 256; v += F.G) {
#ifdef USE_WARM
            { const int bg = v >> 3, s = v & 7; const size_t off = ((size_t)(bg >> 2) * SEQ + 256 * s) * 512 + (bg & 3) * 128;
#pragma unroll 1
              for (int t = 2; t < 6; ++t) touch_lines(ws + WS_KC + (size_t)t * 8 * MiB + off, 512, 256, 1, F.tid); }
#endif
#ifndef NO_NSA
#ifdef NSA_QUEUE
            {
#ifdef NSA_STEAL
                volatile LAS unsigned* qn = (volatile LAS unsigned*)(F.lds + LDSCTL_OFF + 64);
#pragma unroll 1
                for (int gs = 0; gs < 4; ++gs) {
                const int bg = ((v >> 3) & ~3) | (((v >> 3) + gs) & 3); unsigned* qc = (unsigned*)(ws + WS_CTL) + CW_NSAQ + 32 * bg;
                __syncthreads();
#else
                const int bg = v >> 3; unsigned* qc = (unsigned*)(ws + WS_CTL) + CW_NSAQ + 32 * bg; volatile LAS unsigned* qn = (volatile LAS unsigned*)(F.lds + LDSCTL_OFF + 64);
#endif
                if (threadIdx.x == 0) qn[0] = xb_add(qc, 1u);
                __syncthreads();
                unsigned k = qn[0];
#pragma unroll 1
                for (int par = 1; k < 32u; par ^= 1) {
                    if (threadIdx.x == 0) qn[par] = xb_add(qc, 1u);
                    att::nsa_unit(NP, bg >> 2, bg & 3, 31 - (int)k, F.lds
#if DBG
                        , (unsigned*)(ws + WS_DBG + 101 * MiB)
#endif
                        );
                    __syncthreads();
                    k = qn[par];
                }
#ifdef NSA_STEAL
                }
#endif
            }
#else
            { const int bg = v >> 3, s = v & 7;
#pragma unroll 1
              for (int i_ = 0; i_ < 4 + REP_UNIT_N; ++i_) { const int i = i_ < 4 ? i_ : REP_UNIT_I; const unsigned long long qtab = (i == 0) ? 0xcdb9beffdaull : (i == 1) ? 0xbd2b09ca38ull : (i == 2) ? 0x4ad4c6b90full : 0x21c66104a0ull;
                  const int qt = (int)((qtab >> (5 * s)) & 31ull); att::nsa_unit(NP, bg >> 2, bg & 3, qt, F.lds
#if DBG
                  , (unsigned*)(ws + WS_DBG + 101 * MiB)
#endif
                  ); } }
#endif
#endif
        }
    }
    SEAML(4); TS();
    if (IN(5)) REPS(5) {
#if defined(LATE_CONV) && defined(LOCAL_SEAMS)
        if (locseam) {
            if (threadIdx.x == 0) { unsigned* cw = (unsigned*)(ws + WS_CTL) + CW_CONV; while (xb_ld(cw) < 64u) __builtin_amdgcn_s_sleep(8);
                __builtin_amdgcn_fence(__ATOMIC_ACQUIRE, "agent"); __builtin_amdgcn_s_waitcnt(0); }
            __syncthreads();
        }
#endif
        pg8::Gemm g{(const bf16_t*)(ws + WS_A2), (const bf16_t*)(ws + WS_WBRT), MTOK, 2048, 2048}; pg8::StaticOrder S; S.init(MTOK, 2048, F.G, (int)blockIdx.x);
        pg8::EpiMerge E{(const bf16_t*)(F.dout + DO_MA), (const bf16_t*)(F.dout + DO_MB), (bf16_t*)(ws + WS_MERGED)};
        pg8::gemm_phase<pg8::EpiMerge, pg8::StaticOrder, true, true>(F.lds, g, S, E);
    }
    SEAML(5); TS();
    if (IN(6)) REPS(6) {
#ifndef PROBE_G3
#define PROBE_G3 F.G
#endif
        pg8::Gemm g{(const bf16_t*)(ws + WS_MERGED), (const bf16_t*)(ws + WS_WOUTT), MTOK, 2048, 2048}; pg8::StaticOrder S; S.init(MTOK, 2048, PROBE_G3, (int)blockIdx.x);
#ifndef FUSE_FINAL
        pg8::EpiOutB E{(bf16_t*)(ws + WS_XN), (float*)(ws + WS_SSQ)};
        if ((int)blockIdx.x < PROBE_G3) pg8::gemm_phase<pg8::EpiOutB, pg8::StaticOrder, true, true>(F.lds, g, S, E);
#else
        pg8::EpiFinal E{F.x, (float*)F.dout, (float*)(ws + WS_SSQ), (unsigned*)(ws + WS_CTL) + CW_PANEL, (const float*)(ws + WS_ADA), F.g_post};
        pg8::PanelOrder PO; PO.init(MTOK, 2048, F.G, F.vcu);
        if ((F.G & 7) == 0) pg8::gemm_phase<pg8::EpiFinal, pg8::PanelOrder, true, true>(F.lds, g, PO, E);
#endif
    }
#ifndef FUSE_FINAL
    SEAML(6);
#endif
    TS();
#ifndef FUSE_FINAL
#ifdef FINAL_HOIST
    if (IN(7)) { p6_final(F, F.G == 256); }
#else
    if (IN(7)) { p6_final(F, locseam); }
#endif
#endif
    TS();
#if STAMP
    if (F.vcu == 0 && F.tid == 0) { VM_WAIT(); args.out[0] = (float)(ts_[STAMP_B] - ts_[STAMP_A]); }
#endif
#undef IN
#undef SEAM
}

#if DBG
namespace dbg {
constexpr int BD = DBG_BATCH;
constexpr size_t E_PROJ = 0, E_KC = 48 * MiB, E_VC = 48 * MiB + 256 * 1024, E_SEL = 48 * MiB + 512 * 1024, E_AA = 50 * MiB, E_AB = 58 * MiB, E_MG = 66 * MiB, E_OF = 82 * MiB, E_ADA = 98 * MiB, DIAG = 100 * MiB, SELOUT = 101 * MiB;
__global__ void k_f2b(const float* __restrict__ s, bf16_t* __restrict__ d, size_t n) { for (size_t i = (size_t)blockIdx.x * 256 + threadIdx.x; i < n; i += (size_t)gridDim.x * 256) d[i] = (bf16_t)f2bf(s[i]); }
__global__ void k_copy(const float* __restrict__ s, float* __restrict__ d, size_t n) { for (size_t i = (size_t)blockIdx.x * 256 + threadIdx.x; i < n; i += (size_t)gridDim.x * 256) d[i] = s[i]; }
template <class T> __device__ __forceinline__ float tof(T v);
template <> __device__ __forceinline__ float tof<float>(float v) { return v; }
template <> __device__ __forceinline__ float tof<bf16_t>(bf16_t v) { return bf2f(v); }
template <class FT, class ET, int XF> __global__ void k_cmp(const FT* __restrict__ f, int ldf, const ET* __restrict__ e, int lde, int rows, int cols, float fscale, float* __restrict__ acc) {
    __shared__ float sh[8];
    float num = 0.f, den = 0.f;
    for (size_t i = (size_t)blockIdx.x * 256 + threadIdx.x; i < (size_t)rows * cols; i += (size_t)gridDim.x * 256) { const int r = (int)(i / cols), c = (int)(i % cols);
        const float vf = tof<FT>(f[(size_t)r * ldf + c]) * fscale; float ve = tof<ET>(e[(size_t)r * lde + c]);
        if (XF == 1) ve = ve / (1.f + expf(-ve)); if (XF == 2) ve = 1.f / (1.f + expf(-ve));
        num += (vf - ve) * (vf - ve); den += ve * ve; }
    for (int o = 32; o > 0; o >>= 1) { num += __shfl_xor(num, o); den += __shfl_xor(den, o); }
    if ((threadIdx.x & 63) == 0) { sh[threadIdx.x >> 6] = num; sh[4 + (threadIdx.x >> 6)] = den; }
    __syncthreads();
    if (threadIdx.x == 0) { atomicAdd(acc, sh[0] + sh[1] + sh[2] + sh[3]); atomicAdd(acc + 1, sh[4] + sh[5] + sh[6] + sh[7]); }
}
__global__ void k_cmp_sel(const unsigned* __restrict__ f, const unsigned* __restrict__ e, float* __restrict__ acc) {
    const int idx = blockIdx.x * 256 + threadIdx.x; if (idx >= 2048 * 4) return; const int s = idx >> 2;
    const unsigned valid = (s >> 6) == 31 ? 0xffffffffu : ((2u << (s >> 6)) - 1u);
    const bool bad = ((f[idx] ^ e[idx]) & valid) != 0u;
    atomicAdd(acc, bad ? 1.f : 0.f); if (threadIdx.x == 0 && blockIdx.x == 0) atomicAdd(acc + 1, 8192.f);
}
constexpr int NCHK = 24;
__global__ void k_report(const float* __restrict__ diag, float* __restrict__ out, int sel) {
    if (threadIdx.x != 0) return;
    if (sel == 0) { for (int k = 1; k < NCHK; ++k) { const float num = diag[2 * k], den = diag[2 * k + 1]; if (den == 0.f) continue;
            const float err = (k == 19) ? num / den : sqrtf(num / den);
            const float tol = k == 1 ? 1e-4f : (k == 17 || k == 18 || k == 21) ? 3e-2f : k == 19 ? 0.12f : (k == 20 || k == 22 || k == 23) ? 0.1f : 2e-2f;
            if (!(err <= tol)) { out[0] = (float)k * 1.0e4f; return; } }
        out[0] = 7.7e7f; }
    else { const float num = diag[2 * sel], den = diag[2 * sel + 1]; const float err = (sel == 19) ? num / den : sqrtf(num / den); out[0] = err * 1.0e6f; }
}
}
#endif

extern "C" void kernel_launch(void* const* d_in, const int* in_sizes, int n_in, void* d_out, int out_size, void* d_ws, size_t ws_size, hipStream_t stream) {
    static int grid = 0;
    if (grid == 0) {
        int dev = 0, cus = 0;
        if (hipGetDevice(&dev) != hipSuccess || hipDeviceGetAttribute(&cus, hipDeviceAttributeMultiprocessorCount, dev) != hipSuccess) { fprintf(stderr, "kernel_launch: device query failed\n"); grid = -1; return; }
        if (hipFuncSetAttribute((const void*)mk_fwd, hipFuncAttributeMaxDynamicSharedMemorySize, LDS_BYTES) != hipSuccess) { fprintf(stderr, "kernel_launch: hipFuncSetAttribute failed\n"); grid = -1; return; }
        int per_cu = 0;
        if (hipOccupancyMaxActiveBlocksPerMultiprocessor(&per_cu, (const void*)mk_fwd, 512, LDS_BYTES) != hipSuccess || per_cu < 1) fprintf(stderr, "kernel_launch: occupancy query reports %d\n", per_cu);
        (void)hipGetLastError();
        grid = cus;
    }
    if (grid < 0) return;
    if (ws_size < WS_END) { fprintf(stderr, "kernel_launch: workspace too small (%zu < %zu bytes)\n", ws_size, (size_t)WS_END); return; }
    unsigned char* ws = (unsigned char*)d_ws;
#if DBG
    {
        ref::In I;
        I.x = (const float*)d_in[0]; I.c = (const float*)d_in[1]; I.pos = (const int*)d_in[2]; I.w_ada = (const float*)d_in[3]; I.b_ada = (const float*)d_in[4];
        I.g_pre = (const float*)d_in[5]; I.g_post = (const float*)d_in[6]; I.w_in = (const float*)d_in[7]; I.pe_ck = (const float*)d_in[8]; I.pe_cv = (const float*)d_in[9];
        I.w_ck1 = (const float*)d_in[10]; I.w_ck2 = (const float*)d_in[11]; I.w_cv1 = (const float*)d_in[12]; I.w_cv2 = (const float*)d_in[13];
        I.w_br_a = (const float*)d_in[14]; I.w_br_b = (const float*)d_in[15]; I.w_out = (const float*)d_in[16];
        ref::Bufs B = ref::carve((char*)d_ws);
        ref::run_ada(I, B, stream);
        ref::run_batch(I, B, dbg::BD, (float*)d_out, stream);
        unsigned char* E = ws + WS_DBG;
        dbg::k_f2b<<<2048, 256, 0, stream>>>(B.proj, (bf16_t*)(E + dbg::E_PROJ), (size_t)2048 * NIN);
        dbg::k_copy<<<64, 256, 0, stream>>>(B.kc, (float*)(E + dbg::E_KC), 512 * 64); dbg::k_copy<<<64, 256, 0, stream>>>(B.vc, (float*)(E + dbg::E_VC), 512 * 64);
        dbg::k_copy<<<32, 256, 0, stream>>>((const float*)B.selmask, (float*)(E + dbg::E_SEL), 2048 * 4);
        dbg::k_copy<<<1024, 256, 0, stream>>>(B.Aa, (float*)(E + dbg::E_AA), (size_t)2048 * 1024); dbg::k_copy<<<1024, 256, 0, stream>>>(B.Ab, (float*)(E + dbg::E_AB), (size_t)2048 * 1024);
        dbg::k_copy<<<1024, 256, 0, stream>>>(B.mg, (float*)(E + dbg::E_MG), (size_t)2048 * 2048); dbg::k_copy<<<1024, 256, 0, stream>>>(B.of, (float*)(E + dbg::E_OF), (size_t)2048 * 2048);
        dbg::k_copy<<<64, 256, 0, stream>>>(B.ada, (float*)(E + dbg::E_ADA), 8 * 6144);
        (void)hipMemsetAsync(E + dbg::DIAG, 0, 4096, stream);
    }
#endif
    if (hipMemsetAsync(ws + WS_CTL, 0, CTL_ZERO_BYTES, stream) != hipSuccess) { fprintf(stderr, "kernel_launch: memset failed\n"); return; }
    Args a{};
    for (int i = 0; i < 17; ++i) a.in[i] = d_in[i];
    a.out = (float*)d_out; a.ws = ws;
#if ONE_LAUNCH
    a.ph_lo = 0; a.ph_hi = NPHASE;
    { void* kargs[] = {&a}; const hipError_t e = hipLaunchCooperativeKernel((const void*)mk_fwd, dim3(grid), dim3(512), kargs, LDS_BYTES, stream);
      if (e != hipSuccess) fprintf(stderr, "kernel_launch: cooperative launch failed: %s (grid %d)\n", hipGetErrorString(e), grid); }
#else
    for (int p = 0; p < NPHASE && p <= DBG_STOP; ++p) { a.ph_lo = p; a.ph_hi = p + 1; hipLaunchKernelGGL(mk_fwd, dim3(grid), dim3(512), LDS_BYTES, stream, a); }
#endif
#if DBG
    {
        unsigned char* E = ws + WS_DBG; float* diag = (float*)(E + dbg::DIAG); const bf16_t* EP = (const bf16_t*)(E + dbg::E_PROJ);
        const size_t r0 = (size_t)dbg::BD * 2048;
#define CMPB(id, fastptr, ldf, ecol, cols, XF, fs) dbg::k_cmp<bf16_t, bf16_t, XF><<<512, 256, 0, stream>>>((const bf16_t*)(fastptr) + r0 * (ldf), ldf, EP + (ecol), NIN, 2048, cols, fs, diag + 2 * (id))
        dbg::k_cmp<float, float, 0><<<64, 256, 0, stream>>>((const float*)(ws + WS_ADA), 6144, (const float*)(E + dbg::E_ADA), 6144, 8, 6144, 1.f, diag + 2 * 1);
        CMPB(2, ws + WS_QA, 1024, ref::C_QA, 1024, 0, 1.f / QS64);
        CMPB(3, ws + WS_KC + 0 * 8 * MiB, 256, ref::C_KC, 256, 0, 1.f); CMPB(4, ws + WS_KC + 1 * 8 * MiB, 256, ref::C_VC, 256, 0, 1.f); CMPB(5, ws + WS_KC + 2 * 8 * MiB, 256, ref::C_KS, 256, 0, 1.f);
        CMPB(6, ws + WS_KC + 3 * 8 * MiB, 256, ref::C_VS, 256, 0, 1.f); CMPB(7, ws + WS_KC + 4 * 8 * MiB, 256, ref::C_KW, 256, 0, 1.f); CMPB(8, ws + WS_KC + 5 * 8 * MiB, 256, ref::C_VW, 256, 0, 1.f);
        CMPB(9, ws + WS_ZA, 1024, ref::C_ZA, 1024, 1, 1.f);
        if (DBG_STOP < 5) { CMPB(10, ws + WS_QB, 1024, ref::C_QB, 1024, 0, 1.f / QS128); CMPB(11, ws + WS_KB, 1024, ref::C_KB, 1024, 0, 1.f); }
        if (DBG_STOP < 6) { CMPB(14, (unsigned char*)d_out + DO_MA, 2048, ref::C_MA, 2048, 2, 1.f); CMPB(15, (unsigned char*)d_out + DO_MB, 2048, ref::C_MB, 2048, 2, 1.f); }
        if (DBG_STOP == 6) dbg::k_cmp<float, float, 0><<<512, 256, 0, stream>>>((const float*)d_out + r0 * 2048, 2048, (const float*)(E + dbg::E_OF), 2048, 2048, 2048, 1.f, diag + 2 * 23);
        CMPB(12, ws + WS_VB, 1024, ref::C_VB, 1024, 0, 1.f); CMPB(13, ws + WS_ZB, 1024, ref::C_ZB, 1024, 1, 1.f);
        CMPB(16, ws + WS_GA, 64, ref::C_GA, 48, 2, 1.f);
        if (DBG_STOP >= 3) {
        dbg::k_cmp<bf16_t, float, 0><<<64, 256, 0, stream>>>((const bf16_t*)(ws + WS_KCC) + (size_t)dbg::BD * 512 * 64, 64, (const float*)(E + dbg::E_KC), 64, 512, 64, 1.f, diag + 2 * 17);
        dbg::k_cmp<bf16_t, float, 0><<<64, 256, 0, stream>>>((const bf16_t*)(ws + WS_VCC) + (size_t)dbg::BD * 512 * 64, 64, (const float*)(E + dbg::E_VC), 64, 512, 64, 1.f, diag + 2 * 18); }
        if (DBG_STOP >= 4) {
        dbg::k_cmp_sel<<<32, 256, 0, stream>>>((const unsigned*)(E + dbg::SELOUT) + r0 * 4, (const unsigned*)(E + dbg::E_SEL), diag + 2 * 19);
        dbg::k_cmp<bf16_t, float, 0><<<512, 256, 0, stream>>>((const bf16_t*)(ws + WS_A2) + r0 * 2048, 2048, (const float*)(E + dbg::E_AA), 1024, 2048, 1024, 1.f, diag + 2 * 20);
        dbg::k_cmp<bf16_t, float, 0><<<512, 256, 0, stream>>>((const bf16_t*)(ws + WS_A2) + r0 * 2048 + 1024, 2048, (const float*)(E + dbg::E_AB), 1024, 2048, 1024, 1.f, diag + 2 * 21); }
        if (DBG_STOP >= 5)
        dbg::k_cmp<bf16_t, float, 0><<<512, 256, 0, stream>>>((const bf16_t*)(ws + WS_MERGED) + r0 * 2048, 2048, (const float*)(E + dbg::E_MG), 2048, 2048, 2048, 1.f, diag + 2 * 22);
#undef CMPB
        dbg::k_report<<<1, 64, 0, stream>>>(diag, (float*)d_out, DBG_SEL);
    }
#endif
}
```
